# Optimizing an MI355X kernel written in HIP

```python
import jax, jax.numpy as jnp
from jax import lax
import numpy as np

D_MODEL = 1024
BATCH = 8
SEQ = 2048
DEPTH = 2

GRID_W = 64
CTX_LEN = 256
HEAD_DIM = 64
NA_HEADS = D_MODEL // 4 // HEAD_DIM
NA_WIN_R = 8
NA_WIN_C = 16
GQA_HEADS = D_MODEL // 2 // HEAD_DIM
GQA_KV_HEADS = GQA_HEADS // 4
GQA_BLOCK = 128
ROPE_THETA = 10000.0
HGRN_HEADS = D_MODEL // 4 // HEAD_DIM
HGRN_DK = HEAD_DIM
HGRN_DV = HEAD_DIM
HGRN_CHUNK = 16
N_GROUPS = 4
EXPERTS_PER_GROUP = 8
N_EXPERTS = N_GROUPS * EXPERTS_PER_GROUP
EXPERT_TOP_K = 2
EXPERT_FF = D_MODEL // 4
N_MOD = 6
EPS = 1e-6
NEG_INF = -1e30
LB_FLOOR = 1e-20

NA_W = NA_HEADS * HEAD_DIM
GQA_QW = GQA_HEADS * HEAD_DIM
GQA_KW = GQA_KV_HEADS * HEAD_DIM
HG_KW = HGRN_HEADS * HGRN_DK
HG_VW = HGRN_HEADS * HGRN_DV
D_MIX = NA_W + GQA_QW + HG_VW
IN_SPLIT_SIZES = (NA_W, NA_W, NA_W, GQA_QW, GQA_KW, GQA_KW, HG_KW, HG_VW, HG_KW, HG_KW, HG_VW)
D_IN = sum(IN_SPLIT_SIZES)

kernel_name = 'hybrid_na_gqa_hgrn2_hmoe_block'


def rms_norm(x, gain):
    xf = x.astype(jnp.float32)
    y = xf * lax.rsqrt(jnp.mean(xf * xf, axis=-1, keepdims=True) + EPS)
    return (y * gain.astype(jnp.float32)).astype(x.dtype)


def modulate(h, shift, scale):
    return h * (1 + scale) + shift


def to_heads(t, n):
    b, s, _ = t.shape
    return jnp.swapaxes(t.reshape(b, s, n, -1), 1, 2)


def from_heads(t):
    b, n, s, hd = t.shape
    return jnp.swapaxes(t, 1, 2).reshape(b, s, n * hd)


def split_cols(p):
    idx = np.cumsum(IN_SPLIT_SIZES)[:-1].tolist()
    return jnp.split(p, idx, axis=-1)


def axial_rope_tables(n_tokens):
    t = jnp.arange(n_tokens)
    row = (t // GRID_W).astype(jnp.float32)
    col = (t % GRID_W).astype(jnp.float32)
    half = HEAD_DIM // 2
    inv = ROPE_THETA ** (-jnp.arange(0, half, 2, dtype=jnp.float32) / half)
    ang = jnp.concatenate([row[:, None] * inv, col[:, None] * inv], axis=-1)
    return jnp.cos(ang), jnp.sin(ang)


def apply_rope(x, cos, sin):
    xf = x.astype(jnp.float32).reshape(*x.shape[:-1], HEAD_DIM // 2, 2)
    x1, x2 = xf[..., 0], xf[..., 1]
    out = jnp.stack([x1 * cos - x2 * sin, x1 * sin + x2 * cos], axis=-1)
    return out.reshape(x.shape).astype(x.dtype)


def softmax_attend(q, k, v):
    s = jnp.matmul(q, jnp.swapaxes(k, -1, -2)).astype(jnp.float32) * (q.shape[-1] ** -0.5)
    p = jax.nn.softmax(s, axis=-1).astype(v.dtype)
    return jnp.matmul(p, v)


def neighbourhood_attention(q, k, v, k_ctx, v_ctx, rpb):
    b, h, s, hd = q.shape
    rows = s // GRID_W
    wr = min(NA_WIN_R, rows)
    r = jnp.arange(rows)
    row_start = jnp.clip(r - wr // 2, 0, rows - wr)
    key_rows = row_start[:, None] + jnp.arange(wr)
    qg = q.reshape(b, h, rows, GRID_W, hd)
    kb = k.reshape(b, h, rows, GRID_W, hd)[:, :, key_rows].reshape(b, h, rows, wr * GRID_W, hd)
    vb = v.reshape(b, h, rows, GRID_W, hd)[:, :, key_rows].reshape(b, h, rows, wr * GRID_W, hd)
    cidx = jnp.arange(GRID_W)
    col_start = jnp.clip(cidx - NA_WIN_C // 2, 0, GRID_W - NA_WIN_C)
    col_ok = (cidx[None, :] >= col_start[:, None]) & (cidx[None, :] < col_start[:, None] + NA_WIN_C)
    dr = key_rows - r[:, None] + (NA_WIN_R - 1)
    dc = jnp.clip(cidx[None, :] - cidx[:, None] + (NA_WIN_C - 1), 0, 2 * NA_WIN_C - 2)
    bias = rpb.astype(jnp.float32)[:, dr[:, None, :, None], dc[None, :, None, :]]
    bias = jnp.where(col_ok[None, None, :, None, :], bias, NEG_INF).reshape(h, rows, GRID_W, wr * GRID_W)
    scale = hd ** -0.5
    s_nb = jnp.einsum('bhrqd,bhrkd->bhrqk', qg, kb).astype(jnp.float32) * scale + bias
    s_cx = jnp.einsum('bhrqd,bhld->bhrql', qg, k_ctx).astype(jnp.float32) * scale
    p = jax.nn.softmax(jnp.concatenate([s_nb, s_cx], axis=-1), axis=-1).astype(v.dtype)
    n_nb = wr * GRID_W
    out = (jnp.einsum('bhrqk,bhrkd->bhrqd', p[..., :n_nb], vb)
           + jnp.einsum('bhrql,bhld->bhrqd', p[..., n_nb:], v_ctx))
    return out.reshape(b, h, s, hd)


def gqa_block_sweep(q, k_all, v_all):
    b, hkv, g, s, hd = q.shape
    nb = s // GQA_BLOCK
    qb = jnp.moveaxis(q.reshape(b, hkv, g, nb, GQA_BLOCK, hd), 3, 0)
    ob = lax.map(lambda qi: softmax_attend(qi, k_all, v_all), qb)
    return jnp.moveaxis(ob, 0, 3).reshape(b, hkv, g, s, hd)


def hgrn_lower_bounds(lb_raw):
    p = jax.nn.softmax(lb_raw.astype(jnp.float32), axis=0)
    return jnp.cumsum(p, axis=0) - p[0]


def log_forget(z, lb):
    return jnp.logaddexp(jnp.log1p(-lb) + jax.nn.log_sigmoid(z), jnp.log(jnp.maximum(lb, LB_FLOOR)))


def hgrn2_chunkwise(q, k, v, logf, s0):
    b, h, t, dk = q.shape
    dv = v.shape[-1]
    c = HGRN_CHUNK
    n = t // c
    q, k, logf = (a.reshape(b, h, n, c, dk) for a in (q, k, logf))
    v = v.reshape(b, h, n, c, dv)
    cum = jnp.cumsum(logf, axis=3)
    lower = jnp.tril(jnp.ones((c, c), dtype=bool))[:, :, None]
    diff = cum[..., :, None, :] - cum[..., None, :, :]
    decay = jnp.where(lower, jnp.exp(jnp.where(lower, diff, 0.0)), 0.0)
    attn = jnp.einsum('bhntd,bhnsd,bhntsd->bhnts', q, k, decay)
    o_intra = jnp.einsum('bhnts,bhnsv->bhntv', attn, v)
    cum_last = cum[..., -1:, :]
    u = jnp.einsum('bhnsd,bhnsv->bhndv', k * jnp.exp(cum_last - cum), v)
    a = jnp.exp(cum_last[..., 0, :])

    def step(s, xs):
        a_n, u_n = xs
        return a_n[..., None] * s + u_n, s

    s_fin, s_enter = lax.scan(step, s0, (jnp.moveaxis(a, 2, 0), jnp.moveaxis(u, 2, 0)))
    s_enter = jnp.moveaxis(s_enter, 0, 2)
    o_inter = jnp.einsum('bhntd,bhndv->bhntv', q * jnp.exp(cum), s_enter)
    return (o_intra + o_inter).reshape(b, h, t, dv), s_fin


def hgrn2_final_state(k, v, logf):
    cum = jnp.cumsum(logf, axis=2)
    w = k * jnp.exp(cum[:, :, -1:, :] - cum)
    return jnp.einsum('bhtd,bhtv->bhdv', w, v)


def hgrn2_mixer(q, i, f_fwd, f_bwd, g, qc, ic, fc_fwd, fc_bwd, gc, lb, o_norm, ctx_out):
    dt = q.dtype
    nh = HGRN_HEADS
    bsz = q.shape[0]
    scale = HGRN_DK ** -0.5
    h32 = lambda t: to_heads(t, nh).astype(jnp.float32)
    rev = lambda t: t[:, :, ::-1]
    qh, vh = h32(q) * scale, h32(i)
    qch, vch = h32(qc) * scale, h32(ic)
    s_zero = jnp.zeros((bsz, nh, HGRN_DK, HGRN_DV), jnp.float32)
    o_lat, o_ctx = [], []
    for d, (f_l, f_c) in enumerate(((f_fwd, fc_fwd), (f_bwd, fc_bwd))):
        lbd = lb[d].reshape(nh, 1, HGRN_DK)
        logf = log_forget(h32(f_l), lbd)
        logfc = log_forget(h32(f_c), lbd)
        seq_l = (qh, -jnp.expm1(logf), vh, logf)
        seq_c = (qch, -jnp.expm1(logfc), vch, logfc)
        if d == 1:
            seq_l = tuple(rev(t) for t in seq_l)
            seq_c = tuple(rev(t) for t in seq_c)
        if ctx_out:
            oc, s_c = hgrn2_chunkwise(seq_c[0], seq_c[1], seq_c[2], seq_c[3], s_zero)
            o_ctx.append(rev(oc) if d == 1 else oc)
        else:
            s_c = hgrn2_final_state(seq_c[1], seq_c[2], seq_c[3])
        o, _ = hgrn2_chunkwise(seq_l[0], seq_l[1], seq_l[2], seq_l[3], s_c)
        o_lat.append(rev(o) if d == 1 else o)

    def readout(o_sum, gate):
        y = from_heads(rms_norm(o_sum, o_norm))
        return (y * jax.nn.silu(gate.astype(jnp.float32))).astype(dt)

    lat = readout(o_lat[0] + o_lat[1], g)
    ctx_o = readout(o_ctx[0] + o_ctx[1], gc) if ctx_out else None
    return lat, ctx_o


def token_mixers(h, hc, w_in, na_qn, na_kn, na_rpb, gq_qn, gq_kn, lb, hg_on, cos, sin, ctx_out):
    b, s, _ = h.shape
    L = hc.shape[1]
    grp = GQA_HEADS // GQA_KV_HEADS
    a_q, a_k, a_v, b_q, b_k, b_v, c_q, c_i, c_ff, c_fb, c_g = split_cols(h @ w_in)
    ac_q, ac_k, ac_v, bc_q, bc_k, bc_v, cc_q, cc_i, cc_ff, cc_fb, cc_g = split_cols(hc @ w_in)
    qa = rms_norm(to_heads(a_q, NA_HEADS), na_qn)
    ka = rms_norm(to_heads(a_k, NA_HEADS), na_kn)
    va = to_heads(a_v, NA_HEADS)
    kac = rms_norm(to_heads(ac_k, NA_HEADS), na_kn)
    vac = to_heads(ac_v, NA_HEADS)
    o_a = neighbourhood_attention(qa, ka, va, kac, vac, na_rpb)
    qb = apply_rope(rms_norm(to_heads(b_q, GQA_HEADS), gq_qn), cos, sin)
    kb = apply_rope(rms_norm(to_heads(b_k, GQA_KV_HEADS), gq_kn), cos, sin)
    vb = to_heads(b_v, GQA_KV_HEADS)
    kbc = rms_norm(to_heads(bc_k, GQA_KV_HEADS), gq_kn)
    vbc = to_heads(bc_v, GQA_KV_HEADS)
    k_all = jnp.concatenate([kb, kbc], axis=2)[:, :, None]
    v_all = jnp.concatenate([vb, vbc], axis=2)[:, :, None]
    o_b = gqa_block_sweep(qb.reshape(b, GQA_KV_HEADS, grp, s, HEAD_DIM), k_all, v_all)
    o_b = o_b.reshape(b, GQA_HEADS, s, HEAD_DIM)
    o_c, o_cc = hgrn2_mixer(c_q, c_i, c_ff, c_fb, c_g, cc_q, cc_i, cc_ff, cc_fb, cc_g, lb, hg_on, ctx_out)
    mix = jnp.concatenate([from_heads(o_a), from_heads(o_b), o_c], axis=-1)
    if not ctx_out:
        return mix, None
    qac = rms_norm(to_heads(ac_q, NA_HEADS), na_qn)
    o_ac = softmax_attend(qac, kac, vac)
    qbc = rms_norm(to_heads(bc_q, GQA_HEADS), gq_qn).reshape(b, GQA_KV_HEADS, grp, L, HEAD_DIM)
    o_bc = softmax_attend(qbc, kbc[:, :, None], vbc[:, :, None]).reshape(b, GQA_HEADS, L, HEAD_DIM)
    mix_c = jnp.concatenate([from_heads(o_ac), from_heads(o_bc), o_cc], axis=-1)
    return mix, mix_c


def hier_moe(t, w_rg, b_rg, w_re, b_re, w_gate, w_up, w_down):
    g_prob = jax.nn.softmax((t @ w_rg).astype(jnp.float32) + b_rg, axis=-1)
    g_top, g_idx = lax.top_k(g_prob, 1)
    e_logits = ((t @ w_re).astype(jnp.float32) + b_re).reshape(-1, N_GROUPS, EXPERTS_PER_GROUP)
    in_group = jnp.take_along_axis(e_logits, g_idx[:, :, None], axis=1)[:, 0]
    e_top, e_idx = lax.top_k(in_group, EXPERT_TOP_K)
    e_w = jax.nn.softmax(e_top, axis=-1) * g_top
    expert_id = g_idx * EXPERTS_PER_GROUP + e_idx
    combine = jnp.sum(jax.nn.one_hot(expert_id, N_EXPERTS, dtype=jnp.float32) * e_w[..., None], axis=1)
    combine = combine.reshape(-1, N_GROUPS, EXPERTS_PER_GROUP).astype(t.dtype)
    wg = w_gate.reshape(N_GROUPS, EXPERTS_PER_GROUP, D_MODEL, EXPERT_FF)
    wu = w_up.reshape(N_GROUPS, EXPERTS_PER_GROUP, D_MODEL, EXPERT_FF)
    wd = w_down.reshape(N_GROUPS, EXPERTS_PER_GROUP, EXPERT_FF, D_MODEL)
    out = jnp.zeros_like(t)
    for gi in range(N_GROUPS):
        hid = jax.nn.silu(jnp.einsum('td,edf->tef', t, wg[gi])) * jnp.einsum('td,edf->tef', t, wu[gi])
        out = out + jnp.einsum('tef,efd->td', hid * combine[:, gi, :, None], wd[gi])
    return out


def setup_inputs(seed: int = 0) -> dict:
    key = jax.random.key(seed)
    ks = jax.random.split(key, 32)
    nrm = lambda k, shape, sc: jax.random.normal(k, shape, jnp.float32) * sc
    D = D_MODEL
    return {
        'x': nrm(ks[0], (BATCH, SEQ, D), 1.0),
        'c': nrm(ks[1], (BATCH, D), 1.0),
        'ctx': nrm(ks[2], (BATCH, CTX_LEN, D), 1.0),
        'c_ctx': nrm(ks[3], (D,), 1.0),
        'w_ada': nrm(ks[4], (DEPTH, D, N_MOD * D), 0.5 * D ** -0.5),
        'b_ada': nrm(ks[5], (DEPTH, N_MOD * D), 0.02),
        'norm1_g': 1.0 + nrm(ks[6], (DEPTH, D), 0.02),
        'w_in': nrm(ks[7], (DEPTH, D, D_IN), D ** -0.5),
        'na_q_norm': 1.0 + nrm(ks[8], (DEPTH, HEAD_DIM), 0.02),
        'na_k_norm': 1.0 + nrm(ks[9], (DEPTH, HEAD_DIM), 0.02),
        'na_rpb': nrm(ks[10], (DEPTH, NA_HEADS, 2 * NA_WIN_R - 1, 2 * NA_WIN_C - 1), 0.5),
        'gqa_q_norm': 1.0 + nrm(ks[11], (DEPTH, HEAD_DIM), 0.02),
        'gqa_k_norm': 1.0 + nrm(ks[12], (DEPTH, HEAD_DIM), 0.02),
        'hgrn_lb': nrm(ks[13], (DEPTH, 2, HG_KW), 1.0),
        'hgrn_o_norm': 1.0 + nrm(ks[14], (DEPTH, HGRN_DV), 0.02),
        'w_out': nrm(ks[15], (DEPTH, D_MIX, D), D_MIX ** -0.5),
        'norm2_g': 1.0 + nrm(ks[16], (DEPTH, D), 0.02),
        'w_route_group': nrm(ks[17], (DEPTH, D, N_GROUPS), D ** -0.5),
        'b_route_group': nrm(ks[18], (DEPTH, N_GROUPS), 0.01),
        'w_route_expert': nrm(ks[19], (DEPTH, D, N_EXPERTS), D ** -0.5),
        'b_route_expert': nrm(ks[20], (DEPTH, N_EXPERTS), 0.01),
        'w_exp_gate': nrm(ks[21], (DEPTH, N_EXPERTS, D, EXPERT_FF), D ** -0.5),
        'w_exp_up': nrm(ks[22], (DEPTH, N_EXPERTS, D, EXPERT_FF), D ** -0.5),
        'w_exp_down': nrm(ks[23], (DEPTH, N_EXPERTS, EXPERT_FF, D), EXPERT_FF ** -0.5),
    }


def reference(x, c, ctx, c_ctx, w_ada, b_ada, norm1_g, w_in, na_q_norm, na_k_norm, na_rpb,
              gqa_q_norm, gqa_k_norm, hgrn_lb, hgrn_o_norm, w_out, norm2_g, w_route_group,
              b_route_group, w_route_expert, b_route_expert, w_exp_gate, w_exp_up, w_exp_down):
    b, s, d = x.shape
    L = ctx.shape[1]
    cos, sin = axial_rope_tables(s)
    lb_all = hgrn_lower_bounds(hgrn_lb)
    xc = ctx
    for layer in range(DEPTH):
        ctx_out = layer < DEPTH - 1
        mod = (jax.nn.silu(c) @ w_ada[layer] + b_ada[layer]).reshape(b, N_MOD, d)
        mod_c = (jax.nn.silu(c_ctx) @ w_ada[layer] + b_ada[layer]).reshape(N_MOD, d)
        h = modulate(rms_norm(x, norm1_g[layer]), mod[:, 0:1], mod[:, 1:2])
        hc = modulate(rms_norm(xc, norm1_g[layer]), mod_c[0], mod_c[1])
        mix, mix_c = token_mixers(h, hc, w_in[layer], na_q_norm[layer], na_k_norm[layer], na_rpb[layer],
                                  gqa_q_norm[layer], gqa_k_norm[layer], lb_all[layer], hgrn_o_norm[layer],
                                  cos, sin, ctx_out)
        x = x + mod[:, 2:3] * (mix @ w_out[layer])
        moe_args = (w_route_group[layer], b_route_group[layer], w_route_expert[layer],
                    b_route_expert[layer], w_exp_gate[layer], w_exp_up[layer], w_exp_down[layer])
        h2 = modulate(rms_norm(x, norm2_g[layer]), mod[:, 3:4], mod[:, 4:5])
        if ctx_out:
            xc = xc + mod_c[2] * (mix_c @ w_out[layer])
            hc2 = modulate(rms_norm(xc, norm2_g[layer]), mod_c[3], mod_c[4])
            ff = hier_moe(jnp.concatenate([h2.reshape(-1, d), hc2.reshape(-1, d)], axis=0), *moe_args)
            x = x + mod[:, 5:6] * ff[: b * s].reshape(b, s, d)
            xc = xc + mod_c[5] * ff[b * s:].reshape(b, L, d)
        else:
            x = x + mod[:, 5:6] * hier_moe(h2.reshape(-1, d), *moe_args).reshape(b, s, d)
    return x
```

```cpp
#include <hip/hip_runtime.h>
#include <hip/hip_cooperative_groups.h>
#include <cstdio>
#include <cstdint>
#include <math.h>
namespace cg = cooperative_groups;

#define DM 1024
#define SEQ 2048
#define CTXL 256
#define NBATCH 8
#define NLAT (NBATCH * SEQ)
#define NCTX (NBATCH * CTXL)
#define MROWS (NLAT + NCTX)
#define DIN 2816
#define NMOD 6
#define MODW (NMOD * DM)
#define A_Q 0
#define A_K 256
#define A_V 512
#define B_Q 768
#define B_K 1280
#define B_V 1408
#define C_Q 1536
#define C_I 1792
#define C_FF 2048
#define C_FB 2304
#define C_G 2560

typedef unsigned short bf16;
#define LAS __attribute__((address_space(3)))
#define GAS __attribute__((address_space(1)))
typedef unsigned v4u __attribute__((ext_vector_type(4)));
typedef unsigned v2u __attribute__((ext_vector_type(2)));
typedef float v4f __attribute__((ext_vector_type(4)));

__device__ __forceinline__ unsigned f2bf(float f) { unsigned u = __builtin_bit_cast(unsigned, f); return (u + 0x7fffu + ((u >> 16) & 1u)) >> 16; }
__device__ __forceinline__ unsigned pk2(float lo, float hi) { return f2bf(lo) | (f2bf(hi) << 16); }
__device__ __forceinline__ float bf2f(unsigned short v) { return __builtin_bit_cast(float, (unsigned)v << 16); }
__device__ __forceinline__ float bflo(unsigned v) { return __builtin_bit_cast(float, v << 16); }
__device__ __forceinline__ float bfhi(unsigned v) { return __builtin_bit_cast(float, v & 0xffff0000u); }
__device__ __forceinline__ float silu_f(float x) { return x / (1.f + __expf(-x)); }
__device__ __forceinline__ float wave_sum(float v) {
#pragma unroll
    for (int o = 1; o < 64; o <<= 1) v += __shfl_xor(v, o);
    return v;
}
__device__ __forceinline__ int otid(int wv) { unsigned m = ~0u; asm volatile("" : "+s"(m)); asm volatile("" : "+s"(wv)); return wv * 64 + (int)__builtin_amdgcn_mbcnt_hi(m, __builtin_amdgcn_mbcnt_lo(m, 0u)); }
#define LDS_WAIT() asm volatile("s_waitcnt lgkmcnt(0)" ::: "memory")

constexpr size_t MiB = 1u << 20;
constexpr size_t WS_CTL = 0;
constexpr size_t WS_MOD = 1 * MiB;
constexpr size_t WS_LB = 1 * MiB + 512 * 1024;
constexpr size_t WS_EID = 2 * MiB;
constexpr size_t WS_EW = 2 * MiB + 256 * 1024;
constexpr size_t WS_IDX = 3 * MiB;
constexpr size_t WS_XC = 8 * MiB;
constexpr size_t WS_WIN = 16 * MiB;
constexpr size_t WIN_STRIDE = (size_t)DIN * DM * 2;
constexpr size_t WS_WOUT = 28 * MiB;
constexpr size_t WOUT_STRIDE = 2 * MiB;
constexpr size_t WS_WGU = 32 * MiB;
constexpr size_t WGU_STRIDE = 32 * MiB;
constexpr size_t WS_WD = 96 * MiB;
constexpr size_t WD_STRIDE = 16 * MiB;
constexpr size_t WS_H = 128 * MiB;
constexpr size_t WS_MIX = 164 * MiB;
constexpr size_t WS_P = 200 * MiB;
constexpr size_t WS_Y0 = 200 * MiB;
constexpr size_t WS_Y1 = 236 * MiB;
constexpr size_t WS_HID = 272 * MiB;
constexpr size_t WS_SCR = 300 * MiB;
constexpr size_t WS_END = 340 * MiB;

constexpr int NT = 512, NWAVES = 8;
constexpr int LDS_BYTES = 147456;
namespace pg8 {
#define PG8_LAS __attribute__((address_space(3)))
typedef unsigned short bf16_t;
typedef short bf16x8 __attribute__((ext_vector_type(8)));
typedef float f32x4 __attribute__((ext_vector_type(4)));
typedef unsigned u32x4 __attribute__((ext_vector_type(4)));
constexpr int BM = 256, BK = 64, HALF = 128, HTB = HALF * BK * 2  , STAGE_BYTES = 8 * HTB, NXCD = 8, WGM = 8;

__host__ __device__ __forceinline__ int lds_byte(int r, int c) { const int st = (r >> 4) * 2 + (c >> 5), rr = r & 15, cc = c & 31, ob = rr * 64 + cc * 2; return st * 1024 + (ob ^ (((ob >> 9) & 1) << 5)); }
__host__ __device__ __forceinline__ void stage_rc(int b, int& R, int& C) { const int st = b / 1024, sb = b % 1024, swz = sb ^ (((sb >> 9) & 1) << 5); R = (st >> 1) * 16 + swz / 64; C = (st & 1) * 32 + (swz % 64) / 2; }
__host__ __device__ __forceinline__ int perm32(int rho) { const int n = rho >> 4, i = rho & 15; return 8 * (i >> 2) + 4 * n + (i & 3); }

struct Unit { int pm, pn, aux; };
struct Gemm { const bf16_t* A; const bf16_t* Bt; int M, N, K; };

struct StaticOrder {
    int nM, nN, nwg, G, c;
    __host__ __device__ void init(int M, int N, int G_, int c_) { nM = M / BM; nN = N / BM; nwg = nM * nN; G = G_; c = c_; }
    __host__ __device__ bool next(int i, Unit& u) const {
        const long L = (long)i * G + c; if (L >= nwg) return false;
        int wgid = (int)L; { const int q = nwg / NXCD, r = nwg % NXCD, xcd = wgid % NXCD, off = wgid / NXCD; wgid = (xcd < r ? xcd * (q + 1) : r * (q + 1) + (xcd - r) * q) + off; }
        const int nig = WGM * nN, gid = wgid / nig, fm = gid * WGM, gsz = (nM - fm) < WGM ? (nM - fm) : WGM;
        u.pm = fm + ((wgid % nig) % gsz); u.pn = (wgid % nig) / gsz; return true;
    }
    __device__ __forceinline__ void a_ready(const Unit&) const {}
    __device__ __forceinline__ void done(const Unit&) const {}
};

__device__ __forceinline__ unsigned cvt_pk_bf16(float lo, float hi) { unsigned r; asm volatile("v_cvt_pk_bf16_f32 %0, %1, %2" : "=v"(r) : "v"(lo), "v"(hi)); return r; }
typedef float f32x2 __attribute__((ext_vector_type(2)));
__device__ __forceinline__ f32x2 gelu_pk(f32x2 v) {
    const f32x2 av = __builtin_elementwise_abs(v), d = av * 0.2316418882f + 1.0f;
    f32x2 t; t.x = __builtin_amdgcn_rcpf(d.x); t.y = __builtin_amdgcn_rcpf(d.y);
    f32x2 q = t * 0.5307027145f + (-0.7265760135f); q = q * t + 0.7107068705f; q = q * t + (-0.142248368f); q = q * t + 0.127414796f; q = q * t;
    const f32x2 s = (v * v) * (-0.72134752044f);
    f32x2 e; e.x = __builtin_amdgcn_exp2f(s.x); e.y = __builtin_amdgcn_exp2f(s.y);
    const f32x2 m = v * (q * e), r = v - m;
    f32x2 o; o.x = v.x < 0.f ? m.x : r.x; o.y = v.y < 0.f ? m.y : r.y; return o;
}

template <int ACT  > struct EpiBf16 {
    static constexpr bool PERM = true, AFTER_DRAIN = false; static_assert(ACT == 0 || ACT == 1, "EpiBf16: ACT is 0 (none) or 1 (gelu_pk)");
    bf16_t* O; int ldc; const float* bias; int split_cols; size_t split_stride; float scale0;
    __device__ __forceinline__ void operator()(const f32x4 (&acc)[2][2][4][2], const Unit& u, int wr, int wc, int fr, int fq) const {
        const int row0 = u.pm * BM + wr * 64 + fr; int colt = u.pn * BM; bf16_t* base = O;
        float sc = 1.f; if (split_cols) { const int t = colt / split_cols; base += (size_t)t * split_stride; colt -= t * split_cols; if (t == 0) sc = scale0; }
        const int col0 = colt + wc * 32 + 8 * fq, bcol0 = u.pn * BM + wc * 32 + 8 * fq;
        f32x4 bv[2][2];
#pragma unroll
        for (int bj = 0; bj < 2; ++bj)
#pragma unroll
            for (int n = 0; n < 2; ++n) bv[bj][n] = bias ? *(const f32x4*)(bias + bcol0 + bj * HALF + 4 * n) : (f32x4){0.f, 0.f, 0.f, 0.f};
#pragma unroll
        for (int ai = 0; ai < 2; ++ai)
#pragma unroll
            for (int m = 0; m < 4; ++m) { bf16_t* rowp = base + (size_t)(row0 + ai * HALF + m * 16) * ldc + col0;
#pragma unroll
                for (int bj = 0; bj < 2; ++bj) { f32x4 v0 = acc[ai][bj][m][0] + bv[bj][0], v1 = acc[ai][bj][m][1] + bv[bj][1];
                    if (ACT == 1) { f32x2 a = gelu_pk((f32x2){v0[0], v0[1]}), b = gelu_pk((f32x2){v0[2], v0[3]}), c = gelu_pk((f32x2){v1[0], v1[1]}), d = gelu_pk((f32x2){v1[2], v1[3]});
                        v0 = (f32x4){a.x, a.y, b.x, b.y}; v1 = (f32x4){c.x, c.y, d.x, d.y}; }
                    v0 = v0 * sc; v1 = v1 * sc; u32x4 w; w.x = cvt_pk_bf16(v0[0], v0[1]); w.y = cvt_pk_bf16(v0[2], v0[3]); w.z = cvt_pk_bf16(v1[0], v1[1]); w.w = cvt_pk_bf16(v1[2], v1[3]);
                    *(u32x4*)(rowp + bj * HALF) = w; } }
    }
};

template <class Epi, class Sched, bool ALIGN_EPI = false, bool SP2 = false, bool GATHER = false>
__device__ __forceinline__ void gemm_phase(PG8_LAS unsigned char* lds, const Gemm g, const Sched& S, const Epi& E, int wv, const PG8_LAS int* gidx = nullptr) {
    static_assert(SP2 || !GATHER, "GATHER is wired into the SP2 loop only");
    int tid_ = otid(wv);
    const int tid = tid_, wid = __builtin_amdgcn_readfirstlane(tid >> 6), lane = tid & 63, wr = wid >> 2, wc = wid & 3, fr = lane & 15, fq = lane >> 4;
    const int K = g.K, nt = K / BK;
    unsigned voffA[2][2], nvoffA[2][2], voffB[2]; int RA[2], CA[2];
#pragma unroll
    for (int i = 0; i < 2; ++i) { int R, C; stage_rc(tid * 16 + i * 8192, R, C); const int Rb = Epi::PERM ? ((R & ~31) + perm32(R & 31)) : R; RA[i] = R; CA[i] = C;
        voffA[0][i] = voffA[1][i] = nvoffA[0][i] = nvoffA[1][i] = (unsigned)(R * K + C) * 2u; voffB[i] = (unsigned)(Rb * K + C) * 2u; }
#define PG8_GVOFF(dst, uidx) do { if constexpr (GATHER) { _Pragma("unroll") for (int _h = 0; _h < 2; ++_h) _Pragma("unroll") for (int _i = 0; _i < 2; ++_i) dst[_h][_i] = (unsigned)(gidx[(uidx) * 256 + _h * 128 + RA[_i]] * K + CA[_i]) * 2u; } } while (0)
    const size_t kstep = (size_t)(BK * 2);
    const size_t hstep = (size_t)HALF * K * 2;
    const size_t hstepA = GATHER ? (size_t)0 : hstep;
    const size_t tstep = 2 * hstep;
    const unsigned ldsw = (unsigned)wid * 1024u;
    const int aoff = lds_byte(wr * 64 + fr, fq * 8), boff = lds_byte(wc * 32 + fr, fq * 8);
#define PG8_SA(b, h) (((b) * 2 + (h)) * HTB)
#define PG8_SB(b, h) ((4 + (b) * 2 + (h)) * HTB)
#define PG8_STAGE(bufoff, gbase, voff) do { _Pragma("unroll") for (int _i = 0; _i < 2; ++_i) \
        __builtin_amdgcn_global_load_lds((const unsigned*)((const char*)(gbase) + (voff)[_i]), (PG8_LAS unsigned*)(lds + (bufoff) + ldsw + _i * 8192), 16, 0, 0); } while (0)
#define PG8_LDA(dst, b, h) do { _Pragma("unroll") for (int m = 0; m < 4; ++m) _Pragma("unroll") for (int k = 0; k < 2; ++k) dst[m][k] = *(const PG8_LAS bf16x8*)(lds + PG8_SA(b, h) + aoff + m * 2048 + k * 1024); } while (0)
#define PG8_LDB(dst, b, h) do { _Pragma("unroll") for (int n = 0; n < 2; ++n) _Pragma("unroll") for (int k = 0; k < 2; ++k) dst[n][k] = *(const PG8_LAS bf16x8*)(lds + PG8_SB(b, h) + boff + n * 2048 + k * 1024); } while (0)
#define PG8_MMA(ai, bj, At, Bt) do { __builtin_amdgcn_s_setprio(1); _Pragma("unroll") for (int m = 0; m < 4; ++m) _Pragma("unroll") for (int n = 0; n < 2; ++n) _Pragma("unroll") for (int k = 0; k < 2; ++k) \
        acc[ai][bj][m][n] = __builtin_amdgcn_mfma_f32_16x16x32_bf16(Bt[n][k], At[m][k], acc[ai][bj][m][n], 0, 0, 0); __builtin_amdgcn_s_setprio(0); } while (0)
#define PG8_WAIT_V(n) asm volatile("s_waitcnt vmcnt(" #n ")" ::: "memory")
#define PG8_WAIT_L(n) asm volatile("s_waitcnt lgkmcnt(" #n ")" ::: "memory")
#define PG8_BAR __builtin_amdgcn_s_barrier()
#define PG8_SCHED __builtin_amdgcn_sched_barrier(0)
    Unit cur, nxt; int ui = 0;
    if (!S.next(0, cur)) return;
    f32x4 acc[2][2][4][2];
#pragma unroll
    for (int a = 0; a < 2; ++a)
#pragma unroll
        for (int b = 0; b < 2; ++b)
#pragma unroll
            for (int m = 0; m < 4; ++m)
#pragma unroll
                for (int n = 0; n < 2; ++n) acc[a][b][m][n] = (f32x4){0.f, 0.f, 0.f, 0.f};
    bf16x8 At[4][2], B0[2][2], B1[2][2];
    const char* cA = (const char*)g.A + (GATHER ? (size_t)0 : (size_t)cur.pm * tstep); PG8_GVOFF(voffA, 0); const char* cB = (const char*)g.Bt + (size_t)cur.pn * tstep;
    S.a_ready(cur);
    if constexpr (SP2) {
        PG8_STAGE(PG8_SB(0, 0), cB, voffB); PG8_STAGE(PG8_SB(0, 1), cB + hstep, voffB); PG8_STAGE(PG8_SA(0, 0), cA, voffA[0]); PG8_STAGE(PG8_SA(0, 1), cA + hstepA, voffA[1]);
        if (wr == 1) PG8_BAR;
        PG8_WAIT_V(2); PG8_BAR;
        PG8_STAGE(PG8_SB(1, 0), cB + kstep, voffB); PG8_STAGE(PG8_SA(1, 0), cA + kstep, voffA[0]); PG8_STAGE(PG8_SB(1, 1), cB + hstep + kstep, voffB);
        PG8_WAIT_V(6); PG8_BAR;
    } else {
        PG8_STAGE(PG8_SB(0, 0), cB, voffB); PG8_STAGE(PG8_SA(0, 0), cA, voffA[0]); PG8_STAGE(PG8_SB(0, 1), cB + hstep, voffB); PG8_STAGE(PG8_SA(0, 1), cA + hstep, voffA[0]);
        if (wr == 1) PG8_BAR;
        PG8_WAIT_V(4); PG8_BAR;
        PG8_STAGE(PG8_SB(1, 0), cB + kstep, voffB); PG8_STAGE(PG8_SA(1, 0), cA + kstep, voffA[0]); PG8_STAGE(PG8_SB(1, 1), cB + hstep + kstep, voffB);
        PG8_WAIT_V(6); PG8_BAR;
    }
    for (;;) {
        const bool has_next = S.next(ui + 1, nxt);
        const char* nA = (has_next && !GATHER) ? (const char*)g.A + (size_t)nxt.pm * tstep : cA; if (has_next) PG8_GVOFF(nvoffA, ui + 1); const char* nB = has_next ? (const char*)g.Bt + (size_t)nxt.pn * tstep : cB;
        for (int t = 0; t < nt; t += 2) {
            const bool last = (t == nt - 2);
            const char* a1 = cA + (size_t)(t + 1) * kstep;
            const char* a2 = last ? nA : cA + (size_t)(t + 2) * kstep; const char* b2 = last ? nB : cB + (size_t)(t + 2) * kstep;
            const char* a3 = a2 + kstep; const char* b3 = b2 + kstep;
            if (last && has_next) S.a_ready(nxt);
            unsigned vs2[2][2];
#pragma unroll
            for (int _h = 0; _h < 2; ++_h)
#pragma unroll
                for (int _i = 0; _i < 2; ++_i) vs2[_h][_i] = last ? nvoffA[_h][_i] : voffA[_h][_i];
            if constexpr (SP2) {
            PG8_LDB(B0, 0, 0); PG8_LDB(B1, 0, 1); PG8_SCHED; PG8_LDA(At, 0, 0); PG8_STAGE(PG8_SA(1, 1), a1 + hstepA, voffA[1]);
            PG8_WAIT_V(8); PG8_WAIT_L(0); PG8_BAR; PG8_MMA(0, 0, At, B0); PG8_MMA(0, 1, At, B1); PG8_BAR; PG8_SCHED;
            PG8_LDA(At, 0, 1); PG8_STAGE(PG8_SB(0, 0), b2, voffB); PG8_STAGE(PG8_SB(0, 1), b2 + hstep, voffB); PG8_STAGE(PG8_SA(0, 0), a2, vs2[0]);
            PG8_WAIT_V(8); PG8_WAIT_L(0); PG8_BAR; PG8_MMA(1, 0, At, B0); PG8_MMA(1, 1, At, B1); PG8_BAR; PG8_SCHED;
            PG8_LDB(B0, 1, 0); PG8_LDB(B1, 1, 1); PG8_SCHED; PG8_LDA(At, 1, 0); PG8_STAGE(PG8_SA(0, 1), a2 + hstepA, vs2[1]);
            PG8_WAIT_V(8); PG8_WAIT_L(0); PG8_BAR; PG8_MMA(0, 0, At, B0); PG8_MMA(0, 1, At, B1); PG8_BAR; PG8_SCHED;
            PG8_LDA(At, 1, 1); PG8_STAGE(PG8_SB(1, 0), b3, voffB); PG8_STAGE(PG8_SB(1, 1), b3 + hstep, voffB); PG8_STAGE(PG8_SA(1, 0), a3, vs2[0]);
            PG8_WAIT_V(8); PG8_WAIT_L(0); PG8_BAR; PG8_MMA(1, 0, At, B0); PG8_MMA(1, 1, At, B1); PG8_BAR; PG8_SCHED;
            } else {
            PG8_LDB(B0, 0, 0); PG8_SCHED; PG8_LDA(At, 0, 0); PG8_STAGE(PG8_SA(1, 1), a1 + hstep, voffA[0]);
            PG8_WAIT_L(8); PG8_BAR; PG8_WAIT_L(0); PG8_MMA(0, 0, At, B0); PG8_BAR; PG8_SCHED;
            PG8_LDB(B1, 0, 1); PG8_STAGE(PG8_SB(0, 0), b2, voffB);
            PG8_BAR; PG8_WAIT_L(0); PG8_MMA(0, 1, At, B1); PG8_BAR;
            PG8_LDA(At, 0, 1); PG8_STAGE(PG8_SA(0, 0), a2, voffA[0]);
            PG8_BAR; PG8_WAIT_L(0); PG8_MMA(1, 0, At, B0); PG8_BAR; PG8_SCHED;
            PG8_STAGE(PG8_SB(0, 1), b2 + hstep, voffB);
            PG8_WAIT_V(6); PG8_BAR; PG8_MMA(1, 1, At, B1); PG8_BAR;
            PG8_LDB(B0, 1, 0); PG8_SCHED; PG8_LDA(At, 1, 0); PG8_STAGE(PG8_SA(0, 1), a2 + hstep, voffA[0]);
            PG8_WAIT_L(8); PG8_BAR; PG8_WAIT_L(0); PG8_MMA(0, 0, At, B0); PG8_BAR; PG8_SCHED;
            PG8_LDB(B1, 1, 1); PG8_STAGE(PG8_SB(1, 0), b3, voffB);
            PG8_BAR; PG8_WAIT_L(0); PG8_MMA(0, 1, At, B1); PG8_BAR;
            PG8_LDA(At, 1, 1); PG8_STAGE(PG8_SA(1, 0), a3, voffA[0]);
            PG8_BAR; PG8_WAIT_L(0); PG8_MMA(1, 0, At, B0); PG8_BAR; PG8_SCHED;
            PG8_STAGE(PG8_SB(1, 1), b3 + hstep, voffB);
            PG8_WAIT_V(6); PG8_BAR; PG8_MMA(1, 1, At, B1); PG8_BAR;
            }
        }
        if constexpr (ALIGN_EPI) { if (wr == 0) PG8_BAR; }
        if constexpr (!Epi::AFTER_DRAIN) { E(acc, cur, wr, wc, fr, fq); S.done(cur); }
        if (!has_next) break;
#pragma unroll
        for (int a = 0; a < 2; ++a)
#pragma unroll
            for (int b = 0; b < 2; ++b)
#pragma unroll
                for (int m = 0; m < 4; ++m)
#pragma unroll
                    for (int n = 0; n < 2; ++n) acc[a][b][m][n] = (f32x4){0.f, 0.f, 0.f, 0.f};
        cur = nxt; cA = nA; cB = nB; ++ui;
#pragma unroll
        for (int _h = 0; _h < 2; ++_h)
#pragma unroll
            for (int _i = 0; _i < 2; ++_i) voffA[_h][_i] = nvoffA[_h][_i];
        if constexpr (ALIGN_EPI) { if (wr == 1) PG8_BAR; }
    }
    PG8_WAIT_V(0);
    if constexpr (!ALIGN_EPI) { if (wr == 0) PG8_BAR; }
    PG8_BAR;
    if constexpr (Epi::AFTER_DRAIN) { E.fused(acc, cur, wr, wc, fr, fq, lds, wid, lane); S.done(cur); }
#undef PG8_SA
#undef PG8_GVOFF
#undef PG8_SB
#undef PG8_STAGE
#undef PG8_LDA
#undef PG8_LDB
#undef PG8_MMA
#undef PG8_WAIT_V
#undef PG8_WAIT_L
#undef PG8_BAR
#undef PG8_SCHED
}
}


struct Ptrs { const float* in[24]; float* out; unsigned char* ws; int layer; int pad; };
enum { I_X = 0, I_C, I_CTX, I_CCTX, I_WADA, I_BADA, I_N1G, I_WIN, I_NAQN, I_NAKN, I_RPB, I_GQQN, I_GQKN, I_LB, I_HGON, I_WOUT, I_N2G, I_WRG, I_BRG, I_WRE, I_BRE, I_WEG, I_WEU, I_WED };

namespace pg8 {
struct EpiResid {
    static constexpr bool PERM = false, AFTER_DRAIN = false;
    const float* xin_lat; const float* xin_ctx; float* xout_lat; float* xout_ctx; const float* modl; int chunk;
    __device__ __forceinline__ void operator()(const f32x4 (&acc)[2][2][4][2], const Unit& u, int wr, int wc, int fr, int fq) const {
        const int rowt = u.pm * BM; const bool isctx = rowt >= NLAT;
        const float* xin = isctx ? xin_ctx + (size_t)(rowt - NLAT) * DM : xin_lat + (size_t)rowt * DM;
        float* xo = isctx ? xout_ctx + (size_t)(rowt - NLAT) * DM : xout_lat + (size_t)rowt * DM;
        const int mrow = isctx ? 8 : (rowt >> 11);
        const float* gate = modl + (size_t)mrow * MODW + chunk * DM;
        const int col0 = u.pn * BM + wc * 32 + 4 * fq;
#pragma unroll
        for (int bj = 0; bj < 2; ++bj)
#pragma unroll
            for (int n = 0; n < 2; ++n) {
                const int col = col0 + bj * HALF + n * 16;
                const f32x4 gv = *(const f32x4*)(gate + col);
#pragma unroll
                for (int ai = 0; ai < 2; ++ai)
#pragma unroll
                    for (int m = 0; m < 4; ++m) {
                        const size_t off = (size_t)(ai * HALF + wr * 64 + m * 16 + fr) * DM + col;
                        const f32x4 xi = *(const f32x4*)(xin + off);
                        *(f32x4*)(xo + off) = xi + gv * acc[ai][bj][m][n];
                    }
            }
    }
};
}

__device__ __forceinline__ void phase_mod(const Ptrs& p, LAS unsigned char* lds, int wv) {
    if (blockIdx.x >= 192) return;
    LAS float* sc = (LAS float*)lds;
    LAS float* red = (LAS float*)(lds + 36864);
    const int tid = otid(wv);
    const float* c = p.in[I_C]; const float* cc = p.in[I_CCTX];
    for (int i = tid; i < 9 * DM; i += NT) { float v = (i < 8 * DM) ? c[i] : cc[i - 8 * DM]; sc[i] = silu_f(v); }
    __syncthreads();
    float* mod = (float*)(p.ws + WS_MOD);
    for (int u = blockIdx.x; u < 192; u += gridDim.x) {
        const int layer = u / 96, cb = u % 96, cq = tid & 15, kg = tid >> 4;
        const float* w = p.in[I_WADA] + (size_t)layer * DM * MODW + cb * 64 + cq * 4;
        v4f acc[9];
#pragma unroll
        for (int r = 0; r < 9; ++r) acc[r] = (v4f){0.f, 0.f, 0.f, 0.f};
        for (int i = 0; i < 32; ++i) {
            const int k = kg + 32 * i;
            const v4f wv = *(const v4f*)(w + (size_t)k * MODW);
#pragma unroll
            for (int r = 0; r < 9; ++r) acc[r] += sc[r * DM + k] * wv;
        }
#pragma unroll
        for (int r = 0; r < 9; ++r) *(LAS v4f*)(red + (kg * 9 + r) * 64 + cq * 4) = acc[r];
        __syncthreads();
        for (int o = tid; o < 576; o += NT) {
            const int r = o >> 6, c2 = o & 63; float s = 0.f;
            for (int k2 = 0; k2 < 32; ++k2) s += red[(k2 * 9 + r) * 64 + c2];
            mod[((size_t)layer * 9 + r) * MODW + cb * 64 + c2] = s + p.in[I_BADA][layer * MODW + cb * 64 + c2];
        }
        __syncthreads();
    }
}
__device__ __forceinline__ void phase_lb(const Ptrs& p, int wv) {
    if (blockIdx.x == 255 % gridDim.x) {
        const int i = otid(wv);
        const float* raw = p.in[I_LB]; float* lb = (float*)(p.ws + WS_LB);
        float l0 = raw[i], l1 = raw[512 + i];
        lb[i] = 0.f; lb[512 + i] = 1.f / (1.f + __expf(l0 - l1));
    }
}
__device__ __forceinline__ void transpose_item(const float* W, int K, int N, bf16* WT, int row_off, LAS float* scr, int item, int lane) {
    const int nblk = N / 32, kb = item / nblk, nb = item % nblk, k0 = 64 * kb, n0 = 32 * nb;
#pragma unroll 8
    for (int i = 0; i < 32; ++i) { const int kk = 2 * i + (lane >> 5); scr[kk * 33 + (lane & 31)] = W[(size_t)(k0 + kk) * N + n0 + (lane & 31)]; }
    LDS_WAIT(); asm volatile("" ::: "memory");
    const int c = lane & 7;
#pragma unroll
    for (int j = 0; j < 4; ++j) { const int n = (lane >> 3) + 8 * j; const LAS float* s = scr + (8 * c) * 33 + n;
        v4u o; o.x = pk2(s[0 * 33], s[1 * 33]); o.y = pk2(s[2 * 33], s[3 * 33]); o.z = pk2(s[4 * 33], s[5 * 33]); o.w = pk2(s[6 * 33], s[7 * 33]);
        *(v4u*)(WT + (size_t)(row_off + n0 + n) * K + k0 + 8 * c) = o; }
    LDS_WAIT(); asm volatile("" ::: "memory");
}
constexpr int CI_IN = 16 * 88, CI_OUT = 16 * 32, CI_G = 32 * 128, CI_U = 32 * 128, CI_D = 32 * 128, CI_LAYER = CI_IN + CI_OUT + CI_G + CI_U + CI_D;
__device__ __forceinline__ void phase_convert(const Ptrs& p, LAS unsigned char* lds, int layer_lo, int layer_hi, int wv) {
    const int lane = otid(wv) & 63, wave = wv;
    LAS float* scr = (LAS float*)(lds + wave * 16384);
    const int gw = blockIdx.x * NWAVES + wave, NGW = gridDim.x * NWAVES;
    const int n_items = (layer_hi - layer_lo) * CI_LAYER;
    for (int it = gw; it < n_items; it += NGW) {
        const int layer = layer_lo + it / CI_LAYER; int r = it % CI_LAYER;
        if (r < CI_IN) { transpose_item(p.in[I_WIN] + (size_t)layer * DM * DIN, DM, DIN, (bf16*)(p.ws + WS_WIN + layer * WIN_STRIDE), 0, scr, r, lane); continue; } r -= CI_IN;
        if (r < CI_OUT) { transpose_item(p.in[I_WOUT] + (size_t)layer * DM * DM, DM, DM, (bf16*)(p.ws + WS_WOUT + layer * WOUT_STRIDE), 0, scr, r, lane); continue; } r -= CI_OUT;
        if (r < CI_G + CI_U) {
            const int up = r >= CI_G; if (up) r -= CI_G;
            const int e = r >> 7, rem = r & 127, nb = rem & 7, n0 = 32 * nb;
            const int mapped = (n0 >> 7) * 256 + (n0 & 127) + (up ? 128 : 0);
            transpose_item(p.in[up ? I_WEU : I_WEG] + ((size_t)layer * 32 + e) * DM * 256, DM, 256, (bf16*)(p.ws + WS_WGU + layer * WGU_STRIDE) + (size_t)e * 512 * DM, mapped - n0, scr, rem, lane);
            continue;
        }
        r -= CI_G + CI_U;
        { const int e = r >> 7, rem = r & 127;
          transpose_item(p.in[I_WED] + ((size_t)layer * 32 + e) * 256 * DM, 256, DM, (bf16*)(p.ws + WS_WD + layer * WD_STRIDE) + (size_t)e * DM * 256, 0, scr, rem, lane); }
    }
}
__device__ __forceinline__ void phase_norm(const float* xlat, const float* xctx, const float* g, const float* modl, int ch_shift, int ch_scale, bf16* H, int nrows, int wv) {
    const int lane = otid(wv) & 63, wave = wv;
    const int gw = blockIdx.x * NWAVES + wave, NGW = gridDim.x * NWAVES;
    const int per = (nrows + NGW - 1) / NGW;
    const int r0 = gw * per, r1 = min(r0 + per, nrows);
    int cur = -1; v4f gs[4], sh[4];
    for (int r = r0; r < r1; ++r) {
        const int mrow = (r < NLAT) ? (r >> 11) : 8;
        if (mrow != cur) {
            cur = mrow; const float* m = modl + (size_t)mrow * MODW;
#pragma unroll
            for (int j = 0; j < 4; ++j) { const int c = 4 * lane + 256 * j; const v4f gg = *(const v4f*)(g + c), sc = *(const v4f*)(m + ch_scale * DM + c);
                gs[j] = gg * (1.f + sc); sh[j] = *(const v4f*)(m + ch_shift * DM + c); }
        }
        const float* xr = (r < NLAT) ? xlat + (size_t)r * DM : xctx + (size_t)(r - NLAT) * DM;
        v4f v[4]; float s = 0.f;
#pragma unroll
        for (int j = 0; j < 4; ++j) { v[j] = *(const v4f*)(xr + 4 * lane + 256 * j); s += (v[j].x * v[j].x + v[j].y * v[j].y) + (v[j].z * v[j].z + v[j].w * v[j].w); }
        const float rstd = rsqrtf(wave_sum(s) * (1.f / DM) + 1e-6f);
        bf16* orow = H + (size_t)r * DM;
#pragma unroll
        for (int j = 0; j < 4; ++j) { const v4f o = v[j] * rstd * gs[j] + sh[j]; v2u w; w.x = pk2(o.x, o.y); w.y = pk2(o.z, o.w); *(v2u*)(orow + 4 * lane + 256 * j) = w; }
    }
}

constexpr size_t WS_RSS = 6 * MiB;
constexpr size_t WS_WR = 7 * MiB + 512 * 1024;
constexpr int CW_CNT = 1024;
constexpr int LDS_TTAB = 131072;
constexpr int LDS_GIDX = 131072 + 4096;
constexpr int LDS_RT = 131072;

namespace pg8 {
struct EpiResidSS {
    static constexpr bool PERM = false, AFTER_DRAIN = false;
    const float* xin_lat; const float* xin_ctx; float* xout_lat; float* xout_ctx; const float* modl; int chunk; float* rss; int wv;
    __device__ __forceinline__ void operator()(const f32x4 (&acc)[2][2][4][2], const Unit& u, int, int, int, int) const {
        const int l_ = otid(wv) & 63, fr = l_ & 15, fq = l_ >> 4, wr = wv >> 2, wc = wv & 3;
        const int rowt = u.pm * BM; const bool isctx = rowt >= NLAT;
        const float* xin = isctx ? xin_ctx + (size_t)(rowt - NLAT) * DM : xin_lat + (size_t)rowt * DM;
        float* xo = isctx ? xout_ctx + (size_t)(rowt - NLAT) * DM : xout_lat + (size_t)rowt * DM;
        const int mrow = isctx ? 8 : (rowt >> 11);
        const float* gate = modl + (size_t)mrow * MODW + chunk * DM;
        const int col0 = u.pn * BM + wc * 32 + 4 * fq;
        f32x4 gv[2][2];
#pragma unroll
        for (int bj = 0; bj < 2; ++bj)
#pragma unroll
            for (int n = 0; n < 2; ++n) gv[bj][n] = *(const f32x4*)(gate + col0 + bj * HALF + n * 16);
#pragma unroll
        for (int ai = 0; ai < 2; ++ai)
#pragma unroll
            for (int m = 0; m < 4; ++m) {
                const int rl = ai * HALF + wr * 64 + m * 16 + fr; float ss = 0.f;
#pragma unroll
                for (int bj = 0; bj < 2; ++bj)
#pragma unroll
                    for (int n = 0; n < 2; ++n) {
                        const size_t off = (size_t)rl * DM + col0 + bj * HALF + n * 16;
                        const f32x4 xi = *(const f32x4*)(xin + off);
                        const f32x4 o = xi + gv[bj][n] * acc[ai][bj][m][n];
                        *(f32x4*)(xo + off) = o;
                        ss += (o[0] * o[0] + o[1] * o[1]) + (o[2] * o[2] + o[3] * o[3]);
                    }
                ss += __shfl_xor(ss, 16); ss += __shfl_xor(ss, 32);
                if (fq == 0) rss[(size_t)(rowt + rl) * 16 + u.pn * 4 + wc] = ss;
            }
    }
};
struct EpiGU {
    static constexpr bool PERM = true, AFTER_DRAIN = false;
    bf16_t* HID; int wv;
    __device__ __forceinline__ void operator()(const f32x4 (&acc)[2][2][4][2], const Unit& u, int, int, int, int) const {
        const int l_ = otid(wv) & 63, fr = l_ & 15, fq = l_ >> 4, wr = wv >> 2, wc = wv & 3;
        const int pnl = u.pn & 1, row0 = u.pm * BM + wr * 64 + fr, col0 = pnl * 128 + wc * 32 + 8 * fq;
#pragma unroll
        for (int ai = 0; ai < 2; ++ai)
#pragma unroll
            for (int m = 0; m < 4; ++m) {
                bf16_t* rowp = HID + (size_t)(row0 + ai * HALF + m * 16) * 256 + col0;
                float hv[8];
#pragma unroll
                for (int n = 0; n < 2; ++n)
#pragma unroll
                    for (int i = 0; i < 4; ++i) { const float g = acc[ai][0][m][n][i], uu = acc[ai][1][m][n][i]; hv[n * 4 + i] = g / (1.f + __expf(-g)) * uu; }
                u32x4 w; w.x = cvt_pk_bf16(hv[0], hv[1]); w.y = cvt_pk_bf16(hv[2], hv[3]); w.z = cvt_pk_bf16(hv[4], hv[5]); w.w = cvt_pk_bf16(hv[6], hv[7]);
                *(u32x4*)rowp = w;
            }
    }
};
struct EpiDown {
    static constexpr bool PERM = true, AFTER_DRAIN = false;
    bf16_t* Y0; bf16_t* Y1; const PG8_LAS int* rowinfo; int wv;
    __device__ __forceinline__ void operator()(const f32x4 (&acc)[2][2][4][2], const Unit& u, int, int, int, int) const {
        const int l_ = otid(wv) & 63, fr_ = l_ & 15, fq = l_ >> 4, wr = wv >> 2, wc = wv & 3;
        const int col0 = (u.pn & 3) * BM + wc * 32 + 8 * fq;
        const PG8_LAS int* ri = rowinfo + (u.aux * 256 + wr * 64 + fr_) * 2;
#pragma unroll
        for (int ai = 0; ai < 2; ++ai)
#pragma unroll
            for (int m = 0; m < 4; ++m) {
                const int ent = ri[(ai * HALF + m * 16) * 2]; const float w = __builtin_bit_cast(float, ri[(ai * HALF + m * 16) * 2 + 1]);
                if (ent >= 0) {
                    bf16_t* rowp = Y0 + ((size_t)(ent & 1) * ((WS_Y1 - WS_Y0) / 2) + (size_t)(ent >> 1) * DM + col0);
#pragma unroll
                    for (int bj = 0; bj < 2; ++bj) {
                        const f32x4 v0 = acc[ai][bj][m][0] * w, v1 = acc[ai][bj][m][1] * w;
                        u32x4 o; o.x = cvt_pk_bf16(v0[0], v0[1]); o.y = cvt_pk_bf16(v0[2], v0[3]); o.z = cvt_pk_bf16(v1[0], v1[1]); o.w = cvt_pk_bf16(v1[2], v1[3]);
                        *(u32x4*)(rowp + bj * HALF) = o;
                    }
                }
                asm volatile("" ::: "memory");
            }
    }
};
struct MoeOrder {
    const PG8_LAS int* ttab; int ntile, npn, G, c;
    __device__ __forceinline__ bool next(int i, Unit& u) const {
        const int L = i * G + c; if (L >= ntile * npn) return false;
        const int t = L / npn, pl = L % npn; u.pm = t; u.pn = ttab[t * 4] * npn + pl; u.aux = i; return true;
    }
    __device__ __forceinline__ void a_ready(const Unit&) const {}
    __device__ __forceinline__ void done(const Unit&) const {}
};
}

__device__ __forceinline__ void phase_router_w(const Ptrs& p, int wv) {
    const int gt = blockIdx.x * NT + otid(wv), NG = gridDim.x * NT;
    for (int idx = gt; idx < 2 * 48 * DM; idx += NG) {
        const int layer = idx / (48 * DM), r = idx % (48 * DM), n = r >> 10, k = r & 1023;
        float w;
        if (n < 16) w = p.in[I_WRG][((size_t)layer * DM + k) * 4 + (n & 3)];
        else { const int g = ((n - 16) & 15) >> 2, i = n & 3, e = 8 * g + i + (n >= 32 ? 4 : 0); w = p.in[I_WRE][((size_t)layer * DM + k) * 32 + e]; }
        const unsigned hi = f2bf(w); const float lo = w - __builtin_bit_cast(float, hi << 16);
        bf16* base = (bf16*)(p.ws + WS_WR) + (size_t)layer * 2 * 48 * DM;
        base[r] = (bf16)hi; base[48 * DM + r] = (bf16)f2bf(lo);
    }
}

typedef short s8v __attribute__((ext_vector_type(8)));
__device__ __forceinline__ void phase_route(const Ptrs& p, LAS unsigned char* lds, int layer, int nrows, int wv) {
    const int tid = otid(wv), lane = tid & 63, wave = wv;
    LAS int* lcnt = (LAS int*)(lds + LDS_RT); LAS int* gb = lcnt + 32;
    if (tid < 32) lcnt[tid] = 0;
    __syncthreads();
    const int ntiles = nrows / 16, t = wave * gridDim.x + blockIdx.x;
    const float* modl = (const float*)(p.ws + WS_MOD) + (size_t)layer * 9 * MODW;
    int e0 = -1, e1 = -1, lp0 = 0, lp1 = 0, ent0 = 0;
    if (t < ntiles) {
        const int row0 = t * 16, r = row0 + (lane & 15), kq = lane >> 4;
        const int mrow = (row0 < NLAT) ? (row0 >> 11) : 8;
        const float* xr = (r < NLAT) ? p.out + (size_t)r * DM : (const float*)(p.ws + WS_XC) + (size_t)(r - NLAT) * DM;
        const float* g = p.in[I_N2G] + layer * DM; const float* msc = modl + (size_t)mrow * MODW + 4 * DM; const float* msh = modl + (size_t)mrow * MODW + 3 * DM;
        bf16* hrow = (bf16*)(p.ws + WS_H) + (size_t)r * DM;
        const bf16* wr_hi = (const bf16*)(p.ws + WS_WR) + (size_t)layer * 2 * 48 * DM + (size_t)(lane & 15) * DM; const bf16* wr_lo = wr_hi + 48 * DM;
        float ss;
        { const v4f* rs = (const v4f*)((const float*)(p.ws + WS_RSS) + (size_t)r * 16); const v4f a = rs[0], b = rs[1], c = rs[2], d = rs[3];
          ss = ((a.x + a.y) + (a.z + a.w)) + ((b.x + b.y) + (b.z + b.w)) + ((c.x + c.y) + (c.z + c.w)) + ((d.x + d.y) + (d.z + d.w)); }
        const float rstd = rsqrtf(ss * (1.f / DM) + 1e-6f);
        v4f acc[3];
#pragma unroll
        for (int i = 0; i < 3; ++i) acc[i] = (v4f){0.f, 0.f, 0.f, 0.f};
        for (int s = 0; s < 32; ++s) {
            const int c0 = 32 * s + 8 * kq;
            const v4f xa = *(const v4f*)(xr + c0), xb = *(const v4f*)(xr + c0 + 4);
            const v4f ga = *(const v4f*)(g + c0), gbv = *(const v4f*)(g + c0 + 4);
            const v4f sa = *(const v4f*)(msc + c0), sb = *(const v4f*)(msc + c0 + 4);
            const v4f ha = *(const v4f*)(msh + c0), hb = *(const v4f*)(msh + c0 + 4);
            const v4f h0 = xa * rstd * (ga * (1.f + sa)) + ha, h1 = xb * rstd * (gbv * (1.f + sb)) + hb;
            float hv[8] = {h0.x, h0.y, h0.z, h0.w, h1.x, h1.y, h1.z, h1.w};
            unsigned hi[8]; s8v bhi, blo;
#pragma unroll
            for (int j = 0; j < 8; ++j) { hi[j] = f2bf(hv[j]); bhi[j] = (short)hi[j]; blo[j] = (short)f2bf(hv[j] - __builtin_bit_cast(float, hi[j] << 16)); }
            v4u hw; hw.x = hi[0] | (hi[1] << 16); hw.y = hi[2] | (hi[3] << 16); hw.z = hi[4] | (hi[5] << 16); hw.w = hi[6] | (hi[7] << 16);
            *(v4u*)(hrow + c0) = hw;
#pragma unroll
            for (int nt = 0; nt < 3; ++nt) {
                const s8v ahi = *(const s8v*)(wr_hi + (size_t)nt * 16 * DM + c0), alo = *(const s8v*)(wr_lo + (size_t)nt * 16 * DM + c0);
                acc[nt] = __builtin_amdgcn_mfma_f32_16x16x32_bf16(ahi, bhi, acc[nt], 0, 0, 0);
                acc[nt] = __builtin_amdgcn_mfma_f32_16x16x32_bf16(ahi, blo, acc[nt], 0, 0, 0);
                acc[nt] = __builtin_amdgcn_mfma_f32_16x16x32_bf16(alo, bhi, acc[nt], 0, 0, 0);
            }
        }
        const float* brg = p.in[I_BRG] + layer * 4; const float* bre = p.in[I_BRE] + layer * 32;
        float gl[4];
#pragma unroll
        for (int i = 0; i < 4; ++i) gl[i] = acc[0][i] + brg[i];
        int gi = 0; float gm = gl[0];
#pragma unroll
        for (int i = 1; i < 4; ++i) if (gl[i] > gm) { gm = gl[i]; gi = i; }
        float den = 0.f;
#pragma unroll
        for (int i = 0; i < 4; ++i) den += __expf(gl[i] - gm);
        const float gtop = 1.f / den;
        if (kq == gi) {
            float el[8];
#pragma unroll
            for (int i = 0; i < 4; ++i) { el[i] = acc[1][i] + bre[8 * kq + i]; el[4 + i] = acc[2][i] + bre[8 * kq + 4 + i]; }
            int i0 = 0; float v0 = el[0];
#pragma unroll
            for (int i = 1; i < 8; ++i) if (el[i] > v0) { v0 = el[i]; i0 = i; }
            int i1 = -1; float v1 = -3.0e38f;
#pragma unroll
            for (int i = 0; i < 8; ++i) if (i != i0 && el[i] > v1) { v1 = el[i]; i1 = i; }
            const float p1 = __expf(v1 - v0), sden = 1.f / (1.f + p1);
            e0 = gi * 8 + i0; e1 = gi * 8 + i1; ent0 = r * 2;
            float* ew = (float*)(p.ws + WS_EW);
            ew[ent0] = gtop * sden; ew[ent0 + 1] = gtop * p1 * sden;
            lp0 = __hip_atomic_fetch_add(lcnt + e0, 1, __ATOMIC_RELAXED, __HIP_MEMORY_SCOPE_WORKGROUP); lp1 = __hip_atomic_fetch_add(lcnt + e1, 1, __ATOMIC_RELAXED, __HIP_MEMORY_SCOPE_WORKGROUP);
        }
    }
    __syncthreads();
    int* cnt = (int*)(p.ws + WS_CTL) + CW_CNT + layer * 64;
    if (tid < 32) gb[tid] = atomicAdd(&cnt[tid], lcnt[tid]);
    __syncthreads();
    if (e0 >= 0) {
        int* IDX = (int*)(p.ws + WS_IDX);
        IDX[(size_t)e0 * MROWS + gb[e0] + lp0] = ent0;
        IDX[(size_t)e1 * MROWS + gb[e1] + lp1] = ent0 + 1;
    }
}
__device__ __forceinline__ int moe_build_ttab(const Ptrs& p, LAS unsigned char* lds, int layer, int wv) {
    LAS int* ttab = (LAS int*)(lds + LDS_TTAB);
    const int* cnt = (const int*)(p.ws + WS_CTL) + CW_CNT + layer * 64;
    __syncthreads();
    if (otid(wv) == 0) {
        int t = 0;
        for (int e = 0; e < 32; ++e) { const int c = __hip_atomic_load(cnt + e, __ATOMIC_RELAXED, __HIP_MEMORY_SCOPE_AGENT); for (int fp = 0; fp < c; fp += 256) { ttab[t * 4] = e; ttab[t * 4 + 1] = fp; ttab[t * 4 + 2] = c; ++t; } }
        ttab[176 * 4] = t;
    }
    __syncthreads();
    return ttab[176 * 4];
}
__device__ __forceinline__ void phase_moe_gu(const Ptrs& p, LAS unsigned char* lds, int layer, int wv) {
    const int ntile = moe_build_ttab(p, lds, layer, wv);
    LAS int* ttab = (LAS int*)(lds + LDS_TTAB); LAS int* gidx = (LAS int*)(lds + LDS_GIDX);
    pg8::MoeOrder S{ttab, ntile, 2, (int)gridDim.x, (int)blockIdx.x};
    const int* IDX = (const int*)(p.ws + WS_IDX);
    for (int i = 0; i < 3; ++i) {
        pg8::Unit u; if (!S.next(i, u)) break;
        const int e = ttab[u.pm * 4], fp = ttab[u.pm * 4 + 1], c = ttab[u.pm * 4 + 2];
        for (int r = otid(wv); r < 256; r += NT) gidx[i * 256 + r] = (fp + r < c) ? (IDX[(size_t)e * MROWS + fp + r] >> 1) : 0;
    }
    __syncthreads();
    pg8::Gemm g{(const bf16*)(p.ws + WS_H), (const bf16*)(p.ws + WS_WGU + layer * WGU_STRIDE), ntile * 256, 32 * 512, DM};
    pg8::EpiGU E{(bf16*)(p.ws + WS_HID), wv};
    pg8::gemm_phase<pg8::EpiGU, pg8::MoeOrder, true, true, true>(lds, g, S, E, wv, gidx);
}
__device__ __forceinline__ void phase_moe_down(const Ptrs& p, LAS unsigned char* lds, int layer, int wv) {
    const int ntile = moe_build_ttab(p, lds, layer, wv);
    LAS int* ttab = (LAS int*)(lds + LDS_TTAB); LAS int* rowinfo = (LAS int*)(lds + LDS_GIDX);
    pg8::MoeOrder S{ttab, ntile, 4, (int)gridDim.x, (int)blockIdx.x};
    const int* IDX = (const int*)(p.ws + WS_IDX); const float* EW = (const float*)(p.ws + WS_EW);
    for (int i = 0; i < 3; ++i) {
        pg8::Unit u; if (!S.next(i, u)) break;
        const int e = ttab[u.pm * 4], fp = ttab[u.pm * 4 + 1], c = ttab[u.pm * 4 + 2];
        for (int r = otid(wv); r < 256; r += NT) {
            int ent = -1; float w = 0.f;
            if (fp + r < c) { ent = IDX[(size_t)e * MROWS + fp + r]; w = EW[ent]; }
            rowinfo[(i * 256 + r) * 2] = ent; rowinfo[(i * 256 + r) * 2 + 1] = __builtin_bit_cast(int, w);
        }
    }
    __syncthreads();
    pg8::Gemm g{(const bf16*)(p.ws + WS_HID), (const bf16*)(p.ws + WS_WD + layer * WD_STRIDE), ntile * 256, 32 * 1024, 256};
    pg8::EpiDown E{(bf16*)(p.ws + WS_Y0), (bf16*)(p.ws + WS_Y1), rowinfo, wv};
    pg8::gemm_phase<pg8::EpiDown, pg8::MoeOrder, true, true, false>(lds, g, S, E, wv);
}
__device__ __forceinline__ void phase_combine(const Ptrs& p, int layer, int nrows, bool do_norm, int wv) {
    const int lane = otid(wv) & 63, wave = wv;
    const int gw = blockIdx.x * NWAVES + wave, NGW = gridDim.x * NWAVES;
    const int per = (nrows + NGW - 1) / NGW;
    const int r0 = gw * per, r1 = min(r0 + per, nrows);
    const float* modl = (const float*)(p.ws + WS_MOD) + (size_t)layer * 9 * MODW;
    const float* modn = (const float*)(p.ws + WS_MOD) + (size_t)(layer + 1) * 9 * MODW;
    const float* g = p.in[I_N1G] + (layer + 1) * DM;
    const bf16* Y0 = (const bf16*)(p.ws + WS_Y0); const bf16* Y1 = (const bf16*)(p.ws + WS_Y1); bf16* H = (bf16*)(p.ws + WS_H);
    for (int r = r0; r < r1; ++r) {
        const int mrow = (r < NLAT) ? (r >> 11) : 8;
        float* xr = (r < NLAT) ? p.out + (size_t)r * DM : (float*)(p.ws + WS_XC) + (size_t)(r - NLAT) * DM;
        const float* m5 = modl + (size_t)mrow * MODW + 5 * DM;
        v4f v[4]; float s = 0.f;
#pragma unroll
        for (int j = 0; j < 4; ++j) {
            const int c = 4 * lane + 256 * j;
            const v4f x = *(const v4f*)(xr + c), mm = *(const v4f*)(m5 + c);
            const v2u a = *(const v2u*)(Y0 + (size_t)r * DM + c), b = *(const v2u*)(Y1 + (size_t)r * DM + c);
            v4f y; y.x = bflo(a.x) + bflo(b.x); y.y = bfhi(a.x) + bfhi(b.x); y.z = bflo(a.y) + bflo(b.y); y.w = bfhi(a.y) + bfhi(b.y);
            v[j] = x + mm * y;
            *(v4f*)(xr + c) = v[j];
            s += (v[j].x * v[j].x + v[j].y * v[j].y) + (v[j].z * v[j].z + v[j].w * v[j].w);
        }
        if (do_norm) {
            const float rstd = rsqrtf(wave_sum(s) * (1.f / DM) + 1e-6f);
            const float* mn = modn + (size_t)mrow * MODW;
#pragma unroll
            for (int j = 0; j < 4; ++j) {
                const int c = 4 * lane + 256 * j;
                const v4f gg = *(const v4f*)(g + c), sc = *(const v4f*)(mn + DM + c), sh = *(const v4f*)(mn + c);
                const v4f o = v[j] * rstd * (gg * (1.f + sc)) + sh; v2u w; w.x = pk2(o.x, o.y); w.y = pk2(o.z, o.w);
                *(v2u*)(H + (size_t)r * DM + c) = w;
            }
        }
    }
}

__device__ __forceinline__ void w_qknorm_rope(const Ptrs& p, int layer, int unit, int d) {
    const int row = unit / 18, slot = unit % 18;
    int col; const float* gain; bool rope;
    if (slot < 4) { col = A_Q + slot * 64; gain = p.in[I_NAQN] + layer * 64; rope = false; }
    else if (slot < 8) { col = A_K + (slot - 4) * 64; gain = p.in[I_NAKN] + layer * 64; rope = false; }
    else if (slot < 16) { col = B_Q + (slot - 8) * 64; gain = p.in[I_GQQN] + layer * 64; rope = true; }
    else { col = B_K + (slot - 16) * 64; gain = p.in[I_GQKN] + layer * 64; rope = true; }
    bf16* pp = (bf16*)(p.ws + WS_P) + (size_t)row * DIN + col;
    float x = bf2f(pp[d]);
    float ss = wave_sum(x * x);
    float y = x * rsqrtf(ss * (1.f / 64.f) + 1e-6f) * gain[d];
    if (rope && row < NLAT) {
        int t = row & (SEQ - 1);
        float partner = __shfl_xor(y, 1);
        int pi = d >> 1;
        float pos = (pi < 16) ? (float)(t >> 6) : (float)(t & 63);
        float inv = exp2f(-(float)(pi & 15) * (13.287712379549449f / 16.f));
        float ang = pos * inv;
        float cs = __cosf(ang), sn = __sinf(ang);
        y = (d & 1) ? (partner * sn + y * cs) : (y * cs - partner * sn);
    }
    pp[d] = (bf16)f2bf(y);
}
struct OnlineSm { float m, l, acc; };
__device__ __forceinline__ void sm_step(OnlineSm& st, float s, float v) {
    float mn = fmaxf(st.m, s);
    float corr = __expf(st.m - mn), pr = __expf(s - mn);
    st.l = st.l * corr + pr; st.acc = st.acc * corr + pr * v; st.m = mn;
}
__device__ __forceinline__ void w_attn_dense(const bf16* __restrict__ P, bf16* __restrict__ mix, int d, int qrow, int hq, int qcol, int kcol, int vcol, int ocol, int gdiv,
                                             int k0row, int nk0, int k1row, int nk1) {
    const int hk = hq / gdiv;
    float q = bf2f(P[(size_t)qrow * DIN + qcol + hq * 64 + d]) * 0.125f;
    OnlineSm st; st.m = -1e30f; st.l = 0.f; st.acc = 0.f;
    for (int j = 0; j < nk0; ++j) { const bf16* kr = P + (size_t)(k0row + j) * DIN; float s = wave_sum(q * bf2f(kr[kcol + hk * 64 + d])); sm_step(st, s, bf2f(kr[vcol + hk * 64 + d])); }
    for (int j = 0; j < nk1; ++j) { const bf16* kr = P + (size_t)(k1row + j) * DIN; float s = wave_sum(q * bf2f(kr[kcol + hk * 64 + d])); sm_step(st, s, bf2f(kr[vcol + hk * 64 + d])); }
    mix[(size_t)qrow * DM + ocol + hq * 64 + d] = (bf16)f2bf(st.acc / st.l);
}
__device__ __forceinline__ void w_attn_na(const bf16* __restrict__ P, const float* __restrict__ rpb, bf16* __restrict__ mix, int d, int b, int t, int h) {
    const int qrow = b * SEQ + t, r = t >> 6, qc = t & 63;
    float q = bf2f(P[(size_t)qrow * DIN + A_Q + h * 64 + d]) * 0.125f;
    OnlineSm st; st.m = -1e30f; st.l = 0.f; st.acc = 0.f;
    int rs = min(max(r - 4, 0), 32 - 8), cs = min(max(qc - 8, 0), 64 - 16);
    for (int jr = 0; jr < 8; ++jr) {
        int kr_ = rs + jr; int dr = kr_ - r + 7;
        for (int jc = 0; jc < 16; ++jc) {
            int kc = cs + jc; int dc = kc - qc + 15;
            const bf16* kr = P + (size_t)(b * SEQ + kr_ * 64 + kc) * DIN;
            float s = wave_sum(q * bf2f(kr[A_K + h * 64 + d])) + rpb[(h * 15 + dr) * 31 + dc];
            sm_step(st, s, bf2f(kr[A_V + h * 64 + d]));
        }
    }
    for (int j = 0; j < CTXL; ++j) {
        const bf16* kr = P + (size_t)(NLAT + b * CTXL + j) * DIN;
        float s = wave_sum(q * bf2f(kr[A_K + h * 64 + d]));
        sm_step(st, s, bf2f(kr[A_V + h * 64 + d]));
    }
    mix[(size_t)qrow * DM + h * 64 + d] = (bf16)f2bf(st.acc / st.l);
}
__device__ __forceinline__ void w_hgrn(const bf16* __restrict__ P, const float* __restrict__ lbl, float* __restrict__ obuf, int unit, int lane) {
    int b = unit >> 3, h = (unit >> 1) & 3, dir = unit & 1;
    float lbv = lbl[dir * 256 + h * 64 + lane];
    float Sst[64];
#pragma unroll
    for (int i = 0; i < 64; ++i) Sst[i] = 0.f;
    int fcol = (dir == 0 ? C_FF : C_FB) + h * 64;
    for (int step = 0; step < SEQ + CTXL; ++step) {
        int row;
        if (step < CTXL) row = NLAT + b * CTXL + (dir == 0 ? step : CTXL - 1 - step);
        else { int s2 = step - CTXL; row = b * SEQ + (dir == 0 ? s2 : SEQ - 1 - s2); }
        const bf16* pr = P + (size_t)row * DIN;
        float z = bf2f(pr[fcol + lane]);
        float qv = bf2f(pr[C_Q + h * 64 + lane]) * 0.125f;
        float vv = bf2f(pr[C_I + h * 64 + lane]);
        float sg = 1.f / (1.f + __expf(-z));
        float f = lbv + (1.f - lbv) * sg;
        float kk = (1.f - lbv) * (1.f - sg);
        float o = 0.f;
#pragma unroll
        for (int dd = 0; dd < 64; ++dd) {
            float fd = __shfl(f, dd), kd = __shfl(kk, dd), qd = __shfl(qv, dd);
            Sst[dd] = Sst[dd] * fd + kd * vv;
            o += qd * Sst[dd];
        }
        obuf[((size_t)dir * MROWS + row) * 256 + h * 64 + lane] = o;
    }
}
__device__ __forceinline__ void w_hgrn_out(const float* __restrict__ obuf, const bf16* __restrict__ P, const float* __restrict__ on, bf16* __restrict__ mix, int unit, int d) {
    int row = unit >> 2, h = unit & 3;
    float o = obuf[(size_t)row * 256 + h * 64 + d] + obuf[((size_t)MROWS + row) * 256 + h * 64 + d];
    float ss = wave_sum(o * o);
    float y = o * rsqrtf(ss * (1.f / 64.f) + 1e-6f) * on[d];
    float gt = bf2f(P[(size_t)row * DIN + C_G + h * 64 + d]);
    mix[(size_t)row * DM + 768 + h * 64 + d] = (bf16)f2bf(y * silu_f(gt));
}
__device__ __forceinline__ void phase_mixer_naive(const Ptrs& p, int layer, int wv) {
    const int lane = otid(wv) & 63, wave = wv;
    const int gw = wave * gridDim.x + blockIdx.x, NGW = gridDim.x * NWAVES;
    const bf16* P = (const bf16*)(p.ws + WS_P); bf16* MIX = (bf16*)(p.ws + WS_MIX);
    const int n_h = 64, n_na = NBATCH * 4 * SEQ, n_gq = NBATCH * 8 * SEQ, n_nc = (layer == 0) ? NBATCH * 4 * CTXL : 0, n_gc = (layer == 0) ? NBATCH * 8 * CTXL : 0;
    const int total = n_h + n_na + n_gq + n_nc + n_gc;
    for (int u0 = gw; u0 < total; u0 += NGW) {
        int u = u0;
        if (u < n_h) { w_hgrn(P, (const float*)(p.ws + WS_LB) + layer * 512, (float*)(p.ws + WS_SCR), u, lane); continue; } u -= n_h;
        if (u < n_na) { const int t = u & 2047, h = (u >> 11) & 3, b = u >> 13; w_attn_na(P, p.in[I_RPB] + (size_t)layer * 4 * 15 * 31, MIX, lane, b, t, h); continue; } u -= n_na;
        if (u < n_gq) { const int t = u & 2047, h = (u >> 11) & 7, b = u >> 14; w_attn_dense(P, MIX, lane, b * SEQ + t, h, B_Q, B_K, B_V, 256, 4, b * SEQ, SEQ, NLAT + b * CTXL, CTXL); continue; } u -= n_gq;
        if (u < n_nc) { const int t = u & 255, h = (u >> 8) & 3, b = u >> 10; w_attn_dense(P, MIX, lane, NLAT + b * CTXL + t, h, A_Q, A_K, A_V, 0, 1, NLAT + b * CTXL, CTXL, 0, 0); continue; } u -= n_nc;
        { const int t = u & 255, h = (u >> 8) & 7, b = u >> 11; w_attn_dense(P, MIX, lane, NLAT + b * CTXL + t, h, B_Q, B_K, B_V, 256, 4, NLAT + b * CTXL, CTXL, 0, 0); }
    }
}

__global__ void __launch_bounds__(NT, 2) k_mega(Ptrs p) {
    extern __shared__ __attribute__((aligned(16))) unsigned char lds_raw[];
    LAS unsigned char* lds = (LAS unsigned char*)lds_raw;
    cg::grid_group grid = cg::this_grid();
    const int wv = __builtin_amdgcn_readfirstlane(threadIdx.x >> 6);
    const int NGW = gridDim.x * NWAVES;
    phase_mod(p, lds, wv);
    phase_lb(p, wv);
    __syncthreads();
    phase_convert(p, lds, 0, 2, wv);
    phase_router_w(p, wv);
    grid.sync();
    phase_norm(p.in[I_X], p.in[I_CTX], p.in[I_N1G], (const float*)(p.ws + WS_MOD), 0, 1, (bf16*)(p.ws + WS_H), MROWS, wv);
    grid.sync();
    for (int layer = 0; layer < 2; ++layer) {
        const int M = (layer == 0) ? MROWS : NLAT;
        const float* modl = (const float*)(p.ws + WS_MOD) + (size_t)layer * 9 * MODW;
        {
            pg8::Gemm g{(const bf16*)(p.ws + WS_H), (const bf16*)(p.ws + WS_WIN + layer * WIN_STRIDE), MROWS, DIN, DM};
            pg8::StaticOrder S; S.init(MROWS, DIN, gridDim.x, (int)blockIdx.x);
            pg8::EpiBf16<0> E{(bf16*)(p.ws + WS_P), DIN, nullptr, 0, 0, 1.f};
            pg8::gemm_phase<pg8::EpiBf16<0>, pg8::StaticOrder, true, true>(lds, g, S, E, wv);
        }
        grid.sync();
        { const int lane = otid(wv) & 63; for (int u = blockIdx.x * NWAVES + wv; u < MROWS * 18; u += NGW) w_qknorm_rope(p, layer, u, lane); }
        grid.sync();
        phase_mixer_naive(p, layer, wv);
        grid.sync();
        { const int lane = otid(wv) & 63; for (int u = blockIdx.x * NWAVES + wv; u < M * 4; u += NGW) w_hgrn_out((const float*)(p.ws + WS_SCR), (const bf16*)(p.ws + WS_P), p.in[I_HGON] + layer * 64, (bf16*)(p.ws + WS_MIX), u, lane); }
        grid.sync();
        {
            pg8::Gemm g{(const bf16*)(p.ws + WS_MIX), (const bf16*)(p.ws + WS_WOUT + layer * WOUT_STRIDE), M, DM, DM};
            pg8::StaticOrder S; S.init(M, DM, gridDim.x, (int)blockIdx.x);
            pg8::EpiResidSS E{layer == 0 ? p.in[I_X] : p.out, p.in[I_CTX], p.out, (float*)(p.ws + WS_XC), modl, 2, (float*)(p.ws + WS_RSS), wv};
            pg8::gemm_phase<pg8::EpiResidSS, pg8::StaticOrder, true, true>(lds, g, S, E, wv);
        }
        grid.sync();
        phase_route(p, lds, layer, M, wv);
        grid.sync();
        phase_moe_gu(p, lds, layer, wv);
        grid.sync();
        phase_moe_down(p, lds, layer, wv);
        grid.sync();
        phase_combine(p, layer, M, layer == 0, wv);
        if (layer == 0) grid.sync();
    }
}

extern "C" void kernel_launch(void* const* d_in, const int* in_sizes, int n_in, void* d_out, int out_size, void* d_ws, size_t ws_size, hipStream_t stream) {
    static int grid = 0;
    if (grid == 0) {
        if (n_in != 24 || ws_size < WS_END) { fprintf(stderr, "kernel_launch: bad n_in %d or ws_size %zu < %zu\n", n_in, ws_size, (size_t)WS_END); grid = -1; return; }
        int dev = 0, cus = 0, per_cu = 0;
        hipGetDevice(&dev); hipDeviceGetAttribute(&cus, hipDeviceAttributeMultiprocessorCount, dev);
        hipFuncSetAttribute((const void*)k_mega, hipFuncAttributeMaxDynamicSharedMemorySize, LDS_BYTES);
        hipOccupancyMaxActiveBlocksPerMultiprocessor(&per_cu, (const void*)k_mega, NT, LDS_BYTES);
        if (per_cu < 1) { fprintf(stderr, "kernel_launch: occupancy query says %d blocks/CU\n", per_cu); grid = -1; return; }
        grid = cus;
        (void)hipGetLastError();
    }
    if (grid < 0) return;
    Ptrs p{};
    for (int i = 0; i < 24; ++i) p.in[i] = (const float*)d_in[i];
    p.out = (float*)d_out; p.ws = (unsigned char*)d_ws; p.layer = 0; p.pad = 0;
    hipMemsetAsync((unsigned char*)d_ws + WS_CTL, 0, 1 * MiB, stream);
    void* args[] = {&p};
    hipError_t e = hipLaunchCooperativeKernel((const void*)k_mega, dim3(grid), dim3(NT), args, LDS_BYTES, stream);
    if (e != hipSuccess) fprintf(stderr, "cooperative launch failed: %s\n", hipGetErrorString(e));
}
```

```cpp
#include <hip/hip_runtime.h>
#include <hip/hip_cooperative_groups.h>
#include <cstdio>
#include <cstdint>
#include <math.h>
namespace cg = cooperative_groups;

#define DM 1024
#define SEQ 2048
#define CTXL 256
#define NBATCH 8
#define NLAT (NBATCH * SEQ)
#define NCTX (NBATCH * CTXL)
#define MROWS (NLAT + NCTX)
#define DIN 2816
#define NMOD 6
#define MODW (NMOD * DM)
#define A_Q 0
#define A_K 256
#define A_V 512
#define B_Q 768
#define B_K 1280
#define B_V 1408
#define C_Q 1536
#define C_I 1792
#define C_FF 2048
#define C_FB 2304
#define C_G 2560

typedef unsigned short bf16;
#define LAS __attribute__((address_space(3)))
#define GAS __attribute__((address_space(1)))
typedef unsigned v4u __attribute__((ext_vector_type(4)));
typedef unsigned v2u __attribute__((ext_vector_type(2)));
typedef float v4f __attribute__((ext_vector_type(4)));

__device__ __forceinline__ unsigned f2bf(float f) { unsigned u = __builtin_bit_cast(unsigned, f); return (u + 0x7fffu + ((u >> 16) & 1u)) >> 16; }
__device__ __forceinline__ unsigned pk2(float lo, float hi) { return f2bf(lo) | (f2bf(hi) << 16); }
__device__ __forceinline__ float bf2f(unsigned short v) { return __builtin_bit_cast(float, (unsigned)v << 16); }
__device__ __forceinline__ float bflo(unsigned v) { return __builtin_bit_cast(float, v << 16); }
__device__ __forceinline__ float bfhi(unsigned v) { return __builtin_bit_cast(float, v & 0xffff0000u); }
__device__ __forceinline__ float silu_f(float x) { return x / (1.f + __expf(-x)); }
__device__ __forceinline__ float shx(float v, int mask, int lane) { return __builtin_bit_cast(float, __builtin_amdgcn_ds_bpermute((lane ^ mask) << 2, __builtin_bit_cast(int, v))); }
__device__ __forceinline__ float wave_sum(float v, int lane) {
#pragma unroll
    for (int o = 1; o < 64; o <<= 1) v += shx(v, o, lane);
    return v;
}
__device__ __forceinline__ int otid(int wv) { unsigned m = ~0u; asm volatile("" : "+s"(m)); asm volatile("" : "+s"(wv)); return wv * 64 + (int)__builtin_amdgcn_mbcnt_hi(m, __builtin_amdgcn_mbcnt_lo(m, 0u)); }
#define LDS_WAIT() asm volatile("s_waitcnt lgkmcnt(0)" ::: "memory")

constexpr size_t MiB = 1u << 20;
constexpr size_t WS_CTL = 0;
constexpr size_t WS_MOD = 1 * MiB;
constexpr size_t WS_LB = 1 * MiB + 512 * 1024;
constexpr size_t WS_EID = 2 * MiB;
constexpr size_t WS_EW = 2 * MiB + 256 * 1024;
constexpr size_t WS_IDX = 3 * MiB;
constexpr size_t WS_XC = 8 * MiB;
constexpr size_t WS_WIN = 16 * MiB;
constexpr size_t WIN_STRIDE = (size_t)DIN * DM * 2;
constexpr size_t WS_WOUT = 28 * MiB;
constexpr size_t WOUT_STRIDE = 2 * MiB;
constexpr size_t WS_WGU = 32 * MiB;
constexpr size_t WGU_STRIDE = 32 * MiB;
constexpr size_t WS_WD = 96 * MiB;
constexpr size_t WD_STRIDE = 16 * MiB;
constexpr size_t WS_H = 128 * MiB;
constexpr size_t WS_MIX = 164 * MiB;
constexpr size_t WS_P = 200 * MiB;
constexpr size_t WS_Y0 = 200 * MiB;
constexpr size_t WS_Y1 = 236 * MiB;
constexpr size_t WS_HID = 272 * MiB;
constexpr size_t WS_SCR = 300 * MiB;
constexpr size_t WS_END = 340 * MiB;

constexpr int NT = 512, NWAVES = 8;
constexpr int LDS_BYTES = 147456;
namespace pg8 {
#define PG8_LAS __attribute__((address_space(3)))
typedef unsigned short bf16_t;
typedef short bf16x8 __attribute__((ext_vector_type(8)));
typedef float f32x4 __attribute__((ext_vector_type(4)));
typedef unsigned u32x4 __attribute__((ext_vector_type(4)));
constexpr int BM = 256, BK = 64, HALF = 128, HTB = HALF * BK * 2  , STAGE_BYTES = 8 * HTB, NXCD = 8, WGM = 8;

__host__ __device__ __forceinline__ int lds_byte(int r, int c) { const int st = (r >> 4) * 2 + (c >> 5), rr = r & 15, cc = c & 31, ob = rr * 64 + cc * 2; return st * 1024 + (ob ^ (((ob >> 9) & 1) << 5)); }
__host__ __device__ __forceinline__ void stage_rc(int b, int& R, int& C) { const int st = b / 1024, sb = b % 1024, swz = sb ^ (((sb >> 9) & 1) << 5); R = (st >> 1) * 16 + swz / 64; C = (st & 1) * 32 + (swz % 64) / 2; }
__host__ __device__ __forceinline__ int perm32(int rho) { const int n = rho >> 4, i = rho & 15; return 8 * (i >> 2) + 4 * n + (i & 3); }

struct Unit { int pm, pn, aux; };
struct Gemm { const bf16_t* A; const bf16_t* Bt; int M, N, K; };

struct StaticOrder {
    int nM, nN, nwg, G, c;
    __host__ __device__ void init(int M, int N, int G_, int c_) { nM = M / BM; nN = N / BM; nwg = nM * nN; G = G_; c = c_; }
    __host__ __device__ bool next(int i, Unit& u) const {
        const long L = (long)i * G + c; if (L >= nwg) return false;
        int wgid = (int)L; { const int q = nwg / NXCD, r = nwg % NXCD, xcd = wgid % NXCD, off = wgid / NXCD; wgid = (xcd < r ? xcd * (q + 1) : r * (q + 1) + (xcd - r) * q) + off; }
        const int nig = WGM * nN, gid = wgid / nig, fm = gid * WGM, gsz = (nM - fm) < WGM ? (nM - fm) : WGM;
        u.pm = fm + ((wgid % nig) % gsz); u.pn = (wgid % nig) / gsz; return true;
    }
    __device__ __forceinline__ void a_ready(const Unit&) const {}
    __device__ __forceinline__ void done(const Unit&) const {}
};

__device__ __forceinline__ unsigned cvt_pk_bf16(float lo, float hi) { unsigned r; asm volatile("v_cvt_pk_bf16_f32 %0, %1, %2" : "=v"(r) : "v"(lo), "v"(hi)); return r; }
typedef float f32x2 __attribute__((ext_vector_type(2)));
__device__ __forceinline__ f32x2 gelu_pk(f32x2 v) {
    const f32x2 av = __builtin_elementwise_abs(v), d = av * 0.2316418882f + 1.0f;
    f32x2 t; t.x = __builtin_amdgcn_rcpf(d.x); t.y = __builtin_amdgcn_rcpf(d.y);
    f32x2 q = t * 0.5307027145f + (-0.7265760135f); q = q * t + 0.7107068705f; q = q * t + (-0.142248368f); q = q * t + 0.127414796f; q = q * t;
    const f32x2 s = (v * v) * (-0.72134752044f);
    f32x2 e; e.x = __builtin_amdgcn_exp2f(s.x); e.y = __builtin_amdgcn_exp2f(s.y);
    const f32x2 m = v * (q * e), r = v - m;
    f32x2 o; o.x = v.x < 0.f ? m.x : r.x; o.y = v.y < 0.f ? m.y : r.y; return o;
}

template <int ACT  > struct EpiBf16 {
    static constexpr bool PERM = true, AFTER_DRAIN = false; static_assert(ACT == 0 || ACT == 1, "EpiBf16: ACT is 0 (none) or 1 (gelu_pk)");
    bf16_t* O; int ldc; const float* bias; int split_cols; size_t split_stride; float scale0;
    __device__ __forceinline__ void operator()(const f32x4 (&acc)[2][2][4][2], const Unit& u, int wr, int wc, int fr, int fq) const {
        const int row0 = u.pm * BM + wr * 64 + fr; int colt = u.pn * BM; bf16_t* base = O;
        float sc = 1.f; if (split_cols) { const int t = colt / split_cols; base += (size_t)t * split_stride; colt -= t * split_cols; if (t == 0) sc = scale0; }
        const int col0 = colt + wc * 32 + 8 * fq, bcol0 = u.pn * BM + wc * 32 + 8 * fq;
        f32x4 bv[2][2];
#pragma unroll
        for (int bj = 0; bj < 2; ++bj)
#pragma unroll
            for (int n = 0; n < 2; ++n) bv[bj][n] = bias ? *(const f32x4*)(bias + bcol0 + bj * HALF + 4 * n) : (f32x4){0.f, 0.f, 0.f, 0.f};
#pragma unroll
        for (int ai = 0; ai < 2; ++ai)
#pragma unroll
            for (int m = 0; m < 4; ++m) { bf16_t* rowp = base + (size_t)(row0 + ai * HALF + m * 16) * ldc + col0;
#pragma unroll
                for (int bj = 0; bj < 2; ++bj) { f32x4 v0 = acc[ai][bj][m][0] + bv[bj][0], v1 = acc[ai][bj][m][1] + bv[bj][1];
                    if (ACT == 1) { f32x2 a = gelu_pk((f32x2){v0[0], v0[1]}), b = gelu_pk((f32x2){v0[2], v0[3]}), c = gelu_pk((f32x2){v1[0], v1[1]}), d = gelu_pk((f32x2){v1[2], v1[3]});
                        v0 = (f32x4){a.x, a.y, b.x, b.y}; v1 = (f32x4){c.x, c.y, d.x, d.y}; }
                    v0 = v0 * sc; v1 = v1 * sc; u32x4 w; w.x = cvt_pk_bf16(v0[0], v0[1]); w.y = cvt_pk_bf16(v0[2], v0[3]); w.z = cvt_pk_bf16(v1[0], v1[1]); w.w = cvt_pk_bf16(v1[2], v1[3]);
                    *(u32x4*)(rowp + bj * HALF) = w; } }
    }
};

template <class Epi, class Sched, bool ALIGN_EPI = false, bool SP2 = false, bool GATHER = false>
__device__ __forceinline__ void gemm_phase(PG8_LAS unsigned char* lds, const Gemm g, const Sched& S, const Epi& E, int wv, const PG8_LAS int* gidx = nullptr) {
    static_assert(SP2 || !GATHER, "GATHER is wired into the SP2 loop only");
    int tid_ = otid(wv);
    const int tid = tid_, wid = __builtin_amdgcn_readfirstlane(tid >> 6), lane = tid & 63, wr = wid >> 2, wc = wid & 3, fr = lane & 15, fq = lane >> 4;
    const int K = g.K, nt = K / BK;
    unsigned voffA[2][2], nvoffA[2][2], voffB[2]; int RA[2], CA[2];
#pragma unroll
    for (int i = 0; i < 2; ++i) { int R, C; stage_rc(tid * 16 + i * 8192, R, C); const int Rb = Epi::PERM ? ((R & ~31) + perm32(R & 31)) : R; RA[i] = R; CA[i] = C;
        voffA[0][i] = voffA[1][i] = nvoffA[0][i] = nvoffA[1][i] = (unsigned)(R * K + C) * 2u; voffB[i] = (unsigned)(Rb * K + C) * 2u; }
#define PG8_GVOFF(dst, uidx) do { if constexpr (GATHER) { _Pragma("unroll") for (int _h = 0; _h < 2; ++_h) _Pragma("unroll") for (int _i = 0; _i < 2; ++_i) dst[_h][_i] = (unsigned)(gidx[(uidx) * 256 + _h * 128 + RA[_i]] * K + CA[_i]) * 2u; } } while (0)
    const size_t kstep = (size_t)(BK * 2);
    const size_t hstep = (size_t)HALF * K * 2;
    const size_t hstepA = GATHER ? (size_t)0 : hstep;
    const size_t tstep = 2 * hstep;
    const unsigned ldsw = (unsigned)wid * 1024u;
    const int aoff = lds_byte(wr * 64 + fr, fq * 8), boff = lds_byte(wc * 32 + fr, fq * 8);
#define PG8_SA(b, h) (((b) * 2 + (h)) * HTB)
#define PG8_SB(b, h) ((4 + (b) * 2 + (h)) * HTB)
#define PG8_STAGE(bufoff, gbase, voff) do { _Pragma("unroll") for (int _i = 0; _i < 2; ++_i) \
        __builtin_amdgcn_global_load_lds((const unsigned*)((const char*)(gbase) + (voff)[_i]), (PG8_LAS unsigned*)(lds + (bufoff) + ldsw + _i * 8192), 16, 0, 0); } while (0)
#define PG8_LDA(dst, b, h) do { _Pragma("unroll") for (int m = 0; m < 4; ++m) _Pragma("unroll") for (int k = 0; k < 2; ++k) dst[m][k] = *(const PG8_LAS bf16x8*)(lds + PG8_SA(b, h) + aoff + m * 2048 + k * 1024); } while (0)
#define PG8_LDB(dst, b, h) do { _Pragma("unroll") for (int n = 0; n < 2; ++n) _Pragma("unroll") for (int k = 0; k < 2; ++k) dst[n][k] = *(const PG8_LAS bf16x8*)(lds + PG8_SB(b, h) + boff + n * 2048 + k * 1024); } while (0)
#define PG8_MMA(ai, bj, At, Bt) do { __builtin_amdgcn_s_setprio(1); _Pragma("unroll") for (int m = 0; m < 4; ++m) _Pragma("unroll") for (int n = 0; n < 2; ++n) _Pragma("unroll") for (int k = 0; k < 2; ++k) \
        acc[ai][bj][m][n] = __builtin_amdgcn_mfma_f32_16x16x32_bf16(Bt[n][k], At[m][k], acc[ai][bj][m][n], 0, 0, 0); __builtin_amdgcn_s_setprio(0); } while (0)
#define PG8_WAIT_V(n) asm volatile("s_waitcnt vmcnt(" #n ")" ::: "memory")
#define PG8_WAIT_L(n) asm volatile("s_waitcnt lgkmcnt(" #n ")" ::: "memory")
#define PG8_BAR __builtin_amdgcn_s_barrier()
#define PG8_SCHED __builtin_amdgcn_sched_barrier(0)
    Unit cur, nxt; int ui = 0;
    if (!S.next(0, cur)) return;
    f32x4 acc[2][2][4][2];
#pragma unroll
    for (int a = 0; a < 2; ++a)
#pragma unroll
        for (int b = 0; b < 2; ++b)
#pragma unroll
            for (int m = 0; m < 4; ++m)
#pragma unroll
                for (int n = 0; n < 2; ++n) acc[a][b][m][n] = (f32x4){0.f, 0.f, 0.f, 0.f};
    bf16x8 At[4][2], B0[2][2], B1[2][2];
    const char* cA = (const char*)g.A + (GATHER ? (size_t)0 : (size_t)cur.pm * tstep); PG8_GVOFF(voffA, 0); const char* cB = (const char*)g.Bt + (size_t)cur.pn * tstep;
    S.a_ready(cur);
    if constexpr (SP2) {
        PG8_STAGE(PG8_SB(0, 0), cB, voffB); PG8_STAGE(PG8_SB(0, 1), cB + hstep, voffB); PG8_STAGE(PG8_SA(0, 0), cA, voffA[0]); PG8_STAGE(PG8_SA(0, 1), cA + hstepA, voffA[1]);
        if (wr == 1) PG8_BAR;
        PG8_WAIT_V(2); PG8_BAR;
        PG8_STAGE(PG8_SB(1, 0), cB + kstep, voffB); PG8_STAGE(PG8_SA(1, 0), cA + kstep, voffA[0]); PG8_STAGE(PG8_SB(1, 1), cB + hstep + kstep, voffB);
        PG8_WAIT_V(6); PG8_BAR;
    } else {
        PG8_STAGE(PG8_SB(0, 0), cB, voffB); PG8_STAGE(PG8_SA(0, 0), cA, voffA[0]); PG8_STAGE(PG8_SB(0, 1), cB + hstep, voffB); PG8_STAGE(PG8_SA(0, 1), cA + hstep, voffA[0]);
        if (wr == 1) PG8_BAR;
        PG8_WAIT_V(4); PG8_BAR;
        PG8_STAGE(PG8_SB(1, 0), cB + kstep, voffB); PG8_STAGE(PG8_SA(1, 0), cA + kstep, voffA[0]); PG8_STAGE(PG8_SB(1, 1), cB + hstep + kstep, voffB);
        PG8_WAIT_V(6); PG8_BAR;
    }
    for (;;) {
        const bool has_next = S.next(ui + 1, nxt);
        const char* nA = (has_next && !GATHER) ? (const char*)g.A + (size_t)nxt.pm * tstep : cA; if (has_next) PG8_GVOFF(nvoffA, ui + 1); const char* nB = has_next ? (const char*)g.Bt + (size_t)nxt.pn * tstep : cB;
        for (int t = 0; t < nt; t += 2) {
            const bool last = (t == nt - 2);
            const char* a1 = cA + (size_t)(t + 1) * kstep;
            const char* a2 = last ? nA : cA + (size_t)(t + 2) * kstep; const char* b2 = last ? nB : cB + (size_t)(t + 2) * kstep;
            const char* a3 = a2 + kstep; const char* b3 = b2 + kstep;
            if (last && has_next) S.a_ready(nxt);
            unsigned vs2[2][2];
#pragma unroll
            for (int _h = 0; _h < 2; ++_h)
#pragma unroll
                for (int _i = 0; _i < 2; ++_i) vs2[_h][_i] = last ? nvoffA[_h][_i] : voffA[_h][_i];
            if constexpr (SP2) {
            PG8_LDB(B0, 0, 0); PG8_LDB(B1, 0, 1); PG8_SCHED; PG8_LDA(At, 0, 0); PG8_STAGE(PG8_SA(1, 1), a1 + hstepA, voffA[1]);
            PG8_WAIT_V(8); PG8_WAIT_L(0); PG8_BAR; PG8_MMA(0, 0, At, B0); PG8_MMA(0, 1, At, B1); PG8_BAR; PG8_SCHED;
            PG8_LDA(At, 0, 1); PG8_STAGE(PG8_SB(0, 0), b2, voffB); PG8_STAGE(PG8_SB(0, 1), b2 + hstep, voffB); PG8_STAGE(PG8_SA(0, 0), a2, vs2[0]);
            PG8_WAIT_V(8); PG8_WAIT_L(0); PG8_BAR; PG8_MMA(1, 0, At, B0); PG8_MMA(1, 1, At, B1); PG8_BAR; PG8_SCHED;
            PG8_LDB(B0, 1, 0); PG8_LDB(B1, 1, 1); PG8_SCHED; PG8_LDA(At, 1, 0); PG8_STAGE(PG8_SA(0, 1), a2 + hstepA, vs2[1]);
            PG8_WAIT_V(8); PG8_WAIT_L(0); PG8_BAR; PG8_MMA(0, 0, At, B0); PG8_MMA(0, 1, At, B1); PG8_BAR; PG8_SCHED;
            PG8_LDA(At, 1, 1); PG8_STAGE(PG8_SB(1, 0), b3, voffB); PG8_STAGE(PG8_SB(1, 1), b3 + hstep, voffB); PG8_STAGE(PG8_SA(1, 0), a3, vs2[0]);
            PG8_WAIT_V(8); PG8_WAIT_L(0); PG8_BAR; PG8_MMA(1, 0, At, B0); PG8_MMA(1, 1, At, B1); PG8_BAR; PG8_SCHED;
            } else {
            PG8_LDB(B0, 0, 0); PG8_SCHED; PG8_LDA(At, 0, 0); PG8_STAGE(PG8_SA(1, 1), a1 + hstep, voffA[0]);
            PG8_WAIT_L(8); PG8_BAR; PG8_WAIT_L(0); PG8_MMA(0, 0, At, B0); PG8_BAR; PG8_SCHED;
            PG8_LDB(B1, 0, 1); PG8_STAGE(PG8_SB(0, 0), b2, voffB);
            PG8_BAR; PG8_WAIT_L(0); PG8_MMA(0, 1, At, B1); PG8_BAR;
            PG8_LDA(At, 0, 1); PG8_STAGE(PG8_SA(0, 0), a2, voffA[0]);
            PG8_BAR; PG8_WAIT_L(0); PG8_MMA(1, 0, At, B0); PG8_BAR; PG8_SCHED;
            PG8_STAGE(PG8_SB(0, 1), b2 + hstep, voffB);
            PG8_WAIT_V(6); PG8_BAR; PG8_MMA(1, 1, At, B1); PG8_BAR;
            PG8_LDB(B0, 1, 0); PG8_SCHED; PG8_LDA(At, 1, 0); PG8_STAGE(PG8_SA(0, 1), a2 + hstep, voffA[0]);
            PG8_WAIT_L(8); PG8_BAR; PG8_WAIT_L(0); PG8_MMA(0, 0, At, B0); PG8_BAR; PG8_SCHED;
            PG8_LDB(B1, 1, 1); PG8_STAGE(PG8_SB(1, 0), b3, voffB);
            PG8_BAR; PG8_WAIT_L(0); PG8_MMA(0, 1, At, B1); PG8_BAR;
            PG8_LDA(At, 1, 1); PG8_STAGE(PG8_SA(1, 0), a3, voffA[0]);
            PG8_BAR; PG8_WAIT_L(0); PG8_MMA(1, 0, At, B0); PG8_BAR; PG8_SCHED;
            PG8_STAGE(PG8_SB(1, 1), b3 + hstep, voffB);
            PG8_WAIT_V(6); PG8_BAR; PG8_MMA(1, 1, At, B1); PG8_BAR;
            }
        }
        if constexpr (ALIGN_EPI) { if (wr == 0) PG8_BAR; }
        if constexpr (!Epi::AFTER_DRAIN) { E(acc, cur, wr, wc, fr, fq); S.done(cur); }
        if (!has_next) break;
#pragma unroll
        for (int a = 0; a < 2; ++a)
#pragma unroll
            for (int b = 0; b < 2; ++b)
#pragma unroll
                for (int m = 0; m < 4; ++m)
#pragma unroll
                    for (int n = 0; n < 2; ++n) acc[a][b][m][n] = (f32x4){0.f, 0.f, 0.f, 0.f};
        cur = nxt; cA = nA; cB = nB; ++ui;
#pragma unroll
        for (int _h = 0; _h < 2; ++_h)
#pragma unroll
            for (int _i = 0; _i < 2; ++_i) voffA[_h][_i] = nvoffA[_h][_i];
        if constexpr (ALIGN_EPI) { if (wr == 1) PG8_BAR; }
    }
    PG8_WAIT_V(0);
    if constexpr (!ALIGN_EPI) { if (wr == 0) PG8_BAR; }
    PG8_BAR;
    if constexpr (Epi::AFTER_DRAIN) { E.fused(acc, cur, wr, wc, fr, fq, lds, wid, lane); S.done(cur); }
#undef PG8_SA
#undef PG8_GVOFF
#undef PG8_SB
#undef PG8_STAGE
#undef PG8_LDA
#undef PG8_LDB
#undef PG8_MMA
#undef PG8_WAIT_V
#undef PG8_WAIT_L
#undef PG8_BAR
#undef PG8_SCHED
}
}


struct Ptrs { const float* in[24]; float* out; unsigned char* ws; int layer; int pad; };
enum { I_X = 0, I_C, I_CTX, I_CCTX, I_WADA, I_BADA, I_N1G, I_WIN, I_NAQN, I_NAKN, I_RPB, I_GQQN, I_GQKN, I_LB, I_HGON, I_WOUT, I_N2G, I_WRG, I_BRG, I_WRE, I_BRE, I_WEG, I_WEU, I_WED };

namespace pg8 {
struct EpiResid {
    static constexpr bool PERM = false, AFTER_DRAIN = false;
    const float* xin_lat; const float* xin_ctx; float* xout_lat; float* xout_ctx; const float* modl; int chunk;
    __device__ __forceinline__ void operator()(const f32x4 (&acc)[2][2][4][2], const Unit& u, int wr, int wc, int fr, int fq) const {
        const int rowt = u.pm * BM; const bool isctx = rowt >= NLAT;
        const float* xin = isctx ? xin_ctx + (size_t)(rowt - NLAT) * DM : xin_lat + (size_t)rowt * DM;
        float* xo = isctx ? xout_ctx + (size_t)(rowt - NLAT) * DM : xout_lat + (size_t)rowt * DM;
        const int mrow = isctx ? 8 : (rowt >> 11);
        const float* gate = modl + (size_t)mrow * MODW + chunk * DM;
        const int col0 = u.pn * BM + wc * 32 + 4 * fq;
#pragma unroll
        for (int bj = 0; bj < 2; ++bj)
#pragma unroll
            for (int n = 0; n < 2; ++n) {
                const int col = col0 + bj * HALF + n * 16;
                const f32x4 gv = *(const f32x4*)(gate + col);
#pragma unroll
                for (int ai = 0; ai < 2; ++ai)
#pragma unroll
                    for (int m = 0; m < 4; ++m) {
                        const size_t off = (size_t)(ai * HALF + wr * 64 + m * 16 + fr) * DM + col;
                        const f32x4 xi = *(const f32x4*)(xin + off);
                        *(f32x4*)(xo + off) = xi + gv * acc[ai][bj][m][n];
                    }
            }
    }
};
}

__device__ __forceinline__ void phase_mod(const Ptrs& p, LAS unsigned char* lds, int wv) {
    if (blockIdx.x >= 192) return;
    LAS float* sc = (LAS float*)lds;
    LAS float* red = (LAS float*)(lds + 36864);
    const int tid = otid(wv);
    const float* c = p.in[I_C]; const float* cc = p.in[I_CCTX];
    for (int i = tid; i < 9 * DM; i += NT) { float v = (i < 8 * DM) ? c[i] : cc[i - 8 * DM]; sc[i] = silu_f(v); }
    __syncthreads();
    float* mod = (float*)(p.ws + WS_MOD);
    for (int u = blockIdx.x; u < 192; u += gridDim.x) {
        const int layer = u / 96, cb = u % 96, cq = tid & 15, kg = tid >> 4;
        const float* w = p.in[I_WADA] + (size_t)layer * DM * MODW + cb * 64 + cq * 4;
        v4f acc[9];
#pragma unroll
        for (int r = 0; r < 9; ++r) acc[r] = (v4f){0.f, 0.f, 0.f, 0.f};
        for (int i = 0; i < 32; ++i) {
            const int k = kg + 32 * i;
            const v4f wv = *(const v4f*)(w + (size_t)k * MODW);
#pragma unroll
            for (int r = 0; r < 9; ++r) acc[r] += sc[r * DM + k] * wv;
        }
#pragma unroll
        for (int r = 0; r < 9; ++r) *(LAS v4f*)(red + (kg * 9 + r) * 64 + cq * 4) = acc[r];
        __syncthreads();
        for (int o = tid; o < 576; o += NT) {
            const int r = o >> 6, c2 = o & 63; float s = 0.f;
            for (int k2 = 0; k2 < 32; ++k2) s += red[(k2 * 9 + r) * 64 + c2];
            mod[((size_t)layer * 9 + r) * MODW + cb * 64 + c2] = s + p.in[I_BADA][layer * MODW + cb * 64 + c2];
        }
        __syncthreads();
    }
}
__device__ __forceinline__ void phase_lb(const Ptrs& p, int wv) {
    if (blockIdx.x == 255 % gridDim.x) {
        const int i = otid(wv);
        const float* raw = p.in[I_LB]; float* lb = (float*)(p.ws + WS_LB);
        float l0 = raw[i], l1 = raw[512 + i];
        lb[i] = 0.f; lb[512 + i] = 1.f / (1.f + __expf(l0 - l1));
    }
}
__device__ __forceinline__ void transpose_item(const float* W, int K, int N, bf16* WT, int row_off, LAS float* scr, int item, int lane) {
    const int nblk = N / 32, kb = item / nblk, nb = item % nblk, k0 = 64 * kb, n0 = 32 * nb;
#pragma unroll 8
    for (int i = 0; i < 32; ++i) { const int kk = 2 * i + (lane >> 5); scr[kk * 33 + (lane & 31)] = W[(size_t)(k0 + kk) * N + n0 + (lane & 31)]; }
    LDS_WAIT(); asm volatile("" ::: "memory");
    const int c = lane & 7;
#pragma unroll
    for (int j = 0; j < 4; ++j) { const int n = (lane >> 3) + 8 * j; const LAS float* s = scr + (8 * c) * 33 + n;
        v4u o; o.x = pk2(s[0 * 33], s[1 * 33]); o.y = pk2(s[2 * 33], s[3 * 33]); o.z = pk2(s[4 * 33], s[5 * 33]); o.w = pk2(s[6 * 33], s[7 * 33]);
        *(v4u*)(WT + (size_t)(row_off + n0 + n) * K + k0 + 8 * c) = o; }
    LDS_WAIT(); asm volatile("" ::: "memory");
}
constexpr int CI_IN = 16 * 88, CI_OUT = 16 * 32, CI_G = 32 * 128, CI_U = 32 * 128, CI_D = 32 * 128, CI_LAYER = CI_IN + CI_OUT + CI_G + CI_U + CI_D;
__device__ __forceinline__ void phase_convert(const Ptrs& p, LAS unsigned char* lds, int layer_lo, int layer_hi, int wv) {
    const int lane = otid(wv) & 63, wave = wv;
    LAS float* scr = (LAS float*)(lds + wave * 16384);
    const int gw = blockIdx.x * NWAVES + wave, NGW = gridDim.x * NWAVES;
    const int n_items = (layer_hi - layer_lo) * CI_LAYER;
    for (int it = gw; it < n_items; it += NGW) {
        const int layer = layer_lo + it / CI_LAYER; int r = it % CI_LAYER;
        if (r < CI_IN) { transpose_item(p.in[I_WIN] + (size_t)layer * DM * DIN, DM, DIN, (bf16*)(p.ws + WS_WIN + layer * WIN_STRIDE), 0, scr, r, lane); continue; } r -= CI_IN;
        if (r < CI_OUT) { transpose_item(p.in[I_WOUT] + (size_t)layer * DM * DM, DM, DM, (bf16*)(p.ws + WS_WOUT + layer * WOUT_STRIDE), 0, scr, r, lane); continue; } r -= CI_OUT;
        if (r < CI_G + CI_U) {
            const int up = r >= CI_G; if (up) r -= CI_G;
            const int e = r >> 7, rem = r & 127, nb = rem & 7, n0 = 32 * nb;
            const int mapped = (n0 >> 7) * 256 + (n0 & 127) + (up ? 128 : 0);
            transpose_item(p.in[up ? I_WEU : I_WEG] + ((size_t)layer * 32 + e) * DM * 256, DM, 256, (bf16*)(p.ws + WS_WGU + layer * WGU_STRIDE) + (size_t)e * 512 * DM, mapped - n0, scr, rem, lane);
            continue;
        }
        r -= CI_G + CI_U;
        { const int e = r >> 7, rem = r & 127;
          transpose_item(p.in[I_WED] + ((size_t)layer * 32 + e) * 256 * DM, 256, DM, (bf16*)(p.ws + WS_WD + layer * WD_STRIDE) + (size_t)e * DM * 256, 0, scr, rem, lane); }
    }
}
__device__ __forceinline__ void phase_norm(const float* xlat, const float* xctx, const float* g, const float* modl, int ch_shift, int ch_scale, bf16* H, int nrows, int wv) {
    const int lane = otid(wv) & 63, wave = wv;
    const int gw = blockIdx.x * NWAVES + wave, NGW = gridDim.x * NWAVES;
    const int per = (nrows + NGW - 1) / NGW;
    const int r0 = gw * per, r1 = min(r0 + per, nrows);
    int cur = -1; v4f gs[4], sh[4];
    for (int r = r0; r < r1; ++r) {
        const int mrow = (r < NLAT) ? (r >> 11) : 8;
        if (mrow != cur) {
            cur = mrow; const float* m = modl + (size_t)mrow * MODW;
#pragma unroll
            for (int j = 0; j < 4; ++j) { const int c = 4 * lane + 256 * j; const v4f gg = *(const v4f*)(g + c), sc = *(const v4f*)(m + ch_scale * DM + c);
                gs[j] = gg * (1.f + sc); sh[j] = *(const v4f*)(m + ch_shift * DM + c); }
        }
        const float* xr = (r < NLAT) ? xlat + (size_t)r * DM : xctx + (size_t)(r - NLAT) * DM;
        v4f v[4]; float s = 0.f;
#pragma unroll
        for (int j = 0; j < 4; ++j) { v[j] = *(const v4f*)(xr + 4 * lane + 256 * j); s += (v[j].x * v[j].x + v[j].y * v[j].y) + (v[j].z * v[j].z + v[j].w * v[j].w); }
        const float rstd = rsqrtf(wave_sum(s, lane) * (1.f / DM) + 1e-6f);
        bf16* orow = H + (size_t)r * DM;
#pragma unroll
        for (int j = 0; j < 4; ++j) { const v4f o = v[j] * rstd * gs[j] + sh[j]; v2u w; w.x = pk2(o.x, o.y); w.y = pk2(o.z, o.w); *(v2u*)(orow + 4 * lane + 256 * j) = w; }
    }
}

constexpr size_t WS_RSS = 6 * MiB;
constexpr size_t WS_WR = 7 * MiB + 512 * 1024;
constexpr int CW_CNT = 1024;
constexpr int LDS_TTAB = 131072;
constexpr int LDS_GIDX = 131072 + 4096;
constexpr int LDS_RT = 131072;

namespace pg8 {
struct EpiResidSS {
    static constexpr bool PERM = false, AFTER_DRAIN = false;
    const float* xin_lat; const float* xin_ctx; float* xout_lat; float* xout_ctx; const float* modl; int chunk; float* rss; int wv;
    __device__ __forceinline__ void operator()(const f32x4 (&acc)[2][2][4][2], const Unit& u, int, int, int, int) const {
        const int l_ = otid(wv) & 63, fr = l_ & 15, fq = l_ >> 4, wr = wv >> 2, wc = wv & 3;
        const int rowt = u.pm * BM; const bool isctx = rowt >= NLAT;
        const float* xin = isctx ? xin_ctx + (size_t)(rowt - NLAT) * DM : xin_lat + (size_t)rowt * DM;
        float* xo = isctx ? xout_ctx + (size_t)(rowt - NLAT) * DM : xout_lat + (size_t)rowt * DM;
        const int mrow = isctx ? 8 : (rowt >> 11);
        const float* gate = modl + (size_t)mrow * MODW + chunk * DM;
        const int col0 = u.pn * BM + wc * 32 + 4 * fq;
        f32x4 gv[2][2];
#pragma unroll
        for (int bj = 0; bj < 2; ++bj)
#pragma unroll
            for (int n = 0; n < 2; ++n) gv[bj][n] = *(const f32x4*)(gate + col0 + bj * HALF + n * 16);
#pragma unroll
        for (int ai = 0; ai < 2; ++ai)
#pragma unroll
            for (int m = 0; m < 4; ++m) {
                const int rl = ai * HALF + wr * 64 + m * 16 + fr; float ss = 0.f;
#pragma unroll
                for (int bj = 0; bj < 2; ++bj)
#pragma unroll
                    for (int n = 0; n < 2; ++n) {
                        const size_t off = (size_t)rl * DM + col0 + bj * HALF + n * 16;
                        const f32x4 xi = *(const f32x4*)(xin + off);
                        const f32x4 o = xi + gv[bj][n] * acc[ai][bj][m][n];
                        *(f32x4*)(xo + off) = o;
                        ss += (o[0] * o[0] + o[1] * o[1]) + (o[2] * o[2] + o[3] * o[3]);
                    }
                ss += shx(ss, 16, l_); ss += shx(ss, 32, l_);
                if (fq == 0) rss[(size_t)(rowt + rl) * 16 + u.pn * 4 + wc] = ss;
            }
    }
};
struct EpiGU {
    static constexpr bool PERM = true, AFTER_DRAIN = false;
    bf16_t* HID; int wv;
    __device__ __forceinline__ void operator()(const f32x4 (&acc)[2][2][4][2], const Unit& u, int, int, int, int) const {
        const int l_ = otid(wv) & 63, fr = l_ & 15, fq = l_ >> 4, wr = wv >> 2, wc = wv & 3;
        const int pnl = u.pn & 1, row0 = u.pm * BM + wr * 64 + fr, col0 = pnl * 128 + wc * 32 + 8 * fq;
#pragma unroll
        for (int ai = 0; ai < 2; ++ai)
#pragma unroll
            for (int m = 0; m < 4; ++m) {
                bf16_t* rowp = HID + (size_t)(row0 + ai * HALF + m * 16) * 256 + col0;
                float hv[8];
#pragma unroll
                for (int n = 0; n < 2; ++n)
#pragma unroll
                    for (int i = 0; i < 4; ++i) { const float g = acc[ai][0][m][n][i], uu = acc[ai][1][m][n][i]; hv[n * 4 + i] = g / (1.f + __expf(-g)) * uu; }
                u32x4 w; w.x = cvt_pk_bf16(hv[0], hv[1]); w.y = cvt_pk_bf16(hv[2], hv[3]); w.z = cvt_pk_bf16(hv[4], hv[5]); w.w = cvt_pk_bf16(hv[6], hv[7]);
                *(u32x4*)rowp = w;
            }
    }
};
struct EpiDown {
    static constexpr bool PERM = true, AFTER_DRAIN = false;
    bf16_t* Y0; bf16_t* Y1; const PG8_LAS int* rowinfo; int wv;
    __device__ __forceinline__ void operator()(const f32x4 (&acc)[2][2][4][2], const Unit& u, int, int, int, int) const {
        const int l_ = otid(wv) & 63, fr_ = l_ & 15, fq = l_ >> 4, wr = wv >> 2, wc = wv & 3;
        const int col0 = (u.pn & 3) * BM + wc * 32 + 8 * fq;
        const PG8_LAS int* ri = rowinfo + (u.aux * 256 + wr * 64 + fr_) * 2;
#pragma unroll
        for (int ai = 0; ai < 2; ++ai)
#pragma unroll
            for (int m = 0; m < 4; ++m) {
                const int ent = ri[(ai * HALF + m * 16) * 2]; const float w = __builtin_bit_cast(float, ri[(ai * HALF + m * 16) * 2 + 1]);
                if (ent >= 0) {
                    bf16_t* rowp = Y0 + ((size_t)(ent & 1) * ((WS_Y1 - WS_Y0) / 2) + (size_t)(ent >> 1) * DM + col0);
#pragma unroll
                    for (int bj = 0; bj < 2; ++bj) {
                        const f32x4 v0 = acc[ai][bj][m][0] * w, v1 = acc[ai][bj][m][1] * w;
                        u32x4 o; o.x = cvt_pk_bf16(v0[0], v0[1]); o.y = cvt_pk_bf16(v0[2], v0[3]); o.z = cvt_pk_bf16(v1[0], v1[1]); o.w = cvt_pk_bf16(v1[2], v1[3]);
                        *(u32x4*)(rowp + bj * HALF) = o;
                    }
                }
                asm volatile("" ::: "memory");
            }
    }
};
struct MoeOrder {
    const PG8_LAS int* ttab; int ntile, npn, G, c;
    __device__ __forceinline__ bool next(int i, Unit& u) const {
        const int L = i * G + c; if (L >= ntile * npn) return false;
        const int t = L / npn, pl = L % npn; u.pm = t; u.pn = ttab[t * 4] * npn + pl; u.aux = i; return true;
    }
    __device__ __forceinline__ void a_ready(const Unit&) const {}
    __device__ __forceinline__ void done(const Unit&) const {}
};
}

__device__ __forceinline__ void phase_router_w(const Ptrs& p, int wv) {
    const int gt = blockIdx.x * NT + otid(wv), NG = gridDim.x * NT;
    for (int idx = gt; idx < 2 * 48 * DM; idx += NG) {
        const int layer = idx / (48 * DM), r = idx % (48 * DM), n = r >> 10, k = r & 1023;
        float w;
        if (n < 16) w = p.in[I_WRG][((size_t)layer * DM + k) * 4 + (n & 3)];
        else { const int g = ((n - 16) & 15) >> 2, i = n & 3, e = 8 * g + i + (n >= 32 ? 4 : 0); w = p.in[I_WRE][((size_t)layer * DM + k) * 32 + e]; }
        const unsigned hi = f2bf(w); const float lo = w - __builtin_bit_cast(float, hi << 16);
        bf16* base = (bf16*)(p.ws + WS_WR) + (size_t)layer * 2 * 48 * DM;
        base[r] = (bf16)hi; base[48 * DM + r] = (bf16)f2bf(lo);
    }
}

typedef short s8v __attribute__((ext_vector_type(8)));
__device__ __forceinline__ void phase_route(const Ptrs& p, LAS unsigned char* lds, int layer, int nrows, int wv) {
    const int tid = otid(wv), lane = tid & 63, wave = wv;
    LAS int* lcnt = (LAS int*)(lds + LDS_RT); LAS int* gb = lcnt + 32;
    if (tid < 32) lcnt[tid] = 0;
    __syncthreads();
    const int ntiles = nrows / 16, t = wave * gridDim.x + blockIdx.x;
    const float* modl = (const float*)(p.ws + WS_MOD) + (size_t)layer * 9 * MODW;
    int e0 = -1, e1 = -1, lp0 = 0, lp1 = 0, ent0 = 0;
    if (t < ntiles) {
        const int row0 = t * 16, r = row0 + (lane & 15), kq = lane >> 4;
        const int mrow = (row0 < NLAT) ? (row0 >> 11) : 8;
        const float* xr = (r < NLAT) ? p.out + (size_t)r * DM : (const float*)(p.ws + WS_XC) + (size_t)(r - NLAT) * DM;
        const float* g = p.in[I_N2G] + layer * DM; const float* msc = modl + (size_t)mrow * MODW + 4 * DM; const float* msh = modl + (size_t)mrow * MODW + 3 * DM;
        bf16* hrow = (bf16*)(p.ws + WS_H) + (size_t)r * DM;
        const bf16* wr_hi = (const bf16*)(p.ws + WS_WR) + (size_t)layer * 2 * 48 * DM + (size_t)(lane & 15) * DM; const bf16* wr_lo = wr_hi + 48 * DM;
        float ss;
        { const v4f* rs = (const v4f*)((const float*)(p.ws + WS_RSS) + (size_t)r * 16); const v4f a = rs[0], b = rs[1], c = rs[2], d = rs[3];
          ss = ((a.x + a.y) + (a.z + a.w)) + ((b.x + b.y) + (b.z + b.w)) + ((c.x + c.y) + (c.z + c.w)) + ((d.x + d.y) + (d.z + d.w)); }
        const float rstd = rsqrtf(ss * (1.f / DM) + 1e-6f);
        v4f acc[3];
#pragma unroll
        for (int i = 0; i < 3; ++i) acc[i] = (v4f){0.f, 0.f, 0.f, 0.f};
        for (int s = 0; s < 32; ++s) {
            const int c0 = 32 * s + 8 * kq;
            const v4f xa = *(const v4f*)(xr + c0), xb = *(const v4f*)(xr + c0 + 4);
            const v4f ga = *(const v4f*)(g + c0), gbv = *(const v4f*)(g + c0 + 4);
            const v4f sa = *(const v4f*)(msc + c0), sb = *(const v4f*)(msc + c0 + 4);
            const v4f ha = *(const v4f*)(msh + c0), hb = *(const v4f*)(msh + c0 + 4);
            const v4f h0 = xa * rstd * (ga * (1.f + sa)) + ha, h1 = xb * rstd * (gbv * (1.f + sb)) + hb;
            float hv[8] = {h0.x, h0.y, h0.z, h0.w, h1.x, h1.y, h1.z, h1.w};
            unsigned hi[8]; s8v bhi, blo;
#pragma unroll
            for (int j = 0; j < 8; ++j) { hi[j] = f2bf(hv[j]); bhi[j] = (short)hi[j]; blo[j] = (short)f2bf(hv[j] - __builtin_bit_cast(float, hi[j] << 16)); }
            v4u hw; hw.x = hi[0] | (hi[1] << 16); hw.y = hi[2] | (hi[3] << 16); hw.z = hi[4] | (hi[5] << 16); hw.w = hi[6] | (hi[7] << 16);
            *(v4u*)(hrow + c0) = hw;
#pragma unroll
            for (int nt = 0; nt < 3; ++nt) {
                const s8v ahi = *(const s8v*)(wr_hi + (size_t)nt * 16 * DM + c0), alo = *(const s8v*)(wr_lo + (size_t)nt * 16 * DM + c0);
                acc[nt] = __builtin_amdgcn_mfma_f32_16x16x32_bf16(ahi, bhi, acc[nt], 0, 0, 0);
                acc[nt] = __builtin_amdgcn_mfma_f32_16x16x32_bf16(ahi, blo, acc[nt], 0, 0, 0);
                acc[nt] = __builtin_amdgcn_mfma_f32_16x16x32_bf16(alo, bhi, acc[nt], 0, 0, 0);
            }
        }
        const float* brg = p.in[I_BRG] + layer * 4; const float* bre = p.in[I_BRE] + layer * 32;
        float gl[4];
#pragma unroll
        for (int i = 0; i < 4; ++i) gl[i] = acc[0][i] + brg[i];
        int gi = 0; float gm = gl[0];
#pragma unroll
        for (int i = 1; i < 4; ++i) if (gl[i] > gm) { gm = gl[i]; gi = i; }
        float den = 0.f;
#pragma unroll
        for (int i = 0; i < 4; ++i) den += __expf(gl[i] - gm);
        const float gtop = 1.f / den;
        if (kq == gi) {
            float el[8];
#pragma unroll
            for (int i = 0; i < 4; ++i) { el[i] = acc[1][i] + bre[8 * kq + i]; el[4 + i] = acc[2][i] + bre[8 * kq + 4 + i]; }
            int i0 = 0; float v0 = el[0];
#pragma unroll
            for (int i = 1; i < 8; ++i) if (el[i] > v0) { v0 = el[i]; i0 = i; }
            int i1 = -1; float v1 = -3.0e38f;
#pragma unroll
            for (int i = 0; i < 8; ++i) if (i != i0 && el[i] > v1) { v1 = el[i]; i1 = i; }
            const float p1 = __expf(v1 - v0), sden = 1.f / (1.f + p1);
            e0 = gi * 8 + i0; e1 = gi * 8 + i1; ent0 = r * 2;
            float* ew = (float*)(p.ws + WS_EW);
            ew[ent0] = gtop * sden; ew[ent0 + 1] = gtop * p1 * sden;
            lp0 = __hip_atomic_fetch_add(lcnt + e0, 1, __ATOMIC_RELAXED, __HIP_MEMORY_SCOPE_WORKGROUP); lp1 = __hip_atomic_fetch_add(lcnt + e1, 1, __ATOMIC_RELAXED, __HIP_MEMORY_SCOPE_WORKGROUP);
        }
    }
    __syncthreads();
    int* cnt = (int*)(p.ws + WS_CTL) + CW_CNT + layer * 64;
    if (tid < 32) gb[tid] = atomicAdd(&cnt[tid], lcnt[tid]);
    __syncthreads();
    if (e0 >= 0) {
        int* IDX = (int*)(p.ws + WS_IDX);
        IDX[(size_t)e0 * MROWS + gb[e0] + lp0] = ent0;
        IDX[(size_t)e1 * MROWS + gb[e1] + lp1] = ent0 + 1;
    }
}
__device__ __forceinline__ int moe_build_ttab(const Ptrs& p, LAS unsigned char* lds, int layer, int wv) {
    LAS int* ttab = (LAS int*)(lds + LDS_TTAB);
    const int* cnt = (const int*)(p.ws + WS_CTL) + CW_CNT + layer * 64;
    __syncthreads();
    if (otid(wv) == 0) {
        int t = 0;
        for (int e = 0; e < 32; ++e) { const int c = __hip_atomic_load(cnt + e, __ATOMIC_RELAXED, __HIP_MEMORY_SCOPE_AGENT); for (int fp = 0; fp < c; fp += 256) { ttab[t * 4] = e; ttab[t * 4 + 1] = fp; ttab[t * 4 + 2] = c; ++t; } }
        ttab[176 * 4] = t;
    }
    __syncthreads();
    return ttab[176 * 4];
}
__device__ __forceinline__ void phase_moe_gu(const Ptrs& p, LAS unsigned char* lds, int layer, int wv) {
    const int ntile = moe_build_ttab(p, lds, layer, wv);
    LAS int* ttab = (LAS int*)(lds + LDS_TTAB); LAS int* gidx = (LAS int*)(lds + LDS_GIDX);
    pg8::MoeOrder S{ttab, ntile, 2, (int)gridDim.x, (int)blockIdx.x};
    const int* IDX = (const int*)(p.ws + WS_IDX);
    for (int i = 0; i < 3; ++i) {
        pg8::Unit u; if (!S.next(i, u)) break;
        const int e = ttab[u.pm * 4], fp = ttab[u.pm * 4 + 1], c = ttab[u.pm * 4 + 2];
        for (int r = otid(wv); r < 256; r += NT) gidx[i * 256 + r] = (fp + r < c) ? (IDX[(size_t)e * MROWS + fp + r] >> 1) : 0;
    }
    __syncthreads();
    pg8::Gemm g{(const bf16*)(p.ws + WS_H), (const bf16*)(p.ws + WS_WGU + layer * WGU_STRIDE), ntile * 256, 32 * 512, DM};
    pg8::EpiGU E{(bf16*)(p.ws + WS_HID), wv};
    pg8::gemm_phase<pg8::EpiGU, pg8::MoeOrder, true, true, true>(lds, g, S, E, wv, gidx);
}
__device__ __forceinline__ void phase_moe_down(const Ptrs& p, LAS unsigned char* lds, int layer, int wv) {
    const int ntile = moe_build_ttab(p, lds, layer, wv);
    LAS int* ttab = (LAS int*)(lds + LDS_TTAB); LAS int* rowinfo = (LAS int*)(lds + LDS_GIDX);
    pg8::MoeOrder S{ttab, ntile, 4, (int)gridDim.x, (int)blockIdx.x};
    const int* IDX = (const int*)(p.ws + WS_IDX); const float* EW = (const float*)(p.ws + WS_EW);
    for (int i = 0; i < 3; ++i) {
        pg8::Unit u; if (!S.next(i, u)) break;
        const int e = ttab[u.pm * 4], fp = ttab[u.pm * 4 + 1], c = ttab[u.pm * 4 + 2];
        for (int r = otid(wv); r < 256; r += NT) {
            int ent = -1; float w = 0.f;
            if (fp + r < c) { ent = IDX[(size_t)e * MROWS + fp + r]; w = EW[ent]; }
            rowinfo[(i * 256 + r) * 2] = ent; rowinfo[(i * 256 + r) * 2 + 1] = __builtin_bit_cast(int, w);
        }
    }
    __syncthreads();
    pg8::Gemm g{(const bf16*)(p.ws + WS_HID), (const bf16*)(p.ws + WS_WD + layer * WD_STRIDE), ntile * 256, 32 * 1024, 256};
    pg8::EpiDown E{(bf16*)(p.ws + WS_Y0), (bf16*)(p.ws + WS_Y1), rowinfo, wv};
    pg8::gemm_phase<pg8::EpiDown, pg8::MoeOrder, true, true, false>(lds, g, S, E, wv);
}
__device__ __forceinline__ void phase_combine(const Ptrs& p, int layer, int nrows, bool do_norm, int wv) {
    const int lane = otid(wv) & 63, wave = wv;
    const int gw = blockIdx.x * NWAVES + wave, NGW = gridDim.x * NWAVES;
    const int per = (nrows + NGW - 1) / NGW;
    const int r0 = gw * per, r1 = min(r0 + per, nrows);
    const float* modl = (const float*)(p.ws + WS_MOD) + (size_t)layer * 9 * MODW;
    const float* modn = (const float*)(p.ws + WS_MOD) + (size_t)(layer + 1) * 9 * MODW;
    const float* g = p.in[I_N1G] + (layer + 1) * DM;
    const bf16* Y0 = (const bf16*)(p.ws + WS_Y0); const bf16* Y1 = (const bf16*)(p.ws + WS_Y1); bf16* H = (bf16*)(p.ws + WS_H);
    for (int r = r0; r < r1; ++r) {
        const int mrow = (r < NLAT) ? (r >> 11) : 8;
        float* xr = (r < NLAT) ? p.out + (size_t)r * DM : (float*)(p.ws + WS_XC) + (size_t)(r - NLAT) * DM;
        const float* m5 = modl + (size_t)mrow * MODW + 5 * DM;
        v4f v[4]; float s = 0.f;
#pragma unroll
        for (int j = 0; j < 4; ++j) {
            const int c = 4 * lane + 256 * j;
            const v4f x = *(const v4f*)(xr + c), mm = *(const v4f*)(m5 + c);
            const v2u a = *(const v2u*)(Y0 + (size_t)r * DM + c), b = *(const v2u*)(Y1 + (size_t)r * DM + c);
            v4f y; y.x = bflo(a.x) + bflo(b.x); y.y = bfhi(a.x) + bfhi(b.x); y.z = bflo(a.y) + bflo(b.y); y.w = bfhi(a.y) + bfhi(b.y);
            v[j] = x + mm * y;
            *(v4f*)(xr + c) = v[j];
            s += (v[j].x * v[j].x + v[j].y * v[j].y) + (v[j].z * v[j].z + v[j].w * v[j].w);
        }
        if (do_norm) {
            const float rstd = rsqrtf(wave_sum(s, lane) * (1.f / DM) + 1e-6f);
            const float* mn = modn + (size_t)mrow * MODW;
#pragma unroll
            for (int j = 0; j < 4; ++j) {
                const int c = 4 * lane + 256 * j;
                const v4f gg = *(const v4f*)(g + c), sc = *(const v4f*)(mn + DM + c), sh = *(const v4f*)(mn + c);
                const v4f o = v[j] * rstd * (gg * (1.f + sc)) + sh; v2u w; w.x = pk2(o.x, o.y); w.y = pk2(o.z, o.w);
                *(v2u*)(H + (size_t)r * DM + c) = w;
            }
        }
    }
}

namespace hg {
typedef short s4v __attribute__((ext_vector_type(4)));
typedef short s8v __attribute__((ext_vector_type(8)));
typedef short v4i16_t __attribute__((ext_vector_type(4)));
constexpr int TS = 160;
constexpr int TILE_B = 16 * TS;
constexpr int WAVE_LDS = 2 * TILE_B;
constexpr int NSEG = 18;
constexpr size_t SEGU_B = 64 * 64 * 4, SEGA_B = 16 * 64 * 4;
constexpr size_t WS_SEGU = WS_SCR;
constexpr size_t WS_SEGA = WS_SEGU + (size_t)NBATCH * 4 * 2 * NSEG * SEGU_B;
constexpr int OFL_OFF = 8 * WAVE_LDS, OFL_B = 8 * 4 * 64 * 16;
static_assert(WS_SEGA + (size_t)NBATCH * 4 * 2 * NSEG * SEGA_B <= WS_END && OFL_OFF + 3 * OFL_B <= LDS_BYTES, "hgrn scratch");
template <int CTRL> __device__ __forceinline__ float dppf(float x) { return __builtin_bit_cast(float, __builtin_amdgcn_update_dpp(0, __builtin_bit_cast(int, x), CTRL, 0xf, 0xf, true)); }
__device__ __forceinline__ s4v trd(const LAS unsigned char* p) { return __builtin_bit_cast(s4v, __builtin_amdgcn_ds_read_tr16_b64_v4i16((LAS v4i16_t*)p)); }
typedef float f32x2_t __attribute__((ext_vector_type(2))); typedef __bf16 bf16x2_t __attribute__((ext_vector_type(2)));
__device__ __forceinline__ unsigned pkbf(float lo, float hi) { f32x2_t v = {lo, hi}; bf16x2_t b = __builtin_convertvector(v, bf16x2_t); return __builtin_bit_cast(unsigned, b); }
__device__ __forceinline__ float silu_r(float x) { return x * __builtin_amdgcn_rcpf(1.f + __expf(-x)); }
__device__ __forceinline__ s8v mk8(unsigned a, unsigned b, unsigned c, unsigned d) { v4u t; t.x = a; t.y = b; t.z = c; t.w = d; return __builtin_bit_cast(s8v, t); }

template <bool BWD, bool OUT>
__device__ __forceinline__ void chunk(const bf16* __restrict__ P, int row0, int h, const float* __restrict__ lbh, v4f (&S)[4][4], float (&Atot)[16],
                                      LAS unsigned char* vt, LAS unsigned char* kt, int lane_, LAS v4f* OFL, int cidx, bf16* __restrict__ MIX, const float* __restrict__ on) {
    int lane = lane_; asm volatile("" : "+v"(lane));
    const int tok = lane & 15, kq = lane >> 4;
    const bf16* pb = P + (size_t)row0 * DIN + h * 64;
    const unsigned lo = (unsigned)(tok * DIN + 4 * kq);
    v2u zr[4], qr[4]; v4f lbq[4];
#pragma unroll
    for (int m = 0; m < 4; ++m) lbq[m] = *(const v4f*)(lbh + (unsigned)(16 * m + 4 * kq));
#pragma unroll
    for (int m = 0; m < 4; ++m) { zr[m] = *(const v2u*)(pb + (lo + (BWD ? C_FB : C_FF) + 16 * m)); if (OUT) qr[m] = *(const v2u*)(pb + (lo + C_Q + 16 * m)); }
#pragma unroll
    for (int i = 0; i < 2; ++i) { const int pc = lane + 64 * i, r = pc >> 3, ch = pc & 7;
        const v4u vv = *(const v4u*)(pb + (unsigned)(r * DIN + C_I + 8 * ch)); *(LAS v4u*)(vt + r * TS + 16 * ch) = vv; }
    unsigned qf[8], kf[8];
    float A[16];
#pragma unroll
    for (int m = 0; m < 4; ++m)
#pragma unroll
        for (int jp = 0; jp < 2; ++jp) {
            const unsigned zw = jp ? zr[m].y : zr[m].x;
            float kt2[2], qt2[2], kh2[2];
#pragma unroll
            for (int i = 0; i < 2; ++i) {
                const int e = 4 * m + 2 * jp + i;
                const float z = i ? bfhi(zw) : bflo(zw);
                const float sg = __builtin_amdgcn_rcpf(1.f + __expf(-z)), lb = lbq[m][2 * jp + i];
                const float f = lb + (1.f - lb) * sg, kk = (1.f - lb) * (1.f - sg);
                const float lf = __logf(f);
                float c = lf, t = lf;
                if (!BWD) { c += dppf<0x111>(c); c += dppf<0x112>(c); c += dppf<0x114>(c); c += dppf<0x118>(c); }
                else      { c += dppf<0x101>(c); c += dppf<0x102>(c); c += dppf<0x104>(c); c += dppf<0x108>(c); }
                t += dppf<0x128>(t); t += dppf<0x124>(t); t += dppf<0x122>(t); t += dppf<0x121>(t);
                const float Ei = __expf(-fmaxf(c, -80.f)); A[e] = __expf(t);
                kt2[i] = kk * Ei; kh2[i] = kt2[i] * A[e];
                if (OUT) { const unsigned qw = jp ? qr[m].y : qr[m].x; const float q = i ? bfhi(qw) : bflo(qw); qt2[i] = q * 0.125f * __expf(c); } else qt2[i] = 0.f;
            }
            kf[2 * m + jp] = pkbf(kt2[0], kt2[1]); if (OUT) qf[2 * m + jp] = pkbf(qt2[0], qt2[1]);
            *(LAS unsigned*)(kt + tok * TS + (16 * m + 4 * kq + 2 * jp) * 2) = pkbf(kh2[0], kh2[1]);
            __builtin_amdgcn_sched_barrier(0);
        }
    asm volatile("s_waitcnt lgkmcnt(0)" ::: "memory");
    s8v vfr[4], khf[4];
    { const int i4 = tok >> 2, p4 = tok & 3; const LAS unsigned char* va = vt + (4 * kq + i4) * TS + 8 * p4; const LAS unsigned char* ka = kt + (4 * kq + i4) * TS + 8 * p4;
#pragma unroll
      for (int c = 0; c < 4; ++c) { const s4v a = trd(va + 32 * c), b = trd(ka + 32 * c);
          vfr[c] = (s8v){a[0], a[1], a[2], a[3], 0, 0, 0, 0}; khf[c] = (s8v){b[0], b[1], b[2], b[3], 0, 0, 0, 0}; } }
    if (OUT) {
        const s8v q0 = mk8(qf[0], qf[1], qf[2], qf[3]), q1 = mk8(qf[4], qf[5], qf[6], qf[7]);
        const s8v k0 = mk8(kf[0], kf[1], kf[2], kf[3]), k1 = mk8(kf[4], kf[5], kf[6], kf[7]);
        v4f at = (v4f){0.f, 0.f, 0.f, 0.f};
        at = __builtin_amdgcn_mfma_f32_16x16x32_bf16(k0, q0, at, 0, 0, 0);
        at = __builtin_amdgcn_mfma_f32_16x16x32_bf16(k1, q1, at, 0, 0, 0);
#pragma unroll
        for (int j = 0; j < 4; ++j) { const int s = 4 * kq + j; const bool keep = BWD ? (s >= tok) : (s <= tok); at[j] = keep ? at[j] : 0.f; }
        const s8v af = mk8(pkbf(at[0], at[1]), pkbf(at[2], at[3]), 0u, 0u);
        v4f o[4];
#pragma unroll
        for (int vb = 0; vb < 4; ++vb) {
            o[vb] = __builtin_amdgcn_mfma_f32_16x16x32_bf16(vfr[vb], af, (v4f){0.f, 0.f, 0.f, 0.f}, 0, 0, 0);
            const s8v s0 = mk8(pkbf(S[0][vb][0], S[0][vb][1]), pkbf(S[0][vb][2], S[0][vb][3]), pkbf(S[1][vb][0], S[1][vb][1]), pkbf(S[1][vb][2], S[1][vb][3]));
            const s8v s1 = mk8(pkbf(S[2][vb][0], S[2][vb][1]), pkbf(S[2][vb][2], S[2][vb][3]), pkbf(S[3][vb][0], S[3][vb][1]), pkbf(S[3][vb][2], S[3][vb][3]));
            o[vb] = __builtin_amdgcn_mfma_f32_16x16x32_bf16(s0, q0, o[vb], 0, 0, 0);
            o[vb] = __builtin_amdgcn_mfma_f32_16x16x32_bf16(s1, q1, o[vb], 0, 0, 0);
            __builtin_amdgcn_sched_barrier(0);
        }
        LAS v4f* ofl = OFL + (cidx * 4) * 64 + lane;
        if (!BWD) {
#pragma unroll
            for (int vb = 0; vb < 4; ++vb) ofl[vb * 64] = o[vb];
        } else {
            float ss = 0.f;
#pragma unroll
            for (int vb = 0; vb < 4; ++vb) { o[vb] += ofl[vb * 64]; ss += (o[vb].x * o[vb].x + o[vb].y * o[vb].y) + (o[vb].z * o[vb].z + o[vb].w * o[vb].w); }
            ss += shx(ss, 16, lane); ss += shx(ss, 32, lane);
            const float rstd = rsqrtf(ss * (1.f / 64.f) + 1e-6f);
            bf16* mb = MIX + (size_t)row0 * DM + 768 + h * 64; const unsigned lom = (unsigned)(tok * DM + 4 * kq);
#pragma unroll
            for (int vb = 0; vb < 4; ++vb) {
                const v2u gw = *(const v2u*)(pb + (lo + C_G + 16 * vb)); const v4f gn = *(const v4f*)(on + (unsigned)(16 * vb + 4 * kq));
                const float g0 = bflo(gw.x), g1 = bfhi(gw.x), g2 = bflo(gw.y), g3 = bfhi(gw.y);
                v2u w; w.x = pkbf(o[vb].x * rstd * gn.x * silu_r(g0), o[vb].y * rstd * gn.y * silu_r(g1)); w.y = pkbf(o[vb].z * rstd * gn.z * silu_r(g2), o[vb].w * rstd * gn.w * silu_r(g3));
                *(v2u*)(mb + (lom + 16 * vb)) = w;
            }
        }
    }
#pragma unroll
    for (int db = 0; db < 4; ++db) {
        const v4f av = (v4f){A[4 * db], A[4 * db + 1], A[4 * db + 2], A[4 * db + 3]};
#pragma unroll
        for (int vb = 0; vb < 4; ++vb) S[db][vb] = __builtin_amdgcn_mfma_f32_16x16x32_bf16(khf[db], vfr[vb], S[db][vb] * av, 0, 0, 0);
        __builtin_amdgcn_sched_barrier(0);
    }
    if (!OUT) {
#pragma unroll
        for (int e = 0; e < 16; ++e) Atot[e] *= A[e];
    }
    asm volatile("s_waitcnt lgkmcnt(0)" ::: "memory");
}
__device__ __forceinline__ int seg_row0(int b, int seg) { return seg < 2 ? NLAT + b * CTXL + 128 * seg : b * SEQ + 128 * (seg - 2); }
__device__ __forceinline__ int scan_idx(int seg, int dir) { return dir == 0 ? seg : (seg < 2 ? 1 - seg : 19 - seg); }

__device__ __forceinline__ void unit_pass1(const Ptrs& p, int layer, int u, LAS unsigned char* wl, int lane) {
    const int seg = u % NSEG, bh = u / NSEG, h = bh & 3, b = bh >> 2;
    const bf16* P = (const bf16*)(p.ws + WS_P);
    const int kq = lane >> 4, row0 = seg_row0(b, seg);
#pragma unroll 1
    for (int dir = 0; dir < 2; ++dir) {
        float Atot[16]; v4f S[4][4];
        const float* lbv = (const float*)(p.ws + WS_LB) + layer * 512 + dir * 256 + h * 64;
#pragma unroll
        for (int e = 0; e < 16; ++e) Atot[e] = 1.f;
#pragma unroll
        for (int i = 0; i < 4; ++i)
#pragma unroll
            for (int j = 0; j < 4; ++j) S[i][j] = (v4f){0.f, 0.f, 0.f, 0.f};
        if (dir == 0) {
#pragma unroll 1
            for (int c = 0; c < 8; ++c) chunk<false, false>(P, row0 + 16 * c, h, lbv, S, Atot, wl, wl + TILE_B, lane, nullptr, c, nullptr, nullptr); }
        else {
#pragma unroll 1
            for (int c = 7; c >= 0; --c) chunk<true, false>(P, row0 + 16 * c, h, lbv, S, Atot, wl, wl + TILE_B, lane, nullptr, c, nullptr, nullptr); }
        const size_t si = ((size_t)(bh * 2 + dir)) * NSEG + scan_idx(seg, dir);
        float* su = (float*)(p.ws + WS_SEGU + si * SEGU_B) + lane; float* sa = (float*)(p.ws + WS_SEGA + si * SEGA_B) + lane;
#pragma unroll
        for (int i = 0; i < 4; ++i)
#pragma unroll
            for (int j = 0; j < 4; ++j)
#pragma unroll
                for (int r = 0; r < 4; ++r) su[((i * 4 + j) * 4 + r) * 64] = S[i][j][r];
#pragma unroll
        for (int e = 0; e < 16; ++e) sa[e * 64] = Atot[e];
    }
}
__device__ __forceinline__ void unit_pass2(const Ptrs& p, int layer, int u, LAS unsigned char* wl, LAS v4f* OFL, int lane) {
    const int seg = u % NSEG, bh = u / NSEG, h = bh & 3, b = bh >> 2;
    const bf16* P = (const bf16*)(p.ws + WS_P); bf16* MIX = (bf16*)(p.ws + WS_MIX);
    const float* on = p.in[I_HGON] + layer * 64;
    const int kq = lane >> 4, row0 = seg_row0(b, seg);
#pragma unroll 1
    for (int dir = 0; dir < 2; ++dir) {
        float Atot[16]; v4f S[4][4];
        const float* lbv = (const float*)(p.ws + WS_LB) + layer * 512 + dir * 256 + h * 64;
#pragma unroll
        for (int e = 0; e < 16; ++e) Atot[e] = 1.f;
#pragma unroll
        for (int i = 0; i < 4; ++i)
#pragma unroll
            for (int j = 0; j < 4; ++j) S[i][j] = (v4f){0.f, 0.f, 0.f, 0.f};
        const int my = scan_idx(seg, dir); const size_t s0 = ((size_t)(bh * 2 + dir)) * NSEG;
#pragma unroll 1
        for (int sj = 0; sj < my; ++sj) {
            int ln = lane; asm volatile("" : "+v"(ln));
            const float* su = (const float*)(p.ws + WS_SEGU + (s0 + sj) * SEGU_B) + ln; const float* sa = (const float*)(p.ws + WS_SEGA + (s0 + sj) * SEGA_B) + ln;
#pragma unroll
            for (int i = 0; i < 4; ++i) {
                const v4f av = (v4f){sa[(4 * i) * 64], sa[(4 * i + 1) * 64], sa[(4 * i + 2) * 64], sa[(4 * i + 3) * 64]};
#pragma unroll
                for (int j = 0; j < 4; ++j) { const v4f uu = (v4f){su[((i * 4 + j) * 4 + 0) * 64], su[((i * 4 + j) * 4 + 1) * 64], su[((i * 4 + j) * 4 + 2) * 64], su[((i * 4 + j) * 4 + 3) * 64]};
                    S[i][j] = S[i][j] * av + uu; }
                __builtin_amdgcn_sched_barrier(0);
            }
        }
        if (dir == 0) {
#pragma unroll 1
            for (int c = 0; c < 8; ++c) chunk<false, true>(P, row0 + 16 * c, h, lbv, S, Atot, wl, wl + TILE_B, lane, OFL, c, MIX, on); }
        else {
#pragma unroll 1
            for (int c = 7; c >= 0; --c) chunk<true, true>(P, row0 + 16 * c, h, lbv, S, Atot, wl, wl + TILE_B, lane, OFL, c, MIX, on); }
    }
}
}
__device__ __forceinline__ void phase_hgrn1(const Ptrs& p, LAS unsigned char* lds, int layer, int wv) {
    const int lane = otid(wv) & 63; const int u = wv * gridDim.x + blockIdx.x;
    if (u < 32 * hg::NSEG) hg::unit_pass1(p, layer, u, lds + wv * hg::WAVE_LDS, lane);
}
__device__ __forceinline__ void phase_hgrn2(const Ptrs& p, LAS unsigned char* lds, int layer, int wv) {
    const int lane = otid(wv) & 63; const int u = wv * gridDim.x + blockIdx.x;
    if (u < 32 * hg::NSEG && (layer == 0 || (u % hg::NSEG) >= 2)) hg::unit_pass2(p, layer, u, lds + wv * hg::WAVE_LDS, (LAS v4f*)(lds + hg::OFL_OFF + wv * hg::OFL_B), lane);
}
namespace att {
using bf16=unsigned short;
using bf16x8=__attribute__((ext_vector_type(8)))short;
using s16x4=__attribute__((ext_vector_type(4)))short;
using f32x16=__attribute__((ext_vector_type(16)))float;
using u32x4=__attribute__((ext_vector_type(4)))unsigned;
constexpr int D=64,PIN_=DIN,POUT=DM;
constexpr int NW=8,QBLK=32,QB=QBLK*NW,KVBLK=64;
__device__ __forceinline__ int crow(int r,int hi){return (r&3)+8*(r>>2)+4*hi;}
#define SBAR() __builtin_amdgcn_sched_barrier(0)
constexpr int NSLOT=3, SLOTB=8192;
constexpr int LDS_K=0, LDS_V=NSLOT*SLOTB, LDS_WS=2*NSLOT*SLOTB, LDS_OST=LDS_WS+NW*64*4, LDS_BYTES=LDS_OST+NW*4096;
constexpr float C2=0.125f*1.4426950408889634f;
__device__ __forceinline__ void glds16(const void*gsrc,unsigned lds_dst){unsigned keep;
  asm volatile("s_mov_b32 %0, m0\n\ts_mov_b32 m0, %2\n\ts_nop 0\n\tglobal_load_lds_dwordx4 %1, off\n\ts_mov_b32 m0, %0":"=&s"(keep):"v"(gsrc),"s"(lds_dst):"memory");}
__device__ __forceinline__ float max3f(float a,float b,float c){float r;asm("v_max3_f32 %0, %1, %2, %3":"=v"(r):"v"(a),"v"(b),"v"(c));return r;}
__device__ __forceinline__ float max2f(float a,float b){float r;asm("v_max_f32_e32 %0, %1, %2":"=v"(r):"v"(a),"v"(b));return r;}
__device__ __forceinline__ float fadd_s(float a,float b){float r;asm("v_add_f32_e32 %0, %1, %2":"=v"(r):"v"(a),"v"(b));return r;}
__device__ __forceinline__ float fsub_s(float a,float b){float r;asm("v_sub_f32_e32 %0, %1, %2":"=v"(r):"v"(a),"v"(b));return r;}
typedef float f32x2_t __attribute__((ext_vector_type(2))); typedef __bf16 bf16x2_t __attribute__((ext_vector_type(2)));
__device__ __forceinline__ unsigned cvtpk_s(float lo,float hi){f32x2_t v={lo,hi};bf16x2_t b=__builtin_convertvector(v,bf16x2_t);return __builtin_bit_cast(unsigned,b);}
#define WAIT_BAR(N) asm volatile("s_waitcnt vmcnt(" #N ") lgkmcnt(0)\n\ts_barrier":::"memory")

__device__ __forceinline__ void qkt(f32x16&p0,f32x16&p1,const char*Kslot,const bf16x8*qr,const f32x16&negm,int r32,int hi){
  const char*kb=Kslot+hi*1024+r32*16;
  #pragma unroll
  for(int d0=0;d0<4;++d0){
    const bf16x8 b0=*reinterpret_cast<const bf16x8*>(kb+d0*2048);
    const bf16x8 b1=*reinterpret_cast<const bf16x8*>(kb+d0*2048+512);
    if(d0==0){p0=__builtin_amdgcn_mfma_f32_32x32x16_bf16(b0,qr[0],negm,0,0,0);p1=__builtin_amdgcn_mfma_f32_32x32x16_bf16(b1,qr[0],negm,0,0,0);}
    else{p0=__builtin_amdgcn_mfma_f32_32x32x16_bf16(b0,qr[d0],p0,0,0,0);p1=__builtin_amdgcn_mfma_f32_32x32x16_bf16(b1,qr[d0],p1,0,0,0);}}
}
typedef __attribute__((address_space(3))) const char* lds_cptr;
typedef short v4i16_t __attribute__((ext_vector_type(4)));
__device__ __forceinline__ void kload8(bf16x8*kf,lds_cptr kp){
  kf[0]=*(const __attribute__((address_space(3))) bf16x8*)(kp);      kf[1]=*(const __attribute__((address_space(3))) bf16x8*)(kp+512);
  kf[2]=*(const __attribute__((address_space(3))) bf16x8*)(kp+2048); kf[3]=*(const __attribute__((address_space(3))) bf16x8*)(kp+2560);
  kf[4]=*(const __attribute__((address_space(3))) bf16x8*)(kp+4096); kf[5]=*(const __attribute__((address_space(3))) bf16x8*)(kp+4608);
  kf[6]=*(const __attribute__((address_space(3))) bf16x8*)(kp+6144); kf[7]=*(const __attribute__((address_space(3))) bf16x8*)(kp+6656);
}
__device__ __forceinline__ void kload2(bf16x8*kf,lds_cptr kp,int j){ kf[2*j]=*(const __attribute__((address_space(3))) bf16x8*)(kp+j*2048); kf[2*j+1]=*(const __attribute__((address_space(3))) bf16x8*)(kp+j*2048+512); }
__device__ __forceinline__ s16x4 vtr(lds_cptr p){ return __builtin_bit_cast(s16x4,__builtin_amdgcn_ds_read_tr16_b64_v4i16((__attribute__((address_space(3))) v4i16_t*)p)); }
__device__ __forceinline__ float rowmax(const f32x16&p0,const f32x16&p1){
  float a=max3f(p0[0],p0[1],p1[0]),b=max3f(p0[2],p0[3],p1[1]);a=max3f(a,p1[2],p1[3]);
  #pragma unroll
  for(int r=4;r<16;r+=4){a=max3f(a,p0[r],p0[r+1]);b=max3f(b,p0[r+2],p0[r+3]);a=max3f(a,p1[r],p1[r+1]);b=max3f(b,p1[r+2],p1[r+3]);}
  const float m=max2f(a,b);
  auto rr=__builtin_amdgcn_permlane32_swap(__float_as_uint(m),__float_as_uint(m),false,false);
  return max2f(__uint_as_float(rr[0]),__uint_as_float(rr[1]));
}
__device__ __forceinline__ void pv(f32x16*o,int vb,bf16x8 pa0,bf16x8 pa1,bf16x8 pa2,bf16x8 pa3){
  #pragma unroll
  for(int d0=0;d0<2;++d0){s16x4 lo[4],hi[4];
    #pragma unroll
    for(int ks=0;ks<4;++ks){
      asm volatile("ds_read_b64_tr_b16 %0,%1 offset:%c2":"=&v"(lo[ks]):"v"(vb),"i"(d0*4096+ks*1024):"memory");
      asm volatile("ds_read_b64_tr_b16 %0,%1 offset:%c2":"=&v"(hi[ks]):"v"(vb),"i"(d0*4096+ks*1024+512):"memory");}
    asm volatile("s_waitcnt lgkmcnt(0)":::"memory");SBAR();
    #define PK(k) (bf16x8){lo[k][0],lo[k][1],lo[k][2],lo[k][3],hi[k][0],hi[k][1],hi[k][2],hi[k][3]}
    o[d0]=__builtin_amdgcn_mfma_f32_32x32x16_bf16(pa0,PK(0),o[d0],0,0,0);
    o[d0]=__builtin_amdgcn_mfma_f32_32x32x16_bf16(pa1,PK(1),o[d0],0,0,0);
    o[d0]=__builtin_amdgcn_mfma_f32_32x32x16_bf16(pa2,PK(2),o[d0],0,0,0);
    o[d0]=__builtin_amdgcn_mfma_f32_32x32x16_bf16(pa3,PK(3),o[d0],0,0,0);
    #undef PK
  }
}

#ifndef ATTN_STORE16
#define ATTN_STORE16(p,v) (*(u32x4*)(p)=(v))
#endif
template<int THRL,class Hook> __device__ __forceinline__ void attn_unit(const bf16*Q0,const bf16*__restrict__ Kh,const bf16*__restrict__ Vh,int rowa,int na,int rowb,int NT,bf16*O0,const Hook&hook,char*shm,int wid){
  const int lane=otid(wid)&63,r32=lane&31,hi=lane>>5;
  const bf16*Qw=Q0+(long)(wid*QBLK)*PIN_;
  #define TROW(t) ((long)(((t)<na)?(rowa+64*(t)):(rowb+64*((t)-na))))
  const unsigned lds0=(unsigned)(uintptr_t)shm;
  float*wsf=(float*)(shm+LDS_WS)+wid*64;
  const bf16*ksrc=Kh+(long)lane*PIN_+wid*8;
  const bf16*vsrc=Vh+(long)(16*(wid&3)+(lane>>2))*PIN_+(wid>>2)*32+(lane&3)*8;
  const unsigned kdst=lds0+LDS_K+wid*1024, vdst=lds0+LDS_V+wid*1024;
  #define DMA_K(t,slot) glds16(ksrc+TROW(t)*PIN_,(unsigned)__builtin_amdgcn_readfirstlane(kdst+(slot)))
  #define DMA_V(t,slot) glds16(vsrc+TROW(t)*PIN_,(unsigned)__builtin_amdgcn_readfirstlane(vdst+(slot)))
  const int vb0=(int)(lds0+LDS_V)+((lane>>4)&1)*32+(lane&3)*8+(4*hi+((lane&15)>>2))*64;
  const char*Kbase=shm+LDS_K; bf16x8 kf[8];
  const lds_cptr shm3=(lds_cptr)shm; const lds_cptr kp0=shm3+LDS_K+hi*1024+r32*16; const lds_cptr vp0=shm3+LDS_V+((lane>>4)&1)*32+(lane&3)*8+(4*hi+((lane&15)>>2))*64;
  DMA_K(0,0);DMA_V(0,0);DMA_K(1,SLOTB);
  bf16x8 qr[4];
  #pragma unroll
  for(int d0=0;d0<4;++d0)qr[d0]=*reinterpret_cast<const bf16x8*>(&Qw[(long)r32*PIN_+d0*16+hi*8]);
  float zz_=0.f; asm volatile("":"+v"(zz_));
  float mhat=zz_,l_reg=zz_;f32x16 o[2],negm;
  #pragma unroll
  for(int r=0;r<16;++r){o[0][r]=zz_;o[1][r]=zz_;negm[r]=zz_;}
  asm volatile("":"+v"(negm));
  #define CMASK(P0,P1,t) hook(P0,P1,(t),wid,r32,hi)
  bool resc=false;
  #define START(P0,P1) do{ const float rm=rowmax(P0,P1); resc=false; \
    { const float dl=rm; mhat=fadd_s(mhat,dl); \
      _Pragma("unroll") for(int r=0;r<16;++r){P0[r]=fsub_s(P0[r],dl);P1[r]=fsub_s(P1[r],dl);} \
      _Pragma("unroll") for(int r=0;r<16;++r)negm[r]=-mhat; asm volatile("":"+v"(negm)); } \
    _Pragma("unroll") for(int r=0;r<16;++r)P0[r]=__builtin_amdgcn_exp2f(P0[r]); }while(0)
  #define RESC() do{ if(resc){ asm volatile("s_waitcnt lgkmcnt(0)":::"memory"); \
      _Pragma("unroll") for(int d_=0;d_<2;++d_) _Pragma("unroll") for(int r=0;r<16;++r)o[d_][r]*=wsf[crow(r,hi)]; } }while(0)
  f32x16 pA0,pA1,pB0,pB1;
  int sl_prev=0,sl_cur=0,sl_next=SLOTB;
  #define ROT() do{sl_prev=sl_cur;sl_cur=sl_next;sl_next=(sl_next==(NSLOT-1)*SLOTB)?0:sl_next+SLOTB;}while(0)
  DMA_K(2,2*SLOTB);
  WAIT_BAR(3);
  qkt(pA0,pA1,Kbase,qr,negm,r32,hi);asm volatile("s_nop 15\n\ts_nop 7":"+v"(pA0),"+v"(pA1));
  START(pA0,pA1);
  _Pragma("unroll") for(int r=0;r<16;++r)pA1[r]=__builtin_amdgcn_exp2f(pA1[r]);
  WAIT_BAR(0);
  DMA_K(3,0);DMA_V(1,SLOTB);
  ROT();
  kload8(kf,kp0+sl_cur);
  WAIT_BAR(2);
  s16x4 vlo[8],vhi[8]; u32x4 pw0,pw1,pw2,pw3;
  #define PKW(P,B) cvtpk_s(P[B],P[B+1])
  #define PAF(k) __builtin_bit_cast(bf16x8,pw##k)
  #define VFR(i) (bf16x8){vlo[i][0],vlo[i][1],vlo[i][2],vlo[i][3],vhi[i][0],vhi[i][1],vhi[i][2],vhi[i][3]}
  #define PIN(x) asm volatile("":"+v"(x))
  #define MX3(a,b,c) __builtin_fmaxf(__builtin_fmaxf((a),(b)),(c))
  #define GAPA(MF,A0,A1,A2,A3,W0,W1,PW) do{ MF; sacc+=A0; sacc+=A1; sacc+=A2; sacc+=A3; PIN(sacc); W0; W1; PIN(PW); SBAR(); }while(0)
  #define EX(v) __builtin_amdgcn_exp2f(v)
  #define GAPB(MF,X,B) do{ MF; X[B]=EX(X[B]); X[B+1]=EX(X[B+1]); X[B+2]=EX(X[B+2]); X[B+3]=EX(X[B+3]); PIN(X); SBAR(); }while(0)
  #define VRD(i) do{ vlo[i]=vtr(vp_+(((i)>>2)*4096+((i)&3)*1024)); vhi[i]=vtr(vp_+(((i)>>2)*4096+((i)&3)*1024+512)); }while(0)
  #define KRD(G,j) do{ if(G){ kload2(kf,kp0+sl_next,j); SBAR(); } }while(0)
  #define STEP(C0,C1,P0,P1,t,GK,GV,GL) do{ SBAR(); \
    const lds_cptr vp_=vp0+sl_prev; \
    VRD(0); SBAR(); float sacc=(P0[0]+P0[1]); \
    GAPA(C0=__builtin_amdgcn_mfma_f32_32x32x16_bf16(kf[0],qr[0],negm,0,0,0), P0[2],P0[3],P0[4],P0[5],     pw0[0]=PKW(P0,0), pw0[1]=PKW(P0,2), pw0); \
    VRD(4); SBAR(); GAPA(C1=__builtin_amdgcn_mfma_f32_32x32x16_bf16(kf[1],qr[0],negm,0,0,0), P0[6],P0[7],P0[8],P0[9],     pw0[2]=PKW(P0,4), pw0[3]=PKW(P0,6), pw0); \
    VRD(1); SBAR(); GAPA(C0=__builtin_amdgcn_mfma_f32_32x32x16_bf16(kf[2],qr[1],C0,0,0,0),   P0[10],P0[11],P0[12],P0[13], pw1[0]=PKW(P0,8), pw1[1]=PKW(P0,10), pw1); \
    VRD(5); SBAR(); GAPA(C1=__builtin_amdgcn_mfma_f32_32x32x16_bf16(kf[3],qr[1],C1,0,0,0),   P0[14],P0[15],P1[0],P1[1],   pw1[2]=PKW(P0,12),pw1[3]=PKW(P0,14), pw1); \
    VRD(2); SBAR(); GAPA(C0=__builtin_amdgcn_mfma_f32_32x32x16_bf16(kf[4],qr[2],C0,0,0,0),   P1[2],P1[3],P1[4],P1[5],     pw2[0]=PKW(P1,0), pw2[1]=PKW(P1,2), pw2); \
    VRD(6); SBAR(); GAPA(C1=__builtin_amdgcn_mfma_f32_32x32x16_bf16(kf[5],qr[2],C1,0,0,0),   P1[6],P1[7],P1[8],P1[9],     pw2[2]=PKW(P1,4), pw2[3]=PKW(P1,6), pw2); \
    VRD(3); SBAR(); GAPA(C0=__builtin_amdgcn_mfma_f32_32x32x16_bf16(kf[6],qr[3],C0,0,0,0),   P1[10],P1[11],P1[12],P1[13], pw3[0]=PKW(P1,8), pw3[1]=PKW(P1,10), pw3); \
    VRD(7); SBAR(); GAPA(C1=__builtin_amdgcn_mfma_f32_32x32x16_bf16(kf[7],qr[3],C1,0,0,0),   P1[14],P1[15],0.f,0.f,       pw3[2]=PKW(P1,12),pw3[3]=PKW(P1,14), pw3); \
    l_reg+=sacc; \
    if(GK){DMA_K((t)+3,sl_cur);} if(GV){DMA_V((t)+1,sl_next);} \
    CMASK(C0,C1,t); \
    { float a=MX3(C0[0],C0[1],C1[0]),b=MX3(C0[2],C0[3],C1[1]); a=MX3(a,C1[2],C1[3]); \
      _Pragma("unroll") for(int r=4;r<16;r+=4){a=MX3(a,C0[r],C0[r+1]);b=MX3(b,C0[r+2],C0[r+3]);a=MX3(a,C1[r],C1[r+1]);b=MX3(b,C1[r+2],C1[r+3]);} \
      float rm=__builtin_fmaxf(a,b); { auto rr=__builtin_amdgcn_permlane32_swap(__float_as_uint(rm),__float_as_uint(rm),false,false); rm=__builtin_fmaxf(__uint_as_float(rr[0]),__uint_as_float(rr[1])); } \
      resc=false; \
      if(__builtin_expect(__any(rm>(float)THRL),0)){ const float dl=__builtin_fmaxf(rm,0.f); mhat+=dl; \
        _Pragma("unroll") for(int r=0;r<16;++r){C0[r]-=dl;C1[r]-=dl;} \
        _Pragma("unroll") for(int r=0;r<16;++r)negm[r]=-mhat; asm volatile("":"+v"(negm)); \
        const float f=__builtin_amdgcn_exp2f(-dl); l_reg*=f; if(hi==0)wsf[r32]=f; resc=true; } } \
    SBAR(); \
    GAPB(o[0]=__builtin_amdgcn_mfma_f32_32x32x16_bf16(PAF(0),VFR(0),o[0],0,0,0), C0,0); \
    GAPB(o[1]=__builtin_amdgcn_mfma_f32_32x32x16_bf16(PAF(0),VFR(4),o[1],0,0,0), C0,4); \
    KRD(GL,0); GAPB(o[0]=__builtin_amdgcn_mfma_f32_32x32x16_bf16(PAF(1),VFR(1),o[0],0,0,0), C0,8); \
    KRD(GL,1); GAPB(o[1]=__builtin_amdgcn_mfma_f32_32x32x16_bf16(PAF(1),VFR(5),o[1],0,0,0), C0,12); \
    KRD(GL,2); GAPB(o[0]=__builtin_amdgcn_mfma_f32_32x32x16_bf16(PAF(2),VFR(2),o[0],0,0,0), C1,0); \
    KRD(GL,3); GAPB(o[1]=__builtin_amdgcn_mfma_f32_32x32x16_bf16(PAF(2),VFR(6),o[1],0,0,0), C1,4); \
    GAPB(o[0]=__builtin_amdgcn_mfma_f32_32x32x16_bf16(PAF(3),VFR(3),o[0],0,0,0), C1,8); \
    GAPB(o[1]=__builtin_amdgcn_mfma_f32_32x32x16_bf16(PAF(3),VFR(7),o[1],0,0,0), C1,12); \
    }while(0)
  int t=1;
  for(;t+5<NT;t+=2){
    STEP(pB0,pB1,pA0,pA1,t,true,true,true);     WAIT_BAR(2); RESC(); ROT();
    STEP(pA0,pA1,pB0,pB1,t+1,true,true,true);   WAIT_BAR(2); RESC(); ROT();
  }
  #define ENDW(tt) do{ if((tt)+3<NT){WAIT_BAR(2);} else if((tt)+2<NT){WAIT_BAR(1);} else {WAIT_BAR(0);} }while(0)
  for(;t+1<NT;t+=2){
    STEP(pB0,pB1,pA0,pA1,t,(t+3<NT),(t+1<NT),(t+1<NT));       ENDW(t);   RESC(); ROT();
    STEP(pA0,pA1,pB0,pB1,t+1,(t+4<NT),(t+2<NT),(t+2<NT));     ENDW(t+1); RESC(); ROT();
  }
  STEP(pB0,pB1,pA0,pA1,NT-1,false,false,false); RESC();
  { float sacc=pB0[0]+pB0[1]; _Pragma("unroll") for(int r=2;r<16;++r)sacc+=pB0[r]; _Pragma("unroll") for(int r=0;r<16;++r)sacc+=pB1[r]; l_reg+=sacc;
    pw0=(u32x4){PKW(pB0,0),PKW(pB0,2),PKW(pB0,4),PKW(pB0,6)};pw1=(u32x4){PKW(pB0,8),PKW(pB0,10),PKW(pB0,12),PKW(pB0,14)};pw2=(u32x4){PKW(pB1,0),PKW(pB1,2),PKW(pB1,4),PKW(pB1,6)};pw3=(u32x4){PKW(pB1,8),PKW(pB1,10),PKW(pB1,12),PKW(pB1,14)};
    SBAR(); pv(o,vb0+sl_cur,PAF(0),PAF(1),PAF(2),PAF(3)); }
  #undef PKW
  #undef PAF
  #undef VFR
  #undef PIN
  #undef MX3
  #undef GAPA
  #undef GAPB
  #undef EX
  #undef VRD
  #undef KRD
  #undef STEP
  #undef ENDW
  {auto rr=__builtin_amdgcn_permlane32_swap(__float_as_uint(l_reg),__float_as_uint(l_reg),false,false);l_reg=__uint_as_float(rr[0])+__uint_as_float(rr[1]);}
  if(hi==0)wsf[32+r32]=l_reg;asm volatile("s_waitcnt lgkmcnt(0)":::"memory");
  float rli[16];
  #pragma unroll
  for(int r=0;r<16;++r)rli[r]=__builtin_amdgcn_rcpf(wsf[32+crow(r,hi)]);
  bf16*Ow=O0+(long)(wid*QBLK)*POUT;
  { bf16*stg=(bf16*)(shm+LDS_OST)+wid*2048;
    #pragma unroll
    for(int r=0;r<16;++r){const int orow=crow(r,hi);
      #pragma unroll
      for(int d0=0;d0<2;++d0)stg[orow*64+d0*32+r32]=(bf16)f2bf(o[d0][r]*rli[r]);}
    asm volatile("s_waitcnt lgkmcnt(0)":::"memory");
    #pragma unroll
    for(int i=0;i<4;++i){const int row=i*8+(lane>>3),ch=lane&7; const u32x4 v=*(const u32x4*)(stg+row*64+ch*8); ATTN_STORE16(Ow+(long)row*POUT+ch*8,v);} }
  asm volatile("s_waitcnt lgkmcnt(0)\n\ts_barrier":::"memory");
  #undef DMA_K
  #undef DMA_V
  #undef TROW
  #undef CMASK
  #undef START
  #undef RESC
  #undef ROT
}
constexpr int ATTN_LDS_BYTES=LDS_BYTES;
#undef SBAR
#undef WAIT_BAR
}

__device__ __forceinline__ void w_qknorm_rope(const Ptrs& p, int layer, int unit, int d) {
    const int row = unit / 18, slot = unit % 18;
    int col; const float* gain; bool rope;
    if (slot < 4) { col = A_Q + slot * 64; gain = p.in[I_NAQN] + layer * 64; rope = false; }
    else if (slot < 8) { col = A_K + (slot - 4) * 64; gain = p.in[I_NAKN] + layer * 64; rope = false; }
    else if (slot < 16) { col = B_Q + (slot - 8) * 64; gain = p.in[I_GQQN] + layer * 64; rope = true; }
    else { col = B_K + (slot - 16) * 64; gain = p.in[I_GQKN] + layer * 64; rope = true; }
    bf16* pp = (bf16*)(p.ws + WS_P) + (size_t)row * DIN + col;
    float x = bf2f(pp[d]);
    float ss = wave_sum(x * x, d);
    float y = x * rsqrtf(ss * (1.f / 64.f) + 1e-6f) * gain[d];
    if (rope && row < NLAT) {
        int t = row & (SEQ - 1);
        float partner = shx(y, 1, d);
        int pi = d >> 1;
        float pos = (pi < 16) ? (float)(t >> 6) : (float)(t & 63);
        float inv = exp2f(-(float)(pi & 15) * (13.287712379549449f / 16.f));
        float ang = pos * inv;
        float cs = __cosf(ang), sn = __sinf(ang);
        y = (d & 1) ? (partner * sn + y * cs) : (y * cs - partner * sn);
    }
    if (slot < 4 || (slot >= 8 && slot < 16)) y *= att::C2;
    pp[d] = (bf16)f2bf(y);
}
struct NoHook { __device__ __forceinline__ void operator()(att::f32x16&, att::f32x16&, int, int, int, int) const {} };
struct NaHook {
    const LAS float* tab; int r0, kr0;
    __device__ __forceinline__ void operator()(att::f32x16& p0, att::f32x16& p1, int t, int wid, int r32, int hi) const {
        if (t < 4) return;
        const int r = r0 + (wid >> 1), kr = kr0 + t - 4, rs = min(max(r - 4, 0), 24);
        const float NEG = -INFINITY;
        if ((unsigned)(kr - rs) >= 8u) {
#pragma unroll
            for (int i = 0; i < 16; ++i) { p0[i] = NEG; p1[i] = NEG; }
            return;
        }
        const int qc = 32 * (wid & 1) + r32, cs = min(max(qc - 8, 0), 48), kb = 4 * hi - cs;
        const LAS float* tp = tab + (kr - r + 7) * 31 + (4 * hi - qc + 15);
#pragma unroll
        for (int i = 0; i < 16; ++i) {
            const int c = (i & 3) + 8 * (i >> 2);
            const float b0 = tp[c], b1 = tp[c + 32];
            p0[i] = ((unsigned)(kb + c) < 16u) ? p0[i] + b0 : NEG;
            p1[i] = ((unsigned)(kb + c + 32) < 16u) ? p1[i] + b1 : NEG;
        }
    }
};
constexpr int LDS_NATAB = 88064;
__device__ __forceinline__ void phase_attn(const Ptrs& p, unsigned char* lds_gen, int layer, int wv) {
    const bf16* P = (const bf16*)(p.ws + WS_P); bf16* MIX = (bf16*)(p.ws + WS_MIX);
    char* shm = (char*)lds_gen;
    const int c = blockIdx.x, x = c & 7, ci = (c >> 3) & 31;
    for (int i = 0; i < 2; ++i) {
        const int grp = 2 * x + i, b = grp >> 1, kvh = grp & 1, g = ci >> 3, qb = ci & 7, hq = kvh * 4 + g;
        const size_t qrow = (size_t)b * SEQ + qb * 256;
        att::attn_unit<8, NoHook>(P + qrow * DIN + B_Q + hq * 64, P + B_K + kvh * 64, P + B_V + kvh * 64, b * SEQ, 32, NLAT + b * CTXL, 36,
                                  MIX + qrow * DM + 256 + hq * 64, NoHook{}, shm, wv);
    }
    {
        const int grp = 4 * x + (ci >> 3), b = grp >> 2, h = grp & 3, r0 = 4 * (ci & 7);
        const int kr0 = (r0 == 0) ? 0 : (r0 == 28 ? 24 : r0 - 4), nr = (r0 == 0 || r0 == 28) ? 8 : 12;
        LAS float* tab = (LAS float*)((LAS unsigned char*)lds_gen + LDS_NATAB);
        const float* rpb = p.in[I_RPB] + ((size_t)layer * 4 + h) * 15 * 31;
        for (int i = otid(wv); i < 15 * 31; i += NT) tab[i] = rpb[i] * 1.4426950408889634f;
        __syncthreads();
        const size_t qrow = (size_t)b * SEQ + r0 * 64;
        NaHook hook{tab, r0, kr0};
        att::attn_unit<8, NaHook>(P + qrow * DIN + A_Q + h * 64, P + A_K + h * 64, P + A_V + h * 64, NLAT + b * CTXL, 4, b * SEQ + kr0 * 64, 4 + nr,
                                  MIX + qrow * DM + h * 64, hook, shm, wv);
    }
    if (layer == 0 && c < 96) {
        if (c < 32) {
            const int b = c >> 2, h = c & 3; const size_t qrow = (size_t)NLAT + b * CTXL;
            att::attn_unit<8, NoHook>(P + qrow * DIN + A_Q + h * 64, P + A_K + h * 64, P + A_V + h * 64, NLAT + b * CTXL, 4, 0, 4, MIX + qrow * DM + h * 64, NoHook{}, shm, wv);
        } else {
            const int cc = c - 32, b = cc >> 3, hq = cc & 7, kvh = hq >> 2; const size_t qrow = (size_t)NLAT + b * CTXL;
            att::attn_unit<8, NoHook>(P + qrow * DIN + B_Q + hq * 64, P + B_K + kvh * 64, P + B_V + kvh * 64, NLAT + b * CTXL, 4, 0, 4, MIX + qrow * DM + 256 + hq * 64, NoHook{}, shm, wv);
        }
    }
}

__global__ void __launch_bounds__(NT, 2) k_mega(Ptrs p) {
    extern __shared__ __attribute__((aligned(16))) unsigned char lds_raw[];
    LAS unsigned char* lds = (LAS unsigned char*)lds_raw;
    cg::grid_group grid = cg::this_grid();
#define GRID_SYNC() do { asm volatile("s_waitcnt vmcnt(0)" ::: "memory"); grid.sync(); __builtin_amdgcn_fence(__ATOMIC_ACQUIRE, "agent"); asm volatile("s_waitcnt vmcnt(0)" ::: "memory"); } while (0)
    const int wv = __builtin_amdgcn_readfirstlane(threadIdx.x >> 6);
    const int NGW = gridDim.x * NWAVES;
    phase_mod(p, lds, wv);
    phase_lb(p, wv);
    __syncthreads();
    phase_convert(p, lds, 0, 2, wv);
    phase_router_w(p, wv);
    GRID_SYNC();
    phase_norm(p.in[I_X], p.in[I_CTX], p.in[I_N1G], (const float*)(p.ws + WS_MOD), 0, 1, (bf16*)(p.ws + WS_H), MROWS, wv);
    GRID_SYNC();
    for (int layer = 0; layer < 2; ++layer) {
        const int M = (layer == 0) ? MROWS : NLAT;
        const float* modl = (const float*)(p.ws + WS_MOD) + (size_t)layer * 9 * MODW;
        {
            pg8::Gemm g{(const bf16*)(p.ws + WS_H), (const bf16*)(p.ws + WS_WIN + layer * WIN_STRIDE), MROWS, DIN, DM};
            pg8::StaticOrder S; S.init(MROWS, DIN, gridDim.x, (int)blockIdx.x);
            pg8::EpiBf16<0> E{(bf16*)(p.ws + WS_P), DIN, nullptr, 0, 0, 1.f};
            pg8::gemm_phase<pg8::EpiBf16<0>, pg8::StaticOrder, true, true>(lds, g, S, E, wv);
        }
        GRID_SYNC();
        { const int lane = otid(wv) & 63; for (int u = blockIdx.x * NWAVES + wv; u < MROWS * 18; u += NGW) w_qknorm_rope(p, layer, u, lane); }
        GRID_SYNC();
        phase_hgrn1(p, lds, layer, wv);
        GRID_SYNC();
        phase_hgrn2(p, lds, layer, wv);
        __syncthreads();
        phase_attn(p, lds_raw, layer, wv);
        GRID_SYNC();
        {
            pg8::Gemm g{(const bf16*)(p.ws + WS_MIX), (const bf16*)(p.ws + WS_WOUT + layer * WOUT_STRIDE), M, DM, DM};
            pg8::StaticOrder S; S.init(M, DM, gridDim.x, (int)blockIdx.x);
            pg8::EpiResidSS E{layer == 0 ? p.in[I_X] : p.out, p.in[I_CTX], p.out, (float*)(p.ws + WS_XC), modl, 2, (float*)(p.ws + WS_RSS), wv};
            pg8::gemm_phase<pg8::EpiResidSS, pg8::StaticOrder, true, true>(lds, g, S, E, wv);
        }
        GRID_SYNC();
        phase_route(p, lds, layer, M, wv);
        GRID_SYNC();
        phase_moe_gu(p, lds, layer, wv);
        GRID_SYNC();
        phase_moe_down(p, lds, layer, wv);
        GRID_SYNC();
        phase_combine(p, layer, M, layer == 0, wv);
        if (layer == 0) GRID_SYNC();
    }
}

extern "C" void kernel_launch(void* const* d_in, const int* in_sizes, int n_in, void* d_out, int out_size, void* d_ws, size_t ws_size, hipStream_t stream) {
    static int grid = 0;
    if (grid == 0) {
        if (n_in != 24 || ws_size < WS_END) { fprintf(stderr, "kernel_launch: bad n_in %d or ws_size %zu < %zu\n", n_in, ws_size, (size_t)WS_END); grid = -1; return; }
        int dev = 0, cus = 0, per_cu = 0;
        hipGetDevice(&dev); hipDeviceGetAttribute(&cus, hipDeviceAttributeMultiprocessorCount, dev);
        hipFuncSetAttribute((const void*)k_mega, hipFuncAttributeMaxDynamicSharedMemorySize, LDS_BYTES);
        hipOccupancyMaxActiveBlocksPerMultiprocessor(&per_cu, (const void*)k_mega, NT, LDS_BYTES);
        if (per_cu < 1) { fprintf(stderr, "kernel_launch: occupancy query says %d blocks/CU\n", per_cu); grid = -1; return; }
        grid = cus;
        (void)hipGetLastError();
    }
    if (grid < 0) return;
    Ptrs p{};
    for (int i = 0; i < 24; ++i) p.in[i] = (const float*)d_in[i];
    p.out = (float*)d_out; p.ws = (unsigned char*)d_ws; p.layer = 0; p.pad = 0;
    hipMemsetAsync((unsigned char*)d_ws + WS_CTL, 0, 1 * MiB, stream);
    void* args[] = {&p};
    hipError_t e = hipLaunchCooperativeKernel((const void*)k_mega, dim3(grid), dim3(NT), args, LDS_BYTES, stream);
    if (e != hipSuccess) fprintf(stderr, "cooperative launch failed: %s\n", hipGetErrorString(e));
}
```

```cpp
#include <hip/hip_runtime.h>
#include <hip/hip_cooperative_groups.h>
#include <cstdio>
#include <cstdint>
#include <math.h>
namespace cg = cooperative_groups;

#define DM 1024
#define SEQ 2048
#define CTXL 256
#define NBATCH 8
#define NLAT (NBATCH * SEQ)
#define NCTX (NBATCH * CTXL)
#define MROWS (NLAT + NCTX)
#define DIN 2816
#define NMOD 6
#define MODW (NMOD * DM)
#define A_Q 0
#define A_K 256
#define A_V 512
#define B_Q 768
#define B_K 1280
#define B_V 1408
#define C_Q 1536
#define C_I 1792
#define C_FF 2048
#define C_FB 2304
#define C_G 2560

typedef unsigned short bf16;
#define LAS __attribute__((address_space(3)))
#define GAS __attribute__((address_space(1)))
typedef unsigned v4u __attribute__((ext_vector_type(4)));
typedef unsigned v2u __attribute__((ext_vector_type(2)));
typedef float v4f __attribute__((ext_vector_type(4)));

__device__ __forceinline__ unsigned f2bf(float f) { unsigned u = __builtin_bit_cast(unsigned, f); return (u + 0x7fffu + ((u >> 16) & 1u)) >> 16; }
__device__ __forceinline__ unsigned pk2(float lo, float hi) { return f2bf(lo) | (f2bf(hi) << 16); }
__device__ __forceinline__ float bf2f(unsigned short v) { return __builtin_bit_cast(float, (unsigned)v << 16); }
__device__ __forceinline__ float bflo(unsigned v) { return __builtin_bit_cast(float, v << 16); }
__device__ __forceinline__ float bfhi(unsigned v) { return __builtin_bit_cast(float, v & 0xffff0000u); }
__device__ __forceinline__ float silu_f(float x) { return x / (1.f + __expf(-x)); }
__device__ __forceinline__ float shx(float v, int mask, int lane) { return __builtin_bit_cast(float, __builtin_amdgcn_ds_bpermute((lane ^ mask) << 2, __builtin_bit_cast(int, v))); }
__device__ __forceinline__ float wave_sum(float v, int lane) {
#pragma unroll
    for (int o = 1; o < 64; o <<= 1) v += shx(v, o, lane);
    return v;
}
__device__ __forceinline__ int otid(int wv) { unsigned m = ~0u; asm volatile("" : "+s"(m)); asm volatile("" : "+s"(wv)); return wv * 64 + (int)__builtin_amdgcn_mbcnt_hi(m, __builtin_amdgcn_mbcnt_lo(m, 0u)); }
#define LDS_WAIT() asm volatile("s_waitcnt lgkmcnt(0)" ::: "memory")

constexpr size_t MiB = 1u << 20;
constexpr size_t WS_CTL = 0;
constexpr size_t WS_MOD = 1 * MiB;
constexpr size_t WS_LB = 1 * MiB + 512 * 1024;
constexpr size_t WS_EID = 2 * MiB;
constexpr size_t WS_EW = 2 * MiB + 256 * 1024;
constexpr size_t WS_IDX = 3 * MiB;
constexpr size_t WS_XC = 8 * MiB;
constexpr size_t WS_WIN = 16 * MiB;
constexpr size_t WIN_STRIDE = (size_t)DIN * DM * 2;
constexpr size_t WS_WOUT = 28 * MiB;
constexpr size_t WOUT_STRIDE = 2 * MiB;
constexpr size_t WS_WGU = 32 * MiB;
constexpr size_t WGU_STRIDE = 32 * MiB;
constexpr size_t WS_WD = 96 * MiB;
constexpr size_t WD_STRIDE = 16 * MiB;
constexpr size_t WS_H = 128 * MiB;
constexpr size_t WS_MIX = 164 * MiB;
constexpr size_t WS_P = 200 * MiB;
constexpr size_t WS_Y0 = 200 * MiB;
constexpr size_t WS_Y1 = 236 * MiB;
constexpr size_t WS_HID = 272 * MiB;
constexpr size_t WS_SCR = 300 * MiB;
constexpr size_t WS_END = 340 * MiB;

constexpr int NT = 512, NWAVES = 8;
constexpr int LDS_BYTES = 147456;
namespace pg8 {
#define PG8_LAS __attribute__((address_space(3)))
typedef unsigned short bf16_t;
typedef short bf16x8 __attribute__((ext_vector_type(8)));
typedef float f32x4 __attribute__((ext_vector_type(4)));
typedef unsigned u32x4 __attribute__((ext_vector_type(4)));
constexpr int BM = 256, BK = 64, HALF = 128, HTB = HALF * BK * 2  , STAGE_BYTES = 8 * HTB, NXCD = 8, WGM = 8;

__host__ __device__ __forceinline__ int lds_byte(int r, int c) { const int st = (r >> 4) * 2 + (c >> 5), rr = r & 15, cc = c & 31, ob = rr * 64 + cc * 2; return st * 1024 + (ob ^ (((ob >> 9) & 1) << 5)); }
__host__ __device__ __forceinline__ void stage_rc(int b, int& R, int& C) { const int st = b / 1024, sb = b % 1024, swz = sb ^ (((sb >> 9) & 1) << 5); R = (st >> 1) * 16 + swz / 64; C = (st & 1) * 32 + (swz % 64) / 2; }
__host__ __device__ __forceinline__ int perm32(int rho) { const int n = rho >> 4, i = rho & 15; return 8 * (i >> 2) + 4 * n + (i & 3); }

struct Unit { int pm, pn, aux; };
struct Gemm { const bf16_t* A; const bf16_t* Bt; int M, N, K; };

struct StaticOrder {
    int nM, nN, nwg, G, c;
    __host__ __device__ void init(int M, int N, int G_, int c_) { nM = M / BM; nN = N / BM; nwg = nM * nN; G = G_; c = c_; }
    __host__ __device__ bool next(int i, Unit& u) const {
        const long L = (long)i * G + c; if (L >= nwg) return false;
        int wgid = (int)L; { const int q = nwg / NXCD, r = nwg % NXCD, xcd = wgid % NXCD, off = wgid / NXCD; wgid = (xcd < r ? xcd * (q + 1) : r * (q + 1) + (xcd - r) * q) + off; }
        const int nig = WGM * nN, gid = wgid / nig, fm = gid * WGM, gsz = (nM - fm) < WGM ? (nM - fm) : WGM;
        u.pm = fm + ((wgid % nig) % gsz); u.pn = (wgid % nig) / gsz; return true;
    }
    __device__ __forceinline__ void a_ready(const Unit&) const {}
    __device__ __forceinline__ void done(const Unit&) const {}
};

__device__ __forceinline__ unsigned cvt_pk_bf16(float lo, float hi) { unsigned r; asm volatile("v_cvt_pk_bf16_f32 %0, %1, %2" : "=v"(r) : "v"(lo), "v"(hi)); return r; }
typedef float f32x2 __attribute__((ext_vector_type(2)));
__device__ __forceinline__ f32x2 gelu_pk(f32x2 v) {
    const f32x2 av = __builtin_elementwise_abs(v), d = av * 0.2316418882f + 1.0f;
    f32x2 t; t.x = __builtin_amdgcn_rcpf(d.x); t.y = __builtin_amdgcn_rcpf(d.y);
    f32x2 q = t * 0.5307027145f + (-0.7265760135f); q = q * t + 0.7107068705f; q = q * t + (-0.142248368f); q = q * t + 0.127414796f; q = q * t;
    const f32x2 s = (v * v) * (-0.72134752044f);
    f32x2 e; e.x = __builtin_amdgcn_exp2f(s.x); e.y = __builtin_amdgcn_exp2f(s.y);
    const f32x2 m = v * (q * e), r = v - m;
    f32x2 o; o.x = v.x < 0.f ? m.x : r.x; o.y = v.y < 0.f ? m.y : r.y; return o;
}

template <int ACT  > struct EpiBf16 {
    static constexpr bool PERM = true, AFTER_DRAIN = false; static_assert(ACT == 0 || ACT == 1, "EpiBf16: ACT is 0 (none) or 1 (gelu_pk)");
    bf16_t* O; int ldc; const float* bias; int split_cols; size_t split_stride; float scale0;
    __device__ __forceinline__ void operator()(const f32x4 (&acc)[2][2][4][2], const Unit& u, int wr, int wc, int fr, int fq) const {
        const int row0 = u.pm * BM + wr * 64 + fr; int colt = u.pn * BM; bf16_t* base = O;
        float sc = 1.f; if (split_cols) { const int t = colt / split_cols; base += (size_t)t * split_stride; colt -= t * split_cols; if (t == 0) sc = scale0; }
        const int col0 = colt + wc * 32 + 8 * fq, bcol0 = u.pn * BM + wc * 32 + 8 * fq;
        f32x4 bv[2][2];
#pragma unroll
        for (int bj = 0; bj < 2; ++bj)
#pragma unroll
            for (int n = 0; n < 2; ++n) bv[bj][n] = bias ? *(const f32x4*)(bias + bcol0 + bj * HALF + 4 * n) : (f32x4){0.f, 0.f, 0.f, 0.f};
#pragma unroll
        for (int ai = 0; ai < 2; ++ai)
#pragma unroll
            for (int m = 0; m < 4; ++m) { bf16_t* rowp = base + (size_t)(row0 + ai * HALF + m * 16) * ldc + col0;
#pragma unroll
                for (int bj = 0; bj < 2; ++bj) { f32x4 v0 = acc[ai][bj][m][0] + bv[bj][0], v1 = acc[ai][bj][m][1] + bv[bj][1];
                    if (ACT == 1) { f32x2 a = gelu_pk((f32x2){v0[0], v0[1]}), b = gelu_pk((f32x2){v0[2], v0[3]}), c = gelu_pk((f32x2){v1[0], v1[1]}), d = gelu_pk((f32x2){v1[2], v1[3]});
                        v0 = (f32x4){a.x, a.y, b.x, b.y}; v1 = (f32x4){c.x, c.y, d.x, d.y}; }
                    v0 = v0 * sc; v1 = v1 * sc; u32x4 w; w.x = cvt_pk_bf16(v0[0], v0[1]); w.y = cvt_pk_bf16(v0[2], v0[3]); w.z = cvt_pk_bf16(v1[0], v1[1]); w.w = cvt_pk_bf16(v1[2], v1[3]);
                    *(u32x4*)(rowp + bj * HALF) = w; } }
    }
};

template <class Epi, class Sched, bool ALIGN_EPI = false, bool SP2 = false, bool GATHER = false>
__device__ __forceinline__ void gemm_phase(PG8_LAS unsigned char* lds, const Gemm g, const Sched& S, const Epi& E, int wv, const PG8_LAS int* gidx = nullptr) {
    static_assert(SP2 || !GATHER, "GATHER is wired into the SP2 loop only");
    int tid_ = otid(wv);
    const int tid = tid_, wid = __builtin_amdgcn_readfirstlane(tid >> 6), lane = tid & 63, wr = wid >> 2, wc = wid & 3, fr = lane & 15, fq = lane >> 4;
    const int K = g.K, nt = K / BK;
    unsigned voffA[2][2], nvoffA[2][2], voffB[2]; int RA[2], CA[2];
#pragma unroll
    for (int i = 0; i < 2; ++i) { int R, C; stage_rc(tid * 16 + i * 8192, R, C); const int Rb = Epi::PERM ? ((R & ~31) + perm32(R & 31)) : R; RA[i] = R; CA[i] = C;
        voffA[0][i] = voffA[1][i] = nvoffA[0][i] = nvoffA[1][i] = (unsigned)(R * K + C) * 2u; voffB[i] = (unsigned)(Rb * K + C) * 2u; }
#define PG8_GVOFF(dst, uidx) do { if constexpr (GATHER) { _Pragma("unroll") for (int _h = 0; _h < 2; ++_h) _Pragma("unroll") for (int _i = 0; _i < 2; ++_i) dst[_h][_i] = (unsigned)(gidx[(uidx) * 256 + _h * 128 + RA[_i]] * K + CA[_i]) * 2u; } } while (0)
    const size_t kstep = (size_t)(BK * 2);
    const size_t hstep = (size_t)HALF * K * 2;
    const size_t hstepA = GATHER ? (size_t)0 : hstep;
    const size_t tstep = 2 * hstep;
    const unsigned ldsw = (unsigned)wid * 1024u;
    const int aoff = lds_byte(wr * 64 + fr, fq * 8), boff = lds_byte(wc * 32 + fr, fq * 8);
#define PG8_SA(b, h) (((b) * 2 + (h)) * HTB)
#define PG8_SB(b, h) ((4 + (b) * 2 + (h)) * HTB)
#define PG8_STAGE(bufoff, gbase, voff) do { _Pragma("unroll") for (int _i = 0; _i < 2; ++_i) \
        __builtin_amdgcn_global_load_lds((const unsigned*)((const char*)(gbase) + (voff)[_i]), (PG8_LAS unsigned*)(lds + (bufoff) + ldsw + _i * 8192), 16, 0, 0); } while (0)
#define PG8_LDA(dst, b, h) do { _Pragma("unroll") for (int m = 0; m < 4; ++m) _Pragma("unroll") for (int k = 0; k < 2; ++k) dst[m][k] = *(const PG8_LAS bf16x8*)(lds + PG8_SA(b, h) + aoff + m * 2048 + k * 1024); } while (0)
#define PG8_LDB(dst, b, h) do { _Pragma("unroll") for (int n = 0; n < 2; ++n) _Pragma("unroll") for (int k = 0; k < 2; ++k) dst[n][k] = *(const PG8_LAS bf16x8*)(lds + PG8_SB(b, h) + boff + n * 2048 + k * 1024); } while (0)
#define PG8_MMA(ai, bj, At, Bt) do { __builtin_amdgcn_s_setprio(1); _Pragma("unroll") for (int m = 0; m < 4; ++m) _Pragma("unroll") for (int n = 0; n < 2; ++n) _Pragma("unroll") for (int k = 0; k < 2; ++k) \
        acc[ai][bj][m][n] = __builtin_amdgcn_mfma_f32_16x16x32_bf16(Bt[n][k], At[m][k], acc[ai][bj][m][n], 0, 0, 0); __builtin_amdgcn_s_setprio(0); } while (0)
#define PG8_WAIT_V(n) asm volatile("s_waitcnt vmcnt(" #n ")" ::: "memory")
#define PG8_WAIT_L(n) asm volatile("s_waitcnt lgkmcnt(" #n ")" ::: "memory")
#define PG8_BAR __builtin_amdgcn_s_barrier()
#define PG8_SCHED __builtin_amdgcn_sched_barrier(0)
    Unit cur, nxt; int ui = 0;
    if (!S.next(0, cur)) return;
    f32x4 acc[2][2][4][2];
#pragma unroll
    for (int a = 0; a < 2; ++a)
#pragma unroll
        for (int b = 0; b < 2; ++b)
#pragma unroll
            for (int m = 0; m < 4; ++m)
#pragma unroll
                for (int n = 0; n < 2; ++n) acc[a][b][m][n] = (f32x4){0.f, 0.f, 0.f, 0.f};
    bf16x8 At[4][2], B0[2][2], B1[2][2];
    const char* cA = (const char*)g.A + (GATHER ? (size_t)0 : (size_t)cur.pm * tstep); PG8_GVOFF(voffA, 0); const char* cB = (const char*)g.Bt + (size_t)cur.pn * tstep;
    S.a_ready(cur);
    if constexpr (SP2) {
        PG8_STAGE(PG8_SB(0, 0), cB, voffB); PG8_STAGE(PG8_SB(0, 1), cB + hstep, voffB); PG8_STAGE(PG8_SA(0, 0), cA, voffA[0]); PG8_STAGE(PG8_SA(0, 1), cA + hstepA, voffA[1]);
        if (wr == 1) PG8_BAR;
        PG8_WAIT_V(2); PG8_BAR;
        PG8_STAGE(PG8_SB(1, 0), cB + kstep, voffB); PG8_STAGE(PG8_SA(1, 0), cA + kstep, voffA[0]); PG8_STAGE(PG8_SB(1, 1), cB + hstep + kstep, voffB);
        PG8_WAIT_V(6); PG8_BAR;
    } else {
        PG8_STAGE(PG8_SB(0, 0), cB, voffB); PG8_STAGE(PG8_SA(0, 0), cA, voffA[0]); PG8_STAGE(PG8_SB(0, 1), cB + hstep, voffB); PG8_STAGE(PG8_SA(0, 1), cA + hstep, voffA[0]);
        if (wr == 1) PG8_BAR;
        PG8_WAIT_V(4); PG8_BAR;
        PG8_STAGE(PG8_SB(1, 0), cB + kstep, voffB); PG8_STAGE(PG8_SA(1, 0), cA + kstep, voffA[0]); PG8_STAGE(PG8_SB(1, 1), cB + hstep + kstep, voffB);
        PG8_WAIT_V(6); PG8_BAR;
    }
    for (;;) {
        const bool has_next = S.next(ui + 1, nxt);
        const char* nA = (has_next && !GATHER) ? (const char*)g.A + (size_t)nxt.pm * tstep : cA; if (has_next) PG8_GVOFF(nvoffA, ui + 1); const char* nB = has_next ? (const char*)g.Bt + (size_t)nxt.pn * tstep : cB;
        for (int t = 0; t < nt; t += 2) {
            const bool last = (t == nt - 2);
            const char* a1 = cA + (size_t)(t + 1) * kstep;
            const char* a2 = last ? nA : cA + (size_t)(t + 2) * kstep; const char* b2 = last ? nB : cB + (size_t)(t + 2) * kstep;
            const char* a3 = a2 + kstep; const char* b3 = b2 + kstep;
            if (last && has_next) S.a_ready(nxt);
            unsigned vs2[2][2];
#pragma unroll
            for (int _h = 0; _h < 2; ++_h)
#pragma unroll
                for (int _i = 0; _i < 2; ++_i) vs2[_h][_i] = last ? nvoffA[_h][_i] : voffA[_h][_i];
            if constexpr (SP2) {
            PG8_LDB(B0, 0, 0); PG8_LDB(B1, 0, 1); PG8_SCHED; PG8_LDA(At, 0, 0); PG8_STAGE(PG8_SA(1, 1), a1 + hstepA, voffA[1]);
            PG8_WAIT_V(8); PG8_WAIT_L(0); PG8_BAR; PG8_MMA(0, 0, At, B0); PG8_MMA(0, 1, At, B1); PG8_BAR; PG8_SCHED;
            PG8_LDA(At, 0, 1); PG8_STAGE(PG8_SB(0, 0), b2, voffB); PG8_STAGE(PG8_SB(0, 1), b2 + hstep, voffB); PG8_STAGE(PG8_SA(0, 0), a2, vs2[0]);
            PG8_WAIT_V(8); PG8_WAIT_L(0); PG8_BAR; PG8_MMA(1, 0, At, B0); PG8_MMA(1, 1, At, B1); PG8_BAR; PG8_SCHED;
            PG8_LDB(B0, 1, 0); PG8_LDB(B1, 1, 1); PG8_SCHED; PG8_LDA(At, 1, 0); PG8_STAGE(PG8_SA(0, 1), a2 + hstepA, vs2[1]);
            PG8_WAIT_V(8); PG8_WAIT_L(0); PG8_BAR; PG8_MMA(0, 0, At, B0); PG8_MMA(0, 1, At, B1); PG8_BAR; PG8_SCHED;
            PG8_LDA(At, 1, 1); PG8_STAGE(PG8_SB(1, 0), b3, voffB); PG8_STAGE(PG8_SB(1, 1), b3 + hstep, voffB); PG8_STAGE(PG8_SA(1, 0), a3, vs2[0]);
            PG8_WAIT_V(8); PG8_WAIT_L(0); PG8_BAR; PG8_MMA(1, 0, At, B0); PG8_MMA(1, 1, At, B1); PG8_BAR; PG8_SCHED;
            } else {
            PG8_LDB(B0, 0, 0); PG8_SCHED; PG8_LDA(At, 0, 0); PG8_STAGE(PG8_SA(1, 1), a1 + hstep, voffA[0]);
            PG8_WAIT_L(8); PG8_BAR; PG8_WAIT_L(0); PG8_MMA(0, 0, At, B0); PG8_BAR; PG8_SCHED;
            PG8_LDB(B1, 0, 1); PG8_STAGE(PG8_SB(0, 0), b2, voffB);
            PG8_BAR; PG8_WAIT_L(0); PG8_MMA(0, 1, At, B1); PG8_BAR;
            PG8_LDA(At, 0, 1); PG8_STAGE(PG8_SA(0, 0), a2, voffA[0]);
            PG8_BAR; PG8_WAIT_L(0); PG8_MMA(1, 0, At, B0); PG8_BAR; PG8_SCHED;
            PG8_STAGE(PG8_SB(0, 1), b2 + hstep, voffB);
            PG8_WAIT_V(6); PG8_BAR; PG8_MMA(1, 1, At, B1); PG8_BAR;
            PG8_LDB(B0, 1, 0); PG8_SCHED; PG8_LDA(At, 1, 0); PG8_STAGE(PG8_SA(0, 1), a2 + hstep, voffA[0]);
            PG8_WAIT_L(8); PG8_BAR; PG8_WAIT_L(0); PG8_MMA(0, 0, At, B0); PG8_BAR; PG8_SCHED;
            PG8_LDB(B1, 1, 1); PG8_STAGE(PG8_SB(1, 0), b3, voffB);
            PG8_BAR; PG8_WAIT_L(0); PG8_MMA(0, 1, At, B1); PG8_BAR;
            PG8_LDA(At, 1, 1); PG8_STAGE(PG8_SA(1, 0), a3, voffA[0]);
            PG8_BAR; PG8_WAIT_L(0); PG8_MMA(1, 0, At, B0); PG8_BAR; PG8_SCHED;
            PG8_STAGE(PG8_SB(1, 1), b3 + hstep, voffB);
            PG8_WAIT_V(6); PG8_BAR; PG8_MMA(1, 1, At, B1); PG8_BAR;
            }
        }
        if constexpr (ALIGN_EPI) { if (wr == 0) PG8_BAR; }
        if constexpr (!Epi::AFTER_DRAIN) { E(acc, cur, wr, wc, fr, fq); S.done(cur); }
        if (!has_next) break;
#pragma unroll
        for (int a = 0; a < 2; ++a)
#pragma unroll
            for (int b = 0; b < 2; ++b)
#pragma unroll
                for (int m = 0; m < 4; ++m)
#pragma unroll
                    for (int n = 0; n < 2; ++n) acc[a][b][m][n] = (f32x4){0.f, 0.f, 0.f, 0.f};
        cur = nxt; cA = nA; cB = nB; ++ui;
#pragma unroll
        for (int _h = 0; _h < 2; ++_h)
#pragma unroll
            for (int _i = 0; _i < 2; ++_i) voffA[_h][_i] = nvoffA[_h][_i];
        if constexpr (ALIGN_EPI) { if (wr == 1) PG8_BAR; }
    }
    PG8_WAIT_V(0);
    if constexpr (!ALIGN_EPI) { if (wr == 0) PG8_BAR; }
    PG8_BAR;
    if constexpr (Epi::AFTER_DRAIN) { E.fused(acc, cur, wr, wc, fr, fq, lds, wid, lane); S.done(cur); }
#undef PG8_SA
#undef PG8_GVOFF
#undef PG8_SB
#undef PG8_STAGE
#undef PG8_LDA
#undef PG8_LDB
#undef PG8_MMA
#undef PG8_WAIT_V
#undef PG8_WAIT_L
#undef PG8_BAR
#undef PG8_SCHED
}
}


struct Ptrs { const float* in[24]; float* out; unsigned char* ws; int layer; int pad; };
enum { I_X = 0, I_C, I_CTX, I_CCTX, I_WADA, I_BADA, I_N1G, I_WIN, I_NAQN, I_NAKN, I_RPB, I_GQQN, I_GQKN, I_LB, I_HGON, I_WOUT, I_N2G, I_WRG, I_BRG, I_WRE, I_BRE, I_WEG, I_WEU, I_WED };

namespace pg8 {
struct EpiResid {
    static constexpr bool PERM = false, AFTER_DRAIN = false;
    const float* xin_lat; const float* xin_ctx; float* xout_lat; float* xout_ctx; const float* modl; int chunk;
    __device__ __forceinline__ void operator()(const f32x4 (&acc)[2][2][4][2], const Unit& u, int wr, int wc, int fr, int fq) const {
        const int rowt = u.pm * BM; const bool isctx = rowt >= NLAT;
        const float* xin = isctx ? xin_ctx + (size_t)(rowt - NLAT) * DM : xin_lat + (size_t)rowt * DM;
        float* xo = isctx ? xout_ctx + (size_t)(rowt - NLAT) * DM : xout_lat + (size_t)rowt * DM;
        const int mrow = isctx ? 8 : (rowt >> 11);
        const float* gate = modl + (size_t)mrow * MODW + chunk * DM;
        const int col0 = u.pn * BM + wc * 32 + 4 * fq;
#pragma unroll
        for (int bj = 0; bj < 2; ++bj)
#pragma unroll
            for (int n = 0; n < 2; ++n) {
                const int col = col0 + bj * HALF + n * 16;
                const f32x4 gv = *(const f32x4*)(gate + col);
#pragma unroll
                for (int ai = 0; ai < 2; ++ai)
#pragma unroll
                    for (int m = 0; m < 4; ++m) {
                        const size_t off = (size_t)(ai * HALF + wr * 64 + m * 16 + fr) * DM + col;
                        const f32x4 xi = *(const f32x4*)(xin + off);
                        *(f32x4*)(xo + off) = xi + gv * acc[ai][bj][m][n];
                    }
            }
    }
};
}

__device__ __forceinline__ void phase_mod(const Ptrs& p, LAS unsigned char* lds, int wv) {
    if (blockIdx.x >= 192) return;
    LAS float* sc = (LAS float*)lds;
    LAS float* red = (LAS float*)(lds + 36864);
    const int tid = otid(wv);
    const float* c = p.in[I_C]; const float* cc = p.in[I_CCTX];
    for (int i = tid; i < 9 * DM; i += NT) { float v = (i < 8 * DM) ? c[i] : cc[i - 8 * DM]; sc[i] = silu_f(v); }
    __syncthreads();
    float* mod = (float*)(p.ws + WS_MOD);
    for (int u = blockIdx.x; u < 192; u += gridDim.x) {
        const int layer = u / 96, cb = u % 96, cq = tid & 15, kg = tid >> 4;
        const float* w = p.in[I_WADA] + (size_t)layer * DM * MODW + cb * 64 + cq * 4;
        v4f acc[9];
#pragma unroll
        for (int r = 0; r < 9; ++r) acc[r] = (v4f){0.f, 0.f, 0.f, 0.f};
        for (int i = 0; i < 32; ++i) {
            const int k = kg + 32 * i;
            const v4f wv = *(const v4f*)(w + (size_t)k * MODW);
#pragma unroll
            for (int r = 0; r < 9; ++r) acc[r] += sc[r * DM + k] * wv;
        }
#pragma unroll
        for (int r = 0; r < 9; ++r) *(LAS v4f*)(red + (kg * 9 + r) * 64 + cq * 4) = acc[r];
        __syncthreads();
        for (int o = tid; o < 576; o += NT) {
            const int r = o >> 6, c2 = o & 63; float s = 0.f;
            for (int k2 = 0; k2 < 32; ++k2) s += red[(k2 * 9 + r) * 64 + c2];
            mod[((size_t)layer * 9 + r) * MODW + cb * 64 + c2] = s + p.in[I_BADA][layer * MODW + cb * 64 + c2];
        }
        __syncthreads();
    }
}
__device__ __forceinline__ void phase_lb(const Ptrs& p, int wv) {
    if (blockIdx.x == 255 % gridDim.x) {
        const int i = otid(wv);
        const float* raw = p.in[I_LB]; float* lb = (float*)(p.ws + WS_LB);
        float l0 = raw[i], l1 = raw[512 + i];
        lb[i] = 0.f; lb[512 + i] = 1.f / (1.f + __expf(l0 - l1));
    }
}
__device__ __forceinline__ void transpose_item(const float* W, int K, int N, bf16* WT, int row_off, LAS float* scr, int item, int lane) {
    const int nblk = N / 32, kb = item / nblk, nb = item % nblk, k0 = 64 * kb, n0 = 32 * nb;
#pragma unroll 8
    for (int i = 0; i < 32; ++i) { const int kk = 2 * i + (lane >> 5); scr[kk * 33 + (lane & 31)] = W[(size_t)(k0 + kk) * N + n0 + (lane & 31)]; }
    LDS_WAIT(); asm volatile("" ::: "memory");
    const int c = lane & 7;
#pragma unroll
    for (int j = 0; j < 4; ++j) { const int n = (lane >> 3) + 8 * j; const LAS float* s = scr + (8 * c) * 33 + n;
        v4u o; o.x = pk2(s[0 * 33], s[1 * 33]); o.y = pk2(s[2 * 33], s[3 * 33]); o.z = pk2(s[4 * 33], s[5 * 33]); o.w = pk2(s[6 * 33], s[7 * 33]);
        *(v4u*)(WT + (size_t)(row_off + n0 + n) * K + k0 + 8 * c) = o; }
    LDS_WAIT(); asm volatile("" ::: "memory");
}
constexpr int CI_IN = 16 * 88, CI_OUT = 16 * 32, CI_G = 32 * 128, CI_U = 32 * 128, CI_D = 32 * 128, CI_LAYER = CI_IN + CI_OUT + CI_G + CI_U + CI_D;
__device__ __forceinline__ void phase_convert(const Ptrs& p, LAS unsigned char* lds, int layer_lo, int layer_hi, int wv) {
    const int lane = otid(wv) & 63, wave = wv;
    LAS float* scr = (LAS float*)(lds + wave * 16384);
    const int gw = blockIdx.x * NWAVES + wave, NGW = gridDim.x * NWAVES;
    const int n_items = (layer_hi - layer_lo) * CI_LAYER;
    for (int it = gw; it < n_items; it += NGW) {
        const int layer = layer_lo + it / CI_LAYER; int r = it % CI_LAYER;
        if (r < CI_IN) {
            const int n0 = 32 * (r % 88), pn_ = n0 >> 8, w_ = (n0 >> 6) & 3, bj_ = (n0 >> 5) & 1;
            transpose_item(p.in[I_WIN] + (size_t)layer * DM * DIN, DM, DIN, (bf16*)(p.ws + WS_WIN + layer * WIN_STRIDE), (256 * pn_ + 128 * bj_ + 32 * w_) - n0, scr, r, lane); continue; } r -= CI_IN;
        if (r < CI_OUT) { transpose_item(p.in[I_WOUT] + (size_t)layer * DM * DM, DM, DM, (bf16*)(p.ws + WS_WOUT + layer * WOUT_STRIDE), 0, scr, r, lane); continue; } r -= CI_OUT;
        if (r < CI_G + CI_U) {
            const int up = r >= CI_G; if (up) r -= CI_G;
            const int e = r >> 7, rem = r & 127, nb = rem & 7, n0 = 32 * nb;
            const int mapped = (n0 >> 7) * 256 + (n0 & 127) + (up ? 128 : 0);
            transpose_item(p.in[up ? I_WEU : I_WEG] + ((size_t)layer * 32 + e) * DM * 256, DM, 256, (bf16*)(p.ws + WS_WGU + layer * WGU_STRIDE) + (size_t)e * 512 * DM, mapped - n0, scr, rem, lane);
            continue;
        }
        r -= CI_G + CI_U;
        { const int e = r >> 7, rem = r & 127;
          transpose_item(p.in[I_WED] + ((size_t)layer * 32 + e) * 256 * DM, 256, DM, (bf16*)(p.ws + WS_WD + layer * WD_STRIDE) + (size_t)e * DM * 256, 0, scr, rem, lane); }
    }
}
__device__ __forceinline__ void phase_norm(const float* xlat, const float* xctx, const float* g, const float* modl, int ch_shift, int ch_scale, bf16* H, int nrows, int wv) {
    const int lane = otid(wv) & 63, wave = wv;
    const int gw = blockIdx.x * NWAVES + wave, NGW = gridDim.x * NWAVES;
    const int per = (nrows + NGW - 1) / NGW;
    const int r0 = gw * per, r1 = min(r0 + per, nrows);
    int cur = -1; v4f gs[4], sh[4];
    for (int r = r0; r < r1; ++r) {
        const int mrow = (r < NLAT) ? (r >> 11) : 8;
        if (mrow != cur) {
            cur = mrow; const float* m = modl + (size_t)mrow * MODW;
#pragma unroll
            for (int j = 0; j < 4; ++j) { const int c = 4 * lane + 256 * j; const v4f gg = *(const v4f*)(g + c), sc = *(const v4f*)(m + ch_scale * DM + c);
                gs[j] = gg * (1.f + sc); sh[j] = *(const v4f*)(m + ch_shift * DM + c); }
        }
        const float* xr = (r < NLAT) ? xlat + (size_t)r * DM : xctx + (size_t)(r - NLAT) * DM;
        v4f v[4]; float s = 0.f;
#pragma unroll
        for (int j = 0; j < 4; ++j) { v[j] = *(const v4f*)(xr + 4 * lane + 256 * j); s += (v[j].x * v[j].x + v[j].y * v[j].y) + (v[j].z * v[j].z + v[j].w * v[j].w); }
        const float rstd = rsqrtf(wave_sum(s, lane) * (1.f / DM) + 1e-6f);
        bf16* orow = H + (size_t)r * DM;
#pragma unroll
        for (int j = 0; j < 4; ++j) { const v4f o = v[j] * rstd * gs[j] + sh[j]; v2u w; w.x = pk2(o.x, o.y); w.y = pk2(o.z, o.w); *(v2u*)(orow + 4 * lane + 256 * j) = w; }
    }
}

constexpr size_t WS_RSS = 6 * MiB;
constexpr size_t WS_WR = 7 * MiB + 512 * 1024;
constexpr int CW_CNT = 1024;
constexpr int LDS_TTAB = 131072;
constexpr int LDS_GIDX = 131072 + 4096;
constexpr int LDS_RT = 131072;

namespace pg8 {
struct EpiResidSS {
    static constexpr bool PERM = false, AFTER_DRAIN = false;
    const float* xin_lat; const float* xin_ctx; float* xout_lat; float* xout_ctx; const float* modl; int chunk; float* rss; int wv;
    __device__ __forceinline__ void operator()(const f32x4 (&acc)[2][2][4][2], const Unit& u, int, int, int, int) const {
        const int l_ = otid(wv) & 63, fr = l_ & 15, fq = l_ >> 4, wr = wv >> 2, wc = wv & 3;
        const int rowt = u.pm * BM; const bool isctx = rowt >= NLAT;
        const float* xin = isctx ? xin_ctx + (size_t)(rowt - NLAT) * DM : xin_lat + (size_t)rowt * DM;
        float* xo = isctx ? xout_ctx + (size_t)(rowt - NLAT) * DM : xout_lat + (size_t)rowt * DM;
        const int mrow = isctx ? 8 : (rowt >> 11);
        const float* gate = modl + (size_t)mrow * MODW + chunk * DM;
        const int col0 = u.pn * BM + wc * 32 + 4 * fq;
        f32x4 gv[2][2];
#pragma unroll
        for (int bj = 0; bj < 2; ++bj)
#pragma unroll
            for (int n = 0; n < 2; ++n) gv[bj][n] = *(const f32x4*)(gate + col0 + bj * HALF + n * 16);
#pragma unroll
        for (int ai = 0; ai < 2; ++ai)
#pragma unroll
            for (int m = 0; m < 4; ++m) {
                const int rl = ai * HALF + wr * 64 + m * 16 + fr; float ss = 0.f;
#pragma unroll
                for (int bj = 0; bj < 2; ++bj)
#pragma unroll
                    for (int n = 0; n < 2; ++n) {
                        const size_t off = (size_t)rl * DM + col0 + bj * HALF + n * 16;
                        const f32x4 xi = *(const f32x4*)(xin + off);
                        const f32x4 o = xi + gv[bj][n] * acc[ai][bj][m][n];
                        *(f32x4*)(xo + off) = o;
                        ss += (o[0] * o[0] + o[1] * o[1]) + (o[2] * o[2] + o[3] * o[3]);
                    }
                ss += shx(ss, 16, l_); ss += shx(ss, 32, l_);
                if (fq == 0) rss[(size_t)(rowt + rl) * 16 + u.pn * 4 + wc] = ss;
            }
    }
};
struct EpiGU {
    static constexpr bool PERM = true, AFTER_DRAIN = false;
    bf16_t* HID; int wv;
    __device__ __forceinline__ void operator()(const f32x4 (&acc)[2][2][4][2], const Unit& u, int, int, int, int) const {
        const int l_ = otid(wv) & 63, fr = l_ & 15, fq = l_ >> 4, wr = wv >> 2, wc = wv & 3;
        const int pnl = u.pn & 1, row0 = u.pm * BM + wr * 64 + fr, col0 = pnl * 128 + wc * 32 + 8 * fq;
#pragma unroll
        for (int ai = 0; ai < 2; ++ai)
#pragma unroll
            for (int m = 0; m < 4; ++m) {
                bf16_t* rowp = HID + (size_t)(row0 + ai * HALF + m * 16) * 256 + col0;
                float hv[8];
#pragma unroll
                for (int n = 0; n < 2; ++n)
#pragma unroll
                    for (int i = 0; i < 4; ++i) { const float g = acc[ai][0][m][n][i], uu = acc[ai][1][m][n][i]; hv[n * 4 + i] = g / (1.f + __expf(-g)) * uu; }
                u32x4 w; w.x = cvt_pk_bf16(hv[0], hv[1]); w.y = cvt_pk_bf16(hv[2], hv[3]); w.z = cvt_pk_bf16(hv[4], hv[5]); w.w = cvt_pk_bf16(hv[6], hv[7]);
                *(u32x4*)rowp = w;
            }
    }
};
struct EpiDown {
    static constexpr bool PERM = true, AFTER_DRAIN = false;
    bf16_t* Y0; bf16_t* Y1; const PG8_LAS int* rowinfo; int wv;
    __device__ __forceinline__ void operator()(const f32x4 (&acc)[2][2][4][2], const Unit& u, int, int, int, int) const {
        const int l_ = otid(wv) & 63, fr_ = l_ & 15, fq = l_ >> 4, wr = wv >> 2, wc = wv & 3;
        const int col0 = (u.pn & 3) * BM + wc * 32 + 8 * fq;
        const PG8_LAS int* ri = rowinfo + (u.aux * 256 + wr * 64 + fr_) * 2;
#pragma unroll
        for (int ai = 0; ai < 2; ++ai)
#pragma unroll
            for (int m = 0; m < 4; ++m) {
                const int ent = ri[(ai * HALF + m * 16) * 2]; const float w = __builtin_bit_cast(float, ri[(ai * HALF + m * 16) * 2 + 1]);
                if (ent >= 0) {
                    bf16_t* rowp = Y0 + ((size_t)(ent & 1) * ((WS_Y1 - WS_Y0) / 2) + (size_t)(ent >> 1) * DM + col0);
#pragma unroll
                    for (int bj = 0; bj < 2; ++bj) {
                        const f32x4 v0 = acc[ai][bj][m][0] * w, v1 = acc[ai][bj][m][1] * w;
                        u32x4 o; o.x = cvt_pk_bf16(v0[0], v0[1]); o.y = cvt_pk_bf16(v0[2], v0[3]); o.z = cvt_pk_bf16(v1[0], v1[1]); o.w = cvt_pk_bf16(v1[2], v1[3]);
                        *(u32x4*)(rowp + bj * HALF) = o;
                    }
                }
                asm volatile("" ::: "memory");
            }
    }
};
struct MoeOrder {
    const PG8_LAS int* ttab; int ntile, npn, G, c;
    __device__ __forceinline__ bool next(int i, Unit& u) const {
        const int L = i * G + c; if (L >= ntile * npn) return false;
        const int t = L / npn, pl = L % npn; u.pm = t; u.pn = ttab[t * 4] * npn + pl; u.aux = i; return true;
    }
    __device__ __forceinline__ void a_ready(const Unit&) const {}
    __device__ __forceinline__ void done(const Unit&) const {}
};
}

__device__ __forceinline__ void phase_router_w(const Ptrs& p, int wv) {
    const int gt = blockIdx.x * NT + otid(wv), NG = gridDim.x * NT;
    for (int idx = gt; idx < 2 * 48 * DM; idx += NG) {
        const int layer = idx / (48 * DM), r = idx % (48 * DM), n = r >> 10, k = r & 1023;
        float w;
        if (n < 16) w = p.in[I_WRG][((size_t)layer * DM + k) * 4 + (n & 3)];
        else { const int g = ((n - 16) & 15) >> 2, i = n & 3, e = 8 * g + i + (n >= 32 ? 4 : 0); w = p.in[I_WRE][((size_t)layer * DM + k) * 32 + e]; }
        const unsigned hi = f2bf(w); const float lo = w - __builtin_bit_cast(float, hi << 16);
        bf16* base = (bf16*)(p.ws + WS_WR) + (size_t)layer * 2 * 48 * DM;
        base[r] = (bf16)hi; base[48 * DM + r] = (bf16)f2bf(lo);
    }
}

typedef short s8v __attribute__((ext_vector_type(8)));
__device__ __forceinline__ void phase_route(const Ptrs& p, LAS unsigned char* lds, int layer, int nrows, int wv) {
    const int tid = otid(wv), lane = tid & 63, wave = wv;
    LAS int* lcnt = (LAS int*)(lds + LDS_RT); LAS int* gb = lcnt + 32;
    if (tid < 32) lcnt[tid] = 0;
    __syncthreads();
    const int ntiles = nrows / 16, t = wave * gridDim.x + blockIdx.x;
    const float* modl = (const float*)(p.ws + WS_MOD) + (size_t)layer * 9 * MODW;
    int e0 = -1, e1 = -1, lp0 = 0, lp1 = 0, ent0 = 0;
    if (t < ntiles) {
        const int row0 = t * 16, r = row0 + (lane & 15), kq = lane >> 4;
        const int mrow = (row0 < NLAT) ? (row0 >> 11) : 8;
        const float* xr = (r < NLAT) ? p.out + (size_t)r * DM : (const float*)(p.ws + WS_XC) + (size_t)(r - NLAT) * DM;
        const float* g = p.in[I_N2G] + layer * DM; const float* msc = modl + (size_t)mrow * MODW + 4 * DM; const float* msh = modl + (size_t)mrow * MODW + 3 * DM;
        bf16* hrow = (bf16*)(p.ws + WS_H) + (size_t)r * DM;
        const bf16* wr_hi = (const bf16*)(p.ws + WS_WR) + (size_t)layer * 2 * 48 * DM + (size_t)(lane & 15) * DM; const bf16* wr_lo = wr_hi + 48 * DM;
        float ss;
        { const v4f* rs = (const v4f*)((const float*)(p.ws + WS_RSS) + (size_t)r * 16); const v4f a = rs[0], b = rs[1], c = rs[2], d = rs[3];
          ss = ((a.x + a.y) + (a.z + a.w)) + ((b.x + b.y) + (b.z + b.w)) + ((c.x + c.y) + (c.z + c.w)) + ((d.x + d.y) + (d.z + d.w)); }
        const float rstd = rsqrtf(ss * (1.f / DM) + 1e-6f);
        v4f acc[3];
#pragma unroll
        for (int i = 0; i < 3; ++i) acc[i] = (v4f){0.f, 0.f, 0.f, 0.f};
        for (int s = 0; s < 32; ++s) {
            const int c0 = 32 * s + 8 * kq;
            const v4f xa = *(const v4f*)(xr + c0), xb = *(const v4f*)(xr + c0 + 4);
            const v4f ga = *(const v4f*)(g + c0), gbv = *(const v4f*)(g + c0 + 4);
            const v4f sa = *(const v4f*)(msc + c0), sb = *(const v4f*)(msc + c0 + 4);
            const v4f ha = *(const v4f*)(msh + c0), hb = *(const v4f*)(msh + c0 + 4);
            const v4f h0 = xa * rstd * (ga * (1.f + sa)) + ha, h1 = xb * rstd * (gbv * (1.f + sb)) + hb;
            float hv[8] = {h0.x, h0.y, h0.z, h0.w, h1.x, h1.y, h1.z, h1.w};
            unsigned hi[8]; s8v bhi, blo;
#pragma unroll
            for (int j = 0; j < 8; ++j) { hi[j] = f2bf(hv[j]); bhi[j] = (short)hi[j]; blo[j] = (short)f2bf(hv[j] - __builtin_bit_cast(float, hi[j] << 16)); }
            v4u hw; hw.x = hi[0] | (hi[1] << 16); hw.y = hi[2] | (hi[3] << 16); hw.z = hi[4] | (hi[5] << 16); hw.w = hi[6] | (hi[7] << 16);
            *(v4u*)(hrow + c0) = hw;
#pragma unroll
            for (int nt = 0; nt < 3; ++nt) {
                const s8v ahi = *(const s8v*)(wr_hi + (size_t)nt * 16 * DM + c0), alo = *(const s8v*)(wr_lo + (size_t)nt * 16 * DM + c0);
                acc[nt] = __builtin_amdgcn_mfma_f32_16x16x32_bf16(ahi, bhi, acc[nt], 0, 0, 0);
                acc[nt] = __builtin_amdgcn_mfma_f32_16x16x32_bf16(ahi, blo, acc[nt], 0, 0, 0);
                acc[nt] = __builtin_amdgcn_mfma_f32_16x16x32_bf16(alo, bhi, acc[nt], 0, 0, 0);
            }
        }
        const float* brg = p.in[I_BRG] + layer * 4; const float* bre = p.in[I_BRE] + layer * 32;
        float gl[4];
#pragma unroll
        for (int i = 0; i < 4; ++i) gl[i] = acc[0][i] + brg[i];
        int gi = 0; float gm = gl[0];
#pragma unroll
        for (int i = 1; i < 4; ++i) if (gl[i] > gm) { gm = gl[i]; gi = i; }
        float den = 0.f;
#pragma unroll
        for (int i = 0; i < 4; ++i) den += __expf(gl[i] - gm);
        const float gtop = 1.f / den;
        if (kq == gi) {
            float el[8];
#pragma unroll
            for (int i = 0; i < 4; ++i) { el[i] = acc[1][i] + bre[8 * kq + i]; el[4 + i] = acc[2][i] + bre[8 * kq + 4 + i]; }
            int i0 = 0; float v0 = el[0];
#pragma unroll
            for (int i = 1; i < 8; ++i) if (el[i] > v0) { v0 = el[i]; i0 = i; }
            int i1 = -1; float v1 = -3.0e38f;
#pragma unroll
            for (int i = 0; i < 8; ++i) if (i != i0 && el[i] > v1) { v1 = el[i]; i1 = i; }
            const float p1 = __expf(v1 - v0), sden = 1.f / (1.f + p1);
            e0 = gi * 8 + i0; e1 = gi * 8 + i1; ent0 = r * 2;
            float* ew = (float*)(p.ws + WS_EW);
            ew[ent0] = gtop * sden; ew[ent0 + 1] = gtop * p1 * sden;
            lp0 = __hip_atomic_fetch_add(lcnt + e0, 1, __ATOMIC_RELAXED, __HIP_MEMORY_SCOPE_WORKGROUP); lp1 = __hip_atomic_fetch_add(lcnt + e1, 1, __ATOMIC_RELAXED, __HIP_MEMORY_SCOPE_WORKGROUP);
        }
    }
    __syncthreads();
    int* cnt = (int*)(p.ws + WS_CTL) + CW_CNT + layer * 64;
    if (tid < 32) gb[tid] = atomicAdd(&cnt[tid], lcnt[tid]);
    __syncthreads();
    if (e0 >= 0) {
        int* IDX = (int*)(p.ws + WS_IDX);
        IDX[(size_t)e0 * MROWS + gb[e0] + lp0] = ent0;
        IDX[(size_t)e1 * MROWS + gb[e1] + lp1] = ent0 + 1;
    }
}
__device__ __forceinline__ int moe_build_ttab(const Ptrs& p, LAS unsigned char* lds, int layer, int wv) {
    LAS int* ttab = (LAS int*)(lds + LDS_TTAB);
    const int* cnt = (const int*)(p.ws + WS_CTL) + CW_CNT + layer * 64;
    __syncthreads();
    if (otid(wv) == 0) {
        int t = 0;
        for (int e = 0; e < 32; ++e) { const int c = __hip_atomic_load(cnt + e, __ATOMIC_RELAXED, __HIP_MEMORY_SCOPE_AGENT); for (int fp = 0; fp < c; fp += 256) { ttab[t * 4] = e; ttab[t * 4 + 1] = fp; ttab[t * 4 + 2] = c; ++t; } }
        ttab[176 * 4] = t;
    }
    __syncthreads();
    return ttab[176 * 4];
}
__device__ __forceinline__ void phase_moe_gu(const Ptrs& p, LAS unsigned char* lds, int layer, int wv) {
    const int ntile = moe_build_ttab(p, lds, layer, wv);
    LAS int* ttab = (LAS int*)(lds + LDS_TTAB); LAS int* gidx = (LAS int*)(lds + LDS_GIDX);
    pg8::MoeOrder S{ttab, ntile, 2, (int)gridDim.x, (int)blockIdx.x};
    const int* IDX = (const int*)(p.ws + WS_IDX);
    for (int i = 0; i < 3; ++i) {
        pg8::Unit u; if (!S.next(i, u)) break;
        const int e = ttab[u.pm * 4], fp = ttab[u.pm * 4 + 1], c = ttab[u.pm * 4 + 2];
        for (int r = otid(wv); r < 256; r += NT) gidx[i * 256 + r] = (fp + r < c) ? (IDX[(size_t)e * MROWS + fp + r] >> 1) : 0;
    }
    __syncthreads();
    pg8::Gemm g{(const bf16*)(p.ws + WS_H), (const bf16*)(p.ws + WS_WGU + layer * WGU_STRIDE), ntile * 256, 32 * 512, DM};
    pg8::EpiGU E{(bf16*)(p.ws + WS_HID), wv};
    pg8::gemm_phase<pg8::EpiGU, pg8::MoeOrder, true, true, true>(lds, g, S, E, wv, gidx);
}
__device__ __forceinline__ void phase_moe_down(const Ptrs& p, LAS unsigned char* lds, int layer, int wv) {
    const int ntile = moe_build_ttab(p, lds, layer, wv);
    LAS int* ttab = (LAS int*)(lds + LDS_TTAB); LAS int* rowinfo = (LAS int*)(lds + LDS_GIDX);
    pg8::MoeOrder S{ttab, ntile, 4, (int)gridDim.x, (int)blockIdx.x};
    const int* IDX = (const int*)(p.ws + WS_IDX); const float* EW = (const float*)(p.ws + WS_EW);
    for (int i = 0; i < 3; ++i) {
        pg8::Unit u; if (!S.next(i, u)) break;
        const int e = ttab[u.pm * 4], fp = ttab[u.pm * 4 + 1], c = ttab[u.pm * 4 + 2];
        for (int r = otid(wv); r < 256; r += NT) {
            int ent = -1; float w = 0.f;
            if (fp + r < c) { ent = IDX[(size_t)e * MROWS + fp + r]; w = EW[ent]; }
            rowinfo[(i * 256 + r) * 2] = ent; rowinfo[(i * 256 + r) * 2 + 1] = __builtin_bit_cast(int, w);
        }
    }
    __syncthreads();
    pg8::Gemm g{(const bf16*)(p.ws + WS_HID), (const bf16*)(p.ws + WS_WD + layer * WD_STRIDE), ntile * 256, 32 * 1024, 256};
    pg8::EpiDown E{(bf16*)(p.ws + WS_Y0), (bf16*)(p.ws + WS_Y1), rowinfo, wv};
    pg8::gemm_phase<pg8::EpiDown, pg8::MoeOrder, true, true, false>(lds, g, S, E, wv);
}
__device__ __forceinline__ void phase_combine(const Ptrs& p, int layer, int nrows, bool do_norm, int wv) {
    const int lane = otid(wv) & 63, wave = wv;
    const int gw = blockIdx.x * NWAVES + wave, NGW = gridDim.x * NWAVES;
    const int per = (nrows + NGW - 1) / NGW;
    const int r0 = gw * per, r1 = min(r0 + per, nrows);
    const float* modl = (const float*)(p.ws + WS_MOD) + (size_t)layer * 9 * MODW;
    const float* modn = (const float*)(p.ws + WS_MOD) + (size_t)(layer + 1) * 9 * MODW;
    const float* g = p.in[I_N1G] + (layer + 1) * DM;
    const bf16* Y0 = (const bf16*)(p.ws + WS_Y0); const bf16* Y1 = (const bf16*)(p.ws + WS_Y1); bf16* H = (bf16*)(p.ws + WS_H);
    for (int r = r0; r < r1; ++r) {
        const int mrow = (r < NLAT) ? (r >> 11) : 8;
        float* xr = (r < NLAT) ? p.out + (size_t)r * DM : (float*)(p.ws + WS_XC) + (size_t)(r - NLAT) * DM;
        const float* m5 = modl + (size_t)mrow * MODW + 5 * DM;
        v4f v[4]; float s = 0.f;
#pragma unroll
        for (int j = 0; j < 4; ++j) {
            const int c = 4 * lane + 256 * j;
            const v4f x = *(const v4f*)(xr + c), mm = *(const v4f*)(m5 + c);
            const v2u a = *(const v2u*)(Y0 + (size_t)r * DM + c), b = *(const v2u*)(Y1 + (size_t)r * DM + c);
            v4f y; y.x = bflo(a.x) + bflo(b.x); y.y = bfhi(a.x) + bfhi(b.x); y.z = bflo(a.y) + bflo(b.y); y.w = bfhi(a.y) + bfhi(b.y);
            v[j] = x + mm * y;
            *(v4f*)(xr + c) = v[j];
            s += (v[j].x * v[j].x + v[j].y * v[j].y) + (v[j].z * v[j].z + v[j].w * v[j].w);
        }
        if (do_norm) {
            const float rstd = rsqrtf(wave_sum(s, lane) * (1.f / DM) + 1e-6f);
            const float* mn = modn + (size_t)mrow * MODW;
#pragma unroll
            for (int j = 0; j < 4; ++j) {
                const int c = 4 * lane + 256 * j;
                const v4f gg = *(const v4f*)(g + c), sc = *(const v4f*)(mn + DM + c), sh = *(const v4f*)(mn + c);
                const v4f o = v[j] * rstd * (gg * (1.f + sc)) + sh; v2u w; w.x = pk2(o.x, o.y); w.y = pk2(o.z, o.w);
                *(v2u*)(H + (size_t)r * DM + c) = w;
            }
        }
    }
}

namespace hg {
typedef short s4v __attribute__((ext_vector_type(4)));
typedef short s8v __attribute__((ext_vector_type(8)));
typedef short v4i16_t __attribute__((ext_vector_type(4)));
constexpr int TS = 160;
constexpr int TILE_B = 16 * TS;
constexpr int WAVE_LDS = 2 * TILE_B;
constexpr int NSEG = 18;
constexpr size_t SEGU_B = 64 * 64 * 4, SEGA_B = 16 * 64 * 4;
constexpr size_t WS_SEGU = WS_SCR;
constexpr size_t WS_SEGA = WS_SEGU + (size_t)NBATCH * 4 * 2 * NSEG * SEGU_B;
constexpr int OFL_OFF = 8 * WAVE_LDS, OFL_B = 8 * 4 * 64 * 16;
static_assert(WS_SEGA + (size_t)NBATCH * 4 * 2 * NSEG * SEGA_B <= WS_END && OFL_OFF + 3 * OFL_B <= LDS_BYTES, "hgrn scratch");
template <int CTRL> __device__ __forceinline__ float dppf(float x) { return __builtin_bit_cast(float, __builtin_amdgcn_update_dpp(0, __builtin_bit_cast(int, x), CTRL, 0xf, 0xf, true)); }
__device__ __forceinline__ s4v trd(const LAS unsigned char* p) { return __builtin_bit_cast(s4v, __builtin_amdgcn_ds_read_tr16_b64_v4i16((LAS v4i16_t*)p)); }
typedef float f32x2_t __attribute__((ext_vector_type(2))); typedef __bf16 bf16x2_t __attribute__((ext_vector_type(2)));
__device__ __forceinline__ unsigned pkbf(float lo, float hi) { f32x2_t v = {lo, hi}; bf16x2_t b = __builtin_convertvector(v, bf16x2_t); return __builtin_bit_cast(unsigned, b); }
__device__ __forceinline__ float silu_r(float x) { return x * __builtin_amdgcn_rcpf(1.f + __expf(-x)); }
__device__ __forceinline__ s8v mk8(unsigned a, unsigned b, unsigned c, unsigned d) { v4u t; t.x = a; t.y = b; t.z = c; t.w = d; return __builtin_bit_cast(s8v, t); }

template <bool BWD, bool OUT>
__device__ __forceinline__ void chunk(const bf16* __restrict__ P, int row0, int h, const float* __restrict__ lbh, v4f (&S)[4][4], float (&Atot)[16],
                                      LAS unsigned char* vt, LAS unsigned char* kt, int lane_, LAS v4f* OFL, int cidx, bf16* __restrict__ MIX, const float* __restrict__ on) {
    int lane = lane_; asm volatile("" : "+v"(lane));
    const int tok = lane & 15, kq = lane >> 4;
    const bf16* pb = P + (size_t)row0 * DIN + h * 64;
    const unsigned lo = (unsigned)(tok * DIN + 4 * kq);
    v2u zr[4], qr[4]; v4f lbq[4];
#pragma unroll
    for (int m = 0; m < 4; ++m) lbq[m] = *(const v4f*)(lbh + (unsigned)(16 * m + 4 * kq));
#pragma unroll
    for (int m = 0; m < 4; ++m) { zr[m] = *(const v2u*)(pb + (lo + (BWD ? C_FB : C_FF) + 16 * m)); if (OUT) qr[m] = *(const v2u*)(pb + (lo + C_Q + 16 * m)); }
#pragma unroll
    for (int i = 0; i < 2; ++i) { const int pc = lane + 64 * i, r = pc >> 3, ch = pc & 7;
        const v4u vv = *(const v4u*)(pb + (unsigned)(r * DIN + C_I + 8 * ch)); *(LAS v4u*)(vt + r * TS + 16 * ch) = vv; }
    unsigned qf[8], kf[8];
    float A[16];
#pragma unroll
    for (int m = 0; m < 4; ++m)
#pragma unroll
        for (int jp = 0; jp < 2; ++jp) {
            const unsigned zw = jp ? zr[m].y : zr[m].x;
            float kt2[2], qt2[2], kh2[2];
#pragma unroll
            for (int i = 0; i < 2; ++i) {
                const int e = 4 * m + 2 * jp + i;
                const float z = i ? bfhi(zw) : bflo(zw);
                const float sg = __builtin_amdgcn_rcpf(1.f + __expf(-z)), lb = lbq[m][2 * jp + i];
                const float f = lb + (1.f - lb) * sg, kk = (1.f - lb) * (1.f - sg);
                const float lf = __logf(f);
                float c = lf, t = lf;
                if (!BWD) { c += dppf<0x111>(c); c += dppf<0x112>(c); c += dppf<0x114>(c); c += dppf<0x118>(c); }
                else      { c += dppf<0x101>(c); c += dppf<0x102>(c); c += dppf<0x104>(c); c += dppf<0x108>(c); }
                t += dppf<0x128>(t); t += dppf<0x124>(t); t += dppf<0x122>(t); t += dppf<0x121>(t);
                const float Ei = __expf(-fmaxf(c, -80.f)); A[e] = __expf(t);
                kt2[i] = kk * Ei; kh2[i] = kt2[i] * A[e];
                if (OUT) { const unsigned qw = jp ? qr[m].y : qr[m].x; const float q = i ? bfhi(qw) : bflo(qw); qt2[i] = q * 0.125f * __expf(c); } else qt2[i] = 0.f;
            }
            kf[2 * m + jp] = pkbf(kt2[0], kt2[1]); if (OUT) qf[2 * m + jp] = pkbf(qt2[0], qt2[1]);
            *(LAS unsigned*)(kt + tok * TS + (16 * m + 4 * kq + 2 * jp) * 2) = pkbf(kh2[0], kh2[1]);
            __builtin_amdgcn_sched_barrier(0);
        }
    asm volatile("s_waitcnt lgkmcnt(0)" ::: "memory");
    s8v vfr[4], khf[4];
    { const int i4 = tok >> 2, p4 = tok & 3; const LAS unsigned char* va = vt + (4 * kq + i4) * TS + 8 * p4; const LAS unsigned char* ka = kt + (4 * kq + i4) * TS + 8 * p4;
#pragma unroll
      for (int c = 0; c < 4; ++c) { const s4v a = trd(va + 32 * c), b = trd(ka + 32 * c);
          vfr[c] = (s8v){a[0], a[1], a[2], a[3], 0, 0, 0, 0}; khf[c] = (s8v){b[0], b[1], b[2], b[3], 0, 0, 0, 0}; } }
    if (OUT) {
        const s8v q0 = mk8(qf[0], qf[1], qf[2], qf[3]), q1 = mk8(qf[4], qf[5], qf[6], qf[7]);
        const s8v k0 = mk8(kf[0], kf[1], kf[2], kf[3]), k1 = mk8(kf[4], kf[5], kf[6], kf[7]);
        v4f at = (v4f){0.f, 0.f, 0.f, 0.f};
        at = __builtin_amdgcn_mfma_f32_16x16x32_bf16(k0, q0, at, 0, 0, 0);
        at = __builtin_amdgcn_mfma_f32_16x16x32_bf16(k1, q1, at, 0, 0, 0);
#pragma unroll
        for (int j = 0; j < 4; ++j) { const int s = 4 * kq + j; const bool keep = BWD ? (s >= tok) : (s <= tok); at[j] = keep ? at[j] : 0.f; }
        const s8v af = mk8(pkbf(at[0], at[1]), pkbf(at[2], at[3]), 0u, 0u);
        v4f o[4];
#pragma unroll
        for (int vb = 0; vb < 4; ++vb) {
            o[vb] = __builtin_amdgcn_mfma_f32_16x16x32_bf16(vfr[vb], af, (v4f){0.f, 0.f, 0.f, 0.f}, 0, 0, 0);
            const s8v s0 = mk8(pkbf(S[0][vb][0], S[0][vb][1]), pkbf(S[0][vb][2], S[0][vb][3]), pkbf(S[1][vb][0], S[1][vb][1]), pkbf(S[1][vb][2], S[1][vb][3]));
            const s8v s1 = mk8(pkbf(S[2][vb][0], S[2][vb][1]), pkbf(S[2][vb][2], S[2][vb][3]), pkbf(S[3][vb][0], S[3][vb][1]), pkbf(S[3][vb][2], S[3][vb][3]));
            o[vb] = __builtin_amdgcn_mfma_f32_16x16x32_bf16(s0, q0, o[vb], 0, 0, 0);
            o[vb] = __builtin_amdgcn_mfma_f32_16x16x32_bf16(s1, q1, o[vb], 0, 0, 0);
            __builtin_amdgcn_sched_barrier(0);
        }
        LAS v4f* ofl = OFL + (cidx * 4) * 64 + lane;
        if (!BWD) {
#pragma unroll
            for (int vb = 0; vb < 4; ++vb) ofl[vb * 64] = o[vb];
        } else {
            float ss = 0.f;
#pragma unroll
            for (int vb = 0; vb < 4; ++vb) { o[vb] += ofl[vb * 64]; ss += (o[vb].x * o[vb].x + o[vb].y * o[vb].y) + (o[vb].z * o[vb].z + o[vb].w * o[vb].w); }
            ss += shx(ss, 16, lane); ss += shx(ss, 32, lane);
            const float rstd = rsqrtf(ss * (1.f / 64.f) + 1e-6f);
            bf16* mb = MIX + (size_t)row0 * DM + 768 + h * 64; const unsigned lom = (unsigned)(tok * DM + 4 * kq);
#pragma unroll
            for (int vb = 0; vb < 4; ++vb) {
                const v2u gw = *(const v2u*)(pb + (lo + C_G + 16 * vb)); const v4f gn = *(const v4f*)(on + (unsigned)(16 * vb + 4 * kq));
                const float g0 = bflo(gw.x), g1 = bfhi(gw.x), g2 = bflo(gw.y), g3 = bfhi(gw.y);
                v2u w; w.x = pkbf(o[vb].x * rstd * gn.x * silu_r(g0), o[vb].y * rstd * gn.y * silu_r(g1)); w.y = pkbf(o[vb].z * rstd * gn.z * silu_r(g2), o[vb].w * rstd * gn.w * silu_r(g3));
                *(v2u*)(mb + (lom + 16 * vb)) = w;
            }
        }
    }
#pragma unroll
    for (int db = 0; db < 4; ++db) {
        const v4f av = (v4f){A[4 * db], A[4 * db + 1], A[4 * db + 2], A[4 * db + 3]};
#pragma unroll
        for (int vb = 0; vb < 4; ++vb) S[db][vb] = __builtin_amdgcn_mfma_f32_16x16x32_bf16(khf[db], vfr[vb], S[db][vb] * av, 0, 0, 0);
        __builtin_amdgcn_sched_barrier(0);
    }
    if (!OUT) {
#pragma unroll
        for (int e = 0; e < 16; ++e) Atot[e] *= A[e];
    }
    asm volatile("s_waitcnt lgkmcnt(0)" ::: "memory");
}
__device__ __forceinline__ int seg_row0(int b, int seg) { return seg < 2 ? NLAT + b * CTXL + 128 * seg : b * SEQ + 128 * (seg - 2); }
__device__ __forceinline__ int scan_idx(int seg, int dir) { return dir == 0 ? seg : (seg < 2 ? 1 - seg : 19 - seg); }

__device__ __forceinline__ void unit_pass1(const Ptrs& p, int layer, int u, LAS unsigned char* wl, int lane) {
    const int seg = u % NSEG, bh = u / NSEG, h = bh & 3, b = bh >> 2;
    const bf16* P = (const bf16*)(p.ws + WS_P);
    const int kq = lane >> 4, row0 = seg_row0(b, seg);
#pragma unroll 1
    for (int dir = 0; dir < 2; ++dir) {
        float Atot[16]; v4f S[4][4];
        const float* lbv = (const float*)(p.ws + WS_LB) + layer * 512 + dir * 256 + h * 64;
#pragma unroll
        for (int e = 0; e < 16; ++e) Atot[e] = 1.f;
#pragma unroll
        for (int i = 0; i < 4; ++i)
#pragma unroll
            for (int j = 0; j < 4; ++j) S[i][j] = (v4f){0.f, 0.f, 0.f, 0.f};
        if (dir == 0) {
#pragma unroll 1
            for (int c = 0; c < 8; ++c) chunk<false, false>(P, row0 + 16 * c, h, lbv, S, Atot, wl, wl + TILE_B, lane, nullptr, c, nullptr, nullptr); }
        else {
#pragma unroll 1
            for (int c = 7; c >= 0; --c) chunk<true, false>(P, row0 + 16 * c, h, lbv, S, Atot, wl, wl + TILE_B, lane, nullptr, c, nullptr, nullptr); }
        const size_t si = ((size_t)(bh * 2 + dir)) * NSEG + scan_idx(seg, dir);
        float* su = (float*)(p.ws + WS_SEGU + si * SEGU_B) + lane; float* sa = (float*)(p.ws + WS_SEGA + si * SEGA_B) + lane;
#pragma unroll
        for (int i = 0; i < 4; ++i)
#pragma unroll
            for (int j = 0; j < 4; ++j)
#pragma unroll
                for (int r = 0; r < 4; ++r) su[((i * 4 + j) * 4 + r) * 64] = S[i][j][r];
#pragma unroll
        for (int e = 0; e < 16; ++e) sa[e * 64] = Atot[e];
    }
}
__device__ __forceinline__ void unit_pass2(const Ptrs& p, int layer, int u, LAS unsigned char* wl, LAS v4f* OFL, int lane) {
    const int seg = u % NSEG, bh = u / NSEG, h = bh & 3, b = bh >> 2;
    const bf16* P = (const bf16*)(p.ws + WS_P); bf16* MIX = (bf16*)(p.ws + WS_MIX);
    const float* on = p.in[I_HGON] + layer * 64;
    const int kq = lane >> 4, row0 = seg_row0(b, seg);
#pragma unroll 1
    for (int dir = 0; dir < 2; ++dir) {
        float Atot[16]; v4f S[4][4];
        const float* lbv = (const float*)(p.ws + WS_LB) + layer * 512 + dir * 256 + h * 64;
#pragma unroll
        for (int e = 0; e < 16; ++e) Atot[e] = 1.f;
#pragma unroll
        for (int i = 0; i < 4; ++i)
#pragma unroll
            for (int j = 0; j < 4; ++j) S[i][j] = (v4f){0.f, 0.f, 0.f, 0.f};
        const int my = scan_idx(seg, dir); const size_t s0 = ((size_t)(bh * 2 + dir)) * NSEG;
#pragma unroll 1
        for (int sj = 0; sj < my; ++sj) {
            int ln = lane; asm volatile("" : "+v"(ln));
            const float* su = (const float*)(p.ws + WS_SEGU + (s0 + sj) * SEGU_B) + ln; const float* sa = (const float*)(p.ws + WS_SEGA + (s0 + sj) * SEGA_B) + ln;
#pragma unroll
            for (int i = 0; i < 4; ++i) {
                const v4f av = (v4f){sa[(4 * i) * 64], sa[(4 * i + 1) * 64], sa[(4 * i + 2) * 64], sa[(4 * i + 3) * 64]};
#pragma unroll
                for (int j = 0; j < 4; ++j) { const v4f uu = (v4f){su[((i * 4 + j) * 4 + 0) * 64], su[((i * 4 + j) * 4 + 1) * 64], su[((i * 4 + j) * 4 + 2) * 64], su[((i * 4 + j) * 4 + 3) * 64]};
                    S[i][j] = S[i][j] * av + uu; }
                __builtin_amdgcn_sched_barrier(0);
            }
        }
        if (dir == 0) {
#pragma unroll 1
            for (int c = 0; c < 8; ++c) chunk<false, true>(P, row0 + 16 * c, h, lbv, S, Atot, wl, wl + TILE_B, lane, OFL, c, MIX, on); }
        else {
#pragma unroll 1
            for (int c = 7; c >= 0; --c) chunk<true, true>(P, row0 + 16 * c, h, lbv, S, Atot, wl, wl + TILE_B, lane, OFL, c, MIX, on); }
    }
}
}
__device__ __forceinline__ void phase_hgrn1(const Ptrs& p, LAS unsigned char* lds, int layer, int wv) {
    const int lane = otid(wv) & 63; const int u = wv * gridDim.x + blockIdx.x;
    if (u < 32 * hg::NSEG) hg::unit_pass1(p, layer, u, lds + wv * hg::WAVE_LDS, lane);
}
__device__ __forceinline__ void phase_hgrn2(const Ptrs& p, LAS unsigned char* lds, int layer, int wv) {
    const int lane = otid(wv) & 63; const int u = wv * gridDim.x + blockIdx.x;
    if (u < 32 * hg::NSEG && (layer == 0 || (u % hg::NSEG) >= 2)) hg::unit_pass2(p, layer, u, lds + wv * hg::WAVE_LDS, (LAS v4f*)(lds + hg::OFL_OFF + wv * hg::OFL_B), lane);
}
namespace att {
using bf16=unsigned short;
using bf16x8=__attribute__((ext_vector_type(8)))short;
using s16x4=__attribute__((ext_vector_type(4)))short;
using f32x16=__attribute__((ext_vector_type(16)))float;
using u32x4=__attribute__((ext_vector_type(4)))unsigned;
constexpr int D=64,PIN_=DIN,POUT=DM;
constexpr int NW=8,QBLK=32,QB=QBLK*NW,KVBLK=64;
__device__ __forceinline__ int crow(int r,int hi){return (r&3)+8*(r>>2)+4*hi;}
#define SBAR() __builtin_amdgcn_sched_barrier(0)
constexpr int NSLOT=3, SLOTB=8192;
constexpr int LDS_K=0, LDS_V=NSLOT*SLOTB, LDS_WS=2*NSLOT*SLOTB, LDS_OST=LDS_WS+NW*64*4, LDS_BYTES=LDS_OST+NW*4096;
constexpr float C2=0.125f*1.4426950408889634f;
__device__ __forceinline__ void glds16(const void*gsrc,unsigned lds_dst){unsigned keep;
  asm volatile("s_mov_b32 %0, m0\n\ts_mov_b32 m0, %2\n\ts_nop 0\n\tglobal_load_lds_dwordx4 %1, off\n\ts_mov_b32 m0, %0":"=&s"(keep):"v"(gsrc),"s"(lds_dst):"memory");}
__device__ __forceinline__ float max3f(float a,float b,float c){float r;asm("v_max3_f32 %0, %1, %2, %3":"=v"(r):"v"(a),"v"(b),"v"(c));return r;}
__device__ __forceinline__ float max2f(float a,float b){float r;asm("v_max_f32_e32 %0, %1, %2":"=v"(r):"v"(a),"v"(b));return r;}
__device__ __forceinline__ float fadd_s(float a,float b){float r;asm("v_add_f32_e32 %0, %1, %2":"=v"(r):"v"(a),"v"(b));return r;}
__device__ __forceinline__ float fsub_s(float a,float b){float r;asm("v_sub_f32_e32 %0, %1, %2":"=v"(r):"v"(a),"v"(b));return r;}
typedef float f32x2_t __attribute__((ext_vector_type(2))); typedef __bf16 bf16x2_t __attribute__((ext_vector_type(2)));
__device__ __forceinline__ unsigned cvtpk_s(float lo,float hi){f32x2_t v={lo,hi};bf16x2_t b=__builtin_convertvector(v,bf16x2_t);return __builtin_bit_cast(unsigned,b);}
#define WAIT_BAR(N) asm volatile("s_waitcnt vmcnt(" #N ") lgkmcnt(0)\n\ts_barrier":::"memory")

__device__ __forceinline__ void qkt(f32x16&p0,f32x16&p1,const char*Kslot,const bf16x8*qr,const f32x16&negm,int r32,int hi){
  const char*kb=Kslot+hi*1024+r32*16;
  #pragma unroll
  for(int d0=0;d0<4;++d0){
    const bf16x8 b0=*reinterpret_cast<const bf16x8*>(kb+d0*2048);
    const bf16x8 b1=*reinterpret_cast<const bf16x8*>(kb+d0*2048+512);
    if(d0==0){p0=__builtin_amdgcn_mfma_f32_32x32x16_bf16(b0,qr[0],negm,0,0,0);p1=__builtin_amdgcn_mfma_f32_32x32x16_bf16(b1,qr[0],negm,0,0,0);}
    else{p0=__builtin_amdgcn_mfma_f32_32x32x16_bf16(b0,qr[d0],p0,0,0,0);p1=__builtin_amdgcn_mfma_f32_32x32x16_bf16(b1,qr[d0],p1,0,0,0);}}
}
typedef __attribute__((address_space(3))) const char* lds_cptr;
typedef short v4i16_t __attribute__((ext_vector_type(4)));
__device__ __forceinline__ void kload8(bf16x8*kf,lds_cptr kp){
  kf[0]=*(const __attribute__((address_space(3))) bf16x8*)(kp);      kf[1]=*(const __attribute__((address_space(3))) bf16x8*)(kp+512);
  kf[2]=*(const __attribute__((address_space(3))) bf16x8*)(kp+2048); kf[3]=*(const __attribute__((address_space(3))) bf16x8*)(kp+2560);
  kf[4]=*(const __attribute__((address_space(3))) bf16x8*)(kp+4096); kf[5]=*(const __attribute__((address_space(3))) bf16x8*)(kp+4608);
  kf[6]=*(const __attribute__((address_space(3))) bf16x8*)(kp+6144); kf[7]=*(const __attribute__((address_space(3))) bf16x8*)(kp+6656);
}
__device__ __forceinline__ void kload2(bf16x8*kf,lds_cptr kp,int j){ kf[2*j]=*(const __attribute__((address_space(3))) bf16x8*)(kp+j*2048); kf[2*j+1]=*(const __attribute__((address_space(3))) bf16x8*)(kp+j*2048+512); }
__device__ __forceinline__ s16x4 vtr(lds_cptr p){ return __builtin_bit_cast(s16x4,__builtin_amdgcn_ds_read_tr16_b64_v4i16((__attribute__((address_space(3))) v4i16_t*)p)); }
__device__ __forceinline__ float rowmax(const f32x16&p0,const f32x16&p1){
  float a=max3f(p0[0],p0[1],p1[0]),b=max3f(p0[2],p0[3],p1[1]);a=max3f(a,p1[2],p1[3]);
  #pragma unroll
  for(int r=4;r<16;r+=4){a=max3f(a,p0[r],p0[r+1]);b=max3f(b,p0[r+2],p0[r+3]);a=max3f(a,p1[r],p1[r+1]);b=max3f(b,p1[r+2],p1[r+3]);}
  const float m=max2f(a,b);
  auto rr=__builtin_amdgcn_permlane32_swap(__float_as_uint(m),__float_as_uint(m),false,false);
  return max2f(__uint_as_float(rr[0]),__uint_as_float(rr[1]));
}
__device__ __forceinline__ void pv(f32x16*o,int vb,bf16x8 pa0,bf16x8 pa1,bf16x8 pa2,bf16x8 pa3){
  #pragma unroll
  for(int d0=0;d0<2;++d0){s16x4 lo[4],hi[4];
    #pragma unroll
    for(int ks=0;ks<4;++ks){
      asm volatile("ds_read_b64_tr_b16 %0,%1 offset:%c2":"=&v"(lo[ks]):"v"(vb),"i"(d0*4096+ks*1024):"memory");
      asm volatile("ds_read_b64_tr_b16 %0,%1 offset:%c2":"=&v"(hi[ks]):"v"(vb),"i"(d0*4096+ks*1024+512):"memory");}
    asm volatile("s_waitcnt lgkmcnt(0)":::"memory");SBAR();
    #define PK(k) (bf16x8){lo[k][0],lo[k][1],lo[k][2],lo[k][3],hi[k][0],hi[k][1],hi[k][2],hi[k][3]}
    o[d0]=__builtin_amdgcn_mfma_f32_32x32x16_bf16(pa0,PK(0),o[d0],0,0,0);
    o[d0]=__builtin_amdgcn_mfma_f32_32x32x16_bf16(pa1,PK(1),o[d0],0,0,0);
    o[d0]=__builtin_amdgcn_mfma_f32_32x32x16_bf16(pa2,PK(2),o[d0],0,0,0);
    o[d0]=__builtin_amdgcn_mfma_f32_32x32x16_bf16(pa3,PK(3),o[d0],0,0,0);
    #undef PK
  }
}

#ifndef ATTN_STORE16
#define ATTN_STORE16(p,v) (*(u32x4*)(p)=(v))
#endif
template<int THRL,class Hook> __device__ __forceinline__ void attn_unit(const bf16*Q0,const bf16*__restrict__ Kh,const bf16*__restrict__ Vh,int rowa,int na,int rowb,int NT,bf16*O0,const Hook&hook,char*shm,int wid){
  const int lane=otid(wid)&63,r32=lane&31,hi=lane>>5;
  const bf16*Qw=Q0+(long)(wid*QBLK)*PIN_;
  #define TROW(t) ((long)(((t)<na)?(rowa+64*(t)):(rowb+64*((t)-na))))
  const unsigned lds0=(unsigned)(uintptr_t)shm;
  float*wsf=(float*)(shm+LDS_WS)+wid*64;
  const bf16*ksrc=Kh+(long)lane*PIN_+wid*8;
  const bf16*vsrc=Vh+(long)(16*(wid&3)+(lane>>2))*PIN_+(wid>>2)*32+(lane&3)*8;
  const unsigned kdst=lds0+LDS_K+wid*1024, vdst=lds0+LDS_V+wid*1024;
  #define DMA_K(t,slot) glds16(ksrc+TROW(t)*PIN_,(unsigned)__builtin_amdgcn_readfirstlane(kdst+(slot)))
  #define DMA_V(t,slot) glds16(vsrc+TROW(t)*PIN_,(unsigned)__builtin_amdgcn_readfirstlane(vdst+(slot)))
  const int vb0=(int)(lds0+LDS_V)+((lane>>4)&1)*32+(lane&3)*8+(4*hi+((lane&15)>>2))*64;
  const char*Kbase=shm+LDS_K; bf16x8 kf[8];
  const lds_cptr shm3=(lds_cptr)shm; const lds_cptr kp0=shm3+LDS_K+hi*1024+r32*16; const lds_cptr vp0=shm3+LDS_V+((lane>>4)&1)*32+(lane&3)*8+(4*hi+((lane&15)>>2))*64;
  DMA_K(0,0);DMA_V(0,0);DMA_K(1,SLOTB);
  bf16x8 qr[4];
  #pragma unroll
  for(int d0=0;d0<4;++d0)qr[d0]=*reinterpret_cast<const bf16x8*>(&Qw[(long)r32*PIN_+d0*16+hi*8]);
  float zz_=0.f; asm volatile("":"+v"(zz_));
  float mhat=zz_,l_reg=zz_;f32x16 o[2],negm;
  #pragma unroll
  for(int r=0;r<16;++r){o[0][r]=zz_;o[1][r]=zz_;negm[r]=zz_;}
  asm volatile("":"+v"(negm));
  #define CMASK(P0,P1,t) hook(P0,P1,(t),wid,r32,hi)
  bool resc=false;
  #define START(P0,P1) do{ const float rm=rowmax(P0,P1); resc=false; \
    { const float dl=rm; mhat=fadd_s(mhat,dl); \
      _Pragma("unroll") for(int r=0;r<16;++r){P0[r]=fsub_s(P0[r],dl);P1[r]=fsub_s(P1[r],dl);} \
      _Pragma("unroll") for(int r=0;r<16;++r)negm[r]=-mhat; asm volatile("":"+v"(negm)); } \
    _Pragma("unroll") for(int r=0;r<16;++r)P0[r]=__builtin_amdgcn_exp2f(P0[r]); }while(0)
  #define RESC() do{ if(resc){ asm volatile("s_waitcnt lgkmcnt(0)":::"memory"); \
      _Pragma("unroll") for(int d_=0;d_<2;++d_) _Pragma("unroll") for(int r=0;r<16;++r)o[d_][r]*=wsf[crow(r,hi)]; } }while(0)
  f32x16 pA0,pA1,pB0,pB1;
  int sl_prev=0,sl_cur=0,sl_next=SLOTB;
  #define ROT() do{sl_prev=sl_cur;sl_cur=sl_next;sl_next=(sl_next==(NSLOT-1)*SLOTB)?0:sl_next+SLOTB;}while(0)
  DMA_K(2,2*SLOTB);
  WAIT_BAR(3);
  qkt(pA0,pA1,Kbase,qr,negm,r32,hi);asm volatile("s_nop 15\n\ts_nop 7":"+v"(pA0),"+v"(pA1));
  START(pA0,pA1);
  _Pragma("unroll") for(int r=0;r<16;++r)pA1[r]=__builtin_amdgcn_exp2f(pA1[r]);
  WAIT_BAR(0);
  DMA_K(3,0);DMA_V(1,SLOTB);
  ROT();
  kload8(kf,kp0+sl_cur);
  WAIT_BAR(2);
  s16x4 vlo[8],vhi[8]; u32x4 pw0,pw1,pw2,pw3;
  #define PKW(P,B) cvtpk_s(P[B],P[B+1])
  #define PAF(k) __builtin_bit_cast(bf16x8,pw##k)
  #define VFR(i) (bf16x8){vlo[i][0],vlo[i][1],vlo[i][2],vlo[i][3],vhi[i][0],vhi[i][1],vhi[i][2],vhi[i][3]}
  #define PIN(x) asm volatile("":"+v"(x))
  #define MX3(a,b,c) __builtin_fmaxf(__builtin_fmaxf((a),(b)),(c))
  #define GAPA(MF,A0,A1,A2,A3,W0,W1,PW) do{ MF; sacc+=A0; sacc+=A1; sacc+=A2; sacc+=A3; PIN(sacc); W0; W1; PIN(PW); SBAR(); }while(0)
  #define EX(v) __builtin_amdgcn_exp2f(v)
  #define GAPB(MF,X,B) do{ MF; X[B]=EX(X[B]); X[B+1]=EX(X[B+1]); X[B+2]=EX(X[B+2]); X[B+3]=EX(X[B+3]); PIN(X); SBAR(); }while(0)
  #define VRD(i) do{ vlo[i]=vtr(vp_+(((i)>>2)*4096+((i)&3)*1024)); vhi[i]=vtr(vp_+(((i)>>2)*4096+((i)&3)*1024+512)); }while(0)
  #define KRD(G,j) do{ if(G){ kload2(kf,kp0+sl_next,j); SBAR(); } }while(0)
  #define STEP(C0,C1,P0,P1,t,GK,GV,GL) do{ SBAR(); \
    const lds_cptr vp_=vp0+sl_prev; \
    VRD(0); SBAR(); float sacc=(P0[0]+P0[1]); \
    GAPA(C0=__builtin_amdgcn_mfma_f32_32x32x16_bf16(kf[0],qr[0],negm,0,0,0), P0[2],P0[3],P0[4],P0[5],     pw0[0]=PKW(P0,0), pw0[1]=PKW(P0,2), pw0); \
    VRD(4); SBAR(); GAPA(C1=__builtin_amdgcn_mfma_f32_32x32x16_bf16(kf[1],qr[0],negm,0,0,0), P0[6],P0[7],P0[8],P0[9],     pw0[2]=PKW(P0,4), pw0[3]=PKW(P0,6), pw0); \
    VRD(1); SBAR(); GAPA(C0=__builtin_amdgcn_mfma_f32_32x32x16_bf16(kf[2],qr[1],C0,0,0,0),   P0[10],P0[11],P0[12],P0[13], pw1[0]=PKW(P0,8), pw1[1]=PKW(P0,10), pw1); \
    VRD(5); SBAR(); GAPA(C1=__builtin_amdgcn_mfma_f32_32x32x16_bf16(kf[3],qr[1],C1,0,0,0),   P0[14],P0[15],P1[0],P1[1],   pw1[2]=PKW(P0,12),pw1[3]=PKW(P0,14), pw1); \
    VRD(2); SBAR(); GAPA(C0=__builtin_amdgcn_mfma_f32_32x32x16_bf16(kf[4],qr[2],C0,0,0,0),   P1[2],P1[3],P1[4],P1[5],     pw2[0]=PKW(P1,0), pw2[1]=PKW(P1,2), pw2); \
    VRD(6); SBAR(); GAPA(C1=__builtin_amdgcn_mfma_f32_32x32x16_bf16(kf[5],qr[2],C1,0,0,0),   P1[6],P1[7],P1[8],P1[9],     pw2[2]=PKW(P1,4), pw2[3]=PKW(P1,6), pw2); \
    VRD(3); SBAR(); GAPA(C0=__builtin_amdgcn_mfma_f32_32x32x16_bf16(kf[6],qr[3],C0,0,0,0),   P1[10],P1[11],P1[12],P1[13], pw3[0]=PKW(P1,8), pw3[1]=PKW(P1,10), pw3); \
    VRD(7); SBAR(); GAPA(C1=__builtin_amdgcn_mfma_f32_32x32x16_bf16(kf[7],qr[3],C1,0,0,0),   P1[14],P1[15],0.f,0.f,       pw3[2]=PKW(P1,12),pw3[3]=PKW(P1,14), pw3); \
    l_reg+=sacc; \
    if(GK){DMA_K((t)+3,sl_cur);} if(GV){DMA_V((t)+1,sl_next);} \
    CMASK(C0,C1,t); \
    { float a=MX3(C0[0],C0[1],C1[0]),b=MX3(C0[2],C0[3],C1[1]); a=MX3(a,C1[2],C1[3]); \
      _Pragma("unroll") for(int r=4;r<16;r+=4){a=MX3(a,C0[r],C0[r+1]);b=MX3(b,C0[r+2],C0[r+3]);a=MX3(a,C1[r],C1[r+1]);b=MX3(b,C1[r+2],C1[r+3]);} \
      float rm=__builtin_fmaxf(a,b); { auto rr=__builtin_amdgcn_permlane32_swap(__float_as_uint(rm),__float_as_uint(rm),false,false); rm=__builtin_fmaxf(__uint_as_float(rr[0]),__uint_as_float(rr[1])); } \
      resc=false; \
      if(__builtin_expect(__any(rm>(float)THRL),0)){ const float dl=__builtin_fmaxf(rm,0.f); mhat+=dl; \
        _Pragma("unroll") for(int r=0;r<16;++r){C0[r]-=dl;C1[r]-=dl;} \
        _Pragma("unroll") for(int r=0;r<16;++r)negm[r]=-mhat; asm volatile("":"+v"(negm)); \
        const float f=__builtin_amdgcn_exp2f(-dl); l_reg*=f; if(hi==0)wsf[r32]=f; resc=true; } } \
    SBAR(); \
    GAPB(o[0]=__builtin_amdgcn_mfma_f32_32x32x16_bf16(PAF(0),VFR(0),o[0],0,0,0), C0,0); \
    GAPB(o[1]=__builtin_amdgcn_mfma_f32_32x32x16_bf16(PAF(0),VFR(4),o[1],0,0,0), C0,4); \
    KRD(GL,0); GAPB(o[0]=__builtin_amdgcn_mfma_f32_32x32x16_bf16(PAF(1),VFR(1),o[0],0,0,0), C0,8); \
    KRD(GL,1); GAPB(o[1]=__builtin_amdgcn_mfma_f32_32x32x16_bf16(PAF(1),VFR(5),o[1],0,0,0), C0,12); \
    KRD(GL,2); GAPB(o[0]=__builtin_amdgcn_mfma_f32_32x32x16_bf16(PAF(2),VFR(2),o[0],0,0,0), C1,0); \
    KRD(GL,3); GAPB(o[1]=__builtin_amdgcn_mfma_f32_32x32x16_bf16(PAF(2),VFR(6),o[1],0,0,0), C1,4); \
    GAPB(o[0]=__builtin_amdgcn_mfma_f32_32x32x16_bf16(PAF(3),VFR(3),o[0],0,0,0), C1,8); \
    GAPB(o[1]=__builtin_amdgcn_mfma_f32_32x32x16_bf16(PAF(3),VFR(7),o[1],0,0,0), C1,12); \
    }while(0)
  int t=1;
  for(;t+5<NT;t+=2){
    STEP(pB0,pB1,pA0,pA1,t,true,true,true);     WAIT_BAR(2); RESC(); ROT();
    STEP(pA0,pA1,pB0,pB1,t+1,true,true,true);   WAIT_BAR(2); RESC(); ROT();
  }
  #define ENDW(tt) do{ if((tt)+3<NT){WAIT_BAR(2);} else if((tt)+2<NT){WAIT_BAR(1);} else {WAIT_BAR(0);} }while(0)
  for(;t+1<NT;t+=2){
    STEP(pB0,pB1,pA0,pA1,t,(t+3<NT),(t+1<NT),(t+1<NT));       ENDW(t);   RESC(); ROT();
    STEP(pA0,pA1,pB0,pB1,t+1,(t+4<NT),(t+2<NT),(t+2<NT));     ENDW(t+1); RESC(); ROT();
  }
  STEP(pB0,pB1,pA0,pA1,NT-1,false,false,false); RESC();
  { float sacc=pB0[0]+pB0[1]; _Pragma("unroll") for(int r=2;r<16;++r)sacc+=pB0[r]; _Pragma("unroll") for(int r=0;r<16;++r)sacc+=pB1[r]; l_reg+=sacc;
    pw0=(u32x4){PKW(pB0,0),PKW(pB0,2),PKW(pB0,4),PKW(pB0,6)};pw1=(u32x4){PKW(pB0,8),PKW(pB0,10),PKW(pB0,12),PKW(pB0,14)};pw2=(u32x4){PKW(pB1,0),PKW(pB1,2),PKW(pB1,4),PKW(pB1,6)};pw3=(u32x4){PKW(pB1,8),PKW(pB1,10),PKW(pB1,12),PKW(pB1,14)};
    SBAR(); pv(o,vb0+sl_cur,PAF(0),PAF(1),PAF(2),PAF(3)); }
  #undef PKW
  #undef PAF
  #undef VFR
  #undef PIN
  #undef MX3
  #undef GAPA
  #undef GAPB
  #undef EX
  #undef VRD
  #undef KRD
  #undef STEP
  #undef ENDW
  {auto rr=__builtin_amdgcn_permlane32_swap(__float_as_uint(l_reg),__float_as_uint(l_reg),false,false);l_reg=__uint_as_float(rr[0])+__uint_as_float(rr[1]);}
  if(hi==0)wsf[32+r32]=l_reg;asm volatile("s_waitcnt lgkmcnt(0)":::"memory");
  float rli[16];
  #pragma unroll
  for(int r=0;r<16;++r)rli[r]=__builtin_amdgcn_rcpf(wsf[32+crow(r,hi)]);
  bf16*Ow=O0+(long)(wid*QBLK)*POUT;
  { bf16*stg=(bf16*)(shm+LDS_OST)+wid*2048;
    #pragma unroll
    for(int r=0;r<16;++r){const int orow=crow(r,hi);
      #pragma unroll
      for(int d0=0;d0<2;++d0)stg[orow*64+d0*32+r32]=(bf16)f2bf(o[d0][r]*rli[r]);}
    asm volatile("s_waitcnt lgkmcnt(0)":::"memory");
    #pragma unroll
    for(int i=0;i<4;++i){const int row=i*8+(lane>>3),ch=lane&7; const u32x4 v=*(const u32x4*)(stg+row*64+ch*8); ATTN_STORE16(Ow+(long)row*POUT+ch*8,v);} }
  asm volatile("s_waitcnt lgkmcnt(0)\n\ts_barrier":::"memory");
  #undef DMA_K
  #undef DMA_V
  #undef TROW
  #undef CMASK
  #undef START
  #undef RESC
  #undef ROT
}
constexpr int ATTN_LDS_BYTES=LDS_BYTES;
#undef SBAR
#undef WAIT_BAR
}

namespace pg8 {
struct EpiInProj {
    static constexpr bool PERM = true, AFTER_DRAIN = false;
    bf16_t* P; const float* na_qn; const float* na_kn; const float* gq_qn; const float* gq_kn; int wv;
    __device__ __forceinline__ void operator()(const f32x4 (&acc)[2][2][4][2], const Unit& u, int, int, int, int) const {
        const int l_ = otid(wv) & 63, fr = l_ & 15, fq = l_ >> 4, wr = wv >> 2, wc = wv & 3;
        const int pn = u.pn, rowt = u.pm * BM;
        int mode = 0; const float* gain = na_qn; float qs = 1.f;
        if (pn == 0) { mode = 1; gain = na_qn; qs = att::C2; }
        else if (pn == 1) { mode = 1; gain = na_kn; }
        else if (pn == 3 || pn == 4) { mode = 2; gain = gq_qn; qs = att::C2; }
        else if (pn == 5 && wc < 2) { mode = 2; gain = gq_kn; }
        if (mode == 2 && rowt >= NLAT) mode = 1;
        bf16_t* pcol = P + pn * BM + 64 * wc + 8 * fq;
        if (mode == 0) {
#pragma unroll
            for (int ai = 0; ai < 2; ++ai)
#pragma unroll
                for (int m = 0; m < 4; ++m) { bf16_t* rowp = pcol + (size_t)(rowt + ai * HALF + wr * 64 + m * 16 + fr) * DIN;
#pragma unroll
                    for (int bj = 0; bj < 2; ++bj) { const f32x4 v0 = acc[ai][bj][m][0], v1 = acc[ai][bj][m][1];
                        u32x4 w; w.x = cvt_pk_bf16(v0[0], v0[1]); w.y = cvt_pk_bf16(v0[2], v0[3]); w.z = cvt_pk_bf16(v1[0], v1[1]); w.w = cvt_pk_bf16(v1[2], v1[3]);
                        *(u32x4*)(rowp + 32 * bj) = w; } }
            return;
        }
        f32x4 g[2][2]; float invf[2][2];
#pragma unroll
        for (int bj = 0; bj < 2; ++bj)
#pragma unroll
            for (int n = 0; n < 2; ++n) g[bj][n] = *(const f32x4*)(gain + 32 * bj + 8 * fq + 4 * n) * qs;
#pragma unroll
        for (int n = 0; n < 2; ++n)
#pragma unroll
            for (int pp = 0; pp < 2; ++pp) invf[n][pp] = exp2f(-(float)(4 * fq + 2 * n + pp) * (13.287712379549449f / 16.f));
#pragma unroll
        for (int ai = 0; ai < 2; ++ai)
#pragma unroll
            for (int m = 0; m < 4; ++m) {
                const int row = rowt + ai * HALF + wr * 64 + m * 16 + fr;
                f32x4 v[2][2]; float ss = 0.f;
#pragma unroll
                for (int bj = 0; bj < 2; ++bj)
#pragma unroll
                    for (int n = 0; n < 2; ++n) { v[bj][n] = acc[ai][bj][m][n]; ss += (v[bj][n][0] * v[bj][n][0] + v[bj][n][1] * v[bj][n][1]) + (v[bj][n][2] * v[bj][n][2] + v[bj][n][3] * v[bj][n][3]); }
                ss += shx(ss, 16, l_); ss += shx(ss, 32, l_);
                const float rstd = rsqrtf(ss * (1.f / 64.f) + 1e-6f);
#pragma unroll
                for (int bj = 0; bj < 2; ++bj)
#pragma unroll
                    for (int n = 0; n < 2; ++n) {
                        if (mode == 2) {
                        }
                        v[bj][n] = v[bj][n] * rstd * g[bj][n];
                    }
                if (mode == 2) {
                    const int t = row & (SEQ - 1); const float pos[2] = {(float)(t >> 6), (float)(t & 63)};
#pragma unroll
                    for (int bj = 0; bj < 2; ++bj)
#pragma unroll
                        for (int n = 0; n < 2; ++n)
#pragma unroll
                            for (int pp = 0; pp < 2; ++pp) {
                                const float ang = pos[bj] * invf[n][pp], cs = __cosf(ang), sn = __sinf(ang);
                                const float x1 = v[bj][n][2 * pp], x2 = v[bj][n][2 * pp + 1];
                                v[bj][n][2 * pp] = x1 * cs - x2 * sn; v[bj][n][2 * pp + 1] = x1 * sn + x2 * cs;
                            }
                }
                bf16_t* rowp = pcol + (size_t)row * DIN;
#pragma unroll
                for (int bj = 0; bj < 2; ++bj) { const f32x4 v0 = v[bj][0], v1 = v[bj][1];
                    u32x4 w; w.x = cvt_pk_bf16(v0[0], v0[1]); w.y = cvt_pk_bf16(v0[2], v0[3]); w.z = cvt_pk_bf16(v1[0], v1[1]); w.w = cvt_pk_bf16(v1[2], v1[3]);
                    *(u32x4*)(rowp + 32 * bj) = w; }
                asm volatile("" ::: "memory");
            }
    }
};
}

__device__ __forceinline__ void w_qknorm_rope(const Ptrs& p, int layer, int unit, int d) {
    const int row = unit / 18, slot = unit % 18;
    int col; const float* gain; bool rope;
    if (slot < 4) { col = A_Q + slot * 64; gain = p.in[I_NAQN] + layer * 64; rope = false; }
    else if (slot < 8) { col = A_K + (slot - 4) * 64; gain = p.in[I_NAKN] + layer * 64; rope = false; }
    else if (slot < 16) { col = B_Q + (slot - 8) * 64; gain = p.in[I_GQQN] + layer * 64; rope = true; }
    else { col = B_K + (slot - 16) * 64; gain = p.in[I_GQKN] + layer * 64; rope = true; }
    bf16* pp = (bf16*)(p.ws + WS_P) + (size_t)row * DIN + col;
    float x = bf2f(pp[d]);
    float ss = wave_sum(x * x, d);
    float y = x * rsqrtf(ss * (1.f / 64.f) + 1e-6f) * gain[d];
    if (rope && row < NLAT) {
        int t = row & (SEQ - 1);
        float partner = shx(y, 1, d);
        int pi = d >> 1;
        float pos = (pi < 16) ? (float)(t >> 6) : (float)(t & 63);
        float inv = exp2f(-(float)(pi & 15) * (13.287712379549449f / 16.f));
        float ang = pos * inv;
        float cs = __cosf(ang), sn = __sinf(ang);
        y = (d & 1) ? (partner * sn + y * cs) : (y * cs - partner * sn);
    }
    if (slot < 4 || (slot >= 8 && slot < 16)) y *= att::C2;
    pp[d] = (bf16)f2bf(y);
}
struct NoHook { __device__ __forceinline__ void operator()(att::f32x16&, att::f32x16&, int, int, int, int) const {} };
struct NaHook {
    const LAS float* tab; int r0, kr0;
    __device__ __forceinline__ void operator()(att::f32x16& p0, att::f32x16& p1, int t, int wid, int r32, int hi) const {
        if (t < 4) return;
        const int r = r0 + (wid >> 1), kr = kr0 + t - 4, rs = min(max(r - 4, 0), 24);
        const float NEG = -INFINITY;
        if ((unsigned)(kr - rs) >= 8u) {
#pragma unroll
            for (int i = 0; i < 16; ++i) { p0[i] = NEG; p1[i] = NEG; }
            return;
        }
        const int qc = 32 * (wid & 1) + r32, cs = min(max(qc - 8, 0), 48), kb = 4 * hi - cs;
        const LAS float* tp = tab + (kr - r + 7) * 31 + (4 * hi - qc + 15);
#pragma unroll
        for (int i = 0; i < 16; ++i) {
            const int c = (i & 3) + 8 * (i >> 2);
            const float b0 = tp[c], b1 = tp[c + 32];
            p0[i] = ((unsigned)(kb + c) < 16u) ? p0[i] + b0 : NEG;
            p1[i] = ((unsigned)(kb + c + 32) < 16u) ? p1[i] + b1 : NEG;
        }
    }
};
constexpr int LDS_NATAB = 88064;
__device__ __forceinline__ void phase_attn(const Ptrs& p, unsigned char* lds_gen, int layer, int wv) {
    const bf16* P = (const bf16*)(p.ws + WS_P); bf16* MIX = (bf16*)(p.ws + WS_MIX);
    char* shm = (char*)lds_gen;
    const int c = blockIdx.x, x = c & 7, ci = (c >> 3) & 31;
    for (int i = 0; i < 2; ++i) {
        const int grp = 2 * x + i, b = grp >> 1, kvh = grp & 1, g = ci >> 3, qb = ci & 7, hq = kvh * 4 + g;
        const size_t qrow = (size_t)b * SEQ + qb * 256;
        att::attn_unit<8, NoHook>(P + qrow * DIN + B_Q + hq * 64, P + B_K + kvh * 64, P + B_V + kvh * 64, b * SEQ, 32, NLAT + b * CTXL, 36,
                                  MIX + qrow * DM + 256 + hq * 64, NoHook{}, shm, wv);
    }
    {
        const int grp = 4 * x + (ci >> 3), b = grp >> 2, h = grp & 3, r0 = 4 * (ci & 7);
        const int kr0 = (r0 == 0) ? 0 : (r0 == 28 ? 24 : r0 - 4), nr = (r0 == 0 || r0 == 28) ? 8 : 12;
        LAS float* tab = (LAS float*)((LAS unsigned char*)lds_gen + LDS_NATAB);
        const float* rpb = p.in[I_RPB] + ((size_t)layer * 4 + h) * 15 * 31;
        for (int i = otid(wv); i < 15 * 31; i += NT) tab[i] = rpb[i] * 1.4426950408889634f;
        __syncthreads();
        const size_t qrow = (size_t)b * SEQ + r0 * 64;
        NaHook hook{tab, r0, kr0};
        att::attn_unit<8, NaHook>(P + qrow * DIN + A_Q + h * 64, P + A_K + h * 64, P + A_V + h * 64, NLAT + b * CTXL, 4, b * SEQ + kr0 * 64, 4 + nr,
                                  MIX + qrow * DM + h * 64, hook, shm, wv);
    }
    if (layer == 0 && c < 96) {
        if (c < 32) {
            const int b = c >> 2, h = c & 3; const size_t qrow = (size_t)NLAT + b * CTXL;
            att::attn_unit<8, NoHook>(P + qrow * DIN + A_Q + h * 64, P + A_K + h * 64, P + A_V + h * 64, NLAT + b * CTXL, 4, 0, 4, MIX + qrow * DM + h * 64, NoHook{}, shm, wv);
        } else {
            const int cc = c - 32, b = cc >> 3, hq = cc & 7, kvh = hq >> 2; const size_t qrow = (size_t)NLAT + b * CTXL;
            att::attn_unit<8, NoHook>(P + qrow * DIN + B_Q + hq * 64, P + B_K + kvh * 64, P + B_V + kvh * 64, NLAT + b * CTXL, 4, 0, 4, MIX + qrow * DM + 256 + hq * 64, NoHook{}, shm, wv);
        }
    }
}

__global__ void __launch_bounds__(NT, 2) k_mega(Ptrs p) {
    extern __shared__ __attribute__((aligned(16))) unsigned char lds_raw[];
    LAS unsigned char* lds = (LAS unsigned char*)lds_raw;
    cg::grid_group grid = cg::this_grid();
#define GRID_SYNC() do { asm volatile("s_waitcnt vmcnt(0)" ::: "memory"); grid.sync(); __builtin_amdgcn_fence(__ATOMIC_ACQUIRE, "agent"); asm volatile("s_waitcnt vmcnt(0)" ::: "memory"); } while (0)
    const int wv = __builtin_amdgcn_readfirstlane(threadIdx.x >> 6);
    const int NGW = gridDim.x * NWAVES;
    phase_mod(p, lds, wv);
    phase_lb(p, wv);
    __syncthreads();
    phase_convert(p, lds, 0, 2, wv);
    phase_router_w(p, wv);
    GRID_SYNC();
    phase_norm(p.in[I_X], p.in[I_CTX], p.in[I_N1G], (const float*)(p.ws + WS_MOD), 0, 1, (bf16*)(p.ws + WS_H), MROWS, wv);
    GRID_SYNC();
    for (int layer = 0; layer < 2; ++layer) {
        const int M = (layer == 0) ? MROWS : NLAT;
        const float* modl = (const float*)(p.ws + WS_MOD) + (size_t)layer * 9 * MODW;
        {
            pg8::Gemm g{(const bf16*)(p.ws + WS_H), (const bf16*)(p.ws + WS_WIN + layer * WIN_STRIDE), MROWS, DIN, DM};
            pg8::StaticOrder S; S.init(MROWS, DIN, gridDim.x, (int)blockIdx.x);
            pg8::EpiInProj E{(bf16*)(p.ws + WS_P), p.in[I_NAQN] + layer * 64, p.in[I_NAKN] + layer * 64, p.in[I_GQQN] + layer * 64, p.in[I_GQKN] + layer * 64, wv};
            pg8::gemm_phase<pg8::EpiInProj, pg8::StaticOrder, true, true>(lds, g, S, E, wv);
        }
        GRID_SYNC();
        phase_hgrn1(p, lds, layer, wv);
        GRID_SYNC();
        phase_hgrn2(p, lds, layer, wv);
        __syncthreads();
        phase_attn(p, lds_raw, layer, wv);
        GRID_SYNC();
        {
            pg8::Gemm g{(const bf16*)(p.ws + WS_MIX), (const bf16*)(p.ws + WS_WOUT + layer * WOUT_STRIDE), M, DM, DM};
            pg8::StaticOrder S; S.init(M, DM, gridDim.x, (int)blockIdx.x);
            pg8::EpiResidSS E{layer == 0 ? p.in[I_X] : p.out, p.in[I_CTX], p.out, (float*)(p.ws + WS_XC), modl, 2, (float*)(p.ws + WS_RSS), wv};
            pg8::gemm_phase<pg8::EpiResidSS, pg8::StaticOrder, true, true>(lds, g, S, E, wv);
        }
        GRID_SYNC();
        phase_route(p, lds, layer, M, wv);
        GRID_SYNC();
        phase_moe_gu(p, lds, layer, wv);
        GRID_SYNC();
        phase_moe_down(p, lds, layer, wv);
        GRID_SYNC();
        phase_combine(p, layer, M, layer == 0, wv);
        if (layer == 0) GRID_SYNC();
    }
}

extern "C" void kernel_launch(void* const* d_in, const int* in_sizes, int n_in, void* d_out, int out_size, void* d_ws, size_t ws_size, hipStream_t stream) {
    static int grid = 0;
    if (grid == 0) {
        if (n_in != 24 || ws_size < WS_END) { fprintf(stderr, "kernel_launch: bad n_in %d or ws_size %zu < %zu\n", n_in, ws_size, (size_t)WS_END); grid = -1; return; }
        int dev = 0, cus = 0, per_cu = 0;
        hipGetDevice(&dev); hipDeviceGetAttribute(&cus, hipDeviceAttributeMultiprocessorCount, dev);
        hipFuncSetAttribute((const void*)k_mega, hipFuncAttributeMaxDynamicSharedMemorySize, LDS_BYTES);
        hipOccupancyMaxActiveBlocksPerMultiprocessor(&per_cu, (const void*)k_mega, NT, LDS_BYTES);
        if (per_cu < 1) { fprintf(stderr, "kernel_launch: occupancy query says %d blocks/CU\n", per_cu); grid = -1; return; }
        grid = cus;
        (void)hipGetLastError();
    }
    if (grid < 0) return;
    Ptrs p{};
    for (int i = 0; i < 24; ++i) p.in[i] = (const float*)d_in[i];
    p.out = (float*)d_out; p.ws = (unsigned char*)d_ws; p.layer = 0; p.pad = 0;
    hipMemsetAsync((unsigned char*)d_ws + WS_CTL, 0, 1 * MiB, stream);
    void* args[] = {&p};
    hipError_t e = hipLaunchCooperativeKernel((const void*)k_mega, dim3(grid), dim3(NT), args, LDS_BYTES, stream);
    if (e != hipSuccess) fprintf(stderr, "cooperative launch failed: %s\n", hipGetErrorString(e));
}
```

```cpp
#include <hip/hip_runtime.h>
#include <hip/hip_cooperative_groups.h>
#include <cstdio>
#include <cstdint>
#include <math.h>
namespace cg = cooperative_groups;

#define DM 1024
#define SEQ 2048
#define CTXL 256
#define NBATCH 8
#define NLAT (NBATCH * SEQ)
#define NCTX (NBATCH * CTXL)
#define MROWS (NLAT + NCTX)
#define DIN 2816
#define NMOD 6
#define MODW (NMOD * DM)
#define A_Q 0
#define A_K 256
#define A_V 512
#define B_Q 768
#define B_K 1280
#define B_V 1408
#define C_Q 1536
#define C_I 1792
#define C_FF 2048
#define C_FB 2304
#define C_G 2560

typedef unsigned short bf16;
#define LAS __attribute__((address_space(3)))
#define GAS __attribute__((address_space(1)))
typedef unsigned v4u __attribute__((ext_vector_type(4)));
typedef unsigned v2u __attribute__((ext_vector_type(2)));
typedef float v4f __attribute__((ext_vector_type(4)));

__device__ __forceinline__ unsigned f2bf(float f) { unsigned u = __builtin_bit_cast(unsigned, f); return (u + 0x7fffu + ((u >> 16) & 1u)) >> 16; }
__device__ __forceinline__ unsigned pk2(float lo, float hi) { return f2bf(lo) | (f2bf(hi) << 16); }
__device__ __forceinline__ float bf2f(unsigned short v) { return __builtin_bit_cast(float, (unsigned)v << 16); }
__device__ __forceinline__ float bflo(unsigned v) { return __builtin_bit_cast(float, v << 16); }
__device__ __forceinline__ float bfhi(unsigned v) { return __builtin_bit_cast(float, v & 0xffff0000u); }
__device__ __forceinline__ float silu_f(float x) { return x / (1.f + __expf(-x)); }
__device__ __forceinline__ float shx(float v, int mask, int lane) { return __builtin_bit_cast(float, __builtin_amdgcn_ds_bpermute((lane ^ mask) << 2, __builtin_bit_cast(int, v))); }
__device__ __forceinline__ float wave_sum(float v, int lane) {
#pragma unroll
    for (int o = 1; o < 64; o <<= 1) v += shx(v, o, lane);
    return v;
}
__device__ __forceinline__ int otid(int wv) { unsigned m = ~0u; asm volatile("" : "+s"(m)); asm volatile("" : "+s"(wv)); return wv * 64 + (int)__builtin_amdgcn_mbcnt_hi(m, __builtin_amdgcn_mbcnt_lo(m, 0u)); }
#define LDS_WAIT() asm volatile("s_waitcnt lgkmcnt(0)" ::: "memory")

constexpr size_t MiB = 1u << 20;
constexpr size_t WS_CTL = 0;
constexpr size_t WS_MOD = 1 * MiB;
constexpr size_t WS_LB = 1 * MiB + 512 * 1024;
constexpr size_t WS_EID = 2 * MiB;
constexpr size_t WS_EW = 2 * MiB + 256 * 1024;
constexpr size_t WS_IDX = 3 * MiB;
constexpr size_t WS_XC = 8 * MiB;
constexpr size_t WS_WIN = 16 * MiB;
constexpr size_t WIN_STRIDE = (size_t)DIN * DM * 2;
constexpr size_t WS_WOUT = 28 * MiB;
constexpr size_t WOUT_STRIDE = 2 * MiB;
constexpr size_t WS_WGU = 32 * MiB;
constexpr size_t WGU_STRIDE = 32 * MiB;
constexpr size_t WS_WD = 96 * MiB;
constexpr size_t WD_STRIDE = 16 * MiB;
constexpr size_t WS_H = 128 * MiB;
constexpr size_t WS_MIX = 164 * MiB;
constexpr size_t WS_P = 200 * MiB;
constexpr size_t WS_Y0 = 200 * MiB;
constexpr size_t WS_Y1 = 236 * MiB;
constexpr size_t WS_HID = 272 * MiB;
constexpr size_t WS_SCR = 300 * MiB;
constexpr size_t WS_END = 340 * MiB;

constexpr int NT = 512, NWAVES = 8;
constexpr int LDS_BYTES = 147456;
namespace pg8 {
#define PG8_LAS __attribute__((address_space(3)))
typedef unsigned short bf16_t;
typedef short bf16x8 __attribute__((ext_vector_type(8)));
typedef float f32x4 __attribute__((ext_vector_type(4)));
typedef unsigned u32x4 __attribute__((ext_vector_type(4)));
constexpr int BM = 256, BK = 64, HALF = 128, HTB = HALF * BK * 2  , STAGE_BYTES = 8 * HTB, NXCD = 8, WGM = 8;

__host__ __device__ __forceinline__ int lds_byte(int r, int c) { const int st = (r >> 4) * 2 + (c >> 5), rr = r & 15, cc = c & 31, ob = rr * 64 + cc * 2; return st * 1024 + (ob ^ (((ob >> 9) & 1) << 5)); }
__host__ __device__ __forceinline__ void stage_rc(int b, int& R, int& C) { const int st = b / 1024, sb = b % 1024, swz = sb ^ (((sb >> 9) & 1) << 5); R = (st >> 1) * 16 + swz / 64; C = (st & 1) * 32 + (swz % 64) / 2; }
__host__ __device__ __forceinline__ int perm32(int rho) { const int n = rho >> 4, i = rho & 15; return 8 * (i >> 2) + 4 * n + (i & 3); }

struct Unit { int pm, pn, aux; };
struct Gemm { const bf16_t* A; const bf16_t* Bt; int M, N, K; };

struct StaticOrder {
    int nM, nN, nwg, G, c;
    __host__ __device__ void init(int M, int N, int G_, int c_) { nM = M / BM; nN = N / BM; nwg = nM * nN; G = G_; c = c_; }
    __host__ __device__ bool next(int i, Unit& u) const {
        const long L = (long)i * G + c; if (L >= nwg) return false;
        int wgid = (int)L; { const int q = nwg / NXCD, r = nwg % NXCD, xcd = wgid % NXCD, off = wgid / NXCD; wgid = (xcd < r ? xcd * (q + 1) : r * (q + 1) + (xcd - r) * q) + off; }
        const int nig = WGM * nN, gid = wgid / nig, fm = gid * WGM, gsz = (nM - fm) < WGM ? (nM - fm) : WGM;
        u.pm = fm + ((wgid % nig) % gsz); u.pn = (wgid % nig) / gsz; return true;
    }
    __device__ __forceinline__ void a_ready(const Unit&) const {}
    __device__ __forceinline__ void done(const Unit&) const {}
};

__device__ __forceinline__ unsigned cvt_pk_bf16(float lo, float hi) { unsigned r; asm volatile("v_cvt_pk_bf16_f32 %0, %1, %2" : "=v"(r) : "v"(lo), "v"(hi)); return r; }
typedef float f32x2 __attribute__((ext_vector_type(2)));
__device__ __forceinline__ f32x2 gelu_pk(f32x2 v) {
    const f32x2 av = __builtin_elementwise_abs(v), d = av * 0.2316418882f + 1.0f;
    f32x2 t; t.x = __builtin_amdgcn_rcpf(d.x); t.y = __builtin_amdgcn_rcpf(d.y);
    f32x2 q = t * 0.5307027145f + (-0.7265760135f); q = q * t + 0.7107068705f; q = q * t + (-0.142248368f); q = q * t + 0.127414796f; q = q * t;
    const f32x2 s = (v * v) * (-0.72134752044f);
    f32x2 e; e.x = __builtin_amdgcn_exp2f(s.x); e.y = __builtin_amdgcn_exp2f(s.y);
    const f32x2 m = v * (q * e), r = v - m;
    f32x2 o; o.x = v.x < 0.f ? m.x : r.x; o.y = v.y < 0.f ? m.y : r.y; return o;
}

template <int ACT  > struct EpiBf16 {
    static constexpr bool PERM = true, AFTER_DRAIN = false; static_assert(ACT == 0 || ACT == 1, "EpiBf16: ACT is 0 (none) or 1 (gelu_pk)");
    bf16_t* O; int ldc; const float* bias; int split_cols; size_t split_stride; float scale0;
    __device__ __forceinline__ void operator()(const f32x4 (&acc)[2][2][4][2], const Unit& u, int wr, int wc, int fr, int fq) const {
        const int row0 = u.pm * BM + wr * 64 + fr; int colt = u.pn * BM; bf16_t* base = O;
        float sc = 1.f; if (split_cols) { const int t = colt / split_cols; base += (size_t)t * split_stride; colt -= t * split_cols; if (t == 0) sc = scale0; }
        const int col0 = colt + wc * 32 + 8 * fq, bcol0 = u.pn * BM + wc * 32 + 8 * fq;
        f32x4 bv[2][2];
#pragma unroll
        for (int bj = 0; bj < 2; ++bj)
#pragma unroll
            for (int n = 0; n < 2; ++n) bv[bj][n] = bias ? *(const f32x4*)(bias + bcol0 + bj * HALF + 4 * n) : (f32x4){0.f, 0.f, 0.f, 0.f};
#pragma unroll
        for (int ai = 0; ai < 2; ++ai)
#pragma unroll
            for (int m = 0; m < 4; ++m) { bf16_t* rowp = base + (size_t)(row0 + ai * HALF + m * 16) * ldc + col0;
#pragma unroll
                for (int bj = 0; bj < 2; ++bj) { f32x4 v0 = acc[ai][bj][m][0] + bv[bj][0], v1 = acc[ai][bj][m][1] + bv[bj][1];
                    if (ACT == 1) { f32x2 a = gelu_pk((f32x2){v0[0], v0[1]}), b = gelu_pk((f32x2){v0[2], v0[3]}), c = gelu_pk((f32x2){v1[0], v1[1]}), d = gelu_pk((f32x2){v1[2], v1[3]});
                        v0 = (f32x4){a.x, a.y, b.x, b.y}; v1 = (f32x4){c.x, c.y, d.x, d.y}; }
                    v0 = v0 * sc; v1 = v1 * sc; u32x4 w; w.x = cvt_pk_bf16(v0[0], v0[1]); w.y = cvt_pk_bf16(v0[2], v0[3]); w.z = cvt_pk_bf16(v1[0], v1[1]); w.w = cvt_pk_bf16(v1[2], v1[3]);
                    *(u32x4*)(rowp + bj * HALF) = w; } }
    }
};

template <class Epi, class Sched, bool ALIGN_EPI = false, bool SP2 = false, bool GATHER = false>
__device__ __forceinline__ void gemm_phase(PG8_LAS unsigned char* lds, const Gemm g, const Sched& S, const Epi& E, int wv, const PG8_LAS int* gidx = nullptr) {
    static_assert(SP2 || !GATHER, "GATHER is wired into the SP2 loop only");
    int tid_ = otid(wv);
    const int tid = tid_, wid = __builtin_amdgcn_readfirstlane(tid >> 6), lane = tid & 63, wr = wid >> 2, wc = wid & 3, fr = lane & 15, fq = lane >> 4;
    const int K = g.K, nt = K / BK;
    unsigned voffA[2][2], nvoffA[2][2], voffB[2]; int RA[2], CA[2];
#pragma unroll
    for (int i = 0; i < 2; ++i) { int R, C; stage_rc(tid * 16 + i * 8192, R, C); const int Rb = Epi::PERM ? ((R & ~31) + perm32(R & 31)) : R; RA[i] = R; CA[i] = C;
        voffA[0][i] = voffA[1][i] = nvoffA[0][i] = nvoffA[1][i] = (unsigned)(R * K + C) * 2u; voffB[i] = (unsigned)(Rb * K + C) * 2u; }
#define PG8_GVOFF(dst, uidx) do { if constexpr (GATHER) { _Pragma("unroll") for (int _h = 0; _h < 2; ++_h) _Pragma("unroll") for (int _i = 0; _i < 2; ++_i) dst[_h][_i] = (unsigned)(gidx[(uidx) * 256 + _h * 128 + RA[_i]] * K + CA[_i]) * 2u; } } while (0)
    const size_t kstep = (size_t)(BK * 2);
    const size_t hstep = (size_t)HALF * K * 2;
    const size_t hstepA = GATHER ? (size_t)0 : hstep;
    const size_t tstep = 2 * hstep;
    const unsigned ldsw = (unsigned)wid * 1024u;
    const int aoff = lds_byte(wr * 64 + fr, fq * 8), boff = lds_byte(wc * 32 + fr, fq * 8);
#define PG8_SA(b, h) (((b) * 2 + (h)) * HTB)
#define PG8_SB(b, h) ((4 + (b) * 2 + (h)) * HTB)
#define PG8_STAGE(bufoff, gbase, voff) do { _Pragma("unroll") for (int _i = 0; _i < 2; ++_i) \
        __builtin_amdgcn_global_load_lds((const unsigned*)((const char*)(gbase) + (voff)[_i]), (PG8_LAS unsigned*)(lds + (bufoff) + ldsw + _i * 8192), 16, 0, 0); } while (0)
#define PG8_LDA(dst, b, h) do { _Pragma("unroll") for (int m = 0; m < 4; ++m) _Pragma("unroll") for (int k = 0; k < 2; ++k) dst[m][k] = *(const PG8_LAS bf16x8*)(lds + PG8_SA(b, h) + aoff + m * 2048 + k * 1024); } while (0)
#define PG8_LDB(dst, b, h) do { _Pragma("unroll") for (int n = 0; n < 2; ++n) _Pragma("unroll") for (int k = 0; k < 2; ++k) dst[n][k] = *(const PG8_LAS bf16x8*)(lds + PG8_SB(b, h) + boff + n * 2048 + k * 1024); } while (0)
#define PG8_MMA(ai, bj, At, Bt) do { __builtin_amdgcn_s_setprio(1); _Pragma("unroll") for (int m = 0; m < 4; ++m) _Pragma("unroll") for (int n = 0; n < 2; ++n) _Pragma("unroll") for (int k = 0; k < 2; ++k) \
        acc[ai][bj][m][n] = __builtin_amdgcn_mfma_f32_16x16x32_bf16(Bt[n][k], At[m][k], acc[ai][bj][m][n], 0, 0, 0); __builtin_amdgcn_s_setprio(0); } while (0)
#define PG8_WAIT_V(n) asm volatile("s_waitcnt vmcnt(" #n ")" ::: "memory")
#define PG8_WAIT_L(n) asm volatile("s_waitcnt lgkmcnt(" #n ")" ::: "memory")
#define PG8_BAR __builtin_amdgcn_s_barrier()
#define PG8_SCHED __builtin_amdgcn_sched_barrier(0)
    Unit cur, nxt; int ui = 0;
    if (!S.next(0, cur)) return;
    f32x4 acc[2][2][4][2];
#pragma unroll
    for (int a = 0; a < 2; ++a)
#pragma unroll
        for (int b = 0; b < 2; ++b)
#pragma unroll
            for (int m = 0; m < 4; ++m)
#pragma unroll
                for (int n = 0; n < 2; ++n) acc[a][b][m][n] = (f32x4){0.f, 0.f, 0.f, 0.f};
    bf16x8 At[4][2], B0[2][2], B1[2][2];
    const char* cA = (const char*)g.A + (GATHER ? (size_t)0 : (size_t)cur.pm * tstep); PG8_GVOFF(voffA, 0); const char* cB = (const char*)g.Bt + (size_t)cur.pn * tstep;
    S.a_ready(cur);
    if constexpr (SP2) {
        PG8_STAGE(PG8_SB(0, 0), cB, voffB); PG8_STAGE(PG8_SB(0, 1), cB + hstep, voffB); PG8_STAGE(PG8_SA(0, 0), cA, voffA[0]); PG8_STAGE(PG8_SA(0, 1), cA + hstepA, voffA[1]);
        if (wr == 1) PG8_BAR;
        PG8_WAIT_V(2); PG8_BAR;
        PG8_STAGE(PG8_SB(1, 0), cB + kstep, voffB); PG8_STAGE(PG8_SA(1, 0), cA + kstep, voffA[0]); PG8_STAGE(PG8_SB(1, 1), cB + hstep + kstep, voffB);
        PG8_WAIT_V(6); PG8_BAR;
    } else {
        PG8_STAGE(PG8_SB(0, 0), cB, voffB); PG8_STAGE(PG8_SA(0, 0), cA, voffA[0]); PG8_STAGE(PG8_SB(0, 1), cB + hstep, voffB); PG8_STAGE(PG8_SA(0, 1), cA + hstep, voffA[0]);
        if (wr == 1) PG8_BAR;
        PG8_WAIT_V(4); PG8_BAR;
        PG8_STAGE(PG8_SB(1, 0), cB + kstep, voffB); PG8_STAGE(PG8_SA(1, 0), cA + kstep, voffA[0]); PG8_STAGE(PG8_SB(1, 1), cB + hstep + kstep, voffB);
        PG8_WAIT_V(6); PG8_BAR;
    }
    for (;;) {
        const bool has_next = S.next(ui + 1, nxt);
        const char* nA = (has_next && !GATHER) ? (const char*)g.A + (size_t)nxt.pm * tstep : cA; if (has_next) PG8_GVOFF(nvoffA, ui + 1); const char* nB = has_next ? (const char*)g.Bt + (size_t)nxt.pn * tstep : cB;
        for (int t = 0; t < nt; t += 2) {
            const bool last = (t == nt - 2);
            const char* a1 = cA + (size_t)(t + 1) * kstep;
            const char* a2 = last ? nA : cA + (size_t)(t + 2) * kstep; const char* b2 = last ? nB : cB + (size_t)(t + 2) * kstep;
            const char* a3 = a2 + kstep; const char* b3 = b2 + kstep;
            if (last && has_next) S.a_ready(nxt);
            unsigned vs2[2][2];
#pragma unroll
            for (int _h = 0; _h < 2; ++_h)
#pragma unroll
                for (int _i = 0; _i < 2; ++_i) vs2[_h][_i] = last ? nvoffA[_h][_i] : voffA[_h][_i];
            if constexpr (SP2) {
            PG8_LDB(B0, 0, 0); PG8_LDB(B1, 0, 1); PG8_SCHED; PG8_LDA(At, 0, 0); PG8_STAGE(PG8_SA(1, 1), a1 + hstepA, voffA[1]);
            PG8_WAIT_V(8); PG8_WAIT_L(0); PG8_BAR; PG8_MMA(0, 0, At, B0); PG8_MMA(0, 1, At, B1); PG8_BAR; PG8_SCHED;
            PG8_LDA(At, 0, 1); PG8_STAGE(PG8_SB(0, 0), b2, voffB); PG8_STAGE(PG8_SB(0, 1), b2 + hstep, voffB); PG8_STAGE(PG8_SA(0, 0), a2, vs2[0]);
            PG8_WAIT_V(8); PG8_WAIT_L(0); PG8_BAR; PG8_MMA(1, 0, At, B0); PG8_MMA(1, 1, At, B1); PG8_BAR; PG8_SCHED;
            PG8_LDB(B0, 1, 0); PG8_LDB(B1, 1, 1); PG8_SCHED; PG8_LDA(At, 1, 0); PG8_STAGE(PG8_SA(0, 1), a2 + hstepA, vs2[1]);
            PG8_WAIT_V(8); PG8_WAIT_L(0); PG8_BAR; PG8_MMA(0, 0, At, B0); PG8_MMA(0, 1, At, B1); PG8_BAR; PG8_SCHED;
            PG8_LDA(At, 1, 1); PG8_STAGE(PG8_SB(1, 0), b3, voffB); PG8_STAGE(PG8_SB(1, 1), b3 + hstep, voffB); PG8_STAGE(PG8_SA(1, 0), a3, vs2[0]);
            PG8_WAIT_V(8); PG8_WAIT_L(0); PG8_BAR; PG8_MMA(1, 0, At, B0); PG8_MMA(1, 1, At, B1); PG8_BAR; PG8_SCHED;
            } else {
            PG8_LDB(B0, 0, 0); PG8_SCHED; PG8_LDA(At, 0, 0); PG8_STAGE(PG8_SA(1, 1), a1 + hstep, voffA[0]);
            PG8_WAIT_L(8); PG8_BAR; PG8_WAIT_L(0); PG8_MMA(0, 0, At, B0); PG8_BAR; PG8_SCHED;
            PG8_LDB(B1, 0, 1); PG8_STAGE(PG8_SB(0, 0), b2, voffB);
            PG8_BAR; PG8_WAIT_L(0); PG8_MMA(0, 1, At, B1); PG8_BAR;
            PG8_LDA(At, 0, 1); PG8_STAGE(PG8_SA(0, 0), a2, voffA[0]);
            PG8_BAR; PG8_WAIT_L(0); PG8_MMA(1, 0, At, B0); PG8_BAR; PG8_SCHED;
            PG8_STAGE(PG8_SB(0, 1), b2 + hstep, voffB);
            PG8_WAIT_V(6); PG8_BAR; PG8_MMA(1, 1, At, B1); PG8_BAR;
            PG8_LDB(B0, 1, 0); PG8_SCHED; PG8_LDA(At, 1, 0); PG8_STAGE(PG8_SA(0, 1), a2 + hstep, voffA[0]);
            PG8_WAIT_L(8); PG8_BAR; PG8_WAIT_L(0); PG8_MMA(0, 0, At, B0); PG8_BAR; PG8_SCHED;
            PG8_LDB(B1, 1, 1); PG8_STAGE(PG8_SB(1, 0), b3, voffB);
            PG8_BAR; PG8_WAIT_L(0); PG8_MMA(0, 1, At, B1); PG8_BAR;
            PG8_LDA(At, 1, 1); PG8_STAGE(PG8_SA(1, 0), a3, voffA[0]);
            PG8_BAR; PG8_WAIT_L(0); PG8_MMA(1, 0, At, B0); PG8_BAR; PG8_SCHED;
            PG8_STAGE(PG8_SB(1, 1), b3 + hstep, voffB);
            PG8_WAIT_V(6); PG8_BAR; PG8_MMA(1, 1, At, B1); PG8_BAR;
            }
        }
        if constexpr (ALIGN_EPI) { if (wr == 0) PG8_BAR; }
        if constexpr (!Epi::AFTER_DRAIN) { E(acc, cur, wr, wc, fr, fq); S.done(cur); }
        if (!has_next) break;
#pragma unroll
        for (int a = 0; a < 2; ++a)
#pragma unroll
            for (int b = 0; b < 2; ++b)
#pragma unroll
                for (int m = 0; m < 4; ++m)
#pragma unroll
                    for (int n = 0; n < 2; ++n) acc[a][b][m][n] = (f32x4){0.f, 0.f, 0.f, 0.f};
        cur = nxt; cA = nA; cB = nB; ++ui;
#pragma unroll
        for (int _h = 0; _h < 2; ++_h)
#pragma unroll
            for (int _i = 0; _i < 2; ++_i) voffA[_h][_i] = nvoffA[_h][_i];
        if constexpr (ALIGN_EPI) { if (wr == 1) PG8_BAR; }
    }
    PG8_WAIT_V(0);
    if constexpr (!ALIGN_EPI) { if (wr == 0) PG8_BAR; }
    PG8_BAR;
    if constexpr (Epi::AFTER_DRAIN) { E.fused(acc, cur, wr, wc, fr, fq, lds, wid, lane); S.done(cur); }
#undef PG8_SA
#undef PG8_GVOFF
#undef PG8_SB
#undef PG8_STAGE
#undef PG8_LDA
#undef PG8_LDB
#undef PG8_MMA
#undef PG8_WAIT_V
#undef PG8_WAIT_L
#undef PG8_BAR
#undef PG8_SCHED
}
}


struct Ptrs { const float* in[24]; float* out; unsigned char* ws; int layer; int pad; };
enum { I_X = 0, I_C, I_CTX, I_CCTX, I_WADA, I_BADA, I_N1G, I_WIN, I_NAQN, I_NAKN, I_RPB, I_GQQN, I_GQKN, I_LB, I_HGON, I_WOUT, I_N2G, I_WRG, I_BRG, I_WRE, I_BRE, I_WEG, I_WEU, I_WED };

namespace pg8 {
struct EpiResid {
    static constexpr bool PERM = false, AFTER_DRAIN = false;
    const float* xin_lat; const float* xin_ctx; float* xout_lat; float* xout_ctx; const float* modl; int chunk;
    __device__ __forceinline__ void operator()(const f32x4 (&acc)[2][2][4][2], const Unit& u, int wr, int wc, int fr, int fq) const {
        const int rowt = u.pm * BM; const bool isctx = rowt >= NLAT;
        const float* xin = isctx ? xin_ctx + (size_t)(rowt - NLAT) * DM : xin_lat + (size_t)rowt * DM;
        float* xo = isctx ? xout_ctx + (size_t)(rowt - NLAT) * DM : xout_lat + (size_t)rowt * DM;
        const int mrow = isctx ? 8 : (rowt >> 11);
        const float* gate = modl + (size_t)mrow * MODW + chunk * DM;
        const int col0 = u.pn * BM + wc * 32 + 4 * fq;
#pragma unroll
        for (int bj = 0; bj < 2; ++bj)
#pragma unroll
            for (int n = 0; n < 2; ++n) {
                const int col = col0 + bj * HALF + n * 16;
                const f32x4 gv = *(const f32x4*)(gate + col);
#pragma unroll
                for (int ai = 0; ai < 2; ++ai)
#pragma unroll
                    for (int m = 0; m < 4; ++m) {
                        const size_t off = (size_t)(ai * HALF + wr * 64 + m * 16 + fr) * DM + col;
                        const f32x4 xi = *(const f32x4*)(xin + off);
                        *(f32x4*)(xo + off) = xi + gv * acc[ai][bj][m][n];
                    }
            }
    }
};
}

__device__ __forceinline__ void phase_mod(const Ptrs& p, LAS unsigned char* lds, int wv) {
    if (blockIdx.x >= 192) return;
    LAS float* sc = (LAS float*)lds;
    LAS float* red = (LAS float*)(lds + 36864);
    const int tid = otid(wv);
    const float* c = p.in[I_C]; const float* cc = p.in[I_CCTX];
    for (int i = tid; i < 9 * DM; i += NT) { float v = (i < 8 * DM) ? c[i] : cc[i - 8 * DM]; sc[i] = silu_f(v); }
    __syncthreads();
    float* mod = (float*)(p.ws + WS_MOD);
    for (int u = blockIdx.x; u < 192; u += gridDim.x) {
        const int layer = u / 96, cb = u % 96, cq = tid & 15, kg = tid >> 4;
        const float* w = p.in[I_WADA] + (size_t)layer * DM * MODW + cb * 64 + cq * 4;
        v4f acc[9];
#pragma unroll
        for (int r = 0; r < 9; ++r) acc[r] = (v4f){0.f, 0.f, 0.f, 0.f};
        for (int i = 0; i < 32; ++i) {
            const int k = kg + 32 * i;
            const v4f wv = *(const v4f*)(w + (size_t)k * MODW);
#pragma unroll
            for (int r = 0; r < 9; ++r) acc[r] += sc[r * DM + k] * wv;
        }
#pragma unroll
        for (int r = 0; r < 9; ++r) *(LAS v4f*)(red + (kg * 9 + r) * 64 + cq * 4) = acc[r];
        __syncthreads();
        for (int o = tid; o < 576; o += NT) {
            const int r = o >> 6, c2 = o & 63; float s = 0.f;
            for (int k2 = 0; k2 < 32; ++k2) s += red[(k2 * 9 + r) * 64 + c2];
            mod[((size_t)layer * 9 + r) * MODW + cb * 64 + c2] = s + p.in[I_BADA][layer * MODW + cb * 64 + c2];
        }
        __syncthreads();
    }
}
__device__ __forceinline__ void phase_lb(const Ptrs& p, int wv) {
    if (blockIdx.x == 255 % gridDim.x) {
        const int i = otid(wv);
        const float* raw = p.in[I_LB]; float* lb = (float*)(p.ws + WS_LB);
        float l0 = raw[i], l1 = raw[512 + i];
        lb[i] = 0.f; lb[512 + i] = 1.f / (1.f + __expf(l0 - l1));
    }
}
__device__ __forceinline__ void transpose_item(const float* W, int K, int N, bf16* WT, int row_off, LAS float* scr, int item, int lane) {
    const int nblk = N / 32, kb = item / nblk, nb = item % nblk, k0 = 64 * kb, n0 = 32 * nb;
#pragma unroll 8
    for (int i = 0; i < 32; ++i) { const int kk = 2 * i + (lane >> 5); scr[kk * 33 + (lane & 31)] = W[(size_t)(k0 + kk) * N + n0 + (lane & 31)]; }
    LDS_WAIT(); asm volatile("" ::: "memory");
    const int c = lane & 7;
#pragma unroll
    for (int j = 0; j < 4; ++j) { const int n = (lane >> 3) + 8 * j; const LAS float* s = scr + (8 * c) * 33 + n;
        v4u o; o.x = pk2(s[0 * 33], s[1 * 33]); o.y = pk2(s[2 * 33], s[3 * 33]); o.z = pk2(s[4 * 33], s[5 * 33]); o.w = pk2(s[6 * 33], s[7 * 33]);
        *(v4u*)(WT + (size_t)(row_off + n0 + n) * K + k0 + 8 * c) = o; }
    LDS_WAIT(); asm volatile("" ::: "memory");
}
constexpr int CI_IN = 16 * 88, CI_OUT = 16 * 32, CI_G = 32 * 128, CI_U = 32 * 128, CI_D = 32 * 128, CI_LAYER = CI_IN + CI_OUT + CI_G + CI_U + CI_D;
__device__ __forceinline__ void phase_convert(const Ptrs& p, LAS unsigned char* lds, int layer_lo, int layer_hi, int wv) {
    const int lane = otid(wv) & 63, wave = wv;
    LAS float* scr = (LAS float*)(lds + wave * 16384);
    const int gw = blockIdx.x * NWAVES + wave, NGW = gridDim.x * NWAVES;
    const int n_items = (layer_hi - layer_lo) * CI_LAYER;
    for (int it = gw; it < n_items; it += NGW) {
        const int layer = layer_lo + it / CI_LAYER; int r = it % CI_LAYER;
        if (r < CI_IN) {
            const int n0 = 32 * (r % 88), pn_ = n0 >> 8, w_ = (n0 >> 6) & 3, bj_ = (n0 >> 5) & 1;
            transpose_item(p.in[I_WIN] + (size_t)layer * DM * DIN, DM, DIN, (bf16*)(p.ws + WS_WIN + layer * WIN_STRIDE), (256 * pn_ + 128 * bj_ + 32 * w_) - n0, scr, r, lane); continue; } r -= CI_IN;
        if (r < CI_OUT) { transpose_item(p.in[I_WOUT] + (size_t)layer * DM * DM, DM, DM, (bf16*)(p.ws + WS_WOUT + layer * WOUT_STRIDE), 0, scr, r, lane); continue; } r -= CI_OUT;
        if (r < CI_G + CI_U) {
            const int up = r >= CI_G; if (up) r -= CI_G;
            const int e = r >> 7, rem = r & 127, nb = rem & 7, n0 = 32 * nb;
            const int mapped = (n0 >> 7) * 256 + (n0 & 127) + (up ? 128 : 0);
            transpose_item(p.in[up ? I_WEU : I_WEG] + ((size_t)layer * 32 + e) * DM * 256, DM, 256, (bf16*)(p.ws + WS_WGU + layer * WGU_STRIDE) + (size_t)e * 512 * DM, mapped - n0, scr, rem, lane);
            continue;
        }
        r -= CI_G + CI_U;
        { const int e = r >> 7, rem = r & 127;
          transpose_item(p.in[I_WED] + ((size_t)layer * 32 + e) * 256 * DM, 256, DM, (bf16*)(p.ws + WS_WD + layer * WD_STRIDE) + (size_t)e * DM * 256, 0, scr, rem, lane); }
    }
}
__device__ __forceinline__ void phase_norm(const float* xlat, const float* xctx, const float* g, const float* modl, int ch_shift, int ch_scale, bf16* H, int nrows, int wv) {
    const int lane = otid(wv) & 63, wave = wv;
    const int gw = blockIdx.x * NWAVES + wave, NGW = gridDim.x * NWAVES;
    const int per = (nrows + NGW - 1) / NGW;
    const int r0 = gw * per, r1 = min(r0 + per, nrows);
    int cur = -1; v4f gs[4], sh[4];
    for (int r = r0; r < r1; ++r) {
        const int mrow = (r < NLAT) ? (r >> 11) : 8;
        if (mrow != cur) {
            cur = mrow; const float* m = modl + (size_t)mrow * MODW;
#pragma unroll
            for (int j = 0; j < 4; ++j) { const int c = 4 * lane + 256 * j; const v4f gg = *(const v4f*)(g + c), sc = *(const v4f*)(m + ch_scale * DM + c);
                gs[j] = gg * (1.f + sc); sh[j] = *(const v4f*)(m + ch_shift * DM + c); }
        }
        const float* xr = (r < NLAT) ? xlat + (size_t)r * DM : xctx + (size_t)(r - NLAT) * DM;
        v4f v[4]; float s = 0.f;
#pragma unroll
        for (int j = 0; j < 4; ++j) { v[j] = *(const v4f*)(xr + 4 * lane + 256 * j); s += (v[j].x * v[j].x + v[j].y * v[j].y) + (v[j].z * v[j].z + v[j].w * v[j].w); }
        const float rstd = rsqrtf(wave_sum(s, lane) * (1.f / DM) + 1e-6f);
        bf16* orow = H + (size_t)r * DM;
#pragma unroll
        for (int j = 0; j < 4; ++j) { const v4f o = v[j] * rstd * gs[j] + sh[j]; v2u w; w.x = pk2(o.x, o.y); w.y = pk2(o.z, o.w); *(v2u*)(orow + 4 * lane + 256 * j) = w; }
    }
}

constexpr size_t WS_RSS = 6 * MiB;
constexpr size_t WS_WR = 7 * MiB + 512 * 1024;
constexpr int CW_CNT = 1024;
constexpr int LDS_TTAB = 131072;
constexpr int LDS_GIDX = 131072 + 4096;
constexpr int LDS_RT = 131072;

namespace pg8 {
struct EpiResidSS {
    static constexpr bool PERM = false, AFTER_DRAIN = false;
    const float* xin_lat; const float* xin_ctx; float* xout_lat; float* xout_ctx; const float* modl; int chunk; float* rss; int wv;
    __device__ __forceinline__ void operator()(const f32x4 (&acc)[2][2][4][2], const Unit& u, int, int, int, int) const {
        const int l_ = otid(wv) & 63, fr = l_ & 15, fq = l_ >> 4, wr = wv >> 2, wc = wv & 3;
        const int rowt = u.pm * BM; const bool isctx = rowt >= NLAT;
        const float* xin = isctx ? xin_ctx + (size_t)(rowt - NLAT) * DM : xin_lat + (size_t)rowt * DM;
        float* xo = isctx ? xout_ctx + (size_t)(rowt - NLAT) * DM : xout_lat + (size_t)rowt * DM;
        const int mrow = isctx ? 8 : (rowt >> 11);
        const float* gate = modl + (size_t)mrow * MODW + chunk * DM;
        const int col0 = u.pn * BM + wc * 32 + 4 * fq;
        f32x4 gv[2][2];
#pragma unroll
        for (int bj = 0; bj < 2; ++bj)
#pragma unroll
            for (int n = 0; n < 2; ++n) gv[bj][n] = *(const f32x4*)(gate + col0 + bj * HALF + n * 16);
#pragma unroll
        for (int ai = 0; ai < 2; ++ai)
#pragma unroll
            for (int m = 0; m < 4; ++m) {
                const int rl = ai * HALF + wr * 64 + m * 16 + fr; float ss = 0.f;
#pragma unroll
                for (int bj = 0; bj < 2; ++bj)
#pragma unroll
                    for (int n = 0; n < 2; ++n) {
                        const size_t off = (size_t)rl * DM + col0 + bj * HALF + n * 16;
                        const f32x4 xi = *(const f32x4*)(xin + off);
                        const f32x4 o = xi + gv[bj][n] * acc[ai][bj][m][n];
                        *(f32x4*)(xo + off) = o;
                        ss += (o[0] * o[0] + o[1] * o[1]) + (o[2] * o[2] + o[3] * o[3]);
                    }
                ss += shx(ss, 16, l_); ss += shx(ss, 32, l_);
                if (fq == 0) rss[(size_t)(rowt + rl) * 16 + u.pn * 4 + wc] = ss;
            }
    }
};
struct EpiGU {
    static constexpr bool PERM = true, AFTER_DRAIN = false;
    bf16_t* HID; int wv;
    __device__ __forceinline__ void operator()(const f32x4 (&acc)[2][2][4][2], const Unit& u, int, int, int, int) const {
        const int l_ = otid(wv) & 63, fr = l_ & 15, fq = l_ >> 4, wr = wv >> 2, wc = wv & 3;
        const int pnl = u.pn & 1, row0 = u.pm * BM + wr * 64 + fr, col0 = pnl * 128 + wc * 32 + 8 * fq;
#pragma unroll
        for (int ai = 0; ai < 2; ++ai)
#pragma unroll
            for (int m = 0; m < 4; ++m) {
                bf16_t* rowp = HID + (size_t)(row0 + ai * HALF + m * 16) * 256 + col0;
                float hv[8];
#pragma unroll
                for (int n = 0; n < 2; ++n)
#pragma unroll
                    for (int i = 0; i < 4; ++i) { const float g = acc[ai][0][m][n][i], uu = acc[ai][1][m][n][i]; hv[n * 4 + i] = g / (1.f + __expf(-g)) * uu; }
                u32x4 w; w.x = cvt_pk_bf16(hv[0], hv[1]); w.y = cvt_pk_bf16(hv[2], hv[3]); w.z = cvt_pk_bf16(hv[4], hv[5]); w.w = cvt_pk_bf16(hv[6], hv[7]);
                *(u32x4*)rowp = w;
            }
    }
};
struct EpiDown {
    static constexpr bool PERM = true, AFTER_DRAIN = false;
    bf16_t* Y0; bf16_t* Y1; const PG8_LAS int* rowinfo; int wv;
    __device__ __forceinline__ void operator()(const f32x4 (&acc)[2][2][4][2], const Unit& u, int, int, int, int) const {
        const int l_ = otid(wv) & 63, fr_ = l_ & 15, fq = l_ >> 4, wr = wv >> 2, wc = wv & 3;
        const int col0 = (u.pn & 3) * BM + wc * 32 + 8 * fq;
        const PG8_LAS int* ri = rowinfo + (u.aux * 256 + wr * 64 + fr_) * 2;
#pragma unroll
        for (int ai = 0; ai < 2; ++ai)
#pragma unroll
            for (int m = 0; m < 4; ++m) {
                const int ent = ri[(ai * HALF + m * 16) * 2]; const float w = __builtin_bit_cast(float, ri[(ai * HALF + m * 16) * 2 + 1]);
                if (ent >= 0) {
                    bf16_t* rowp = Y0 + ((size_t)(ent & 1) * ((WS_Y1 - WS_Y0) / 2) + (size_t)(ent >> 1) * DM + col0);
#pragma unroll
                    for (int bj = 0; bj < 2; ++bj) {
                        const f32x4 v0 = acc[ai][bj][m][0] * w, v1 = acc[ai][bj][m][1] * w;
                        u32x4 o; o.x = cvt_pk_bf16(v0[0], v0[1]); o.y = cvt_pk_bf16(v0[2], v0[3]); o.z = cvt_pk_bf16(v1[0], v1[1]); o.w = cvt_pk_bf16(v1[2], v1[3]);
                        *(u32x4*)(rowp + bj * HALF) = o;
                    }
                }
                asm volatile("" ::: "memory");
            }
    }
};
struct MoeOrder {
    const PG8_LAS int* ttab; int ntile, npn, G, c;
    __device__ __forceinline__ bool next(int i, Unit& u) const {
        const int L = i * G + c; if (L >= ntile * npn) return false;
        const int t = L / npn, pl = L % npn; u.pm = t; u.pn = ttab[t * 4] * npn + pl; u.aux = i; return true;
    }
    __device__ __forceinline__ void a_ready(const Unit&) const {}
    __device__ __forceinline__ void done(const Unit&) const {}
};
}

__device__ __forceinline__ void phase_router_w(const Ptrs& p, int wv) {
    const int gt = blockIdx.x * NT + otid(wv), NG = gridDim.x * NT;
    for (int idx = gt; idx < 2 * 48 * DM; idx += NG) {
        const int layer = idx / (48 * DM), r = idx % (48 * DM), n = r >> 10, k = r & 1023;
        float w;
        if (n < 16) w = p.in[I_WRG][((size_t)layer * DM + k) * 4 + (n & 3)];
        else { const int g = ((n - 16) & 15) >> 2, i = n & 3, e = 8 * g + i + (n >= 32 ? 4 : 0); w = p.in[I_WRE][((size_t)layer * DM + k) * 32 + e]; }
        const unsigned hi = f2bf(w); const float lo = w - __builtin_bit_cast(float, hi << 16);
        bf16* base = (bf16*)(p.ws + WS_WR) + (size_t)layer * 2 * 48 * DM;
        base[r] = (bf16)hi; base[48 * DM + r] = (bf16)f2bf(lo);
    }
}

typedef short s8v __attribute__((ext_vector_type(8)));
__device__ __forceinline__ void phase_route(const Ptrs& p, LAS unsigned char* lds, int layer, int nrows, int wv) {
    const int tid = otid(wv), lane = tid & 63, wave = wv;
    LAS int* lcnt = (LAS int*)(lds + LDS_RT); LAS int* gb = lcnt + 32;
    if (tid < 32) lcnt[tid] = 0;
    __syncthreads();
    const int ntiles = nrows / 16, t = wave * gridDim.x + blockIdx.x;
    const float* modl = (const float*)(p.ws + WS_MOD) + (size_t)layer * 9 * MODW;
    int e0 = -1, e1 = -1, lp0 = 0, lp1 = 0, ent0 = 0;
    if (t < ntiles) {
        const int row0 = t * 16, r = row0 + (lane & 15), kq = lane >> 4;
        const int mrow = (row0 < NLAT) ? (row0 >> 11) : 8;
        const float* xr = (r < NLAT) ? p.out + (size_t)r * DM : (const float*)(p.ws + WS_XC) + (size_t)(r - NLAT) * DM;
        const float* g = p.in[I_N2G] + layer * DM; const float* msc = modl + (size_t)mrow * MODW + 4 * DM; const float* msh = modl + (size_t)mrow * MODW + 3 * DM;
        bf16* hrow = (bf16*)(p.ws + WS_H) + (size_t)r * DM;
        const bf16* wr_hi = (const bf16*)(p.ws + WS_WR) + (size_t)layer * 2 * 48 * DM + (size_t)(lane & 15) * DM; const bf16* wr_lo = wr_hi + 48 * DM;
        float ss;
        { const v4f* rs = (const v4f*)((const float*)(p.ws + WS_RSS) + (size_t)r * 16); const v4f a = rs[0], b = rs[1], c = rs[2], d = rs[3];
          ss = ((a.x + a.y) + (a.z + a.w)) + ((b.x + b.y) + (b.z + b.w)) + ((c.x + c.y) + (c.z + c.w)) + ((d.x + d.y) + (d.z + d.w)); }
        const float rstd = rsqrtf(ss * (1.f / DM) + 1e-6f);
        v4f acc[3];
#pragma unroll
        for (int i = 0; i < 3; ++i) acc[i] = (v4f){0.f, 0.f, 0.f, 0.f};
        for (int s = 0; s < 32; ++s) {
            const int c0 = 32 * s + 8 * kq;
            const v4f xa = *(const v4f*)(xr + c0), xb = *(const v4f*)(xr + c0 + 4);
            const v4f ga = *(const v4f*)(g + c0), gbv = *(const v4f*)(g + c0 + 4);
            const v4f sa = *(const v4f*)(msc + c0), sb = *(const v4f*)(msc + c0 + 4);
            const v4f ha = *(const v4f*)(msh + c0), hb = *(const v4f*)(msh + c0 + 4);
            const v4f h0 = xa * rstd * (ga * (1.f + sa)) + ha, h1 = xb * rstd * (gbv * (1.f + sb)) + hb;
            float hv[8] = {h0.x, h0.y, h0.z, h0.w, h1.x, h1.y, h1.z, h1.w};
            unsigned hi[8]; s8v bhi, blo;
#pragma unroll
            for (int j = 0; j < 8; ++j) { hi[j] = f2bf(hv[j]); bhi[j] = (short)hi[j]; blo[j] = (short)f2bf(hv[j] - __builtin_bit_cast(float, hi[j] << 16)); }
            v4u hw; hw.x = hi[0] | (hi[1] << 16); hw.y = hi[2] | (hi[3] << 16); hw.z = hi[4] | (hi[5] << 16); hw.w = hi[6] | (hi[7] << 16);
            *(v4u*)(hrow + c0) = hw;
#pragma unroll
            for (int nt = 0; nt < 3; ++nt) {
                const s8v ahi = *(const s8v*)(wr_hi + (size_t)nt * 16 * DM + c0), alo = *(const s8v*)(wr_lo + (size_t)nt * 16 * DM + c0);
                acc[nt] = __builtin_amdgcn_mfma_f32_16x16x32_bf16(ahi, bhi, acc[nt], 0, 0, 0);
                acc[nt] = __builtin_amdgcn_mfma_f32_16x16x32_bf16(ahi, blo, acc[nt], 0, 0, 0);
                acc[nt] = __builtin_amdgcn_mfma_f32_16x16x32_bf16(alo, bhi, acc[nt], 0, 0, 0);
            }
        }
        const float* brg = p.in[I_BRG] + layer * 4; const float* bre = p.in[I_BRE] + layer * 32;
        float gl[4];
#pragma unroll
        for (int i = 0; i < 4; ++i) gl[i] = acc[0][i] + brg[i];
        int gi = 0; float gm = gl[0];
#pragma unroll
        for (int i = 1; i < 4; ++i) if (gl[i] > gm) { gm = gl[i]; gi = i; }
        float den = 0.f;
#pragma unroll
        for (int i = 0; i < 4; ++i) den += __expf(gl[i] - gm);
        const float gtop = 1.f / den;
        if (kq == gi) {
            float el[8];
#pragma unroll
            for (int i = 0; i < 4; ++i) { el[i] = acc[1][i] + bre[8 * kq + i]; el[4 + i] = acc[2][i] + bre[8 * kq + 4 + i]; }
            int i0 = 0; float v0 = el[0];
#pragma unroll
            for (int i = 1; i < 8; ++i) if (el[i] > v0) { v0 = el[i]; i0 = i; }
            int i1 = -1; float v1 = -3.0e38f;
#pragma unroll
            for (int i = 0; i < 8; ++i) if (i != i0 && el[i] > v1) { v1 = el[i]; i1 = i; }
            const float p1 = __expf(v1 - v0), sden = 1.f / (1.f + p1);
            e0 = gi * 8 + i0; e1 = gi * 8 + i1; ent0 = r * 2;
            float* ew = (float*)(p.ws + WS_EW);
            ew[ent0] = gtop * sden; ew[ent0 + 1] = gtop * p1 * sden;
            lp0 = __hip_atomic_fetch_add(lcnt + e0, 1, __ATOMIC_RELAXED, __HIP_MEMORY_SCOPE_WORKGROUP); lp1 = __hip_atomic_fetch_add(lcnt + e1, 1, __ATOMIC_RELAXED, __HIP_MEMORY_SCOPE_WORKGROUP);
        }
    }
    __syncthreads();
    int* cnt = (int*)(p.ws + WS_CTL) + CW_CNT + layer * 64;
    if (tid < 32) gb[tid] = atomicAdd(&cnt[tid], lcnt[tid]);
    __syncthreads();
    if (e0 >= 0) {
        int* IDX = (int*)(p.ws + WS_IDX);
        IDX[(size_t)e0 * MROWS + gb[e0] + lp0] = ent0;
        IDX[(size_t)e1 * MROWS + gb[e1] + lp1] = ent0 + 1;
    }
}
__device__ __forceinline__ int moe_build_ttab(const Ptrs& p, LAS unsigned char* lds, int layer, int wv) {
    LAS int* ttab = (LAS int*)(lds + LDS_TTAB);
    const int* cnt = (const int*)(p.ws + WS_CTL) + CW_CNT + layer * 64;
    __syncthreads();
    if (otid(wv) == 0) {
        int t = 0;
        for (int e = 0; e < 32; ++e) { const int c = __hip_atomic_load(cnt + e, __ATOMIC_RELAXED, __HIP_MEMORY_SCOPE_AGENT); for (int fp = 0; fp < c; fp += 256) { ttab[t * 4] = e; ttab[t * 4 + 1] = fp; ttab[t * 4 + 2] = c; ++t; } }
        ttab[176 * 4] = t;
    }
    __syncthreads();
    return ttab[176 * 4];
}
__device__ __forceinline__ void phase_moe_gu(const Ptrs& p, LAS unsigned char* lds, int layer, int wv) {
    const int ntile = moe_build_ttab(p, lds, layer, wv);
    LAS int* ttab = (LAS int*)(lds + LDS_TTAB); LAS int* gidx = (LAS int*)(lds + LDS_GIDX);
    pg8::MoeOrder S{ttab, ntile, 2, (int)gridDim.x, (int)blockIdx.x};
    const int* IDX = (const int*)(p.ws + WS_IDX);
    for (int i = 0; i < 3; ++i) {
        pg8::Unit u; if (!S.next(i, u)) break;
        const int e = ttab[u.pm * 4], fp = ttab[u.pm * 4 + 1], c = ttab[u.pm * 4 + 2];
        for (int r = otid(wv); r < 256; r += NT) gidx[i * 256 + r] = (fp + r < c) ? (IDX[(size_t)e * MROWS + fp + r] >> 1) : 0;
    }
    __syncthreads();
    pg8::Gemm g{(const bf16*)(p.ws + WS_H), (const bf16*)(p.ws + WS_WGU + layer * WGU_STRIDE), ntile * 256, 32 * 512, DM};
    pg8::EpiGU E{(bf16*)(p.ws + WS_HID), wv};
    pg8::gemm_phase<pg8::EpiGU, pg8::MoeOrder, true, true, true>(lds, g, S, E, wv, gidx);
}
__device__ __forceinline__ void phase_moe_down(const Ptrs& p, LAS unsigned char* lds, int layer, int wv) {
    const int ntile = moe_build_ttab(p, lds, layer, wv);
    LAS int* ttab = (LAS int*)(lds + LDS_TTAB); LAS int* rowinfo = (LAS int*)(lds + LDS_GIDX);
    pg8::MoeOrder S{ttab, ntile, 4, (int)gridDim.x, (int)blockIdx.x};
    const int* IDX = (const int*)(p.ws + WS_IDX); const float* EW = (const float*)(p.ws + WS_EW);
    for (int i = 0; i < 3; ++i) {
        pg8::Unit u; if (!S.next(i, u)) break;
        const int e = ttab[u.pm * 4], fp = ttab[u.pm * 4 + 1], c = ttab[u.pm * 4 + 2];
        for (int r = otid(wv); r < 256; r += NT) {
            int ent = -1; float w = 0.f;
            if (fp + r < c) { ent = IDX[(size_t)e * MROWS + fp + r]; w = EW[ent]; }
            rowinfo[(i * 256 + r) * 2] = ent; rowinfo[(i * 256 + r) * 2 + 1] = __builtin_bit_cast(int, w);
        }
    }
    __syncthreads();
    pg8::Gemm g{(const bf16*)(p.ws + WS_HID), (const bf16*)(p.ws + WS_WD + layer * WD_STRIDE), ntile * 256, 32 * 1024, 256};
    pg8::EpiDown E{(bf16*)(p.ws + WS_Y0), (bf16*)(p.ws + WS_Y1), rowinfo, wv};
    pg8::gemm_phase<pg8::EpiDown, pg8::MoeOrder, true, true, false>(lds, g, S, E, wv);
}
__device__ __forceinline__ void phase_combine(const Ptrs& p, int layer, int nrows, bool do_norm, int wv) {
    const int lane = otid(wv) & 63, wave = wv;
    const int gw = blockIdx.x * NWAVES + wave, NGW = gridDim.x * NWAVES;
    const int per = (nrows + NGW - 1) / NGW;
    const int r0 = gw * per, r1 = min(r0 + per, nrows);
    const float* modl = (const float*)(p.ws + WS_MOD) + (size_t)layer * 9 * MODW;
    const float* modn = (const float*)(p.ws + WS_MOD) + (size_t)(layer + 1) * 9 * MODW;
    const float* g = p.in[I_N1G] + (layer + 1) * DM;
    const bf16* Y0 = (const bf16*)(p.ws + WS_Y0); const bf16* Y1 = (const bf16*)(p.ws + WS_Y1); bf16* H = (bf16*)(p.ws + WS_H);
    for (int r = r0; r < r1; ++r) {
        const int mrow = (r < NLAT) ? (r >> 11) : 8;
        float* xr = (r < NLAT) ? p.out + (size_t)r * DM : (float*)(p.ws + WS_XC) + (size_t)(r - NLAT) * DM;
        const float* m5 = modl + (size_t)mrow * MODW + 5 * DM;
        v4f v[4]; float s = 0.f;
#pragma unroll
        for (int j = 0; j < 4; ++j) {
            const int c = 4 * lane + 256 * j;
            const v4f x = *(const v4f*)(xr + c), mm = *(const v4f*)(m5 + c);
            const v2u a = *(const v2u*)(Y0 + (size_t)r * DM + c), b = *(const v2u*)(Y1 + (size_t)r * DM + c);
            v4f y; y.x = bflo(a.x) + bflo(b.x); y.y = bfhi(a.x) + bfhi(b.x); y.z = bflo(a.y) + bflo(b.y); y.w = bfhi(a.y) + bfhi(b.y);
            v[j] = x + mm * y;
            *(v4f*)(xr + c) = v[j];
            s += (v[j].x * v[j].x + v[j].y * v[j].y) + (v[j].z * v[j].z + v[j].w * v[j].w);
        }
        if (do_norm) {
            const float rstd = rsqrtf(wave_sum(s, lane) * (1.f / DM) + 1e-6f);
            const float* mn = modn + (size_t)mrow * MODW;
#pragma unroll
            for (int j = 0; j < 4; ++j) {
                const int c = 4 * lane + 256 * j;
                const v4f gg = *(const v4f*)(g + c), sc = *(const v4f*)(mn + DM + c), sh = *(const v4f*)(mn + c);
                const v4f o = v[j] * rstd * (gg * (1.f + sc)) + sh; v2u w; w.x = pk2(o.x, o.y); w.y = pk2(o.z, o.w);
                *(v2u*)(H + (size_t)r * DM + c) = w;
            }
        }
    }
}

namespace hg {
typedef short s4v __attribute__((ext_vector_type(4)));
typedef short s8v __attribute__((ext_vector_type(8)));
typedef short v4i16_t __attribute__((ext_vector_type(4)));
constexpr int TS = 160;
constexpr int TILE_B = 16 * TS;
constexpr int WAVE_LDS = 2 * TILE_B;
constexpr int NSEG = 18;
constexpr size_t SEGU_B = 64 * 64 * 4, SEGA_B = 16 * 64 * 4;
constexpr size_t WS_SEGU = WS_SCR;
constexpr size_t WS_SEGA = WS_SEGU + (size_t)NBATCH * 4 * 2 * NSEG * SEGU_B;
constexpr int OFL_OFF = 8 * WAVE_LDS, OFL_B = 8 * 4 * 64 * 16;
static_assert(WS_SEGA + (size_t)NBATCH * 4 * 2 * NSEG * SEGA_B <= WS_END && OFL_OFF + 3 * OFL_B <= LDS_BYTES, "hgrn scratch");
template <int CTRL> __device__ __forceinline__ float dppf(float x) { return __builtin_bit_cast(float, __builtin_amdgcn_update_dpp(0, __builtin_bit_cast(int, x), CTRL, 0xf, 0xf, true)); }
__device__ __forceinline__ s4v trd(const LAS unsigned char* p) { return __builtin_bit_cast(s4v, __builtin_amdgcn_ds_read_tr16_b64_v4i16((LAS v4i16_t*)p)); }
typedef float f32x2_t __attribute__((ext_vector_type(2))); typedef __bf16 bf16x2_t __attribute__((ext_vector_type(2)));
__device__ __forceinline__ unsigned pkbf(float lo, float hi) { f32x2_t v = {lo, hi}; bf16x2_t b = __builtin_convertvector(v, bf16x2_t); return __builtin_bit_cast(unsigned, b); }
__device__ __forceinline__ float silu_r(float x) { return x * __builtin_amdgcn_rcpf(1.f + __expf(-x)); }
__device__ __forceinline__ s8v mk8(unsigned a, unsigned b, unsigned c, unsigned d) { v4u t; t.x = a; t.y = b; t.z = c; t.w = d; return __builtin_bit_cast(s8v, t); }

template <bool BWD, bool OUT>
__device__ __forceinline__ void chunk(const bf16* __restrict__ P, int row0, int h, const float* __restrict__ lbh, v4f (&S)[4][4], float (&Atot)[16],
                                      LAS unsigned char* vt, LAS unsigned char* kt, int lane_, LAS v4f* OFL, int cidx, bf16* __restrict__ MIX, const float* __restrict__ on) {
    int lane = lane_; asm volatile("" : "+v"(lane));
    const int tok = lane & 15, kq = lane >> 4;
    const bf16* pb = P + (size_t)row0 * DIN + h * 64;
    const unsigned lo = (unsigned)(tok * DIN + 4 * kq);
    v2u zr[4], qr[4]; v4f lbq[4];
#pragma unroll
    for (int m = 0; m < 4; ++m) lbq[m] = *(const v4f*)(lbh + (unsigned)(16 * m + 4 * kq));
#pragma unroll
    for (int m = 0; m < 4; ++m) { zr[m] = *(const v2u*)(pb + (lo + (BWD ? C_FB : C_FF) + 16 * m)); if (OUT) qr[m] = *(const v2u*)(pb + (lo + C_Q + 16 * m)); }
#pragma unroll
    for (int i = 0; i < 2; ++i) { const int pc = lane + 64 * i, r = pc >> 3, ch = pc & 7;
        const v4u vv = *(const v4u*)(pb + (unsigned)(r * DIN + C_I + 8 * ch)); *(LAS v4u*)(vt + r * TS + 16 * ch) = vv; }
    unsigned qf[8], kf[8];
    float A[16];
#pragma unroll
    for (int m = 0; m < 4; ++m)
#pragma unroll
        for (int jp = 0; jp < 2; ++jp) {
            const unsigned zw = jp ? zr[m].y : zr[m].x;
            float kt2[2], qt2[2], kh2[2];
#pragma unroll
            for (int i = 0; i < 2; ++i) {
                const int e = 4 * m + 2 * jp + i;
                const float z = i ? bfhi(zw) : bflo(zw);
                const float sg = __builtin_amdgcn_rcpf(1.f + __expf(-z)), lb = lbq[m][2 * jp + i];
                const float f = lb + (1.f - lb) * sg, kk = (1.f - lb) * (1.f - sg);
                const float lf = __logf(f);
                float c = lf, t = lf;
                if (!BWD) { c += dppf<0x111>(c); c += dppf<0x112>(c); c += dppf<0x114>(c); c += dppf<0x118>(c); }
                else      { c += dppf<0x101>(c); c += dppf<0x102>(c); c += dppf<0x104>(c); c += dppf<0x108>(c); }
                t += dppf<0x128>(t); t += dppf<0x124>(t); t += dppf<0x122>(t); t += dppf<0x121>(t);
                const float Ei = __expf(-fmaxf(c, -80.f)); A[e] = __expf(t);
                kt2[i] = kk * Ei; kh2[i] = kt2[i] * A[e];
                if (OUT) { const unsigned qw = jp ? qr[m].y : qr[m].x; const float q = i ? bfhi(qw) : bflo(qw); qt2[i] = q * 0.125f * __expf(c); } else qt2[i] = 0.f;
            }
            kf[2 * m + jp] = pkbf(kt2[0], kt2[1]); if (OUT) qf[2 * m + jp] = pkbf(qt2[0], qt2[1]);
            *(LAS unsigned*)(kt + tok * TS + (16 * m + 4 * kq + 2 * jp) * 2) = pkbf(kh2[0], kh2[1]);
            __builtin_amdgcn_sched_barrier(0);
        }
    asm volatile("s_waitcnt lgkmcnt(0)" ::: "memory");
    s8v vfr[4], khf[4];
    { const int i4 = tok >> 2, p4 = tok & 3; const LAS unsigned char* va = vt + (4 * kq + i4) * TS + 8 * p4; const LAS unsigned char* ka = kt + (4 * kq + i4) * TS + 8 * p4;
#pragma unroll
      for (int c = 0; c < 4; ++c) { const s4v a = trd(va + 32 * c), b = trd(ka + 32 * c);
          vfr[c] = (s8v){a[0], a[1], a[2], a[3], 0, 0, 0, 0}; khf[c] = (s8v){b[0], b[1], b[2], b[3], 0, 0, 0, 0}; } }
    if (OUT) {
        const s8v q0 = mk8(qf[0], qf[1], qf[2], qf[3]), q1 = mk8(qf[4], qf[5], qf[6], qf[7]);
        const s8v k0 = mk8(kf[0], kf[1], kf[2], kf[3]), k1 = mk8(kf[4], kf[5], kf[6], kf[7]);
        v4f at = (v4f){0.f, 0.f, 0.f, 0.f};
        at = __builtin_amdgcn_mfma_f32_16x16x32_bf16(k0, q0, at, 0, 0, 0);
        at = __builtin_amdgcn_mfma_f32_16x16x32_bf16(k1, q1, at, 0, 0, 0);
#pragma unroll
        for (int j = 0; j < 4; ++j) { const int s = 4 * kq + j; const bool keep = BWD ? (s >= tok) : (s <= tok); at[j] = keep ? at[j] : 0.f; }
        const s8v af = mk8(pkbf(at[0], at[1]), pkbf(at[2], at[3]), 0u, 0u);
        v4f o[4];
#pragma unroll
        for (int vb = 0; vb < 4; ++vb) {
            o[vb] = __builtin_amdgcn_mfma_f32_16x16x32_bf16(vfr[vb], af, (v4f){0.f, 0.f, 0.f, 0.f}, 0, 0, 0);
            const s8v s0 = mk8(pkbf(S[0][vb][0], S[0][vb][1]), pkbf(S[0][vb][2], S[0][vb][3]), pkbf(S[1][vb][0], S[1][vb][1]), pkbf(S[1][vb][2], S[1][vb][3]));
            const s8v s1 = mk8(pkbf(S[2][vb][0], S[2][vb][1]), pkbf(S[2][vb][2], S[2][vb][3]), pkbf(S[3][vb][0], S[3][vb][1]), pkbf(S[3][vb][2], S[3][vb][3]));
            o[vb] = __builtin_amdgcn_mfma_f32_16x16x32_bf16(s0, q0, o[vb], 0, 0, 0);
            o[vb] = __builtin_amdgcn_mfma_f32_16x16x32_bf16(s1, q1, o[vb], 0, 0, 0);
            __builtin_amdgcn_sched_barrier(0);
        }
        LAS v4f* ofl = OFL + (cidx * 4) * 64 + lane;
        if (!BWD) {
#pragma unroll
            for (int vb = 0; vb < 4; ++vb) ofl[vb * 64] = o[vb];
        } else {
            float ss = 0.f;
#pragma unroll
            for (int vb = 0; vb < 4; ++vb) { o[vb] += ofl[vb * 64]; ss += (o[vb].x * o[vb].x + o[vb].y * o[vb].y) + (o[vb].z * o[vb].z + o[vb].w * o[vb].w); }
            ss += shx(ss, 16, lane); ss += shx(ss, 32, lane);
            const float rstd = rsqrtf(ss * (1.f / 64.f) + 1e-6f);
            bf16* mb = MIX + (size_t)row0 * DM + 768 + h * 64; const unsigned lom = (unsigned)(tok * DM + 4 * kq);
#pragma unroll
            for (int vb = 0; vb < 4; ++vb) {
                const v2u gw = *(const v2u*)(pb + (lo + C_G + 16 * vb)); const v4f gn = *(const v4f*)(on + (unsigned)(16 * vb + 4 * kq));
                const float g0 = bflo(gw.x), g1 = bfhi(gw.x), g2 = bflo(gw.y), g3 = bfhi(gw.y);
                v2u w; w.x = pkbf(o[vb].x * rstd * gn.x * silu_r(g0), o[vb].y * rstd * gn.y * silu_r(g1)); w.y = pkbf(o[vb].z * rstd * gn.z * silu_r(g2), o[vb].w * rstd * gn.w * silu_r(g3));
                *(v2u*)(mb + (lom + 16 * vb)) = w;
            }
        }
    }
#pragma unroll
    for (int db = 0; db < 4; ++db) {
        const v4f av = (v4f){A[4 * db], A[4 * db + 1], A[4 * db + 2], A[4 * db + 3]};
#pragma unroll
        for (int vb = 0; vb < 4; ++vb) S[db][vb] = __builtin_amdgcn_mfma_f32_16x16x32_bf16(khf[db], vfr[vb], S[db][vb] * av, 0, 0, 0);
        __builtin_amdgcn_sched_barrier(0);
    }
    if (!OUT) {
#pragma unroll
        for (int e = 0; e < 16; ++e) Atot[e] *= A[e];
    }
    asm volatile("s_waitcnt lgkmcnt(0)" ::: "memory");
}
__device__ __forceinline__ int seg_row0(int b, int seg) { return seg < 2 ? NLAT + b * CTXL + 128 * seg : b * SEQ + 128 * (seg - 2); }
__device__ __forceinline__ int scan_idx(int seg, int dir) { return dir == 0 ? seg : (seg < 2 ? 1 - seg : 19 - seg); }

__device__ __forceinline__ void unit_pass1(const Ptrs& p, int layer, int u, LAS unsigned char* wl, int lane) {
    const int seg = u % NSEG, bh = u / NSEG, h = bh & 3, b = bh >> 2;
    const bf16* P = (const bf16*)(p.ws + WS_P);
    const int kq = lane >> 4, row0 = seg_row0(b, seg);
#pragma unroll 1
    for (int dir = 0; dir < 2; ++dir) {
        float Atot[16]; v4f S[4][4];
        const float* lbv = (const float*)(p.ws + WS_LB) + layer * 512 + dir * 256 + h * 64;
#pragma unroll
        for (int e = 0; e < 16; ++e) Atot[e] = 1.f;
#pragma unroll
        for (int i = 0; i < 4; ++i)
#pragma unroll
            for (int j = 0; j < 4; ++j) S[i][j] = (v4f){0.f, 0.f, 0.f, 0.f};
        if (dir == 0) {
#pragma unroll 1
            for (int c = 0; c < 8; ++c) chunk<false, false>(P, row0 + 16 * c, h, lbv, S, Atot, wl, wl + TILE_B, lane, nullptr, c, nullptr, nullptr); }
        else {
#pragma unroll 1
            for (int c = 7; c >= 0; --c) chunk<true, false>(P, row0 + 16 * c, h, lbv, S, Atot, wl, wl + TILE_B, lane, nullptr, c, nullptr, nullptr); }
        const size_t si = ((size_t)(bh * 2 + dir)) * NSEG + scan_idx(seg, dir);
        float* su = (float*)(p.ws + WS_SEGU + si * SEGU_B) + lane; float* sa = (float*)(p.ws + WS_SEGA + si * SEGA_B) + lane;
#pragma unroll
        for (int i = 0; i < 4; ++i)
#pragma unroll
            for (int j = 0; j < 4; ++j)
#pragma unroll
                for (int r = 0; r < 4; ++r) su[((i * 4 + j) * 4 + r) * 64] = S[i][j][r];
#pragma unroll
        for (int e = 0; e < 16; ++e) sa[e * 64] = Atot[e];
    }
}
__device__ __forceinline__ void unit_pass2(const Ptrs& p, int layer, int u, LAS unsigned char* wl, LAS v4f* OFL, int lane) {
    const int seg = u % NSEG, bh = u / NSEG, h = bh & 3, b = bh >> 2;
    const bf16* P = (const bf16*)(p.ws + WS_P); bf16* MIX = (bf16*)(p.ws + WS_MIX);
    const float* on = p.in[I_HGON] + layer * 64;
    const int kq = lane >> 4, row0 = seg_row0(b, seg);
#pragma unroll 1
    for (int dir = 0; dir < 2; ++dir) {
        float Atot[16]; v4f S[4][4];
        const float* lbv = (const float*)(p.ws + WS_LB) + layer * 512 + dir * 256 + h * 64;
#pragma unroll
        for (int e = 0; e < 16; ++e) Atot[e] = 1.f;
#pragma unroll
        for (int i = 0; i < 4; ++i)
#pragma unroll
            for (int j = 0; j < 4; ++j) S[i][j] = (v4f){0.f, 0.f, 0.f, 0.f};
        const int my = scan_idx(seg, dir); const size_t s0 = ((size_t)(bh * 2 + dir)) * NSEG;
#pragma unroll 1
        for (int sj = 0; sj < my; ++sj) {
            int ln = lane; asm volatile("" : "+v"(ln));
            const float* su = (const float*)(p.ws + WS_SEGU + (s0 + sj) * SEGU_B) + ln; const float* sa = (const float*)(p.ws + WS_SEGA + (s0 + sj) * SEGA_B) + ln;
#pragma unroll
            for (int i = 0; i < 4; ++i) {
                const v4f av = (v4f){sa[(4 * i) * 64], sa[(4 * i + 1) * 64], sa[(4 * i + 2) * 64], sa[(4 * i + 3) * 64]};
#pragma unroll
                for (int j = 0; j < 4; ++j) { const v4f uu = (v4f){su[((i * 4 + j) * 4 + 0) * 64], su[((i * 4 + j) * 4 + 1) * 64], su[((i * 4 + j) * 4 + 2) * 64], su[((i * 4 + j) * 4 + 3) * 64]};
                    S[i][j] = S[i][j] * av + uu; }
                __builtin_amdgcn_sched_barrier(0);
            }
        }
        if (dir == 0) {
#pragma unroll 1
            for (int c = 0; c < 8; ++c) chunk<false, true>(P, row0 + 16 * c, h, lbv, S, Atot, wl, wl + TILE_B, lane, OFL, c, MIX, on); }
        else {
#pragma unroll 1
            for (int c = 7; c >= 0; --c) chunk<true, true>(P, row0 + 16 * c, h, lbv, S, Atot, wl, wl + TILE_B, lane, OFL, c, MIX, on); }
    }
}
}
__device__ __forceinline__ void phase_hgrn1(const Ptrs& p, LAS unsigned char* lds, int layer, int wv) {
    const int lane = otid(wv) & 63; const int u = wv * gridDim.x + blockIdx.x;
    if (u < 32 * hg::NSEG) hg::unit_pass1(p, layer, u, lds + wv * hg::WAVE_LDS, lane);
}
__device__ __forceinline__ void phase_hgrn2(const Ptrs& p, LAS unsigned char* lds, int layer, int wv) {
    const int lane = otid(wv) & 63; const int u = wv * gridDim.x + blockIdx.x;
    if (u < 32 * hg::NSEG && (layer == 0 || (u % hg::NSEG) >= 2)) hg::unit_pass2(p, layer, u, lds + wv * hg::WAVE_LDS, (LAS v4f*)(lds + hg::OFL_OFF + wv * hg::OFL_B), lane);
}
namespace att {
using bf16=unsigned short;
using bf16x8=__attribute__((ext_vector_type(8)))short;
using s16x4=__attribute__((ext_vector_type(4)))short;
using f32x16=__attribute__((ext_vector_type(16)))float;
using u32x4=__attribute__((ext_vector_type(4)))unsigned;
constexpr int D=64,PIN_=DIN,POUT=DM;
constexpr int NW=8,QBLK=32,QB=QBLK*NW,KVBLK=64;
__device__ __forceinline__ int crow(int r,int hi){return (r&3)+8*(r>>2)+4*hi;}
#define SBAR() __builtin_amdgcn_sched_barrier(0)
constexpr int NSLOT=3, SLOTB=8192;
constexpr int LDS_K=0, LDS_V=NSLOT*SLOTB, LDS_WS=2*NSLOT*SLOTB, LDS_OST=LDS_WS+NW*64*4, LDS_BYTES=LDS_OST+NW*4096;
constexpr float C2=0.125f*1.4426950408889634f;
__device__ __forceinline__ void glds16(const void*gsrc,unsigned lds_dst){unsigned keep;
  asm volatile("s_mov_b32 %0, m0\n\ts_mov_b32 m0, %2\n\ts_nop 0\n\tglobal_load_lds_dwordx4 %1, off\n\ts_mov_b32 m0, %0":"=&s"(keep):"v"(gsrc),"s"(lds_dst):"memory");}
__device__ __forceinline__ float max3f(float a,float b,float c){float r;asm("v_max3_f32 %0, %1, %2, %3":"=v"(r):"v"(a),"v"(b),"v"(c));return r;}
__device__ __forceinline__ float max2f(float a,float b){float r;asm("v_max_f32_e32 %0, %1, %2":"=v"(r):"v"(a),"v"(b));return r;}
__device__ __forceinline__ float fadd_s(float a,float b){float r;asm("v_add_f32_e32 %0, %1, %2":"=v"(r):"v"(a),"v"(b));return r;}
__device__ __forceinline__ float fsub_s(float a,float b){float r;asm("v_sub_f32_e32 %0, %1, %2":"=v"(r):"v"(a),"v"(b));return r;}
typedef float f32x2_t __attribute__((ext_vector_type(2))); typedef __bf16 bf16x2_t __attribute__((ext_vector_type(2)));
__device__ __forceinline__ unsigned cvtpk_s(float lo,float hi){f32x2_t v={lo,hi};bf16x2_t b=__builtin_convertvector(v,bf16x2_t);return __builtin_bit_cast(unsigned,b);}
#define WAIT_BAR(N) asm volatile("s_waitcnt vmcnt(" #N ") lgkmcnt(0)\n\ts_barrier":::"memory")

__device__ __forceinline__ void qkt(f32x16&p0,f32x16&p1,const char*Kslot,const bf16x8*qr,const f32x16&negm,int r32,int hi){
  const char*kb=Kslot+hi*1024+r32*16;
  #pragma unroll
  for(int d0=0;d0<4;++d0){
    const bf16x8 b0=*reinterpret_cast<const bf16x8*>(kb+d0*2048);
    const bf16x8 b1=*reinterpret_cast<const bf16x8*>(kb+d0*2048+512);
    if(d0==0){p0=__builtin_amdgcn_mfma_f32_32x32x16_bf16(b0,qr[0],negm,0,0,0);p1=__builtin_amdgcn_mfma_f32_32x32x16_bf16(b1,qr[0],negm,0,0,0);}
    else{p0=__builtin_amdgcn_mfma_f32_32x32x16_bf16(b0,qr[d0],p0,0,0,0);p1=__builtin_amdgcn_mfma_f32_32x32x16_bf16(b1,qr[d0],p1,0,0,0);}}
}
typedef __attribute__((address_space(3))) const char* lds_cptr;
typedef short v4i16_t __attribute__((ext_vector_type(4)));
__device__ __forceinline__ void kload8(bf16x8*kf,lds_cptr kp){
  kf[0]=*(const __attribute__((address_space(3))) bf16x8*)(kp);      kf[1]=*(const __attribute__((address_space(3))) bf16x8*)(kp+512);
  kf[2]=*(const __attribute__((address_space(3))) bf16x8*)(kp+2048); kf[3]=*(const __attribute__((address_space(3))) bf16x8*)(kp+2560);
  kf[4]=*(const __attribute__((address_space(3))) bf16x8*)(kp+4096); kf[5]=*(const __attribute__((address_space(3))) bf16x8*)(kp+4608);
  kf[6]=*(const __attribute__((address_space(3))) bf16x8*)(kp+6144); kf[7]=*(const __attribute__((address_space(3))) bf16x8*)(kp+6656);
}
__device__ __forceinline__ void kload2(bf16x8*kf,lds_cptr kp,int j){ kf[2*j]=*(const __attribute__((address_space(3))) bf16x8*)(kp+j*2048); kf[2*j+1]=*(const __attribute__((address_space(3))) bf16x8*)(kp+j*2048+512); }
__device__ __forceinline__ s16x4 vtr(lds_cptr p){ return __builtin_bit_cast(s16x4,__builtin_amdgcn_ds_read_tr16_b64_v4i16((__attribute__((address_space(3))) v4i16_t*)p)); }
__device__ __forceinline__ float rowmax(const f32x16&p0,const f32x16&p1){
  float a=max3f(p0[0],p0[1],p1[0]),b=max3f(p0[2],p0[3],p1[1]);a=max3f(a,p1[2],p1[3]);
  #pragma unroll
  for(int r=4;r<16;r+=4){a=max3f(a,p0[r],p0[r+1]);b=max3f(b,p0[r+2],p0[r+3]);a=max3f(a,p1[r],p1[r+1]);b=max3f(b,p1[r+2],p1[r+3]);}
  const float m=max2f(a,b);
  auto rr=__builtin_amdgcn_permlane32_swap(__float_as_uint(m),__float_as_uint(m),false,false);
  return max2f(__uint_as_float(rr[0]),__uint_as_float(rr[1]));
}
__device__ __forceinline__ void pv(f32x16*o,int vb,bf16x8 pa0,bf16x8 pa1,bf16x8 pa2,bf16x8 pa3){
  #pragma unroll
  for(int d0=0;d0<2;++d0){s16x4 lo[4],hi[4];
    #pragma unroll
    for(int ks=0;ks<4;++ks){
      asm volatile("ds_read_b64_tr_b16 %0,%1 offset:%c2":"=&v"(lo[ks]):"v"(vb),"i"(d0*4096+ks*1024):"memory");
      asm volatile("ds_read_b64_tr_b16 %0,%1 offset:%c2":"=&v"(hi[ks]):"v"(vb),"i"(d0*4096+ks*1024+512):"memory");}
    asm volatile("s_waitcnt lgkmcnt(0)":::"memory");SBAR();
    #define PK(k) (bf16x8){lo[k][0],lo[k][1],lo[k][2],lo[k][3],hi[k][0],hi[k][1],hi[k][2],hi[k][3]}
    o[d0]=__builtin_amdgcn_mfma_f32_32x32x16_bf16(pa0,PK(0),o[d0],0,0,0);
    o[d0]=__builtin_amdgcn_mfma_f32_32x32x16_bf16(pa1,PK(1),o[d0],0,0,0);
    o[d0]=__builtin_amdgcn_mfma_f32_32x32x16_bf16(pa2,PK(2),o[d0],0,0,0);
    o[d0]=__builtin_amdgcn_mfma_f32_32x32x16_bf16(pa3,PK(3),o[d0],0,0,0);
    #undef PK
  }
}

#ifndef ATTN_STORE16
#define ATTN_STORE16(p,v) (*(u32x4*)(p)=(v))
#endif
template<int THRL,class Hook> __device__ __forceinline__ void attn_unit(const bf16*Q0,const bf16*__restrict__ Kh,const bf16*__restrict__ Vh,int rowa,int na,int rowb,int NT,bf16*O0,const Hook&hook,char*shm,int wid){
  const int lane=otid(wid)&63,r32=lane&31,hi=lane>>5;
  const bf16*Qw=Q0+(long)(wid*QBLK)*PIN_;
  #define TROW(t) ((long)(((t)<na)?(rowa+64*(t)):(rowb+64*((t)-na))))
  const unsigned lds0=(unsigned)(uintptr_t)shm;
  float*wsf=(float*)(shm+LDS_WS)+wid*64;
  const bf16*ksrc=Kh+(long)lane*PIN_+wid*8;
  const bf16*vsrc=Vh+(long)(16*(wid&3)+(lane>>2))*PIN_+(wid>>2)*32+(lane&3)*8;
  const unsigned kdst=lds0+LDS_K+wid*1024, vdst=lds0+LDS_V+wid*1024;
  #define DMA_K(t,slot) glds16(ksrc+TROW(t)*PIN_,(unsigned)__builtin_amdgcn_readfirstlane(kdst+(slot)))
  #define DMA_V(t,slot) glds16(vsrc+TROW(t)*PIN_,(unsigned)__builtin_amdgcn_readfirstlane(vdst+(slot)))
  const int vb0=(int)(lds0+LDS_V)+((lane>>4)&1)*32+(lane&3)*8+(4*hi+((lane&15)>>2))*64;
  const char*Kbase=shm+LDS_K; bf16x8 kf[8];
  const lds_cptr shm3=(lds_cptr)shm; const lds_cptr kp0=shm3+LDS_K+hi*1024+r32*16; const lds_cptr vp0=shm3+LDS_V+((lane>>4)&1)*32+(lane&3)*8+(4*hi+((lane&15)>>2))*64;
  DMA_K(0,0);DMA_V(0,0);DMA_K(1,SLOTB);
  bf16x8 qr[4];
  #pragma unroll
  for(int d0=0;d0<4;++d0)qr[d0]=*reinterpret_cast<const bf16x8*>(&Qw[(long)r32*PIN_+d0*16+hi*8]);
  float zz_=0.f; asm volatile("":"+v"(zz_));
  float mhat=zz_,l_reg=zz_;f32x16 o[2],negm;
  #pragma unroll
  for(int r=0;r<16;++r){o[0][r]=zz_;o[1][r]=zz_;negm[r]=zz_;}
  asm volatile("":"+v"(negm));
  #define CMASK(P0,P1,t) hook(P0,P1,(t),wid,r32,hi)
  bool resc=false;
  #define START(P0,P1) do{ const float rm=rowmax(P0,P1); resc=false; \
    { const float dl=rm; mhat=fadd_s(mhat,dl); \
      _Pragma("unroll") for(int r=0;r<16;++r){P0[r]=fsub_s(P0[r],dl);P1[r]=fsub_s(P1[r],dl);} \
      _Pragma("unroll") for(int r=0;r<16;++r)negm[r]=-mhat; asm volatile("":"+v"(negm)); } \
    _Pragma("unroll") for(int r=0;r<16;++r)P0[r]=__builtin_amdgcn_exp2f(P0[r]); }while(0)
  #define RESC() do{ if(resc){ asm volatile("s_waitcnt lgkmcnt(0)":::"memory"); \
      _Pragma("unroll") for(int d_=0;d_<2;++d_) _Pragma("unroll") for(int r=0;r<16;++r)o[d_][r]*=wsf[crow(r,hi)]; } }while(0)
  f32x16 pA0,pA1,pB0,pB1;
  int sl_prev=0,sl_cur=0,sl_next=SLOTB;
  #define ROT() do{sl_prev=sl_cur;sl_cur=sl_next;sl_next=(sl_next==(NSLOT-1)*SLOTB)?0:sl_next+SLOTB;}while(0)
  DMA_K(2,2*SLOTB);
  WAIT_BAR(3);
  qkt(pA0,pA1,Kbase,qr,negm,r32,hi);asm volatile("s_nop 15\n\ts_nop 7":"+v"(pA0),"+v"(pA1));
  START(pA0,pA1);
  _Pragma("unroll") for(int r=0;r<16;++r)pA1[r]=__builtin_amdgcn_exp2f(pA1[r]);
  WAIT_BAR(0);
  DMA_K(3,0);DMA_V(1,SLOTB);
  ROT();
  kload8(kf,kp0+sl_cur);
  WAIT_BAR(2);
  s16x4 vlo[8],vhi[8]; u32x4 pw0,pw1,pw2,pw3;
  #define PKW(P,B) cvtpk_s(P[B],P[B+1])
  #define PAF(k) __builtin_bit_cast(bf16x8,pw##k)
  #define VFR(i) (bf16x8){vlo[i][0],vlo[i][1],vlo[i][2],vlo[i][3],vhi[i][0],vhi[i][1],vhi[i][2],vhi[i][3]}
  #define PIN(x) asm volatile("":"+v"(x))
  #define MX3(a,b,c) __builtin_fmaxf(__builtin_fmaxf((a),(b)),(c))
  #define GAPA(MF,A0,A1,A2,A3,W0,W1,PW) do{ MF; sacc+=A0; sacc+=A1; sacc+=A2; sacc+=A3; PIN(sacc); W0; W1; PIN(PW); SBAR(); }while(0)
  #define EX(v) __builtin_amdgcn_exp2f(v)
  #define GAPB(MF,X,B) do{ MF; X[B]=EX(X[B]); X[B+1]=EX(X[B+1]); X[B+2]=EX(X[B+2]); X[B+3]=EX(X[B+3]); PIN(X); SBAR(); }while(0)
  #define VRD(i) do{ vlo[i]=vtr(vp_+(((i)>>2)*4096+((i)&3)*1024)); vhi[i]=vtr(vp_+(((i)>>2)*4096+((i)&3)*1024+512)); }while(0)
  #define KRD(G,j) do{ if(G){ kload2(kf,kp0+sl_next,j); SBAR(); } }while(0)
  #define STEP(C0,C1,P0,P1,t,GK,GV,GL) do{ SBAR(); \
    const lds_cptr vp_=vp0+sl_prev; \
    VRD(0); SBAR(); float sacc=(P0[0]+P0[1]); \
    GAPA(C0=__builtin_amdgcn_mfma_f32_32x32x16_bf16(kf[0],qr[0],negm,0,0,0), P0[2],P0[3],P0[4],P0[5],     pw0[0]=PKW(P0,0), pw0[1]=PKW(P0,2), pw0); \
    VRD(4); SBAR(); GAPA(C1=__builtin_amdgcn_mfma_f32_32x32x16_bf16(kf[1],qr[0],negm,0,0,0), P0[6],P0[7],P0[8],P0[9],     pw0[2]=PKW(P0,4), pw0[3]=PKW(P0,6), pw0); \
    VRD(1); SBAR(); GAPA(C0=__builtin_amdgcn_mfma_f32_32x32x16_bf16(kf[2],qr[1],C0,0,0,0),   P0[10],P0[11],P0[12],P0[13], pw1[0]=PKW(P0,8), pw1[1]=PKW(P0,10), pw1); \
    VRD(5); SBAR(); GAPA(C1=__builtin_amdgcn_mfma_f32_32x32x16_bf16(kf[3],qr[1],C1,0,0,0),   P0[14],P0[15],P1[0],P1[1],   pw1[2]=PKW(P0,12),pw1[3]=PKW(P0,14), pw1); \
    VRD(2); SBAR(); GAPA(C0=__builtin_amdgcn_mfma_f32_32x32x16_bf16(kf[4],qr[2],C0,0,0,0),   P1[2],P1[3],P1[4],P1[5],     pw2[0]=PKW(P1,0), pw2[1]=PKW(P1,2), pw2); \
    VRD(6); SBAR(); GAPA(C1=__builtin_amdgcn_mfma_f32_32x32x16_bf16(kf[5],qr[2],C1,0,0,0),   P1[6],P1[7],P1[8],P1[9],     pw2[2]=PKW(P1,4), pw2[3]=PKW(P1,6), pw2); \
    VRD(3); SBAR(); GAPA(C0=__builtin_amdgcn_mfma_f32_32x32x16_bf16(kf[6],qr[3],C0,0,0,0),   P1[10],P1[11],P1[12],P1[13], pw3[0]=PKW(P1,8), pw3[1]=PKW(P1,10), pw3); \
    VRD(7); SBAR(); GAPA(C1=__builtin_amdgcn_mfma_f32_32x32x16_bf16(kf[7],qr[3],C1,0,0,0),   P1[14],P1[15],0.f,0.f,       pw3[2]=PKW(P1,12),pw3[3]=PKW(P1,14), pw3); \
    l_reg+=sacc; \
    if(GK){DMA_K((t)+3,sl_cur);} if(GV){DMA_V((t)+1,sl_next);} \
    CMASK(C0,C1,t); \
    { float a=MX3(C0[0],C0[1],C1[0]),b=MX3(C0[2],C0[3],C1[1]); a=MX3(a,C1[2],C1[3]); \
      _Pragma("unroll") for(int r=4;r<16;r+=4){a=MX3(a,C0[r],C0[r+1]);b=MX3(b,C0[r+2],C0[r+3]);a=MX3(a,C1[r],C1[r+1]);b=MX3(b,C1[r+2],C1[r+3]);} \
      float rm=__builtin_fmaxf(a,b); { auto rr=__builtin_amdgcn_permlane32_swap(__float_as_uint(rm),__float_as_uint(rm),false,false); rm=__builtin_fmaxf(__uint_as_float(rr[0]),__uint_as_float(rr[1])); } \
      resc=false; \
      if(__builtin_expect(__any(rm>(float)THRL),0)){ const float dl=__builtin_fmaxf(rm,0.f); mhat+=dl; \
        _Pragma("unroll") for(int r=0;r<16;++r){C0[r]-=dl;C1[r]-=dl;} \
        _Pragma("unroll") for(int r=0;r<16;++r)negm[r]=-mhat; asm volatile("":"+v"(negm)); \
        const float f=__builtin_amdgcn_exp2f(-dl); l_reg*=f; if(hi==0)wsf[r32]=f; resc=true; } } \
    SBAR(); \
    GAPB(o[0]=__builtin_amdgcn_mfma_f32_32x32x16_bf16(PAF(0),VFR(0),o[0],0,0,0), C0,0); \
    GAPB(o[1]=__builtin_amdgcn_mfma_f32_32x32x16_bf16(PAF(0),VFR(4),o[1],0,0,0), C0,4); \
    KRD(GL,0); GAPB(o[0]=__builtin_amdgcn_mfma_f32_32x32x16_bf16(PAF(1),VFR(1),o[0],0,0,0), C0,8); \
    KRD(GL,1); GAPB(o[1]=__builtin_amdgcn_mfma_f32_32x32x16_bf16(PAF(1),VFR(5),o[1],0,0,0), C0,12); \
    KRD(GL,2); GAPB(o[0]=__builtin_amdgcn_mfma_f32_32x32x16_bf16(PAF(2),VFR(2),o[0],0,0,0), C1,0); \
    KRD(GL,3); GAPB(o[1]=__builtin_amdgcn_mfma_f32_32x32x16_bf16(PAF(2),VFR(6),o[1],0,0,0), C1,4); \
    GAPB(o[0]=__builtin_amdgcn_mfma_f32_32x32x16_bf16(PAF(3),VFR(3),o[0],0,0,0), C1,8); \
    GAPB(o[1]=__builtin_amdgcn_mfma_f32_32x32x16_bf16(PAF(3),VFR(7),o[1],0,0,0), C1,12); \
    }while(0)
  int t=1;
  for(;t+5<NT;t+=2){
    STEP(pB0,pB1,pA0,pA1,t,true,true,true);     WAIT_BAR(2); RESC(); ROT();
    STEP(pA0,pA1,pB0,pB1,t+1,true,true,true);   WAIT_BAR(2); RESC(); ROT();
  }
  #define ENDW(tt) do{ if((tt)+3<NT){WAIT_BAR(2);} else if((tt)+2<NT){WAIT_BAR(1);} else {WAIT_BAR(0);} }while(0)
  for(;t+1<NT;t+=2){
    STEP(pB0,pB1,pA0,pA1,t,(t+3<NT),(t+1<NT),(t+1<NT));       ENDW(t);   RESC(); ROT();
    STEP(pA0,pA1,pB0,pB1,t+1,(t+4<NT),(t+2<NT),(t+2<NT));     ENDW(t+1); RESC(); ROT();
  }
  STEP(pB0,pB1,pA0,pA1,NT-1,false,false,false); RESC();
  { float sacc=pB0[0]+pB0[1]; _Pragma("unroll") for(int r=2;r<16;++r)sacc+=pB0[r]; _Pragma("unroll") for(int r=0;r<16;++r)sacc+=pB1[r]; l_reg+=sacc;
    pw0=(u32x4){PKW(pB0,0),PKW(pB0,2),PKW(pB0,4),PKW(pB0,6)};pw1=(u32x4){PKW(pB0,8),PKW(pB0,10),PKW(pB0,12),PKW(pB0,14)};pw2=(u32x4){PKW(pB1,0),PKW(pB1,2),PKW(pB1,4),PKW(pB1,6)};pw3=(u32x4){PKW(pB1,8),PKW(pB1,10),PKW(pB1,12),PKW(pB1,14)};
    SBAR(); pv(o,vb0+sl_cur,PAF(0),PAF(1),PAF(2),PAF(3)); }
  #undef PKW
  #undef PAF
  #undef VFR
  #undef PIN
  #undef MX3
  #undef GAPA
  #undef GAPB
  #undef EX
  #undef VRD
  #undef KRD
  #undef STEP
  #undef ENDW
  {auto rr=__builtin_amdgcn_permlane32_swap(__float_as_uint(l_reg),__float_as_uint(l_reg),false,false);l_reg=__uint_as_float(rr[0])+__uint_as_float(rr[1]);}
  if(hi==0)wsf[32+r32]=l_reg;asm volatile("s_waitcnt lgkmcnt(0)":::"memory");
  float rli[16];
  #pragma unroll
  for(int r=0;r<16;++r)rli[r]=__builtin_amdgcn_rcpf(wsf[32+crow(r,hi)]);
  bf16*Ow=O0+(long)(wid*QBLK)*POUT;
  { bf16*stg=(bf16*)(shm+LDS_OST)+wid*2048;
    #pragma unroll
    for(int r=0;r<16;++r){const int orow=crow(r,hi);
      #pragma unroll
      for(int d0=0;d0<2;++d0)stg[orow*64+d0*32+r32]=(bf16)f2bf(o[d0][r]*rli[r]);}
    asm volatile("s_waitcnt lgkmcnt(0)":::"memory");
    #pragma unroll
    for(int i=0;i<4;++i){const int row=i*8+(lane>>3),ch=lane&7; const u32x4 v=*(const u32x4*)(stg+row*64+ch*8); ATTN_STORE16(Ow+(long)row*POUT+ch*8,v);} }
  asm volatile("s_waitcnt lgkmcnt(0)\n\ts_barrier":::"memory");
  #undef DMA_K
  #undef DMA_V
  #undef TROW
  #undef CMASK
  #undef START
  #undef RESC
  #undef ROT
}
constexpr int ATTN_LDS_BYTES=LDS_BYTES;
#undef SBAR
#undef WAIT_BAR
}

namespace pg8 {
struct EpiInProj {
    static constexpr bool PERM = true, AFTER_DRAIN = false;
    bf16_t* P; const float* na_qn; const float* na_kn; const float* gq_qn; const float* gq_kn; int wv;
    __device__ __forceinline__ void operator()(const f32x4 (&acc)[2][2][4][2], const Unit& u, int, int, int, int) const {
        const int l_ = otid(wv) & 63, fr = l_ & 15, fq = l_ >> 4, wr = wv >> 2, wc = wv & 3;
        const int pn = u.pn, rowt = u.pm * BM;
        int mode = 0; const float* gain = na_qn; float qs = 1.f;
        if (pn == 0) { mode = 1; gain = na_qn; qs = att::C2; }
        else if (pn == 1) { mode = 1; gain = na_kn; }
        else if (pn == 3 || pn == 4) { mode = 2; gain = gq_qn; qs = att::C2; }
        else if (pn == 5 && wc < 2) { mode = 2; gain = gq_kn; }
        if (mode == 2 && rowt >= NLAT) mode = 1;
        bf16_t* pcol = P + pn * BM + 64 * wc + 8 * fq;
        if (mode == 0) {
#pragma unroll
            for (int ai = 0; ai < 2; ++ai)
#pragma unroll
                for (int m = 0; m < 4; ++m) { bf16_t* rowp = pcol + (size_t)(rowt + ai * HALF + wr * 64 + m * 16 + fr) * DIN;
#pragma unroll
                    for (int bj = 0; bj < 2; ++bj) { const f32x4 v0 = acc[ai][bj][m][0], v1 = acc[ai][bj][m][1];
                        u32x4 w; w.x = cvt_pk_bf16(v0[0], v0[1]); w.y = cvt_pk_bf16(v0[2], v0[3]); w.z = cvt_pk_bf16(v1[0], v1[1]); w.w = cvt_pk_bf16(v1[2], v1[3]);
                        *(u32x4*)(rowp + 32 * bj) = w; } }
            return;
        }
        f32x4 g[2][2]; float invf[2][2];
#pragma unroll
        for (int bj = 0; bj < 2; ++bj)
#pragma unroll
            for (int n = 0; n < 2; ++n) g[bj][n] = *(const f32x4*)(gain + 32 * bj + 8 * fq + 4 * n) * qs;
#pragma unroll
        for (int n = 0; n < 2; ++n)
#pragma unroll
            for (int pp = 0; pp < 2; ++pp) invf[n][pp] = exp2f(-(float)(4 * fq + 2 * n + pp) * (13.287712379549449f / 16.f));
#pragma unroll
        for (int ai = 0; ai < 2; ++ai)
#pragma unroll
            for (int m = 0; m < 4; ++m) {
                const int row = rowt + ai * HALF + wr * 64 + m * 16 + fr;
                f32x4 v[2][2]; float ss = 0.f;
#pragma unroll
                for (int bj = 0; bj < 2; ++bj)
#pragma unroll
                    for (int n = 0; n < 2; ++n) { v[bj][n] = acc[ai][bj][m][n]; ss += (v[bj][n][0] * v[bj][n][0] + v[bj][n][1] * v[bj][n][1]) + (v[bj][n][2] * v[bj][n][2] + v[bj][n][3] * v[bj][n][3]); }
                ss += shx(ss, 16, l_); ss += shx(ss, 32, l_);
                const float rstd = rsqrtf(ss * (1.f / 64.f) + 1e-6f);
#pragma unroll
                for (int bj = 0; bj < 2; ++bj)
#pragma unroll
                    for (int n = 0; n < 2; ++n) {
                        if (mode == 2) {
                        }
                        v[bj][n] = v[bj][n] * rstd * g[bj][n];
                    }
                if (mode == 2) {
                    const int t = row & (SEQ - 1); const float pos[2] = {(float)(t >> 6), (float)(t & 63)};
#pragma unroll
                    for (int bj = 0; bj < 2; ++bj)
#pragma unroll
                        for (int n = 0; n < 2; ++n)
#pragma unroll
                            for (int pp = 0; pp < 2; ++pp) {
                                const float ang = pos[bj] * invf[n][pp], cs = __cosf(ang), sn = __sinf(ang);
                                const float x1 = v[bj][n][2 * pp], x2 = v[bj][n][2 * pp + 1];
                                v[bj][n][2 * pp] = x1 * cs - x2 * sn; v[bj][n][2 * pp + 1] = x1 * sn + x2 * cs;
                            }
                }
                bf16_t* rowp = pcol + (size_t)row * DIN;
#pragma unroll
                for (int bj = 0; bj < 2; ++bj) { const f32x4 v0 = v[bj][0], v1 = v[bj][1];
                    u32x4 w; w.x = cvt_pk_bf16(v0[0], v0[1]); w.y = cvt_pk_bf16(v0[2], v0[3]); w.z = cvt_pk_bf16(v1[0], v1[1]); w.w = cvt_pk_bf16(v1[2], v1[3]);
                    *(u32x4*)(rowp + 32 * bj) = w; }
                asm volatile("" ::: "memory");
            }
    }
};
}

__device__ __forceinline__ void w_qknorm_rope(const Ptrs& p, int layer, int unit, int d) {
    const int row = unit / 18, slot = unit % 18;
    int col; const float* gain; bool rope;
    if (slot < 4) { col = A_Q + slot * 64; gain = p.in[I_NAQN] + layer * 64; rope = false; }
    else if (slot < 8) { col = A_K + (slot - 4) * 64; gain = p.in[I_NAKN] + layer * 64; rope = false; }
    else if (slot < 16) { col = B_Q + (slot - 8) * 64; gain = p.in[I_GQQN] + layer * 64; rope = true; }
    else { col = B_K + (slot - 16) * 64; gain = p.in[I_GQKN] + layer * 64; rope = true; }
    bf16* pp = (bf16*)(p.ws + WS_P) + (size_t)row * DIN + col;
    float x = bf2f(pp[d]);
    float ss = wave_sum(x * x, d);
    float y = x * rsqrtf(ss * (1.f / 64.f) + 1e-6f) * gain[d];
    if (rope && row < NLAT) {
        int t = row & (SEQ - 1);
        float partner = shx(y, 1, d);
        int pi = d >> 1;
        float pos = (pi < 16) ? (float)(t >> 6) : (float)(t & 63);
        float inv = exp2f(-(float)(pi & 15) * (13.287712379549449f / 16.f));
        float ang = pos * inv;
        float cs = __cosf(ang), sn = __sinf(ang);
        y = (d & 1) ? (partner * sn + y * cs) : (y * cs - partner * sn);
    }
    if (slot < 4 || (slot >= 8 && slot < 16)) y *= att::C2;
    pp[d] = (bf16)f2bf(y);
}
struct NoHook { __device__ __forceinline__ void operator()(att::f32x16&, att::f32x16&, int, int, int, int) const {} };
struct NaHook {
    const LAS float* tab; int r0, kr0;
    __device__ __forceinline__ void operator()(att::f32x16& p0, att::f32x16& p1, int t, int wid, int r32, int hi) const {
        if (t < 4) return;
        const int r = r0 + (wid >> 1), kr = kr0 + t - 4, rs = min(max(r - 4, 0), 24);
        const float NEG = -INFINITY;
        if ((unsigned)(kr - rs) >= 8u) {
#pragma unroll
            for (int i = 0; i < 16; ++i) { p0[i] = NEG; p1[i] = NEG; }
            return;
        }
        const int qc = 32 * (wid & 1) + r32, cs = min(max(qc - 8, 0), 48), kb = 4 * hi - cs;
        const LAS float* tp = tab + (kr - r + 7) * 31 + (4 * hi - qc + 15);
#pragma unroll
        for (int i = 0; i < 16; ++i) {
            const int c = (i & 3) + 8 * (i >> 2);
            const float b0 = tp[c], b1 = tp[c + 32];
            p0[i] = ((unsigned)(kb + c) < 16u) ? p0[i] + b0 : NEG;
            p1[i] = ((unsigned)(kb + c + 32) < 16u) ? p1[i] + b1 : NEG;
        }
    }
};
constexpr int LDS_NATAB = 88064;
__device__ __forceinline__ void phase_attn(const Ptrs& p, unsigned char* lds_gen, int layer, int wv) {
    const bf16* P = (const bf16*)(p.ws + WS_P); bf16* MIX = (bf16*)(p.ws + WS_MIX);
    char* shm = (char*)lds_gen;
    const int c = blockIdx.x, x = c & 7, ci = (c >> 3) & 31;
    for (int i = 0; i < 2; ++i) {
        const int grp = 2 * x + i, b = grp >> 1, kvh = grp & 1, g = ci >> 3, qb = ci & 7, hq = kvh * 4 + g;
        const size_t qrow = (size_t)b * SEQ + qb * 256;
        att::attn_unit<8, NoHook>(P + qrow * DIN + B_Q + hq * 64, P + B_K + kvh * 64, P + B_V + kvh * 64, b * SEQ, 32, NLAT + b * CTXL, 36,
                                  MIX + qrow * DM + 256 + hq * 64, NoHook{}, shm, wv);
    }
    {
        const int grp = 4 * x + (ci >> 3), b = grp >> 2, h = grp & 3, r0 = 4 * (ci & 7);
        const int kr0 = (r0 == 0) ? 0 : (r0 == 28 ? 24 : r0 - 4), nr = (r0 == 0 || r0 == 28) ? 8 : 12;
        LAS float* tab = (LAS float*)((LAS unsigned char*)lds_gen + LDS_NATAB);
        const float* rpb = p.in[I_RPB] + ((size_t)layer * 4 + h) * 15 * 31;
        for (int i = otid(wv); i < 15 * 31; i += NT) tab[i] = rpb[i] * 1.4426950408889634f;
        __syncthreads();
        const size_t qrow = (size_t)b * SEQ + r0 * 64;
        NaHook hook{tab, r0, kr0};
        att::attn_unit<8, NaHook>(P + qrow * DIN + A_Q + h * 64, P + A_K + h * 64, P + A_V + h * 64, NLAT + b * CTXL, 4, b * SEQ + kr0 * 64, 4 + nr,
                                  MIX + qrow * DM + h * 64, hook, shm, wv);
    }
    if (layer == 0 && c < 96) {
        if (c < 32) {
            const int b = c >> 2, h = c & 3; const size_t qrow = (size_t)NLAT + b * CTXL;
            att::attn_unit<8, NoHook>(P + qrow * DIN + A_Q + h * 64, P + A_K + h * 64, P + A_V + h * 64, NLAT + b * CTXL, 4, 0, 4, MIX + qrow * DM + h * 64, NoHook{}, shm, wv);
        } else {
            const int cc = c - 32, b = cc >> 3, hq = cc & 7, kvh = hq >> 2; const size_t qrow = (size_t)NLAT + b * CTXL;
            att::attn_unit<8, NoHook>(P + qrow * DIN + B_Q + hq * 64, P + B_K + kvh * 64, P + B_V + kvh * 64, NLAT + b * CTXL, 4, 0, 4, MIX + qrow * DM + 256 + hq * 64, NoHook{}, shm, wv);
        }
    }
}


#define XB_TMO      128
#define XB_XCNT(j)  (256  + 64 * (j))
#define XB_XSUB(j)  (1280 + 64 * (j))
#define XB_XGEN(j)  (2304 + 64 * (j))
#define XB_TOP      3328
#define XB_TOPGEN   3392
#define XCD_BAR_WORDS 3456
#define XB_SPIN_CAP (1u << 18)
constexpr int CW_BAR = 4096;
constexpr int LDS_XB = LDS_BYTES - 64;
__device__ __forceinline__ unsigned xb_ld(unsigned* p)              { return __hip_atomic_load(p, __ATOMIC_RELAXED, __HIP_MEMORY_SCOPE_AGENT); }
__device__ __forceinline__ unsigned xb_add(unsigned* p, unsigned v) { return __hip_atomic_fetch_add(p, v, __ATOMIC_RELAXED, __HIP_MEMORY_SCOPE_AGENT); }
__device__ __forceinline__ unsigned xb_xcc_id() { return (unsigned)__builtin_amdgcn_s_getreg((3 << 11) | 20) & 0xFu; }
#define XB_SPIN(cond, bar) do { unsigned _sp = 0; while (cond) { __builtin_amdgcn_s_sleep(1); \
    if ((++_sp & 255u) == 0u) { if (xb_ld(&(bar)[XB_TMO])) break; if (_sp > XB_SPIN_CAP) { atomicAdd(&(bar)[XB_TMO], 1u); break; } } } } while (0)
struct XcdBarrier { unsigned* bar; unsigned x; volatile LAS unsigned* st; };
__device__ __forceinline__ XcdBarrier xcd_barrier_post(unsigned* bar, volatile LAS unsigned* st, int wv) {
    XcdBarrier b; b.bar = bar; b.x = xb_xcc_id(); b.st = st;
    if (otid(wv) == 0) (void)xb_add(&bar[XB_XCNT(b.x)], 1u);
    return b;
}
__device__ __forceinline__ void xcd_barrier_complete(unsigned* bar, unsigned x, unsigned& nloc, unsigned& nx) {
    const unsigned G = gridDim.x * gridDim.y * gridDim.z;
    unsigned sum, cnt, mine, sp = 0u;
    for (;;) {
        sum = 0u; cnt = 0u; mine = 0u;
#pragma unroll
        for (unsigned j = 0; j < 16; ++j) { const unsigned c = xb_ld(&bar[XB_XCNT(j)]); sum += c; cnt += (c > 0u) ? 1u : 0u; mine = (j == x) ? c : mine; }
        if (sum == G) break;
        __builtin_amdgcn_s_sleep(1);
        if ((++sp & 255u) == 0u) { if (xb_ld(&bar[XB_TMO])) break; if (sp > XB_SPIN_CAP) { atomicAdd(&bar[XB_TMO], 1u); break; } }
    }
    nloc = mine > 0u ? mine : 1u; nx = cnt > 0u ? cnt : 1u;
}
__device__ __forceinline__ void xcd_barrier(const XcdBarrier& b, int wv) {
    asm volatile("s_waitcnt vmcnt(0)" ::: "memory");
    __syncthreads();
    if (otid(wv) == 0) {
        unsigned* bar = b.bar; unsigned bx = b.x; asm volatile("" : "+s"(bx));
        __builtin_amdgcn_s_waitcnt(0);
        unsigned nloc = b.st[0], nx = b.st[1];
        if (nloc == 0u) { xcd_barrier_complete(bar, bx, nloc, nx); b.st[0] = nloc; b.st[1] = nx; }
        const unsigned old = xb_add(&bar[XB_XSUB(bx)], 1u);
        const unsigned gen = old / nloc;
        if (old + 1u == (gen + 1u) * nloc) {
            __builtin_amdgcn_fence(__ATOMIC_RELEASE, "agent");
            asm volatile("s_waitcnt vmcnt(0)" ::: "memory");
            const unsigned og = xb_add(&bar[XB_TOP], 1u);
            const unsigned tg = og / nx;
            if (og + 1u == (tg + 1u) * nx) xb_add(&bar[XB_TOPGEN], 1u);
            else XB_SPIN(xb_ld(&bar[XB_TOPGEN]) == tg, bar);
            __builtin_amdgcn_fence(__ATOMIC_ACQUIRE, "agent");
            xb_add(&bar[XB_XGEN(bx)], 1u);
            asm volatile("s_waitcnt vmcnt(0)" ::: "memory");
        } else {
            XB_SPIN(xb_ld(&bar[XB_XGEN(bx)]) == gen, bar);
            __builtin_amdgcn_fence(__ATOMIC_ACQUIRE, "agent");
            asm volatile("s_waitcnt vmcnt(0)" ::: "memory");
        }
    }
    __syncthreads();
}

__global__ void __launch_bounds__(NT, 2) k_mega(Ptrs p) {
    extern __shared__ __attribute__((aligned(16))) unsigned char lds_raw[];
    LAS unsigned char* lds = (LAS unsigned char*)lds_raw;
    cg::grid_group grid = cg::this_grid();
    const int wv = __builtin_amdgcn_readfirstlane(threadIdx.x >> 6);
#define CG_SYNC() do { asm volatile("s_waitcnt vmcnt(0)" ::: "memory"); grid.sync(); __builtin_amdgcn_fence(__ATOMIC_ACQUIRE, "agent"); asm volatile("s_waitcnt vmcnt(0)" ::: "memory"); } while (0)
#define GRID_SYNC() xcd_barrier(xbar, wv)
    if (otid(wv) < 16) ((LAS unsigned*)(lds + LDS_XB))[otid(wv)] = 0u;
    __syncthreads();
    const XcdBarrier xbar = xcd_barrier_post((unsigned*)(p.ws + WS_CTL) + CW_BAR, (volatile LAS unsigned*)(lds + LDS_XB), wv);
    const int NGW = gridDim.x * NWAVES;
    phase_mod(p, lds, wv);
    phase_lb(p, wv);
    __syncthreads();
    phase_convert(p, lds, 0, 2, wv);
    phase_router_w(p, wv);
    CG_SYNC();
    phase_norm(p.in[I_X], p.in[I_CTX], p.in[I_N1G], (const float*)(p.ws + WS_MOD), 0, 1, (bf16*)(p.ws + WS_H), MROWS, wv);
    GRID_SYNC();
    for (int layer = 0; layer < 2; ++layer) {
        const int M = (layer == 0) ? MROWS : NLAT;
        const float* modl = (const float*)(p.ws + WS_MOD) + (size_t)layer * 9 * MODW;
        {
            pg8::Gemm g{(const bf16*)(p.ws + WS_H), (const bf16*)(p.ws + WS_WIN + layer * WIN_STRIDE), MROWS, DIN, DM};
            pg8::StaticOrder S; S.init(MROWS, DIN, gridDim.x, (int)blockIdx.x);
            pg8::EpiInProj E{(bf16*)(p.ws + WS_P), p.in[I_NAQN] + layer * 64, p.in[I_NAKN] + layer * 64, p.in[I_GQQN] + layer * 64, p.in[I_GQKN] + layer * 64, wv};
            pg8::gemm_phase<pg8::EpiInProj, pg8::StaticOrder, true, true>(lds, g, S, E, wv);
        }
        GRID_SYNC();
        phase_hgrn1(p, lds, layer, wv);
        GRID_SYNC();
        phase_hgrn2(p, lds, layer, wv);
        __syncthreads();
        phase_attn(p, lds_raw, layer, wv);
        GRID_SYNC();
        {
            pg8::Gemm g{(const bf16*)(p.ws + WS_MIX), (const bf16*)(p.ws + WS_WOUT + layer * WOUT_STRIDE), M, DM, DM};
            pg8::StaticOrder S; S.init(M, DM, gridDim.x, (int)blockIdx.x);
            pg8::EpiResidSS E{layer == 0 ? p.in[I_X] : p.out, p.in[I_CTX], p.out, (float*)(p.ws + WS_XC), modl, 2, (float*)(p.ws + WS_RSS), wv};
            pg8::gemm_phase<pg8::EpiResidSS, pg8::StaticOrder, true, true>(lds, g, S, E, wv);
        }
        GRID_SYNC();
        phase_route(p, lds, layer, M, wv);
        GRID_SYNC();
        phase_moe_gu(p, lds, layer, wv);
        GRID_SYNC();
        phase_moe_down(p, lds, layer, wv);
        GRID_SYNC();
        phase_combine(p, layer, M, layer == 0, wv);
        if (layer == 0) GRID_SYNC();
    }
}

extern "C" void kernel_launch(void* const* d_in, const int* in_sizes, int n_in, void* d_out, int out_size, void* d_ws, size_t ws_size, hipStream_t stream) {
    static int grid = 0;
    if (grid == 0) {
        if (n_in != 24 || ws_size < WS_END) { fprintf(stderr, "kernel_launch: bad n_in %d or ws_size %zu < %zu\n", n_in, ws_size, (size_t)WS_END); grid = -1; return; }
        int dev = 0, cus = 0, per_cu = 0;
        hipGetDevice(&dev); hipDeviceGetAttribute(&cus, hipDeviceAttributeMultiprocessorCount, dev);
        hipFuncSetAttribute((const void*)k_mega, hipFuncAttributeMaxDynamicSharedMemorySize, LDS_BYTES);
        hipOccupancyMaxActiveBlocksPerMultiprocessor(&per_cu, (const void*)k_mega, NT, LDS_BYTES);
        if (per_cu < 1) { fprintf(stderr, "kernel_launch: occupancy query says %d blocks/CU\n", per_cu); grid = -1; return; }
        grid = cus;
        (void)hipGetLastError();
    }
    if (grid < 0) return;
    Ptrs p{};
    for (int i = 0; i < 24; ++i) p.in[i] = (const float*)d_in[i];
    p.out = (float*)d_out; p.ws = (unsigned char*)d_ws; p.layer = 0; p.pad = 0;
    hipMemsetAsync((unsigned char*)d_ws + WS_CTL, 0, 1 * MiB, stream);
    void* args[] = {&p};
    hipError_t e = hipLaunchCooperativeKernel((const void*)k_mega, dim3(grid), dim3(NT), args, LDS_BYTES, stream);
    if (e != hipSuccess) fprintf(stderr, "cooperative launch failed: %s\n", hipGetErrorString(e));
}
```

```cpp
#include <hip/hip_runtime.h>
#include <hip/hip_cooperative_groups.h>
#include <cstdio>
#include <cstdint>
#include <math.h>
namespace cg = cooperative_groups;

#define DM 1024
#define SEQ 2048
#define CTXL 256
#define NBATCH 8
#define NLAT (NBATCH * SEQ)
#define NCTX (NBATCH * CTXL)
#define MROWS (NLAT + NCTX)
#define DIN 2816
#define NMOD 6
#define MODW (NMOD * DM)
#define A_Q 0
#define A_K 256
#define A_V 512
#define B_Q 768
#define B_K 1280
#define B_V 1408
#define C_Q 1536
#define C_I 1792
#define C_FF 2048
#define C_FB 2304
#define C_G 2560

typedef unsigned short bf16;
#define LAS __attribute__((address_space(3)))
#define GAS __attribute__((address_space(1)))
typedef unsigned v4u __attribute__((ext_vector_type(4)));
typedef unsigned v2u __attribute__((ext_vector_type(2)));
typedef float v4f __attribute__((ext_vector_type(4)));

__device__ __forceinline__ unsigned f2bf(float f) { unsigned u = __builtin_bit_cast(unsigned, f); return (u + 0x7fffu + ((u >> 16) & 1u)) >> 16; }
__device__ __forceinline__ unsigned pk2(float lo, float hi) { return f2bf(lo) | (f2bf(hi) << 16); }
__device__ __forceinline__ float bf2f(unsigned short v) { return __builtin_bit_cast(float, (unsigned)v << 16); }
__device__ __forceinline__ float bflo(unsigned v) { return __builtin_bit_cast(float, v << 16); }
__device__ __forceinline__ float bfhi(unsigned v) { return __builtin_bit_cast(float, v & 0xffff0000u); }
__device__ __forceinline__ float silu_f(float x) { return x / (1.f + __expf(-x)); }
__device__ __forceinline__ float shx(float v, int mask, int lane) { return __builtin_bit_cast(float, __builtin_amdgcn_ds_bpermute((lane ^ mask) << 2, __builtin_bit_cast(int, v))); }
__device__ __forceinline__ float wave_sum(float v, int lane) {
#pragma unroll
    for (int o = 1; o < 64; o <<= 1) v += shx(v, o, lane);
    return v;
}
__device__ __forceinline__ int otid(int wv) { unsigned m = ~0u; asm volatile("" : "+s"(m)); asm volatile("" : "+s"(wv)); return wv * 64 + (int)__builtin_amdgcn_mbcnt_hi(m, __builtin_amdgcn_mbcnt_lo(m, 0u)); }
#define LDS_WAIT() asm volatile("s_waitcnt lgkmcnt(0)" ::: "memory")

constexpr size_t MiB = 1u << 20;
constexpr size_t WS_CTL = 0;
constexpr size_t WS_MOD = 1 * MiB;
constexpr size_t WS_LB = 1 * MiB + 512 * 1024;
constexpr size_t WS_EID = 2 * MiB;
constexpr size_t WS_EW = 2 * MiB + 256 * 1024;
constexpr size_t WS_IDX = 3 * MiB;
constexpr size_t WS_XC = 8 * MiB;
constexpr size_t WS_WIN = 16 * MiB;
constexpr size_t WIN_STRIDE = (size_t)DIN * DM * 2;
constexpr size_t WS_WOUT = 28 * MiB;
constexpr size_t WOUT_STRIDE = 2 * MiB;
constexpr size_t WS_WGU = 32 * MiB;
constexpr size_t WGU_STRIDE = 32 * MiB;
constexpr size_t WS_WD = 96 * MiB;
constexpr size_t WD_STRIDE = 16 * MiB;
constexpr size_t WS_H = 128 * MiB;
constexpr size_t WS_MIX = 164 * MiB;
constexpr size_t WS_P = 200 * MiB;
constexpr size_t WS_Y0 = 200 * MiB;
constexpr size_t WS_Y1 = 236 * MiB;
constexpr size_t WS_HID = 272 * MiB;
constexpr size_t WS_SCR = 300 * MiB;
constexpr size_t WS_END = 340 * MiB;

constexpr int NT = 512, NWAVES = 8;
constexpr int LDS_BYTES = 147456;
namespace pg8 {
#define PG8_LAS __attribute__((address_space(3)))
typedef unsigned short bf16_t;
typedef short bf16x8 __attribute__((ext_vector_type(8)));
typedef float f32x4 __attribute__((ext_vector_type(4)));
typedef unsigned u32x4 __attribute__((ext_vector_type(4)));
constexpr int BM = 256, BK = 64, HALF = 128, HTB = HALF * BK * 2  , STAGE_BYTES = 8 * HTB, NXCD = 8, WGM = 8;

__host__ __device__ __forceinline__ int lds_byte(int r, int c) { const int st = (r >> 4) * 2 + (c >> 5), rr = r & 15, cc = c & 31, ob = rr * 64 + cc * 2; return st * 1024 + (ob ^ (((ob >> 9) & 1) << 5)); }
__host__ __device__ __forceinline__ void stage_rc(int b, int& R, int& C) { const int st = b / 1024, sb = b % 1024, swz = sb ^ (((sb >> 9) & 1) << 5); R = (st >> 1) * 16 + swz / 64; C = (st & 1) * 32 + (swz % 64) / 2; }
__host__ __device__ __forceinline__ int perm32(int rho) { const int n = rho >> 4, i = rho & 15; return 8 * (i >> 2) + 4 * n + (i & 3); }

struct Unit { int pm, pn, aux; };
struct Gemm { const bf16_t* A; const bf16_t* Bt; int M, N, K; };

struct StaticOrder {
    int nM, nN, nwg, G, c;
    __host__ __device__ void init(int M, int N, int G_, int c_) { nM = M / BM; nN = N / BM; nwg = nM * nN; G = G_; c = c_; }
    __host__ __device__ bool next(int i, Unit& u) const {
        const long L = (long)i * G + c; if (L >= nwg) return false;
        int wgid = (int)L; { const int q = nwg / NXCD, r = nwg % NXCD, xcd = wgid % NXCD, off = wgid / NXCD; wgid = (xcd < r ? xcd * (q + 1) : r * (q + 1) + (xcd - r) * q) + off; }
        const int nig = WGM * nN, gid = wgid / nig, fm = gid * WGM, gsz = (nM - fm) < WGM ? (nM - fm) : WGM;
        u.pm = fm + ((wgid % nig) % gsz); u.pn = (wgid % nig) / gsz; return true;
    }
    __device__ __forceinline__ void a_ready(const Unit&) const {}
    __device__ __forceinline__ void done(const Unit&) const {}
};

__device__ __forceinline__ unsigned cvt_pk_bf16(float lo, float hi) { unsigned r; asm volatile("v_cvt_pk_bf16_f32 %0, %1, %2" : "=v"(r) : "v"(lo), "v"(hi)); return r; }
typedef float f32x2 __attribute__((ext_vector_type(2)));
__device__ __forceinline__ f32x2 gelu_pk(f32x2 v) {
    const f32x2 av = __builtin_elementwise_abs(v), d = av * 0.2316418882f + 1.0f;
    f32x2 t; t.x = __builtin_amdgcn_rcpf(d.x); t.y = __builtin_amdgcn_rcpf(d.y);
    f32x2 q = t * 0.5307027145f + (-0.7265760135f); q = q * t + 0.7107068705f; q = q * t + (-0.142248368f); q = q * t + 0.127414796f; q = q * t;
    const f32x2 s = (v * v) * (-0.72134752044f);
    f32x2 e; e.x = __builtin_amdgcn_exp2f(s.x); e.y = __builtin_amdgcn_exp2f(s.y);
    const f32x2 m = v * (q * e), r = v - m;
    f32x2 o; o.x = v.x < 0.f ? m.x : r.x; o.y = v.y < 0.f ? m.y : r.y; return o;
}

template <int ACT  > struct EpiBf16 {
    static constexpr bool PERM = true, AFTER_DRAIN = false; static_assert(ACT == 0 || ACT == 1, "EpiBf16: ACT is 0 (none) or 1 (gelu_pk)");
    bf16_t* O; int ldc; const float* bias; int split_cols; size_t split_stride; float scale0;
    __device__ __forceinline__ void operator()(const f32x4 (&acc)[2][2][4][2], const Unit& u, int wr, int wc, int fr, int fq) const {
        const int row0 = u.pm * BM + wr * 64 + fr; int colt = u.pn * BM; bf16_t* base = O;
        float sc = 1.f; if (split_cols) { const int t = colt / split_cols; base += (size_t)t * split_stride; colt -= t * split_cols; if (t == 0) sc = scale0; }
        const int col0 = colt + wc * 32 + 8 * fq, bcol0 = u.pn * BM + wc * 32 + 8 * fq;
        f32x4 bv[2][2];
#pragma unroll
        for (int bj = 0; bj < 2; ++bj)
#pragma unroll
            for (int n = 0; n < 2; ++n) bv[bj][n] = bias ? *(const f32x4*)(bias + bcol0 + bj * HALF + 4 * n) : (f32x4){0.f, 0.f, 0.f, 0.f};
#pragma unroll
        for (int ai = 0; ai < 2; ++ai)
#pragma unroll
            for (int m = 0; m < 4; ++m) { bf16_t* rowp = base + (size_t)(row0 + ai * HALF + m * 16) * ldc + col0;
#pragma unroll
                for (int bj = 0; bj < 2; ++bj) { f32x4 v0 = acc[ai][bj][m][0] + bv[bj][0], v1 = acc[ai][bj][m][1] + bv[bj][1];
                    if (ACT == 1) { f32x2 a = gelu_pk((f32x2){v0[0], v0[1]}), b = gelu_pk((f32x2){v0[2], v0[3]}), c = gelu_pk((f32x2){v1[0], v1[1]}), d = gelu_pk((f32x2){v1[2], v1[3]});
                        v0 = (f32x4){a.x, a.y, b.x, b.y}; v1 = (f32x4){c.x, c.y, d.x, d.y}; }
                    v0 = v0 * sc; v1 = v1 * sc; u32x4 w; w.x = cvt_pk_bf16(v0[0], v0[1]); w.y = cvt_pk_bf16(v0[2], v0[3]); w.z = cvt_pk_bf16(v1[0], v1[1]); w.w = cvt_pk_bf16(v1[2], v1[3]);
                    *(u32x4*)(rowp + bj * HALF) = w; } }
    }
};

template <class Epi, class Sched, bool ALIGN_EPI = false, bool SP2 = false, bool GATHER = false>
__device__ __forceinline__ void gemm_phase(PG8_LAS unsigned char* lds, const Gemm g, const Sched& S, const Epi& E, int wv, const PG8_LAS int* gidx = nullptr) {
    static_assert(SP2 || !GATHER, "GATHER is wired into the SP2 loop only");
    int tid_ = otid(wv);
    const int tid = tid_, wid = __builtin_amdgcn_readfirstlane(tid >> 6), lane = tid & 63, wr = wid >> 2, wc = wid & 3, fr = lane & 15, fq = lane >> 4;
    const int K = g.K, nt = K / BK;
    unsigned voffA[2][2], nvoffA[2][2], voffB[2]; int RA[2], CA[2];
#pragma unroll
    for (int i = 0; i < 2; ++i) { int R, C; stage_rc(tid * 16 + i * 8192, R, C); const int Rb = Epi::PERM ? ((R & ~31) + perm32(R & 31)) : R; RA[i] = R; CA[i] = C;
        voffA[0][i] = voffA[1][i] = nvoffA[0][i] = nvoffA[1][i] = (unsigned)(R * K + C) * 2u; voffB[i] = (unsigned)(Rb * K + C) * 2u; }
#define PG8_GVOFF(dst, uidx) do { if constexpr (GATHER) { _Pragma("unroll") for (int _h = 0; _h < 2; ++_h) _Pragma("unroll") for (int _i = 0; _i < 2; ++_i) dst[_h][_i] = (unsigned)(gidx[(uidx) * 256 + _h * 128 + RA[_i]] * K + CA[_i]) * 2u; } } while (0)
    const size_t kstep = (size_t)(BK * 2);
    const size_t hstep = (size_t)HALF * K * 2;
    const size_t hstepA = GATHER ? (size_t)0 : hstep;
    const size_t tstep = 2 * hstep;
    const unsigned ldsw = (unsigned)wid * 1024u;
    const int aoff = lds_byte(wr * 64 + fr, fq * 8), boff = lds_byte(wc * 32 + fr, fq * 8);
#define PG8_SA(b, h) (((b) * 2 + (h)) * HTB)
#define PG8_SB(b, h) ((4 + (b) * 2 + (h)) * HTB)
#define PG8_STAGE(bufoff, gbase, voff) do { _Pragma("unroll") for (int _i = 0; _i < 2; ++_i) \
        __builtin_amdgcn_global_load_lds((const unsigned*)((const char*)(gbase) + (voff)[_i]), (PG8_LAS unsigned*)(lds + (bufoff) + ldsw + _i * 8192), 16, 0, 0); } while (0)
#define PG8_LDA(dst, b, h) do { _Pragma("unroll") for (int m = 0; m < 4; ++m) _Pragma("unroll") for (int k = 0; k < 2; ++k) dst[m][k] = *(const PG8_LAS bf16x8*)(lds + PG8_SA(b, h) + aoff + m * 2048 + k * 1024); } while (0)
#define PG8_LDB(dst, b, h) do { _Pragma("unroll") for (int n = 0; n < 2; ++n) _Pragma("unroll") for (int k = 0; k < 2; ++k) dst[n][k] = *(const PG8_LAS bf16x8*)(lds + PG8_SB(b, h) + boff + n * 2048 + k * 1024); } while (0)
#define PG8_MMA(ai, bj, At, Bt) do { __builtin_amdgcn_s_setprio(1); _Pragma("unroll") for (int m = 0; m < 4; ++m) _Pragma("unroll") for (int n = 0; n < 2; ++n) _Pragma("unroll") for (int k = 0; k < 2; ++k) \
        acc[ai][bj][m][n] = __builtin_amdgcn_mfma_f32_16x16x32_bf16(Bt[n][k], At[m][k], acc[ai][bj][m][n], 0, 0, 0); __builtin_amdgcn_s_setprio(0); } while (0)
#define PG8_WAIT_V(n) asm volatile("s_waitcnt vmcnt(" #n ")" ::: "memory")
#define PG8_WAIT_L(n) asm volatile("s_waitcnt lgkmcnt(" #n ")" ::: "memory")
#define PG8_BAR __builtin_amdgcn_s_barrier()
#define PG8_SCHED __builtin_amdgcn_sched_barrier(0)
    Unit cur, nxt; int ui = 0;
    if (!S.next(0, cur)) return;
    f32x4 acc[2][2][4][2];
#pragma unroll
    for (int a = 0; a < 2; ++a)
#pragma unroll
        for (int b = 0; b < 2; ++b)
#pragma unroll
            for (int m = 0; m < 4; ++m)
#pragma unroll
                for (int n = 0; n < 2; ++n) acc[a][b][m][n] = (f32x4){0.f, 0.f, 0.f, 0.f};
    bf16x8 At[4][2], B0[2][2], B1[2][2];
    const char* cA = (const char*)g.A + (GATHER ? (size_t)0 : (size_t)cur.pm * tstep); PG8_GVOFF(voffA, 0); const char* cB = (const char*)g.Bt + (size_t)cur.pn * tstep;
    S.a_ready(cur);
    if constexpr (SP2) {
        PG8_STAGE(PG8_SB(0, 0), cB, voffB); PG8_STAGE(PG8_SB(0, 1), cB + hstep, voffB); PG8_STAGE(PG8_SA(0, 0), cA, voffA[0]); PG8_STAGE(PG8_SA(0, 1), cA + hstepA, voffA[1]);
        if (wr == 1) PG8_BAR;
        PG8_WAIT_V(2); PG8_BAR;
        PG8_STAGE(PG8_SB(1, 0), cB + kstep, voffB); PG8_STAGE(PG8_SA(1, 0), cA + kstep, voffA[0]); PG8_STAGE(PG8_SB(1, 1), cB + hstep + kstep, voffB);
        PG8_WAIT_V(6); PG8_BAR;
    } else {
        PG8_STAGE(PG8_SB(0, 0), cB, voffB); PG8_STAGE(PG8_SA(0, 0), cA, voffA[0]); PG8_STAGE(PG8_SB(0, 1), cB + hstep, voffB); PG8_STAGE(PG8_SA(0, 1), cA + hstep, voffA[0]);
        if (wr == 1) PG8_BAR;
        PG8_WAIT_V(4); PG8_BAR;
        PG8_STAGE(PG8_SB(1, 0), cB + kstep, voffB); PG8_STAGE(PG8_SA(1, 0), cA + kstep, voffA[0]); PG8_STAGE(PG8_SB(1, 1), cB + hstep + kstep, voffB);
        PG8_WAIT_V(6); PG8_BAR;
    }
    for (;;) {
        const bool has_next = S.next(ui + 1, nxt);
        const char* nA = (has_next && !GATHER) ? (const char*)g.A + (size_t)nxt.pm * tstep : cA; if (has_next) PG8_GVOFF(nvoffA, ui + 1); const char* nB = has_next ? (const char*)g.Bt + (size_t)nxt.pn * tstep : cB;
        for (int t = 0; t < nt; t += 2) {
            const bool last = (t == nt - 2);
            const char* a1 = cA + (size_t)(t + 1) * kstep;
            const char* a2 = last ? nA : cA + (size_t)(t + 2) * kstep; const char* b2 = last ? nB : cB + (size_t)(t + 2) * kstep;
            const char* a3 = a2 + kstep; const char* b3 = b2 + kstep;
            if (last && has_next) S.a_ready(nxt);
            unsigned vs2[2][2];
#pragma unroll
            for (int _h = 0; _h < 2; ++_h)
#pragma unroll
                for (int _i = 0; _i < 2; ++_i) vs2[_h][_i] = last ? nvoffA[_h][_i] : voffA[_h][_i];
            if constexpr (SP2) {
            PG8_LDB(B0, 0, 0); PG8_LDB(B1, 0, 1); PG8_SCHED; PG8_LDA(At, 0, 0); PG8_STAGE(PG8_SA(1, 1), a1 + hstepA, voffA[1]);
            PG8_WAIT_V(8); PG8_WAIT_L(0); PG8_BAR; PG8_MMA(0, 0, At, B0); PG8_MMA(0, 1, At, B1); PG8_BAR; PG8_SCHED;
            PG8_LDA(At, 0, 1); PG8_STAGE(PG8_SB(0, 0), b2, voffB); PG8_STAGE(PG8_SB(0, 1), b2 + hstep, voffB); PG8_STAGE(PG8_SA(0, 0), a2, vs2[0]);
            PG8_WAIT_V(8); PG8_WAIT_L(0); PG8_BAR; PG8_MMA(1, 0, At, B0); PG8_MMA(1, 1, At, B1); PG8_BAR; PG8_SCHED;
            PG8_LDB(B0, 1, 0); PG8_LDB(B1, 1, 1); PG8_SCHED; PG8_LDA(At, 1, 0); PG8_STAGE(PG8_SA(0, 1), a2 + hstepA, vs2[1]);
            PG8_WAIT_V(8); PG8_WAIT_L(0); PG8_BAR; PG8_MMA(0, 0, At, B0); PG8_MMA(0, 1, At, B1); PG8_BAR; PG8_SCHED;
            PG8_LDA(At, 1, 1); PG8_STAGE(PG8_SB(1, 0), b3, voffB); PG8_STAGE(PG8_SB(1, 1), b3 + hstep, voffB); PG8_STAGE(PG8_SA(1, 0), a3, vs2[0]);
            PG8_WAIT_V(8); PG8_WAIT_L(0); PG8_BAR; PG8_MMA(1, 0, At, B0); PG8_MMA(1, 1, At, B1); PG8_BAR; PG8_SCHED;
            } else {
            PG8_LDB(B0, 0, 0); PG8_SCHED; PG8_LDA(At, 0, 0); PG8_STAGE(PG8_SA(1, 1), a1 + hstep, voffA[0]);
            PG8_WAIT_L(8); PG8_BAR; PG8_WAIT_L(0); PG8_MMA(0, 0, At, B0); PG8_BAR; PG8_SCHED;
            PG8_LDB(B1, 0, 1); PG8_STAGE(PG8_SB(0, 0), b2, voffB);
            PG8_BAR; PG8_WAIT_L(0); PG8_MMA(0, 1, At, B1); PG8_BAR;
            PG8_LDA(At, 0, 1); PG8_STAGE(PG8_SA(0, 0), a2, voffA[0]);
            PG8_BAR; PG8_WAIT_L(0); PG8_MMA(1, 0, At, B0); PG8_BAR; PG8_SCHED;
            PG8_STAGE(PG8_SB(0, 1), b2 + hstep, voffB);
            PG8_WAIT_V(6); PG8_BAR; PG8_MMA(1, 1, At, B1); PG8_BAR;
            PG8_LDB(B0, 1, 0); PG8_SCHED; PG8_LDA(At, 1, 0); PG8_STAGE(PG8_SA(0, 1), a2 + hstep, voffA[0]);
            PG8_WAIT_L(8); PG8_BAR; PG8_WAIT_L(0); PG8_MMA(0, 0, At, B0); PG8_BAR; PG8_SCHED;
            PG8_LDB(B1, 1, 1); PG8_STAGE(PG8_SB(1, 0), b3, voffB);
            PG8_BAR; PG8_WAIT_L(0); PG8_MMA(0, 1, At, B1); PG8_BAR;
            PG8_LDA(At, 1, 1); PG8_STAGE(PG8_SA(1, 0), a3, voffA[0]);
            PG8_BAR; PG8_WAIT_L(0); PG8_MMA(1, 0, At, B0); PG8_BAR; PG8_SCHED;
            PG8_STAGE(PG8_SB(1, 1), b3 + hstep, voffB);
            PG8_WAIT_V(6); PG8_BAR; PG8_MMA(1, 1, At, B1); PG8_BAR;
            }
        }
        if constexpr (ALIGN_EPI) { if (wr == 0) PG8_BAR; }
        if constexpr (!Epi::AFTER_DRAIN) { E(acc, cur, wr, wc, fr, fq); S.done(cur); }
        if (!has_next) break;
#pragma unroll
        for (int a = 0; a < 2; ++a)
#pragma unroll
            for (int b = 0; b < 2; ++b)
#pragma unroll
                for (int m = 0; m < 4; ++m)
#pragma unroll
                    for (int n = 0; n < 2; ++n) acc[a][b][m][n] = (f32x4){0.f, 0.f, 0.f, 0.f};
        cur = nxt; cA = nA; cB = nB; ++ui;
#pragma unroll
        for (int _h = 0; _h < 2; ++_h)
#pragma unroll
            for (int _i = 0; _i < 2; ++_i) voffA[_h][_i] = nvoffA[_h][_i];
        if constexpr (ALIGN_EPI) { if (wr == 1) PG8_BAR; }
    }
    PG8_WAIT_V(0);
    if constexpr (!ALIGN_EPI) { if (wr == 0) PG8_BAR; }
    PG8_BAR;
    if constexpr (Epi::AFTER_DRAIN) { E.fused(acc, cur, wr, wc, fr, fq, lds, wid, lane); S.done(cur); }
#undef PG8_SA
#undef PG8_GVOFF
#undef PG8_SB
#undef PG8_STAGE
#undef PG8_LDA
#undef PG8_LDB
#undef PG8_MMA
#undef PG8_WAIT_V
#undef PG8_WAIT_L
#undef PG8_BAR
#undef PG8_SCHED
}
}


struct Ptrs { const float* in[24]; float* out; unsigned char* ws; int layer; int pad; };
enum { I_X = 0, I_C, I_CTX, I_CCTX, I_WADA, I_BADA, I_N1G, I_WIN, I_NAQN, I_NAKN, I_RPB, I_GQQN, I_GQKN, I_LB, I_HGON, I_WOUT, I_N2G, I_WRG, I_BRG, I_WRE, I_BRE, I_WEG, I_WEU, I_WED };

namespace pg8 {
struct EpiResid {
    static constexpr bool PERM = false, AFTER_DRAIN = false;
    const float* xin_lat; const float* xin_ctx; float* xout_lat; float* xout_ctx; const float* modl; int chunk;
    __device__ __forceinline__ void operator()(const f32x4 (&acc)[2][2][4][2], const Unit& u, int wr, int wc, int fr, int fq) const {
        const int rowt = u.pm * BM; const bool isctx = rowt >= NLAT;
        const float* xin = isctx ? xin_ctx + (size_t)(rowt - NLAT) * DM : xin_lat + (size_t)rowt * DM;
        float* xo = isctx ? xout_ctx + (size_t)(rowt - NLAT) * DM : xout_lat + (size_t)rowt * DM;
        const int mrow = isctx ? 8 : (rowt >> 11);
        const float* gate = modl + (size_t)mrow * MODW + chunk * DM;
        const int col0 = u.pn * BM + wc * 32 + 4 * fq;
#pragma unroll
        for (int bj = 0; bj < 2; ++bj)
#pragma unroll
            for (int n = 0; n < 2; ++n) {
                const int col = col0 + bj * HALF + n * 16;
                const f32x4 gv = *(const f32x4*)(gate + col);
#pragma unroll
                for (int ai = 0; ai < 2; ++ai)
#pragma unroll
                    for (int m = 0; m < 4; ++m) {
                        const size_t off = (size_t)(ai * HALF + wr * 64 + m * 16 + fr) * DM + col;
                        const f32x4 xi = *(const f32x4*)(xin + off);
                        *(f32x4*)(xo + off) = xi + gv * acc[ai][bj][m][n];
                    }
            }
    }
};
}

__device__ __forceinline__ void phase_mod(const Ptrs& p, LAS unsigned char* lds, int wv) {
    if (blockIdx.x >= 192) return;
    LAS float* sc = (LAS float*)lds;
    LAS float* red = (LAS float*)(lds + 36864);
    const int tid = otid(wv);
    const float* c = p.in[I_C]; const float* cc = p.in[I_CCTX];
    for (int i = tid; i < 9 * DM; i += NT) { float v = (i < 8 * DM) ? c[i] : cc[i - 8 * DM]; sc[i] = silu_f(v); }
    __syncthreads();
    float* mod = (float*)(p.ws + WS_MOD);
    for (int u = blockIdx.x; u < 192; u += gridDim.x) {
        const int layer = u / 96, cb = u % 96, cq = tid & 15, kg = tid >> 4;
        const float* w = p.in[I_WADA] + (size_t)layer * DM * MODW + cb * 64 + cq * 4;
        v4f acc[9];
#pragma unroll
        for (int r = 0; r < 9; ++r) acc[r] = (v4f){0.f, 0.f, 0.f, 0.f};
        for (int i = 0; i < 32; ++i) {
            const int k = kg + 32 * i;
            const v4f wv = *(const v4f*)(w + (size_t)k * MODW);
#pragma unroll
            for (int r = 0; r < 9; ++r) acc[r] += sc[r * DM + k] * wv;
        }
#pragma unroll
        for (int r = 0; r < 9; ++r) *(LAS v4f*)(red + (kg * 9 + r) * 64 + cq * 4) = acc[r];
        __syncthreads();
        for (int o = tid; o < 576; o += NT) {
            const int r = o >> 6, c2 = o & 63; float s = 0.f;
            for (int k2 = 0; k2 < 32; ++k2) s += red[(k2 * 9 + r) * 64 + c2];
            mod[((size_t)layer * 9 + r) * MODW + cb * 64 + c2] = s + p.in[I_BADA][layer * MODW + cb * 64 + c2];
        }
        __syncthreads();
    }
}
__device__ __forceinline__ void phase_lb(const Ptrs& p, int wv) {
    if (blockIdx.x == 255 % gridDim.x) {
        const int i = otid(wv);
        const float* raw = p.in[I_LB]; float* lb = (float*)(p.ws + WS_LB);
        float l0 = raw[i], l1 = raw[512 + i];
        lb[i] = 0.f; lb[512 + i] = 1.f / (1.f + __expf(l0 - l1));
    }
}
__device__ __forceinline__ void transpose_item(const float* W, int K, int N, bf16* WT, int row_off, LAS float* scr, int item, int lane) {
    const int nblk = N / 32, kb = item / nblk, nb = item % nblk, k0 = 64 * kb, n0 = 32 * nb;
#pragma unroll 8
    for (int i = 0; i < 32; ++i) { const int kk = 2 * i + (lane >> 5); scr[kk * 33 + (lane & 31)] = W[(size_t)(k0 + kk) * N + n0 + (lane & 31)]; }
    LDS_WAIT(); asm volatile("" ::: "memory");
    const int c = lane & 7;
#pragma unroll
    for (int j = 0; j < 4; ++j) { const int n = (lane >> 3) + 8 * j; const LAS float* s = scr + (8 * c) * 33 + n;
        v4u o; o.x = pk2(s[0 * 33], s[1 * 33]); o.y = pk2(s[2 * 33], s[3 * 33]); o.z = pk2(s[4 * 33], s[5 * 33]); o.w = pk2(s[6 * 33], s[7 * 33]);
        *(v4u*)(WT + (size_t)(row_off + n0 + n) * K + k0 + 8 * c) = o; }
    LDS_WAIT(); asm volatile("" ::: "memory");
}
constexpr int CI_IN = 16 * 88, CI_OUT = 16 * 32, CI_G = 32 * 128, CI_U = 32 * 128, CI_D = 32 * 128, CI_LAYER = CI_IN + CI_OUT + CI_G + CI_U + CI_D;
__device__ __forceinline__ void phase_convert(const Ptrs& p, LAS unsigned char* lds, int layer_lo, int layer_hi, int wv) {
    const int lane = otid(wv) & 63, wave = wv;
    LAS float* scr = (LAS float*)(lds + wave * 16384);
    const int gw = blockIdx.x * NWAVES + wave, NGW = gridDim.x * NWAVES;
    const int n_items = (layer_hi - layer_lo) * CI_LAYER;
    for (int it = gw; it < n_items; it += NGW) {
        const int layer = layer_lo + it / CI_LAYER; int r = it % CI_LAYER;
        if (r < CI_IN) {
            const int n0 = 32 * (r % 88), pn_ = n0 >> 8, w_ = (n0 >> 6) & 3, bj_ = (n0 >> 5) & 1;
            transpose_item(p.in[I_WIN] + (size_t)layer * DM * DIN, DM, DIN, (bf16*)(p.ws + WS_WIN + layer * WIN_STRIDE), (256 * pn_ + 128 * bj_ + 32 * w_) - n0, scr, r, lane); continue; } r -= CI_IN;
        if (r < CI_OUT) { transpose_item(p.in[I_WOUT] + (size_t)layer * DM * DM, DM, DM, (bf16*)(p.ws + WS_WOUT + layer * WOUT_STRIDE), 0, scr, r, lane); continue; } r -= CI_OUT;
        if (r < CI_G + CI_U) {
            const int up = r >= CI_G; if (up) r -= CI_G;
            const int e = r >> 7, rem = r & 127, nb = rem & 7, n0 = 32 * nb;
            const int mapped = (n0 >> 7) * 256 + (n0 & 127) + (up ? 128 : 0);
            transpose_item(p.in[up ? I_WEU : I_WEG] + ((size_t)layer * 32 + e) * DM * 256, DM, 256, (bf16*)(p.ws + WS_WGU + layer * WGU_STRIDE) + (size_t)e * 512 * DM, mapped - n0, scr, rem, lane);
            continue;
        }
        r -= CI_G + CI_U;
        { const int e = r >> 7, rem = r & 127;
          transpose_item(p.in[I_WED] + ((size_t)layer * 32 + e) * 256 * DM, 256, DM, (bf16*)(p.ws + WS_WD + layer * WD_STRIDE) + (size_t)e * DM * 256, 0, scr, rem, lane); }
    }
}
__device__ __forceinline__ void phase_norm(const float* xlat, const float* xctx, const float* g, const float* modl, int ch_shift, int ch_scale, bf16* H, int nrows, int wv) {
    const int lane = otid(wv) & 63, wave = wv;
    const int gw = blockIdx.x * NWAVES + wave, NGW = gridDim.x * NWAVES;
    const int per = (nrows + NGW - 1) / NGW;
    const int r0 = gw * per, r1 = min(r0 + per, nrows);
    int cur = -1; v4f gs[4], sh[4];
    for (int r = r0; r < r1; ++r) {
        const int mrow = (r < NLAT) ? (r >> 11) : 8;
        if (mrow != cur) {
            cur = mrow; const float* m = modl + (size_t)mrow * MODW;
#pragma unroll
            for (int j = 0; j < 4; ++j) { const int c = 4 * lane + 256 * j; const v4f gg = *(const v4f*)(g + c), sc = *(const v4f*)(m + ch_scale * DM + c);
                gs[j] = gg * (1.f + sc); sh[j] = *(const v4f*)(m + ch_shift * DM + c); }
        }
        const float* xr = (r < NLAT) ? xlat + (size_t)r * DM : xctx + (size_t)(r - NLAT) * DM;
        v4f v[4]; float s = 0.f;
#pragma unroll
        for (int j = 0; j < 4; ++j) { v[j] = *(const v4f*)(xr + 4 * lane + 256 * j); s += (v[j].x * v[j].x + v[j].y * v[j].y) + (v[j].z * v[j].z + v[j].w * v[j].w); }
        const float rstd = rsqrtf(wave_sum(s, lane) * (1.f / DM) + 1e-6f);
        bf16* orow = H + (size_t)r * DM;
#pragma unroll
        for (int j = 0; j < 4; ++j) { const v4f o = v[j] * rstd * gs[j] + sh[j]; v2u w; w.x = pk2(o.x, o.y); w.y = pk2(o.z, o.w); *(v2u*)(orow + 4 * lane + 256 * j) = w; }
    }
}

constexpr size_t WS_RSS = 6 * MiB;
constexpr size_t WS_WR = 7 * MiB + 512 * 1024;
constexpr int CW_CNT = 1024;
constexpr int LDS_TTAB = 131072;
constexpr int LDS_GIDX = 131072 + 4096;
constexpr int LDS_RT = 131072;

namespace pg8 {
struct EpiResidSS {
    static constexpr bool PERM = false, AFTER_DRAIN = false;
    const float* xin_lat; const float* xin_ctx; float* xout_lat; float* xout_ctx; const float* modl; int chunk; float* rss; int wv;
    __device__ __forceinline__ void operator()(const f32x4 (&acc)[2][2][4][2], const Unit& u, int, int, int, int) const {
        const int l_ = otid(wv) & 63, fr = l_ & 15, fq = l_ >> 4, wr = wv >> 2, wc = wv & 3;
        const int rowt = u.pm * BM; const bool isctx = rowt >= NLAT;
        const float* xin = isctx ? xin_ctx + (size_t)(rowt - NLAT) * DM : xin_lat + (size_t)rowt * DM;
        float* xo = isctx ? xout_ctx + (size_t)(rowt - NLAT) * DM : xout_lat + (size_t)rowt * DM;
        const int mrow = isctx ? 8 : (rowt >> 11);
        const float* gate = modl + (size_t)mrow * MODW + chunk * DM;
        const int col0 = u.pn * BM + wc * 32 + 4 * fq;
        f32x4 gv[2][2];
#pragma unroll
        for (int bj = 0; bj < 2; ++bj)
#pragma unroll
            for (int n = 0; n < 2; ++n) gv[bj][n] = *(const f32x4*)(gate + col0 + bj * HALF + n * 16);
#pragma unroll
        for (int ai = 0; ai < 2; ++ai)
#pragma unroll
            for (int m = 0; m < 4; ++m) {
                const int rl = ai * HALF + wr * 64 + m * 16 + fr; float ss = 0.f;
#pragma unroll
                for (int bj = 0; bj < 2; ++bj)
#pragma unroll
                    for (int n = 0; n < 2; ++n) {
                        const size_t off = (size_t)rl * DM + col0 + bj * HALF + n * 16;
                        const f32x4 xi = *(const f32x4*)(xin + off);
                        const f32x4 o = xi + gv[bj][n] * acc[ai][bj][m][n];
                        *(f32x4*)(xo + off) = o;
                        ss += (o[0] * o[0] + o[1] * o[1]) + (o[2] * o[2] + o[3] * o[3]);
                    }
                ss += shx(ss, 16, l_); ss += shx(ss, 32, l_);
                if (fq == 0) rss[(size_t)(rowt + rl) * 16 + u.pn * 4 + wc] = ss;
            }
    }
};
struct EpiGU {
    static constexpr bool PERM = true, AFTER_DRAIN = false;
    bf16_t* HID; int wv;
    __device__ __forceinline__ void operator()(const f32x4 (&acc)[2][2][4][2], const Unit& u, int, int, int, int) const {
        const int l_ = otid(wv) & 63, fr = l_ & 15, fq = l_ >> 4, wr = wv >> 2, wc = wv & 3;
        const int pnl = u.pn & 1, row0 = u.pm * BM + wr * 64 + fr, col0 = pnl * 128 + wc * 32 + 8 * fq;
#pragma unroll
        for (int ai = 0; ai < 2; ++ai)
#pragma unroll
            for (int m = 0; m < 4; ++m) {
                bf16_t* rowp = HID + (size_t)(row0 + ai * HALF + m * 16) * 256 + col0;
                float hv[8];
#pragma unroll
                for (int n = 0; n < 2; ++n)
#pragma unroll
                    for (int i = 0; i < 4; ++i) { const float g = acc[ai][0][m][n][i], uu = acc[ai][1][m][n][i]; hv[n * 4 + i] = g / (1.f + __expf(-g)) * uu; }
                u32x4 w; w.x = cvt_pk_bf16(hv[0], hv[1]); w.y = cvt_pk_bf16(hv[2], hv[3]); w.z = cvt_pk_bf16(hv[4], hv[5]); w.w = cvt_pk_bf16(hv[6], hv[7]);
                *(u32x4*)rowp = w;
            }
    }
};
struct EpiDown {
    static constexpr bool PERM = true, AFTER_DRAIN = false;
    bf16_t* Y0; bf16_t* Y1; const PG8_LAS int* rowinfo; int wv;
    __device__ __forceinline__ void operator()(const f32x4 (&acc)[2][2][4][2], const Unit& u, int, int, int, int) const {
        const int l_ = otid(wv) & 63, fr_ = l_ & 15, fq = l_ >> 4, wr = wv >> 2, wc = wv & 3;
        const int col0 = (u.pn & 3) * BM + wc * 32 + 8 * fq;
        const PG8_LAS int* ri = rowinfo + (u.aux * 256 + wr * 64 + fr_) * 2;
#pragma unroll
        for (int ai = 0; ai < 2; ++ai)
#pragma unroll
            for (int m = 0; m < 4; ++m) {
                const int ent = ri[(ai * HALF + m * 16) * 2]; const float w = __builtin_bit_cast(float, ri[(ai * HALF + m * 16) * 2 + 1]);
                if (ent >= 0) {
                    bf16_t* rowp = Y0 + ((size_t)(ent & 1) * ((WS_Y1 - WS_Y0) / 2) + (size_t)(ent >> 1) * DM + col0);
#pragma unroll
                    for (int bj = 0; bj < 2; ++bj) {
                        const f32x4 v0 = acc[ai][bj][m][0] * w, v1 = acc[ai][bj][m][1] * w;
                        u32x4 o; o.x = cvt_pk_bf16(v0[0], v0[1]); o.y = cvt_pk_bf16(v0[2], v0[3]); o.z = cvt_pk_bf16(v1[0], v1[1]); o.w = cvt_pk_bf16(v1[2], v1[3]);
                        *(u32x4*)(rowp + bj * HALF) = o;
                    }
                }
                asm volatile("" ::: "memory");
            }
    }
};
struct MoeOrder {
    const PG8_LAS int* ttab; int ntile, npn, G, c;
    __device__ __forceinline__ bool next(int i, Unit& u) const {
        const int L = i * G + c; if (L >= ntile * npn) return false;
        const int t = L / npn, pl = L % npn; u.pm = t; u.pn = ttab[t * 4] * npn + pl; u.aux = i; return true;
    }
    __device__ __forceinline__ void a_ready(const Unit&) const {}
    __device__ __forceinline__ void done(const Unit&) const {}
};
}

__device__ __forceinline__ void phase_router_w(const Ptrs& p, int wv) {
    const int gt = blockIdx.x * NT + otid(wv), NG = gridDim.x * NT;
    for (int idx = gt; idx < 2 * 48 * DM; idx += NG) {
        const int layer = idx / (48 * DM), r = idx % (48 * DM), n = r >> 10, k = r & 1023;
        float w;
        if (n < 16) w = p.in[I_WRG][((size_t)layer * DM + k) * 4 + (n & 3)];
        else { const int g = ((n - 16) & 15) >> 2, i = n & 3, e = 8 * g + i + (n >= 32 ? 4 : 0); w = p.in[I_WRE][((size_t)layer * DM + k) * 32 + e]; }
        const unsigned hi = f2bf(w); const float lo = w - __builtin_bit_cast(float, hi << 16);
        bf16* base = (bf16*)(p.ws + WS_WR) + (size_t)layer * 2 * 48 * DM;
        base[r] = (bf16)hi; base[48 * DM + r] = (bf16)f2bf(lo);
    }
}

typedef short s8v __attribute__((ext_vector_type(8)));
__device__ __forceinline__ void phase_route(const Ptrs& p, LAS unsigned char* lds, int layer, int nrows, int wv) {
    const int tid = otid(wv), lane = tid & 63, wave = wv;
    LAS int* lcnt = (LAS int*)(lds + LDS_RT); LAS int* gb = lcnt + 32;
    if (tid < 32) lcnt[tid] = 0;
    __syncthreads();
    const int ntiles = nrows / 16, t = wave * gridDim.x + blockIdx.x;
    const float* modl = (const float*)(p.ws + WS_MOD) + (size_t)layer * 9 * MODW;
    int e0 = -1, e1 = -1, lp0 = 0, lp1 = 0, ent0 = 0;
    if (t < ntiles) {
        const int row0 = t * 16, r = row0 + (lane & 15), kq = lane >> 4;
        const int mrow = (row0 < NLAT) ? (row0 >> 11) : 8;
        const float* xr = (r < NLAT) ? p.out + (size_t)r * DM : (const float*)(p.ws + WS_XC) + (size_t)(r - NLAT) * DM;
        const float* g = p.in[I_N2G] + layer * DM; const float* msc = modl + (size_t)mrow * MODW + 4 * DM; const float* msh = modl + (size_t)mrow * MODW + 3 * DM;
        bf16* hrow = (bf16*)(p.ws + WS_H) + (size_t)r * DM;
        const bf16* wr_hi = (const bf16*)(p.ws + WS_WR) + (size_t)layer * 2 * 48 * DM + (size_t)(lane & 15) * DM; const bf16* wr_lo = wr_hi + 48 * DM;
        float ss;
        { const v4f* rs = (const v4f*)((const float*)(p.ws + WS_RSS) + (size_t)r * 16); const v4f a = rs[0], b = rs[1], c = rs[2], d = rs[3];
          ss = ((a.x + a.y) + (a.z + a.w)) + ((b.x + b.y) + (b.z + b.w)) + ((c.x + c.y) + (c.z + c.w)) + ((d.x + d.y) + (d.z + d.w)); }
        const float rstd = rsqrtf(ss * (1.f / DM) + 1e-6f);
        v4f acc[3];
#pragma unroll
        for (int i = 0; i < 3; ++i) acc[i] = (v4f){0.f, 0.f, 0.f, 0.f};
        for (int s = 0; s < 32; ++s) {
            const int c0 = 32 * s + 8 * kq;
            const v4f xa = *(const v4f*)(xr + c0), xb = *(const v4f*)(xr + c0 + 4);
            const v4f ga = *(const v4f*)(g + c0), gbv = *(const v4f*)(g + c0 + 4);
            const v4f sa = *(const v4f*)(msc + c0), sb = *(const v4f*)(msc + c0 + 4);
            const v4f ha = *(const v4f*)(msh + c0), hb = *(const v4f*)(msh + c0 + 4);
            const v4f h0 = xa * rstd * (ga * (1.f + sa)) + ha, h1 = xb * rstd * (gbv * (1.f + sb)) + hb;
            float hv[8] = {h0.x, h0.y, h0.z, h0.w, h1.x, h1.y, h1.z, h1.w};
            unsigned hi[8]; s8v bhi, blo;
#pragma unroll
            for (int j = 0; j < 8; ++j) { hi[j] = f2bf(hv[j]); bhi[j] = (short)hi[j]; blo[j] = (short)f2bf(hv[j] - __builtin_bit_cast(float, hi[j] << 16)); }
            v4u hw; hw.x = hi[0] | (hi[1] << 16); hw.y = hi[2] | (hi[3] << 16); hw.z = hi[4] | (hi[5] << 16); hw.w = hi[6] | (hi[7] << 16);
            *(v4u*)(hrow + c0) = hw;
#pragma unroll
            for (int nt = 0; nt < 3; ++nt) {
                const s8v ahi = *(const s8v*)(wr_hi + (size_t)nt * 16 * DM + c0), alo = *(const s8v*)(wr_lo + (size_t)nt * 16 * DM + c0);
                acc[nt] = __builtin_amdgcn_mfma_f32_16x16x32_bf16(ahi, bhi, acc[nt], 0, 0, 0);
                acc[nt] = __builtin_amdgcn_mfma_f32_16x16x32_bf16(ahi, blo, acc[nt], 0, 0, 0);
                acc[nt] = __builtin_amdgcn_mfma_f32_16x16x32_bf16(alo, bhi, acc[nt], 0, 0, 0);
            }
        }
        const float* brg = p.in[I_BRG] + layer * 4; const float* bre = p.in[I_BRE] + layer * 32;
        float gl[4];
#pragma unroll
        for (int i = 0; i < 4; ++i) gl[i] = acc[0][i] + brg[i];
        int gi = 0; float gm = gl[0];
#pragma unroll
        for (int i = 1; i < 4; ++i) if (gl[i] > gm) { gm = gl[i]; gi = i; }
        float den = 0.f;
#pragma unroll
        for (int i = 0; i < 4; ++i) den += __expf(gl[i] - gm);
        const float gtop = 1.f / den;
        if (kq == gi) {
            float el[8];
#pragma unroll
            for (int i = 0; i < 4; ++i) { el[i] = acc[1][i] + bre[8 * kq + i]; el[4 + i] = acc[2][i] + bre[8 * kq + 4 + i]; }
            int i0 = 0; float v0 = el[0];
#pragma unroll
            for (int i = 1; i < 8; ++i) if (el[i] > v0) { v0 = el[i]; i0 = i; }
            int i1 = -1; float v1 = -3.0e38f;
#pragma unroll
            for (int i = 0; i < 8; ++i) if (i != i0 && el[i] > v1) { v1 = el[i]; i1 = i; }
            const float p1 = __expf(v1 - v0), sden = 1.f / (1.f + p1);
            e0 = gi * 8 + i0; e1 = gi * 8 + i1; ent0 = r * 2;
            float* ew = (float*)(p.ws + WS_EW);
            ew[ent0] = gtop * sden; ew[ent0 + 1] = gtop * p1 * sden;
            lp0 = __hip_atomic_fetch_add(lcnt + e0, 1, __ATOMIC_RELAXED, __HIP_MEMORY_SCOPE_WORKGROUP); lp1 = __hip_atomic_fetch_add(lcnt + e1, 1, __ATOMIC_RELAXED, __HIP_MEMORY_SCOPE_WORKGROUP);
        }
    }
    __syncthreads();
    int* cnt = (int*)(p.ws + WS_CTL) + CW_CNT + layer * 64;
    if (tid < 32) gb[tid] = atomicAdd(&cnt[tid], lcnt[tid]);
    __syncthreads();
    if (e0 >= 0) {
        int* IDX = (int*)(p.ws + WS_IDX);
        IDX[(size_t)e0 * MROWS + gb[e0] + lp0] = ent0;
        IDX[(size_t)e1 * MROWS + gb[e1] + lp1] = ent0 + 1;
    }
}
__device__ __forceinline__ int moe_build_ttab(const Ptrs& p, LAS unsigned char* lds, int layer, int wv) {
    LAS int* ttab = (LAS int*)(lds + LDS_TTAB);
    const int* cnt = (const int*)(p.ws + WS_CTL) + CW_CNT + layer * 64;
    __syncthreads();
    if (otid(wv) == 0) {
        int t = 0;
        for (int e = 0; e < 32; ++e) { const int c = __hip_atomic_load(cnt + e, __ATOMIC_RELAXED, __HIP_MEMORY_SCOPE_AGENT); for (int fp = 0; fp < c; fp += 256) { ttab[t * 4] = e; ttab[t * 4 + 1] = fp; ttab[t * 4 + 2] = c; ++t; } }
        ttab[176 * 4] = t;
    }
    __syncthreads();
    return ttab[176 * 4];
}
__device__ __forceinline__ void phase_moe_gu(const Ptrs& p, LAS unsigned char* lds, int layer, int wv) {
    const int ntile = moe_build_ttab(p, lds, layer, wv);
    LAS int* ttab = (LAS int*)(lds + LDS_TTAB); LAS int* gidx = (LAS int*)(lds + LDS_GIDX);
    pg8::MoeOrder S{ttab, ntile, 2, (int)gridDim.x, (int)blockIdx.x};
    const int* IDX = (const int*)(p.ws + WS_IDX);
    for (int i = 0; i < 3; ++i) {
        pg8::Unit u; if (!S.next(i, u)) break;
        const int e = ttab[u.pm * 4], fp = ttab[u.pm * 4 + 1], c = ttab[u.pm * 4 + 2];
        for (int r = otid(wv); r < 256; r += NT) gidx[i * 256 + r] = (fp + r < c) ? (IDX[(size_t)e * MROWS + fp + r] >> 1) : 0;
    }
    __syncthreads();
    pg8::Gemm g{(const bf16*)(p.ws + WS_H), (const bf16*)(p.ws + WS_WGU + layer * WGU_STRIDE), ntile * 256, 32 * 512, DM};
    pg8::EpiGU E{(bf16*)(p.ws + WS_HID), wv};
    pg8::gemm_phase<pg8::EpiGU, pg8::MoeOrder, true, true, true>(lds, g, S, E, wv, gidx);
}
__device__ __forceinline__ void phase_moe_down(const Ptrs& p, LAS unsigned char* lds, int layer, int wv) {
    const int ntile = moe_build_ttab(p, lds, layer, wv);
    LAS int* ttab = (LAS int*)(lds + LDS_TTAB); LAS int* rowinfo = (LAS int*)(lds + LDS_GIDX);
    pg8::MoeOrder S{ttab, ntile, 4, (int)gridDim.x, (int)blockIdx.x};
    const int* IDX = (const int*)(p.ws + WS_IDX); const float* EW = (const float*)(p.ws + WS_EW);
    for (int i = 0; i < 3; ++i) {
        pg8::Unit u; if (!S.next(i, u)) break;
        const int e = ttab[u.pm * 4], fp = ttab[u.pm * 4 + 1], c = ttab[u.pm * 4 + 2];
        for (int r = otid(wv); r < 256; r += NT) {
            int ent = -1; float w = 0.f;
            if (fp + r < c) { ent = IDX[(size_t)e * MROWS + fp + r]; w = EW[ent]; }
            rowinfo[(i * 256 + r) * 2] = ent; rowinfo[(i * 256 + r) * 2 + 1] = __builtin_bit_cast(int, w);
        }
    }
    __syncthreads();
    pg8::Gemm g{(const bf16*)(p.ws + WS_HID), (const bf16*)(p.ws + WS_WD + layer * WD_STRIDE), ntile * 256, 32 * 1024, 256};
    pg8::EpiDown E{(bf16*)(p.ws + WS_Y0), (bf16*)(p.ws + WS_Y1), rowinfo, wv};
    pg8::gemm_phase<pg8::EpiDown, pg8::MoeOrder, true, true, false>(lds, g, S, E, wv);
}
__device__ __forceinline__ void phase_combine(const Ptrs& p, int layer, int nrows, bool do_norm, int wv) {
    const int lane = otid(wv) & 63, wave = wv;
    const int gw = blockIdx.x * NWAVES + wave, NGW = gridDim.x * NWAVES;
    const int per = (nrows + NGW - 1) / NGW;
    const int r0 = gw * per, r1 = min(r0 + per, nrows);
    const float* modl = (const float*)(p.ws + WS_MOD) + (size_t)layer * 9 * MODW;
    const float* modn = (const float*)(p.ws + WS_MOD) + (size_t)(layer + 1) * 9 * MODW;
    const float* g = p.in[I_N1G] + (layer + 1) * DM;
    const bf16* Y0 = (const bf16*)(p.ws + WS_Y0); const bf16* Y1 = (const bf16*)(p.ws + WS_Y1); bf16* H = (bf16*)(p.ws + WS_H);
    for (int r = r0; r < r1; ++r) {
        const int mrow = (r < NLAT) ? (r >> 11) : 8;
        float* xr = (r < NLAT) ? p.out + (size_t)r * DM : (float*)(p.ws + WS_XC) + (size_t)(r - NLAT) * DM;
        const float* m5 = modl + (size_t)mrow * MODW + 5 * DM;
        v4f v[4]; float s = 0.f;
#pragma unroll
        for (int j = 0; j < 4; ++j) {
            const int c = 4 * lane + 256 * j;
            const v4f x = *(const v4f*)(xr + c), mm = *(const v4f*)(m5 + c);
            const v2u a = *(const v2u*)(Y0 + (size_t)r * DM + c), b = *(const v2u*)(Y1 + (size_t)r * DM + c);
            v4f y; y.x = bflo(a.x) + bflo(b.x); y.y = bfhi(a.x) + bfhi(b.x); y.z = bflo(a.y) + bflo(b.y); y.w = bfhi(a.y) + bfhi(b.y);
            v[j] = x + mm * y;
            *(v4f*)(xr + c) = v[j];
            s += (v[j].x * v[j].x + v[j].y * v[j].y) + (v[j].z * v[j].z + v[j].w * v[j].w);
        }
        if (do_norm) {
            const float rstd = rsqrtf(wave_sum(s, lane) * (1.f / DM) + 1e-6f);
            const float* mn = modn + (size_t)mrow * MODW;
#pragma unroll
            for (int j = 0; j < 4; ++j) {
                const int c = 4 * lane + 256 * j;
                const v4f gg = *(const v4f*)(g + c), sc = *(const v4f*)(mn + DM + c), sh = *(const v4f*)(mn + c);
                const v4f o = v[j] * rstd * (gg * (1.f + sc)) + sh; v2u w; w.x = pk2(o.x, o.y); w.y = pk2(o.z, o.w);
                *(v2u*)(H + (size_t)r * DM + c) = w;
            }
        }
    }
}

namespace hg {
typedef short s4v __attribute__((ext_vector_type(4)));
typedef short s8v __attribute__((ext_vector_type(8)));
typedef short v4i16_t __attribute__((ext_vector_type(4)));
constexpr int TS = 160;
constexpr int TILE_B = 16 * TS;
constexpr int WAVE_LDS = 2 * TILE_B;
constexpr int NSEG = 18;
constexpr size_t SEGU_B = 64 * 64 * 4, SEGA_B = 16 * 64 * 4;
constexpr size_t WS_SEGU = WS_SCR;
constexpr size_t WS_SEGA = WS_SEGU + (size_t)NBATCH * 4 * 2 * NSEG * SEGU_B;
static_assert(WS_SEGA + (size_t)NBATCH * 4 * 2 * NSEG * SEGA_B <= WS_END && 8 * WAVE_LDS <= 40960 && 40960 + 6 * 16384 <= LDS_BYTES - 64, "hgrn scratch");
template <int CTRL> __device__ __forceinline__ float dppf(float x) { return __builtin_bit_cast(float, __builtin_amdgcn_update_dpp(0, __builtin_bit_cast(int, x), CTRL, 0xf, 0xf, true)); }
__device__ __forceinline__ s4v trd(const LAS unsigned char* p) { return __builtin_bit_cast(s4v, __builtin_amdgcn_ds_read_tr16_b64_v4i16((LAS v4i16_t*)p)); }
typedef float f32x2_t __attribute__((ext_vector_type(2))); typedef __bf16 bf16x2_t __attribute__((ext_vector_type(2)));
__device__ __forceinline__ unsigned pkbf(float lo, float hi) { f32x2_t v = {lo, hi}; bf16x2_t b = __builtin_convertvector(v, bf16x2_t); return __builtin_bit_cast(unsigned, b); }
__device__ __forceinline__ float silu_r(float x) { return x * __builtin_amdgcn_rcpf(1.f + __expf(-x)); }
__device__ __forceinline__ s8v mk8(unsigned a, unsigned b, unsigned c, unsigned d) { v4u t; t.x = a; t.y = b; t.z = c; t.w = d; return __builtin_bit_cast(s8v, t); }

template <bool BWD, int OUT>
__device__ __forceinline__ void chunk(const bf16* __restrict__ P, int row0, int h, const float* __restrict__ lbh, v4f (&S)[4][4], float (&Atot)[16],
                                      LAS unsigned char* vt, LAS unsigned char* kt, int lane_, LAS v4f* OFL, int cidx, bf16* __restrict__ MIX, const float* __restrict__ on) {
    int lane = lane_; asm volatile("" : "+v"(lane));
    const int tok = lane & 15, kq = lane >> 4;
    const bf16* pb = P + (size_t)row0 * DIN + h * 64;
    const unsigned lo = (unsigned)(tok * DIN + 4 * kq);
    v2u zr[4], qr[4]; v4f lbq[4];
#pragma unroll
    for (int m = 0; m < 4; ++m) lbq[m] = *(const v4f*)(lbh + (unsigned)(16 * m + 4 * kq));
#pragma unroll
    for (int m = 0; m < 4; ++m) { zr[m] = *(const v2u*)(pb + (lo + (BWD ? C_FB : C_FF) + 16 * m)); if (OUT != 0) qr[m] = *(const v2u*)(pb + (lo + C_Q + 16 * m)); }
#pragma unroll
    for (int i = 0; i < 2; ++i) { const int pc = lane + 64 * i, r = pc >> 3, ch = pc & 7;
        const v4u vv = *(const v4u*)(pb + (unsigned)(r * DIN + C_I + 8 * ch)); *(LAS v4u*)(vt + r * TS + 16 * ch) = vv; }
    unsigned qf[8], kf[8];
    float A[16];
#pragma unroll
    for (int m = 0; m < 4; ++m)
#pragma unroll
        for (int jp = 0; jp < 2; ++jp) {
            const unsigned zw = jp ? zr[m].y : zr[m].x;
            float kt2[2], qt2[2], kh2[2];
#pragma unroll
            for (int i = 0; i < 2; ++i) {
                const int e = 4 * m + 2 * jp + i;
                const float z = i ? bfhi(zw) : bflo(zw);
                const float sg = __builtin_amdgcn_rcpf(1.f + __expf(-z)), lb = lbq[m][2 * jp + i];
                const float f = lb + (1.f - lb) * sg, kk = (1.f - lb) * (1.f - sg);
                const float lf = __logf(f);
                float c = lf, t = lf;
                if (!BWD) { c += dppf<0x111>(c); c += dppf<0x112>(c); c += dppf<0x114>(c); c += dppf<0x118>(c); }
                else      { c += dppf<0x101>(c); c += dppf<0x102>(c); c += dppf<0x104>(c); c += dppf<0x108>(c); }
                t += dppf<0x128>(t); t += dppf<0x124>(t); t += dppf<0x122>(t); t += dppf<0x121>(t);
                const float Ei = __expf(-fmaxf(c, -80.f)); A[e] = __expf(t);
                kt2[i] = kk * Ei; kh2[i] = kt2[i] * A[e];
                if (OUT != 0) { const unsigned qw = jp ? qr[m].y : qr[m].x; const float q = i ? bfhi(qw) : bflo(qw); qt2[i] = q * 0.125f * __expf(c); } else qt2[i] = 0.f;
            }
            kf[2 * m + jp] = pkbf(kt2[0], kt2[1]); if (OUT != 0) qf[2 * m + jp] = pkbf(qt2[0], qt2[1]);
            *(LAS unsigned*)(kt + tok * TS + (16 * m + 4 * kq + 2 * jp) * 2) = pkbf(kh2[0], kh2[1]);
            __builtin_amdgcn_sched_barrier(0);
        }
    asm volatile("s_waitcnt lgkmcnt(0)" ::: "memory");
    s8v vfr[4], khf[4];
    { const int i4 = tok >> 2, p4 = tok & 3; const LAS unsigned char* va = vt + (4 * kq + i4) * TS + 8 * p4; const LAS unsigned char* ka = kt + (4 * kq + i4) * TS + 8 * p4;
#pragma unroll
      for (int c = 0; c < 4; ++c) { const s4v a = trd(va + 32 * c), b = trd(ka + 32 * c);
          vfr[c] = (s8v){a[0], a[1], a[2], a[3], 0, 0, 0, 0}; khf[c] = (s8v){b[0], b[1], b[2], b[3], 0, 0, 0, 0}; } }
    if (OUT != 0) {
        const s8v q0 = mk8(qf[0], qf[1], qf[2], qf[3]), q1 = mk8(qf[4], qf[5], qf[6], qf[7]);
        const s8v k0 = mk8(kf[0], kf[1], kf[2], kf[3]), k1 = mk8(kf[4], kf[5], kf[6], kf[7]);
        v4f at = (v4f){0.f, 0.f, 0.f, 0.f};
        at = __builtin_amdgcn_mfma_f32_16x16x32_bf16(k0, q0, at, 0, 0, 0);
        at = __builtin_amdgcn_mfma_f32_16x16x32_bf16(k1, q1, at, 0, 0, 0);
#pragma unroll
        for (int j = 0; j < 4; ++j) { const int s = 4 * kq + j; const bool keep = BWD ? (s >= tok) : (s <= tok); at[j] = keep ? at[j] : 0.f; }
        const s8v af = mk8(pkbf(at[0], at[1]), pkbf(at[2], at[3]), 0u, 0u);
        v4f o[4];
#pragma unroll
        for (int vb = 0; vb < 4; ++vb) {
            o[vb] = __builtin_amdgcn_mfma_f32_16x16x32_bf16(vfr[vb], af, (v4f){0.f, 0.f, 0.f, 0.f}, 0, 0, 0);
            const s8v s0 = mk8(pkbf(S[0][vb][0], S[0][vb][1]), pkbf(S[0][vb][2], S[0][vb][3]), pkbf(S[1][vb][0], S[1][vb][1]), pkbf(S[1][vb][2], S[1][vb][3]));
            const s8v s1 = mk8(pkbf(S[2][vb][0], S[2][vb][1]), pkbf(S[2][vb][2], S[2][vb][3]), pkbf(S[3][vb][0], S[3][vb][1]), pkbf(S[3][vb][2], S[3][vb][3]));
            o[vb] = __builtin_amdgcn_mfma_f32_16x16x32_bf16(s0, q0, o[vb], 0, 0, 0);
            o[vb] = __builtin_amdgcn_mfma_f32_16x16x32_bf16(s1, q1, o[vb], 0, 0, 0);
            __builtin_amdgcn_sched_barrier(0);
        }
        LAS v4f* ofl = OFL + (cidx * 4) * 64 + lane;
        if (OUT == 1) {
#pragma unroll
            for (int vb = 0; vb < 4; ++vb) ofl[vb * 64] = o[vb];
        } else {
            float ss = 0.f;
#pragma unroll
            for (int vb = 0; vb < 4; ++vb) { o[vb] += ofl[vb * 64]; ss += (o[vb].x * o[vb].x + o[vb].y * o[vb].y) + (o[vb].z * o[vb].z + o[vb].w * o[vb].w); }
            ss += shx(ss, 16, lane); ss += shx(ss, 32, lane);
            const float rstd = rsqrtf(ss * (1.f / 64.f) + 1e-6f);
            bf16* mb = MIX + (size_t)row0 * DM + 768 + h * 64; const unsigned lom = (unsigned)(tok * DM + 4 * kq);
#pragma unroll
            for (int vb = 0; vb < 4; ++vb) {
                const v2u gw = *(const v2u*)(pb + (lo + C_G + 16 * vb)); const v4f gn = *(const v4f*)(on + (unsigned)(16 * vb + 4 * kq));
                const float g0 = bflo(gw.x), g1 = bfhi(gw.x), g2 = bflo(gw.y), g3 = bfhi(gw.y);
                v2u w; w.x = pkbf(o[vb].x * rstd * gn.x * silu_r(g0), o[vb].y * rstd * gn.y * silu_r(g1)); w.y = pkbf(o[vb].z * rstd * gn.z * silu_r(g2), o[vb].w * rstd * gn.w * silu_r(g3));
                *(v2u*)(mb + (lom + 16 * vb)) = w;
            }
        }
    }
#pragma unroll
    for (int db = 0; db < 4; ++db) {
        const v4f av = (v4f){A[4 * db], A[4 * db + 1], A[4 * db + 2], A[4 * db + 3]};
#pragma unroll
        for (int vb = 0; vb < 4; ++vb) S[db][vb] = __builtin_amdgcn_mfma_f32_16x16x32_bf16(khf[db], vfr[vb], S[db][vb] * av, 0, 0, 0);
        __builtin_amdgcn_sched_barrier(0);
    }
    if (OUT == 0) {
#pragma unroll
        for (int e = 0; e < 16; ++e) Atot[e] *= A[e];
    }
    asm volatile("s_waitcnt lgkmcnt(0)" ::: "memory");
}
__device__ __forceinline__ int seg_row0(int b, int seg) { return seg < 2 ? NLAT + b * CTXL + 128 * seg : b * SEQ + 128 * (seg - 2); }
__device__ __forceinline__ int scan_idx(int seg, int dir) { return dir == 0 ? seg : (seg < 2 ? 1 - seg : 19 - seg); }

__device__ __forceinline__ void unit_pass1(const Ptrs& p, int layer, int u, LAS unsigned char* wl, int lane) {
    const int dir = u & 1, bhs = u >> 1, seg = bhs % NSEG, bh = bhs / NSEG, h = bh & 3, b = bh >> 2;
    const bf16* P = (const bf16*)(p.ws + WS_P);
    const int row0 = seg_row0(b, seg);
    float Atot[16]; v4f S[4][4];
    const float* lbv = (const float*)(p.ws + WS_LB) + layer * 512 + dir * 256 + h * 64;
#pragma unroll
    for (int e = 0; e < 16; ++e) Atot[e] = 1.f;
#pragma unroll
    for (int i = 0; i < 4; ++i)
#pragma unroll
        for (int j = 0; j < 4; ++j) S[i][j] = (v4f){0.f, 0.f, 0.f, 0.f};
    if (dir == 0) {
#pragma unroll 1
        for (int c = 0; c < 8; ++c) chunk<false, 0>(P, row0 + 16 * c, h, lbv, S, Atot, wl, wl + TILE_B, lane, nullptr, c, nullptr, nullptr);
    } else {
#pragma unroll 1
        for (int c = 7; c >= 0; --c) chunk<true, 0>(P, row0 + 16 * c, h, lbv, S, Atot, wl, wl + TILE_B, lane, nullptr, c, nullptr, nullptr);
    }
    const size_t si = ((size_t)(bh * 2 + dir)) * NSEG + scan_idx(seg, dir);
    float* su = (float*)(p.ws + WS_SEGU + si * SEGU_B) + lane; float* sa = (float*)(p.ws + WS_SEGA + si * SEGA_B) + lane;
#pragma unroll
    for (int i = 0; i < 4; ++i)
#pragma unroll
        for (int j = 0; j < 4; ++j)
#pragma unroll
            for (int r = 0; r < 4; ++r) su[((i * 4 + j) * 4 + r) * 64] = S[i][j][r];
#pragma unroll
    for (int e = 0; e < 16; ++e) sa[e * 64] = Atot[e];
}
template <bool BWD>
__device__ __forceinline__ void unit_pass2(const Ptrs& p, int layer, int pu, LAS unsigned char* wl, LAS v4f* ofl_own, LAS v4f* ofl_partner, int lane, bool active) {
    const int seg = pu % NSEG, bh = pu / NSEG, h = bh & 3, b = bh >> 2;
    const bf16* P = (const bf16*)(p.ws + WS_P); bf16* MIX = (bf16*)(p.ws + WS_MIX);
    const float* on = p.in[I_HGON] + layer * 64;
    const int row0 = seg_row0(b, seg);
    constexpr int dir = BWD ? 1 : 0;
    float Atot[16]; v4f S[4][4];
    const float* lbv = (const float*)(p.ws + WS_LB) + layer * 512 + dir * 256 + h * 64;
    if (active) {
        {
            const size_t si = ((size_t)(bh * 2 + dir)) * NSEG + scan_idx(seg, dir);
            int ln = lane; asm volatile("" : "+v"(ln));
            const float* su = (const float*)(p.ws + WS_SEGU + si * SEGU_B) + ln;
#pragma unroll
            for (int i = 0; i < 4; ++i)
#pragma unroll
                for (int j = 0; j < 4; ++j) S[i][j] = (v4f){su[((i * 4 + j) * 4 + 0) * 64], su[((i * 4 + j) * 4 + 1) * 64], su[((i * 4 + j) * 4 + 2) * 64], su[((i * 4 + j) * 4 + 3) * 64]};
        }
#pragma unroll 1
        for (int k = 0; k < 4; ++k) { const int c = BWD ? 7 - k : k; chunk<BWD, 1>(P, row0 + 16 * c, h, lbv, S, Atot, wl, wl + TILE_B, lane, ofl_own, k, MIX, on); }
    }
    __syncthreads();
    if (active) {
#pragma unroll 1
        for (int k = 4; k < 8; ++k) { const int c = BWD ? 7 - k : k; chunk<BWD, 2>(P, row0 + 16 * c, h, lbv, S, Atot, wl, wl + TILE_B, lane, ofl_partner, 7 - k, MIX, on); }
    }
}
}
constexpr int LDS_HG_OFL = 40960, HG_OFL_B = 16384;
__device__ __forceinline__ void phase_hgrn1(const Ptrs& p, LAS unsigned char* lds, int layer, int wv) {
    const int lane = otid(wv) & 63; const int u = wv * gridDim.x + blockIdx.x;
    if (u < 2 * 32 * hg::NSEG) hg::unit_pass1(p, layer, u, lds + wv * hg::WAVE_LDS, lane);
}
__device__ __forceinline__ void phase_hgrn2(const Ptrs& p, LAS unsigned char* lds, int layer, int wv) {
    const int lane = otid(wv) & 63; const int pu = (wv >> 1) * gridDim.x + blockIdx.x;
    const bool active = pu < 32 * hg::NSEG && (layer == 0 || (pu % hg::NSEG) >= 2) && wv < 6;
    LAS v4f* own = (LAS v4f*)(lds + LDS_HG_OFL + (wv < 6 ? wv : 0) * HG_OFL_B); LAS v4f* partner = (LAS v4f*)(lds + LDS_HG_OFL + (wv < 6 ? (wv ^ 1) : 0) * HG_OFL_B);
    if (wv & 1) hg::unit_pass2<true>(p, layer, pu, lds + wv * hg::WAVE_LDS, own, partner, lane, active);
    else        hg::unit_pass2<false>(p, layer, pu, lds + wv * hg::WAVE_LDS, own, partner, lane, active);
}

__device__ __forceinline__ void phase_hgrn_scan(const Ptrs& p, int wv) {
    const int t = blockIdx.x * NT + otid(wv);
#pragma unroll 1
    for (int half = 0; half < 2; ++half) {
        const int e = t + half * (int)(gridDim.x * NT);
        if (e >= 64 * 4096) break;
        const int bhd = e >> 12, r = (e >> 6) & 63, l = e & 63;
        float* su = (float*)(p.ws + hg::WS_SEGU + (size_t)bhd * hg::NSEG * hg::SEGU_B) + r * 64 + l;
        const float* sa = (const float*)(p.ws + hg::WS_SEGA + (size_t)bhd * hg::NSEG * hg::SEGA_B) + (4 * (r >> 4) + (r & 3)) * 64 + l;
        float u[hg::NSEG], a[hg::NSEG];
#pragma unroll
        for (int j = 0; j < hg::NSEG; ++j) { u[j] = su[(size_t)j * 4096]; a[j] = sa[(size_t)j * 1024]; }
        float st = 0.f;
#pragma unroll
        for (int j = 0; j < hg::NSEG; ++j) { su[(size_t)j * 4096] = st; st = a[j] * st + u[j]; }
    }
}
namespace att {
using bf16=unsigned short;
using bf16x8=__attribute__((ext_vector_type(8)))short;
using s16x4=__attribute__((ext_vector_type(4)))short;
using f32x16=__attribute__((ext_vector_type(16)))float;
using u32x4=__attribute__((ext_vector_type(4)))unsigned;
constexpr int D=64,PIN_=DIN,POUT=DM;
constexpr int NW=8,QBLK=32,QB=QBLK*NW,KVBLK=64;
__device__ __forceinline__ int crow(int r,int hi){return (r&3)+8*(r>>2)+4*hi;}
#define SBAR() __builtin_amdgcn_sched_barrier(0)
constexpr int NSLOT=3, SLOTB=8192;
constexpr int LDS_K=0, LDS_V=NSLOT*SLOTB, LDS_WS=2*NSLOT*SLOTB, LDS_OST=LDS_WS+NW*64*4, LDS_BYTES=LDS_OST+NW*4096;
constexpr float C2=0.125f*1.4426950408889634f;
__device__ __forceinline__ void glds16(const void*gsrc,unsigned lds_dst){unsigned keep;
  asm volatile("s_mov_b32 %0, m0\n\ts_mov_b32 m0, %2\n\ts_nop 0\n\tglobal_load_lds_dwordx4 %1, off\n\ts_mov_b32 m0, %0":"=&s"(keep):"v"(gsrc),"s"(lds_dst):"memory");}
__device__ __forceinline__ float max3f(float a,float b,float c){float r;asm("v_max3_f32 %0, %1, %2, %3":"=v"(r):"v"(a),"v"(b),"v"(c));return r;}
__device__ __forceinline__ float max2f(float a,float b){float r;asm("v_max_f32_e32 %0, %1, %2":"=v"(r):"v"(a),"v"(b));return r;}
__device__ __forceinline__ float fadd_s(float a,float b){float r;asm("v_add_f32_e32 %0, %1, %2":"=v"(r):"v"(a),"v"(b));return r;}
__device__ __forceinline__ float fsub_s(float a,float b){float r;asm("v_sub_f32_e32 %0, %1, %2":"=v"(r):"v"(a),"v"(b));return r;}
typedef float f32x2_t __attribute__((ext_vector_type(2))); typedef __bf16 bf16x2_t __attribute__((ext_vector_type(2)));
__device__ __forceinline__ unsigned cvtpk_s(float lo,float hi){f32x2_t v={lo,hi};bf16x2_t b=__builtin_convertvector(v,bf16x2_t);return __builtin_bit_cast(unsigned,b);}
#define WAIT_BAR(N) asm volatile("s_waitcnt vmcnt(" #N ") lgkmcnt(0)\n\ts_barrier":::"memory")

__device__ __forceinline__ void qkt(f32x16&p0,f32x16&p1,const char*Kslot,const bf16x8*qr,const f32x16&negm,int r32,int hi){
  const char*kb=Kslot+hi*1024+r32*16;
  #pragma unroll
  for(int d0=0;d0<4;++d0){
    const bf16x8 b0=*reinterpret_cast<const bf16x8*>(kb+d0*2048);
    const bf16x8 b1=*reinterpret_cast<const bf16x8*>(kb+d0*2048+512);
    if(d0==0){p0=__builtin_amdgcn_mfma_f32_32x32x16_bf16(b0,qr[0],negm,0,0,0);p1=__builtin_amdgcn_mfma_f32_32x32x16_bf16(b1,qr[0],negm,0,0,0);}
    else{p0=__builtin_amdgcn_mfma_f32_32x32x16_bf16(b0,qr[d0],p0,0,0,0);p1=__builtin_amdgcn_mfma_f32_32x32x16_bf16(b1,qr[d0],p1,0,0,0);}}
}
typedef __attribute__((address_space(3))) const char* lds_cptr;
typedef short v4i16_t __attribute__((ext_vector_type(4)));
__device__ __forceinline__ void kload8(bf16x8*kf,lds_cptr kp){
  kf[0]=*(const __attribute__((address_space(3))) bf16x8*)(kp);      kf[1]=*(const __attribute__((address_space(3))) bf16x8*)(kp+512);
  kf[2]=*(const __attribute__((address_space(3))) bf16x8*)(kp+2048); kf[3]=*(const __attribute__((address_space(3))) bf16x8*)(kp+2560);
  kf[4]=*(const __attribute__((address_space(3))) bf16x8*)(kp+4096); kf[5]=*(const __attribute__((address_space(3))) bf16x8*)(kp+4608);
  kf[6]=*(const __attribute__((address_space(3))) bf16x8*)(kp+6144); kf[7]=*(const __attribute__((address_space(3))) bf16x8*)(kp+6656);
}
__device__ __forceinline__ void kload2(bf16x8*kf,lds_cptr kp,int j){ kf[2*j]=*(const __attribute__((address_space(3))) bf16x8*)(kp+j*2048); kf[2*j+1]=*(const __attribute__((address_space(3))) bf16x8*)(kp+j*2048+512); }
__device__ __forceinline__ s16x4 vtr(lds_cptr p){ return __builtin_bit_cast(s16x4,__builtin_amdgcn_ds_read_tr16_b64_v4i16((__attribute__((address_space(3))) v4i16_t*)p)); }
__device__ __forceinline__ float rowmax(const f32x16&p0,const f32x16&p1){
  float a=max3f(p0[0],p0[1],p1[0]),b=max3f(p0[2],p0[3],p1[1]);a=max3f(a,p1[2],p1[3]);
  #pragma unroll
  for(int r=4;r<16;r+=4){a=max3f(a,p0[r],p0[r+1]);b=max3f(b,p0[r+2],p0[r+3]);a=max3f(a,p1[r],p1[r+1]);b=max3f(b,p1[r+2],p1[r+3]);}
  const float m=max2f(a,b);
  auto rr=__builtin_amdgcn_permlane32_swap(__float_as_uint(m),__float_as_uint(m),false,false);
  return max2f(__uint_as_float(rr[0]),__uint_as_float(rr[1]));
}
__device__ __forceinline__ void pv(f32x16*o,int vb,bf16x8 pa0,bf16x8 pa1,bf16x8 pa2,bf16x8 pa3){
  #pragma unroll
  for(int d0=0;d0<2;++d0){s16x4 lo[4],hi[4];
    #pragma unroll
    for(int ks=0;ks<4;++ks){
      asm volatile("ds_read_b64_tr_b16 %0,%1 offset:%c2":"=&v"(lo[ks]):"v"(vb),"i"(d0*4096+ks*1024):"memory");
      asm volatile("ds_read_b64_tr_b16 %0,%1 offset:%c2":"=&v"(hi[ks]):"v"(vb),"i"(d0*4096+ks*1024+512):"memory");}
    asm volatile("s_waitcnt lgkmcnt(0)":::"memory");SBAR();
    #define PK(k) (bf16x8){lo[k][0],lo[k][1],lo[k][2],lo[k][3],hi[k][0],hi[k][1],hi[k][2],hi[k][3]}
    o[d0]=__builtin_amdgcn_mfma_f32_32x32x16_bf16(pa0,PK(0),o[d0],0,0,0);
    o[d0]=__builtin_amdgcn_mfma_f32_32x32x16_bf16(pa1,PK(1),o[d0],0,0,0);
    o[d0]=__builtin_amdgcn_mfma_f32_32x32x16_bf16(pa2,PK(2),o[d0],0,0,0);
    o[d0]=__builtin_amdgcn_mfma_f32_32x32x16_bf16(pa3,PK(3),o[d0],0,0,0);
    #undef PK
  }
}

#ifndef ATTN_STORE16
#define ATTN_STORE16(p,v) (*(u32x4*)(p)=(v))
#endif
template<int THRL,class Hook> __device__ __forceinline__ void attn_unit(const bf16*Q0,const bf16*__restrict__ Kh,const bf16*__restrict__ Vh,int rowa,int na,int rowb,int NT,bf16*O0,const Hook&hook,char*shm,int wid){
  const int lane=otid(wid)&63,r32=lane&31,hi=lane>>5;
  const bf16*Qw=Q0+(long)(wid*QBLK)*PIN_;
  #define TROW(t) ((long)(((t)<na)?(rowa+64*(t)):(rowb+64*((t)-na))))
  const unsigned lds0=(unsigned)(uintptr_t)shm;
  float*wsf=(float*)(shm+LDS_WS)+wid*64;
  const bf16*ksrc=Kh+(long)lane*PIN_+wid*8;
  const bf16*vsrc=Vh+(long)(16*(wid&3)+(lane>>2))*PIN_+(wid>>2)*32+(lane&3)*8;
  const unsigned kdst=lds0+LDS_K+wid*1024, vdst=lds0+LDS_V+wid*1024;
  #define DMA_K(t,slot) glds16(ksrc+TROW(t)*PIN_,(unsigned)__builtin_amdgcn_readfirstlane(kdst+(slot)))
  #define DMA_V(t,slot) glds16(vsrc+TROW(t)*PIN_,(unsigned)__builtin_amdgcn_readfirstlane(vdst+(slot)))
  const int vb0=(int)(lds0+LDS_V)+((lane>>4)&1)*32+(lane&3)*8+(4*hi+((lane&15)>>2))*64;
  const char*Kbase=shm+LDS_K; bf16x8 kf[8];
  const lds_cptr shm3=(lds_cptr)shm; const lds_cptr kp0=shm3+LDS_K+hi*1024+r32*16; const lds_cptr vp0=shm3+LDS_V+((lane>>4)&1)*32+(lane&3)*8+(4*hi+((lane&15)>>2))*64;
  DMA_K(0,0);DMA_V(0,0);DMA_K(1,SLOTB);
  bf16x8 qr[4];
  #pragma unroll
  for(int d0=0;d0<4;++d0)qr[d0]=*reinterpret_cast<const bf16x8*>(&Qw[(long)r32*PIN_+d0*16+hi*8]);
  float zz_=0.f; asm volatile("":"+v"(zz_));
  float mhat=zz_,l_reg=zz_;f32x16 o[2],negm;
  #pragma unroll
  for(int r=0;r<16;++r){o[0][r]=zz_;o[1][r]=zz_;negm[r]=zz_;}
  asm volatile("":"+v"(negm));
  #define CMASK(P0,P1,t) hook(P0,P1,(t),wid,r32,hi)
  bool resc=false;
  #define START(P0,P1) do{ const float rm=rowmax(P0,P1); resc=false; \
    { const float dl=rm; mhat=fadd_s(mhat,dl); \
      _Pragma("unroll") for(int r=0;r<16;++r){P0[r]=fsub_s(P0[r],dl);P1[r]=fsub_s(P1[r],dl);} \
      _Pragma("unroll") for(int r=0;r<16;++r)negm[r]=-mhat; asm volatile("":"+v"(negm)); } \
    _Pragma("unroll") for(int r=0;r<16;++r)P0[r]=__builtin_amdgcn_exp2f(P0[r]); }while(0)
  #define RESC() do{ if(resc){ asm volatile("s_waitcnt lgkmcnt(0)":::"memory"); \
      _Pragma("unroll") for(int d_=0;d_<2;++d_) _Pragma("unroll") for(int r=0;r<16;++r)o[d_][r]*=wsf[crow(r,hi)]; } }while(0)
  f32x16 pA0,pA1,pB0,pB1;
  int sl_prev=0,sl_cur=0,sl_next=SLOTB;
  #define ROT() do{sl_prev=sl_cur;sl_cur=sl_next;sl_next=(sl_next==(NSLOT-1)*SLOTB)?0:sl_next+SLOTB;}while(0)
  DMA_K(2,2*SLOTB);
  WAIT_BAR(3);
  qkt(pA0,pA1,Kbase,qr,negm,r32,hi);asm volatile("s_nop 15\n\ts_nop 7":"+v"(pA0),"+v"(pA1));
  START(pA0,pA1);
  _Pragma("unroll") for(int r=0;r<16;++r)pA1[r]=__builtin_amdgcn_exp2f(pA1[r]);
  WAIT_BAR(0);
  DMA_K(3,0);DMA_V(1,SLOTB);
  ROT();
  kload8(kf,kp0+sl_cur);
  WAIT_BAR(2);
  s16x4 vlo[8],vhi[8]; u32x4 pw0,pw1,pw2,pw3;
  #define PKW(P,B) cvtpk_s(P[B],P[B+1])
  #define PAF(k) __builtin_bit_cast(bf16x8,pw##k)
  #define VFR(i) (bf16x8){vlo[i][0],vlo[i][1],vlo[i][2],vlo[i][3],vhi[i][0],vhi[i][1],vhi[i][2],vhi[i][3]}
  #define PIN(x) asm volatile("":"+v"(x))
  #define MX3(a,b,c) __builtin_fmaxf(__builtin_fmaxf((a),(b)),(c))
  #define GAPA(MF,A0,A1,A2,A3,W0,W1,PW) do{ MF; sacc+=A0; sacc+=A1; sacc+=A2; sacc+=A3; PIN(sacc); W0; W1; PIN(PW); SBAR(); }while(0)
  #define EX(v) __builtin_amdgcn_exp2f(v)
  #define GAPB(MF,X,B) do{ MF; X[B]=EX(X[B]); X[B+1]=EX(X[B+1]); X[B+2]=EX(X[B+2]); X[B+3]=EX(X[B+3]); PIN(X); SBAR(); }while(0)
  #define VRD(i) do{ vlo[i]=vtr(vp_+(((i)>>2)*4096+((i)&3)*1024)); vhi[i]=vtr(vp_+(((i)>>2)*4096+((i)&3)*1024+512)); }while(0)
  #define KRD(G,j) do{ if(G){ kload2(kf,kp0+sl_next,j); SBAR(); } }while(0)
  #define STEP(C0,C1,P0,P1,t,GK,GV,GL) do{ SBAR(); \
    const lds_cptr vp_=vp0+sl_prev; \
    VRD(0); SBAR(); float sacc=(P0[0]+P0[1]); \
    GAPA(C0=__builtin_amdgcn_mfma_f32_32x32x16_bf16(kf[0],qr[0],negm,0,0,0), P0[2],P0[3],P0[4],P0[5],     pw0[0]=PKW(P0,0), pw0[1]=PKW(P0,2), pw0); \
    VRD(4); SBAR(); GAPA(C1=__builtin_amdgcn_mfma_f32_32x32x16_bf16(kf[1],qr[0],negm,0,0,0), P0[6],P0[7],P0[8],P0[9],     pw0[2]=PKW(P0,4), pw0[3]=PKW(P0,6), pw0); \
    VRD(1); SBAR(); GAPA(C0=__builtin_amdgcn_mfma_f32_32x32x16_bf16(kf[2],qr[1],C0,0,0,0),   P0[10],P0[11],P0[12],P0[13], pw1[0]=PKW(P0,8), pw1[1]=PKW(P0,10), pw1); \
    VRD(5); SBAR(); GAPA(C1=__builtin_amdgcn_mfma_f32_32x32x16_bf16(kf[3],qr[1],C1,0,0,0),   P0[14],P0[15],P1[0],P1[1],   pw1[2]=PKW(P0,12),pw1[3]=PKW(P0,14), pw1); \
    VRD(2); SBAR(); GAPA(C0=__builtin_amdgcn_mfma_f32_32x32x16_bf16(kf[4],qr[2],C0,0,0,0),   P1[2],P1[3],P1[4],P1[5],     pw2[0]=PKW(P1,0), pw2[1]=PKW(P1,2), pw2); \
    VRD(6); SBAR(); GAPA(C1=__builtin_amdgcn_mfma_f32_32x32x16_bf16(kf[5],qr[2],C1,0,0,0),   P1[6],P1[7],P1[8],P1[9],     pw2[2]=PKW(P1,4), pw2[3]=PKW(P1,6), pw2); \
    VRD(3); SBAR(); GAPA(C0=__builtin_amdgcn_mfma_f32_32x32x16_bf16(kf[6],qr[3],C0,0,0,0),   P1[10],P1[11],P1[12],P1[13], pw3[0]=PKW(P1,8), pw3[1]=PKW(P1,10), pw3); \
    VRD(7); SBAR(); GAPA(C1=__builtin_amdgcn_mfma_f32_32x32x16_bf16(kf[7],qr[3],C1,0,0,0),   P1[14],P1[15],0.f,0.f,       pw3[2]=PKW(P1,12),pw3[3]=PKW(P1,14), pw3); \
    l_reg+=sacc; \
    if(GK){DMA_K((t)+3,sl_cur);} if(GV){DMA_V((t)+1,sl_next);} \
    CMASK(C0,C1,t); \
    { float a=MX3(C0[0],C0[1],C1[0]),b=MX3(C0[2],C0[3],C1[1]); a=MX3(a,C1[2],C1[3]); \
      _Pragma("unroll") for(int r=4;r<16;r+=4){a=MX3(a,C0[r],C0[r+1]);b=MX3(b,C0[r+2],C0[r+3]);a=MX3(a,C1[r],C1[r+1]);b=MX3(b,C1[r+2],C1[r+3]);} \
      float rm=__builtin_fmaxf(a,b); { auto rr=__builtin_amdgcn_permlane32_swap(__float_as_uint(rm),__float_as_uint(rm),false,false); rm=__builtin_fmaxf(__uint_as_float(rr[0]),__uint_as_float(rr[1])); } \
      resc=false; \
      if(__builtin_expect(__any(rm>(float)THRL),0)){ const float dl=__builtin_fmaxf(rm,0.f); mhat+=dl; \
        _Pragma("unroll") for(int r=0;r<16;++r){C0[r]-=dl;C1[r]-=dl;} \
        _Pragma("unroll") for(int r=0;r<16;++r)negm[r]=-mhat; asm volatile("":"+v"(negm)); \
        const float f=__builtin_amdgcn_exp2f(-dl); l_reg*=f; if(hi==0)wsf[r32]=f; resc=true; } } \
    SBAR(); \
    GAPB(o[0]=__builtin_amdgcn_mfma_f32_32x32x16_bf16(PAF(0),VFR(0),o[0],0,0,0), C0,0); \
    GAPB(o[1]=__builtin_amdgcn_mfma_f32_32x32x16_bf16(PAF(0),VFR(4),o[1],0,0,0), C0,4); \
    KRD(GL,0); GAPB(o[0]=__builtin_amdgcn_mfma_f32_32x32x16_bf16(PAF(1),VFR(1),o[0],0,0,0), C0,8); \
    KRD(GL,1); GAPB(o[1]=__builtin_amdgcn_mfma_f32_32x32x16_bf16(PAF(1),VFR(5),o[1],0,0,0), C0,12); \
    KRD(GL,2); GAPB(o[0]=__builtin_amdgcn_mfma_f32_32x32x16_bf16(PAF(2),VFR(2),o[0],0,0,0), C1,0); \
    KRD(GL,3); GAPB(o[1]=__builtin_amdgcn_mfma_f32_32x32x16_bf16(PAF(2),VFR(6),o[1],0,0,0), C1,4); \
    GAPB(o[0]=__builtin_amdgcn_mfma_f32_32x32x16_bf16(PAF(3),VFR(3),o[0],0,0,0), C1,8); \
    GAPB(o[1]=__builtin_amdgcn_mfma_f32_32x32x16_bf16(PAF(3),VFR(7),o[1],0,0,0), C1,12); \
    }while(0)
  int t=1;
  for(;t+5<NT;t+=2){
    STEP(pB0,pB1,pA0,pA1,t,true,true,true);     WAIT_BAR(2); RESC(); ROT();
    STEP(pA0,pA1,pB0,pB1,t+1,true,true,true);   WAIT_BAR(2); RESC(); ROT();
  }
  #define ENDW(tt) do{ if((tt)+3<NT){WAIT_BAR(2);} else if((tt)+2<NT){WAIT_BAR(1);} else {WAIT_BAR(0);} }while(0)
  for(;t+1<NT;t+=2){
    STEP(pB0,pB1,pA0,pA1,t,(t+3<NT),(t+1<NT),(t+1<NT));       ENDW(t);   RESC(); ROT();
    STEP(pA0,pA1,pB0,pB1,t+1,(t+4<NT),(t+2<NT),(t+2<NT));     ENDW(t+1); RESC(); ROT();
  }
  STEP(pB0,pB1,pA0,pA1,NT-1,false,false,false); RESC();
  { float sacc=pB0[0]+pB0[1]; _Pragma("unroll") for(int r=2;r<16;++r)sacc+=pB0[r]; _Pragma("unroll") for(int r=0;r<16;++r)sacc+=pB1[r]; l_reg+=sacc;
    pw0=(u32x4){PKW(pB0,0),PKW(pB0,2),PKW(pB0,4),PKW(pB0,6)};pw1=(u32x4){PKW(pB0,8),PKW(pB0,10),PKW(pB0,12),PKW(pB0,14)};pw2=(u32x4){PKW(pB1,0),PKW(pB1,2),PKW(pB1,4),PKW(pB1,6)};pw3=(u32x4){PKW(pB1,8),PKW(pB1,10),PKW(pB1,12),PKW(pB1,14)};
    SBAR(); pv(o,vb0+sl_cur,PAF(0),PAF(1),PAF(2),PAF(3)); }
  #undef PKW
  #undef PAF
  #undef VFR
  #undef PIN
  #undef MX3
  #undef GAPA
  #undef GAPB
  #undef EX
  #undef VRD
  #undef KRD
  #undef STEP
  #undef ENDW
  {auto rr=__builtin_amdgcn_permlane32_swap(__float_as_uint(l_reg),__float_as_uint(l_reg),false,false);l_reg=__uint_as_float(rr[0])+__uint_as_float(rr[1]);}
  if(hi==0)wsf[32+r32]=l_reg;asm volatile("s_waitcnt lgkmcnt(0)":::"memory");
  float rli[16];
  #pragma unroll
  for(int r=0;r<16;++r)rli[r]=__builtin_amdgcn_rcpf(wsf[32+crow(r,hi)]);
  bf16*Ow=O0+(long)(wid*QBLK)*POUT;
  { bf16*stg=(bf16*)(shm+LDS_OST)+wid*2048;
    #pragma unroll
    for(int r=0;r<16;++r){const int orow=crow(r,hi);
      #pragma unroll
      for(int d0=0;d0<2;++d0)stg[orow*64+d0*32+r32]=(bf16)f2bf(o[d0][r]*rli[r]);}
    asm volatile("s_waitcnt lgkmcnt(0)":::"memory");
    #pragma unroll
    for(int i=0;i<4;++i){const int row=i*8+(lane>>3),ch=lane&7; const u32x4 v=*(const u32x4*)(stg+row*64+ch*8); ATTN_STORE16(Ow+(long)row*POUT+ch*8,v);} }
  asm volatile("s_waitcnt lgkmcnt(0)\n\ts_barrier":::"memory");
  #undef DMA_K
  #undef DMA_V
  #undef TROW
  #undef CMASK
  #undef START
  #undef RESC
  #undef ROT
}
constexpr int ATTN_LDS_BYTES=LDS_BYTES;
#undef SBAR
#undef WAIT_BAR
}

namespace pg8 {
struct EpiInProj {
    static constexpr bool PERM = true, AFTER_DRAIN = false;
    bf16_t* P; const float* na_qn; const float* na_kn; const float* gq_qn; const float* gq_kn; int wv;
    __device__ __forceinline__ void operator()(const f32x4 (&acc)[2][2][4][2], const Unit& u, int, int, int, int) const {
        const int l_ = otid(wv) & 63, fr = l_ & 15, fq = l_ >> 4, wr = wv >> 2, wc = wv & 3;
        const int pn = u.pn, rowt = u.pm * BM;
        int mode = 0; const float* gain = na_qn; float qs = 1.f;
        if (pn == 0) { mode = 1; gain = na_qn; qs = att::C2; }
        else if (pn == 1) { mode = 1; gain = na_kn; }
        else if (pn == 3 || pn == 4) { mode = 2; gain = gq_qn; qs = att::C2; }
        else if (pn == 5 && wc < 2) { mode = 2; gain = gq_kn; }
        if (mode == 2 && rowt >= NLAT) mode = 1;
        bf16_t* pcol = P + pn * BM + 64 * wc + 8 * fq;
        if (mode == 0) {
#pragma unroll
            for (int ai = 0; ai < 2; ++ai)
#pragma unroll
                for (int m = 0; m < 4; ++m) { bf16_t* rowp = pcol + (size_t)(rowt + ai * HALF + wr * 64 + m * 16 + fr) * DIN;
#pragma unroll
                    for (int bj = 0; bj < 2; ++bj) { const f32x4 v0 = acc[ai][bj][m][0], v1 = acc[ai][bj][m][1];
                        u32x4 w; w.x = cvt_pk_bf16(v0[0], v0[1]); w.y = cvt_pk_bf16(v0[2], v0[3]); w.z = cvt_pk_bf16(v1[0], v1[1]); w.w = cvt_pk_bf16(v1[2], v1[3]);
                        *(u32x4*)(rowp + 32 * bj) = w; } }
            return;
        }
        f32x4 g[2][2]; float invf[2][2];
#pragma unroll
        for (int bj = 0; bj < 2; ++bj)
#pragma unroll
            for (int n = 0; n < 2; ++n) g[bj][n] = *(const f32x4*)(gain + 32 * bj + 8 * fq + 4 * n) * qs;
#pragma unroll
        for (int n = 0; n < 2; ++n)
#pragma unroll
            for (int pp = 0; pp < 2; ++pp) invf[n][pp] = exp2f(-(float)(4 * fq + 2 * n + pp) * (13.287712379549449f / 16.f));
#pragma unroll
        for (int ai = 0; ai < 2; ++ai)
#pragma unroll
            for (int m = 0; m < 4; ++m) {
                const int row = rowt + ai * HALF + wr * 64 + m * 16 + fr;
                f32x4 v[2][2]; float ss = 0.f;
#pragma unroll
                for (int bj = 0; bj < 2; ++bj)
#pragma unroll
                    for (int n = 0; n < 2; ++n) { v[bj][n] = acc[ai][bj][m][n]; ss += (v[bj][n][0] * v[bj][n][0] + v[bj][n][1] * v[bj][n][1]) + (v[bj][n][2] * v[bj][n][2] + v[bj][n][3] * v[bj][n][3]); }
                ss += shx(ss, 16, l_); ss += shx(ss, 32, l_);
                const float rstd = rsqrtf(ss * (1.f / 64.f) + 1e-6f);
#pragma unroll
                for (int bj = 0; bj < 2; ++bj)
#pragma unroll
                    for (int n = 0; n < 2; ++n) {
                        if (mode == 2) {
                        }
                        v[bj][n] = v[bj][n] * rstd * g[bj][n];
                    }
                if (mode == 2) {
                    const int t = row & (SEQ - 1); const float pos[2] = {(float)(t >> 6), (float)(t & 63)};
#pragma unroll
                    for (int bj = 0; bj < 2; ++bj)
#pragma unroll
                        for (int n = 0; n < 2; ++n)
#pragma unroll
                            for (int pp = 0; pp < 2; ++pp) {
                                const float ang = pos[bj] * invf[n][pp], cs = __cosf(ang), sn = __sinf(ang);
                                const float x1 = v[bj][n][2 * pp], x2 = v[bj][n][2 * pp + 1];
                                v[bj][n][2 * pp] = x1 * cs - x2 * sn; v[bj][n][2 * pp + 1] = x1 * sn + x2 * cs;
                            }
                }
                bf16_t* rowp = pcol + (size_t)row * DIN;
#pragma unroll
                for (int bj = 0; bj < 2; ++bj) { const f32x4 v0 = v[bj][0], v1 = v[bj][1];
                    u32x4 w; w.x = cvt_pk_bf16(v0[0], v0[1]); w.y = cvt_pk_bf16(v0[2], v0[3]); w.z = cvt_pk_bf16(v1[0], v1[1]); w.w = cvt_pk_bf16(v1[2], v1[3]);
                    *(u32x4*)(rowp + 32 * bj) = w; }
                asm volatile("" ::: "memory");
            }
    }
};
}

__device__ __forceinline__ void w_qknorm_rope(const Ptrs& p, int layer, int unit, int d) {
    const int row = unit / 18, slot = unit % 18;
    int col; const float* gain; bool rope;
    if (slot < 4) { col = A_Q + slot * 64; gain = p.in[I_NAQN] + layer * 64; rope = false; }
    else if (slot < 8) { col = A_K + (slot - 4) * 64; gain = p.in[I_NAKN] + layer * 64; rope = false; }
    else if (slot < 16) { col = B_Q + (slot - 8) * 64; gain = p.in[I_GQQN] + layer * 64; rope = true; }
    else { col = B_K + (slot - 16) * 64; gain = p.in[I_GQKN] + layer * 64; rope = true; }
    bf16* pp = (bf16*)(p.ws + WS_P) + (size_t)row * DIN + col;
    float x = bf2f(pp[d]);
    float ss = wave_sum(x * x, d);
    float y = x * rsqrtf(ss * (1.f / 64.f) + 1e-6f) * gain[d];
    if (rope && row < NLAT) {
        int t = row & (SEQ - 1);
        float partner = shx(y, 1, d);
        int pi = d >> 1;
        float pos = (pi < 16) ? (float)(t >> 6) : (float)(t & 63);
        float inv = exp2f(-(float)(pi & 15) * (13.287712379549449f / 16.f));
        float ang = pos * inv;
        float cs = __cosf(ang), sn = __sinf(ang);
        y = (d & 1) ? (partner * sn + y * cs) : (y * cs - partner * sn);
    }
    if (slot < 4 || (slot >= 8 && slot < 16)) y *= att::C2;
    pp[d] = (bf16)f2bf(y);
}
struct NoHook { __device__ __forceinline__ void operator()(att::f32x16&, att::f32x16&, int, int, int, int) const {} };
struct NaHook {
    const LAS float* tab; int r0, kr0;
    __device__ __forceinline__ void operator()(att::f32x16& p0, att::f32x16& p1, int t, int wid, int r32, int hi) const {
        if (t < 4) return;
        const int r = r0 + (wid >> 1), kr = kr0 + t - 4, rs = min(max(r - 4, 0), 24);
        const float NEG = -INFINITY;
        if ((unsigned)(kr - rs) >= 8u) {
#pragma unroll
            for (int i = 0; i < 16; ++i) { p0[i] = NEG; p1[i] = NEG; }
            return;
        }
        const int qc = 32 * (wid & 1) + r32, cs = min(max(qc - 8, 0), 48), kb = 4 * hi - cs;
        const LAS float* tp = tab + (kr - r + 7) * 31 + (4 * hi - qc + 15);
#pragma unroll
        for (int i = 0; i < 16; ++i) {
            const int c = (i & 3) + 8 * (i >> 2);
            const float b0 = tp[c], b1 = tp[c + 32];
            p0[i] = ((unsigned)(kb + c) < 16u) ? p0[i] + b0 : NEG;
            p1[i] = ((unsigned)(kb + c + 32) < 16u) ? p1[i] + b1 : NEG;
        }
    }
};
constexpr int LDS_NATAB = 88064;
__device__ __forceinline__ void phase_attn(const Ptrs& p, unsigned char* lds_gen, int layer, int wv) {
    const bf16* P = (const bf16*)(p.ws + WS_P); bf16* MIX = (bf16*)(p.ws + WS_MIX);
    char* shm = (char*)lds_gen;
    const int c = blockIdx.x, x = c & 7, ci = (c >> 3) & 31;
    for (int i = 0; i < 2; ++i) {
        const int grp = 2 * x + i, b = grp >> 1, kvh = grp & 1, g = ci >> 3, qb = ci & 7, hq = kvh * 4 + g;
        const size_t qrow = (size_t)b * SEQ + qb * 256;
        att::attn_unit<8, NoHook>(P + qrow * DIN + B_Q + hq * 64, P + B_K + kvh * 64, P + B_V + kvh * 64, b * SEQ, 32, NLAT + b * CTXL, 36,
                                  MIX + qrow * DM + 256 + hq * 64, NoHook{}, shm, wv);
    }
    {
        const int grp = 4 * x + (ci >> 3), b = grp >> 2, h = grp & 3, r0 = 4 * (ci & 7);
        const int kr0 = (r0 == 0) ? 0 : (r0 == 28 ? 24 : r0 - 4), nr = (r0 == 0 || r0 == 28) ? 8 : 12;
        LAS float* tab = (LAS float*)((LAS unsigned char*)lds_gen + LDS_NATAB);
        const float* rpb = p.in[I_RPB] + ((size_t)layer * 4 + h) * 15 * 31;
        for (int i = otid(wv); i < 15 * 31; i += NT) tab[i] = rpb[i] * 1.4426950408889634f;
        __syncthreads();
        const size_t qrow = (size_t)b * SEQ + r0 * 64;
        NaHook hook{tab, r0, kr0};
        att::attn_unit<8, NaHook>(P + qrow * DIN + A_Q + h * 64, P + A_K + h * 64, P + A_V + h * 64, NLAT + b * CTXL, 4, b * SEQ + kr0 * 64, 4 + nr,
                                  MIX + qrow * DM + h * 64, hook, shm, wv);
    }
    if (layer == 0 && c < 96) {
        if (c < 32) {
            const int b = c >> 2, h = c & 3; const size_t qrow = (size_t)NLAT + b * CTXL;
            att::attn_unit<8, NoHook>(P + qrow * DIN + A_Q + h * 64, P + A_K + h * 64, P + A_V + h * 64, NLAT + b * CTXL, 4, 0, 4, MIX + qrow * DM + h * 64, NoHook{}, shm, wv);
        } else {
            const int cc = c - 32, b = cc >> 3, hq = cc & 7, kvh = hq >> 2; const size_t qrow = (size_t)NLAT + b * CTXL;
            att::attn_unit<8, NoHook>(P + qrow * DIN + B_Q + hq * 64, P + B_K + kvh * 64, P + B_V + kvh * 64, NLAT + b * CTXL, 4, 0, 4, MIX + qrow * DM + 256 + hq * 64, NoHook{}, shm, wv);
        }
    }
}


#define XB_TMO      128
#define XB_XCNT(j)  (256  + 64 * (j))
#define XB_XSUB(j)  (1280 + 64 * (j))
#define XB_XGEN(j)  (2304 + 64 * (j))
#define XB_TOP      3328
#define XB_TOPGEN   3392
#define XCD_BAR_WORDS 3456
#define XB_SPIN_CAP (1u << 18)
constexpr int CW_BAR = 4096;
constexpr int LDS_XB = LDS_BYTES - 64;
__device__ __forceinline__ unsigned xb_ld(unsigned* p)              { return __hip_atomic_load(p, __ATOMIC_RELAXED, __HIP_MEMORY_SCOPE_AGENT); }
__device__ __forceinline__ unsigned xb_add(unsigned* p, unsigned v) { return __hip_atomic_fetch_add(p, v, __ATOMIC_RELAXED, __HIP_MEMORY_SCOPE_AGENT); }
__device__ __forceinline__ unsigned xb_xcc_id() { return (unsigned)__builtin_amdgcn_s_getreg((3 << 11) | 20) & 0xFu; }
#define XB_SPIN(cond, bar) do { unsigned _sp = 0; while (cond) { __builtin_amdgcn_s_sleep(1); \
    if ((++_sp & 255u) == 0u) { if (xb_ld(&(bar)[XB_TMO])) break; if (_sp > XB_SPIN_CAP) { atomicAdd(&(bar)[XB_TMO], 1u); break; } } } } while (0)
struct XcdBarrier { unsigned* bar; unsigned x; volatile LAS unsigned* st; };
__device__ __forceinline__ XcdBarrier xcd_barrier_post(unsigned* bar, volatile LAS unsigned* st, int wv) {
    XcdBarrier b; b.bar = bar; b.x = xb_xcc_id(); b.st = st;
    if (otid(wv) == 0) (void)xb_add(&bar[XB_XCNT(b.x)], 1u);
    return b;
}
__device__ __forceinline__ void xcd_barrier_complete(unsigned* bar, unsigned x, unsigned& nloc, unsigned& nx) {
    const unsigned G = gridDim.x * gridDim.y * gridDim.z;
    unsigned sum, cnt, mine, sp = 0u;
    for (;;) {
        sum = 0u; cnt = 0u; mine = 0u;
#pragma unroll
        for (unsigned j = 0; j < 16; ++j) { const unsigned c = xb_ld(&bar[XB_XCNT(j)]); sum += c; cnt += (c > 0u) ? 1u : 0u; mine = (j == x) ? c : mine; }
        if (sum == G) break;
        __builtin_amdgcn_s_sleep(1);
        if ((++sp & 255u) == 0u) { if (xb_ld(&bar[XB_TMO])) break; if (sp > XB_SPIN_CAP) { atomicAdd(&bar[XB_TMO], 1u); break; } }
    }
    nloc = mine > 0u ? mine : 1u; nx = cnt > 0u ? cnt : 1u;
}
__device__ __forceinline__ void xcd_barrier(const XcdBarrier& b, int wv) {
    asm volatile("s_waitcnt vmcnt(0)" ::: "memory");
    __syncthreads();
    if (otid(wv) == 0) {
        unsigned* bar = b.bar; unsigned bx = b.x; asm volatile("" : "+s"(bx));
        __builtin_amdgcn_s_waitcnt(0);
        unsigned nloc = b.st[0], nx = b.st[1];
        if (nloc == 0u) { xcd_barrier_complete(bar, bx, nloc, nx); b.st[0] = nloc; b.st[1] = nx; }
        const unsigned old = xb_add(&bar[XB_XSUB(bx)], 1u);
        const unsigned gen = old / nloc;
        if (old + 1u == (gen + 1u) * nloc) {
            __builtin_amdgcn_fence(__ATOMIC_RELEASE, "agent");
            asm volatile("s_waitcnt vmcnt(0)" ::: "memory");
            const unsigned og = xb_add(&bar[XB_TOP], 1u);
            const unsigned tg = og / nx;
            if (og + 1u == (tg + 1u) * nx) xb_add(&bar[XB_TOPGEN], 1u);
            else XB_SPIN(xb_ld(&bar[XB_TOPGEN]) == tg, bar);
            __builtin_amdgcn_fence(__ATOMIC_ACQUIRE, "agent");
            xb_add(&bar[XB_XGEN(bx)], 1u);
            asm volatile("s_waitcnt vmcnt(0)" ::: "memory");
        } else {
            XB_SPIN(xb_ld(&bar[XB_XGEN(bx)]) == gen, bar);
            __builtin_amdgcn_fence(__ATOMIC_ACQUIRE, "agent");
            asm volatile("s_waitcnt vmcnt(0)" ::: "memory");
        }
    }
    __syncthreads();
}

__global__ void __launch_bounds__(NT, 2) k_mega(Ptrs p) {
    extern __shared__ __attribute__((aligned(16))) unsigned char lds_raw[];
    LAS unsigned char* lds = (LAS unsigned char*)lds_raw;
    cg::grid_group grid = cg::this_grid();
    const int wv = __builtin_amdgcn_readfirstlane(threadIdx.x >> 6);
#define CG_SYNC() do { asm volatile("s_waitcnt vmcnt(0)" ::: "memory"); grid.sync(); __builtin_amdgcn_fence(__ATOMIC_ACQUIRE, "agent"); asm volatile("s_waitcnt vmcnt(0)" ::: "memory"); } while (0)
#define GRID_SYNC() xcd_barrier(xbar, wv)
    if (otid(wv) < 16) ((LAS unsigned*)(lds + LDS_XB))[otid(wv)] = 0u;
    __syncthreads();
    const XcdBarrier xbar = xcd_barrier_post((unsigned*)(p.ws + WS_CTL) + CW_BAR, (volatile LAS unsigned*)(lds + LDS_XB), wv);
    const int NGW = gridDim.x * NWAVES;
    phase_mod(p, lds, wv);
    phase_lb(p, wv);
    __syncthreads();
    phase_convert(p, lds, 0, 2, wv);
    phase_router_w(p, wv);
    CG_SYNC();
    phase_norm(p.in[I_X], p.in[I_CTX], p.in[I_N1G], (const float*)(p.ws + WS_MOD), 0, 1, (bf16*)(p.ws + WS_H), MROWS, wv);
    GRID_SYNC();
    for (int layer = 0; layer < 2; ++layer) {
        const int M = (layer == 0) ? MROWS : NLAT;
        const float* modl = (const float*)(p.ws + WS_MOD) + (size_t)layer * 9 * MODW;
        {
            pg8::Gemm g{(const bf16*)(p.ws + WS_H), (const bf16*)(p.ws + WS_WIN + layer * WIN_STRIDE), MROWS, DIN, DM};
            pg8::StaticOrder S; S.init(MROWS, DIN, gridDim.x, (int)blockIdx.x);
            pg8::EpiInProj E{(bf16*)(p.ws + WS_P), p.in[I_NAQN] + layer * 64, p.in[I_NAKN] + layer * 64, p.in[I_GQQN] + layer * 64, p.in[I_GQKN] + layer * 64, wv};
            pg8::gemm_phase<pg8::EpiInProj, pg8::StaticOrder, true, true>(lds, g, S, E, wv);
        }
        GRID_SYNC();
        phase_hgrn1(p, lds, layer, wv);
        GRID_SYNC();
        phase_hgrn_scan(p, wv);
        GRID_SYNC();
        phase_hgrn2(p, lds, layer, wv);
        __syncthreads();
        phase_attn(p, lds_raw, layer, wv);
        GRID_SYNC();
        {
            pg8::Gemm g{(const bf16*)(p.ws + WS_MIX), (const bf16*)(p.ws + WS_WOUT + layer * WOUT_STRIDE), M, DM, DM};
            pg8::StaticOrder S; S.init(M, DM, gridDim.x, (int)blockIdx.x);
            pg8::EpiResidSS E{layer == 0 ? p.in[I_X] : p.out, p.in[I_CTX], p.out, (float*)(p.ws + WS_XC), modl, 2, (float*)(p.ws + WS_RSS), wv};
            pg8::gemm_phase<pg8::EpiResidSS, pg8::StaticOrder, true, true>(lds, g, S, E, wv);
        }
        GRID_SYNC();
        phase_route(p, lds, layer, M, wv);
        GRID_SYNC();
        phase_moe_gu(p, lds, layer, wv);
        GRID_SYNC();
        phase_moe_down(p, lds, layer, wv);
        GRID_SYNC();
        phase_combine(p, layer, M, layer == 0, wv);
        if (layer == 0) GRID_SYNC();
    }
}

extern "C" void kernel_launch(void* const* d_in, const int* in_sizes, int n_in, void* d_out, int out_size, void* d_ws, size_t ws_size, hipStream_t stream) {
    static int grid = 0;
    if (grid == 0) {
        if (n_in != 24 || ws_size < WS_END) { fprintf(stderr, "kernel_launch: bad n_in %d or ws_size %zu < %zu\n", n_in, ws_size, (size_t)WS_END); grid = -1; return; }
        int dev = 0, cus = 0, per_cu = 0;
        hipGetDevice(&dev); hipDeviceGetAttribute(&cus, hipDeviceAttributeMultiprocessorCount, dev);
        hipFuncSetAttribute((const void*)k_mega, hipFuncAttributeMaxDynamicSharedMemorySize, LDS_BYTES);
        hipOccupancyMaxActiveBlocksPerMultiprocessor(&per_cu, (const void*)k_mega, NT, LDS_BYTES);
        if (per_cu < 1) { fprintf(stderr, "kernel_launch: occupancy query says %d blocks/CU\n", per_cu); grid = -1; return; }
        grid = cus;
        (void)hipGetLastError();
    }
    if (grid < 0) return;
    Ptrs p{};
    for (int i = 0; i < 24; ++i) p.in[i] = (const float*)d_in[i];
    p.out = (float*)d_out; p.ws = (unsigned char*)d_ws; p.layer = 0; p.pad = 0;
    hipMemsetAsync((unsigned char*)d_ws + WS_CTL, 0, 1 * MiB, stream);
    void* args[] = {&p};
    hipError_t e = hipLaunchCooperativeKernel((const void*)k_mega, dim3(grid), dim3(NT), args, LDS_BYTES, stream);
    if (e != hipSuccess) fprintf(stderr, "cooperative launch failed: %s\n", hipGetErrorString(e));
}
```

```cpp
#include <hip/hip_runtime.h>
#include <hip/hip_cooperative_groups.h>
#include <cstdio>
#include <cstdint>
#include <math.h>
namespace cg = cooperative_groups;

#define DM 1024
#define SEQ 2048
#define CTXL 256
#define NBATCH 8
#define NLAT (NBATCH * SEQ)
#define NCTX (NBATCH * CTXL)
#define MROWS (NLAT + NCTX)
#define DIN 2816
#define NMOD 6
#define MODW (NMOD * DM)
#define A_Q 0
#define A_K 256
#define A_V 512
#define B_Q 768
#define B_K 1280
#define B_V 1408
#define C_Q 1536
#define C_I 1792
#define C_FF 2048
#define C_FB 2304
#define C_G 2560

typedef unsigned short bf16;
#define LAS __attribute__((address_space(3)))
#define GAS __attribute__((address_space(1)))
typedef unsigned v4u __attribute__((ext_vector_type(4)));
typedef unsigned v2u __attribute__((ext_vector_type(2)));
typedef float v4f __attribute__((ext_vector_type(4)));

__device__ __forceinline__ unsigned f2bf(float f) { unsigned u = __builtin_bit_cast(unsigned, f); return (u + 0x7fffu + ((u >> 16) & 1u)) >> 16; }
__device__ __forceinline__ unsigned pk2(float lo, float hi) { return f2bf(lo) | (f2bf(hi) << 16); }
__device__ __forceinline__ float bf2f(unsigned short v) { return __builtin_bit_cast(float, (unsigned)v << 16); }
__device__ __forceinline__ float bflo(unsigned v) { return __builtin_bit_cast(float, v << 16); }
__device__ __forceinline__ float bfhi(unsigned v) { return __builtin_bit_cast(float, v & 0xffff0000u); }
__device__ __forceinline__ float silu_f(float x) { return x / (1.f + __expf(-x)); }
__device__ __forceinline__ float shx(float v, int mask, int lane) { return __builtin_bit_cast(float, __builtin_amdgcn_ds_bpermute((lane ^ mask) << 2, __builtin_bit_cast(int, v))); }
__device__ __forceinline__ float wave_sum(float v, int lane) {
#pragma unroll
    for (int o = 1; o < 64; o <<= 1) v += shx(v, o, lane);
    return v;
}
__device__ __forceinline__ int otid(int wv) { unsigned m = ~0u; asm volatile("" : "+s"(m)); asm volatile("" : "+s"(wv)); return wv * 64 + (int)__builtin_amdgcn_mbcnt_hi(m, __builtin_amdgcn_mbcnt_lo(m, 0u)); }
#define LDS_WAIT() asm volatile("s_waitcnt lgkmcnt(0)" ::: "memory")

constexpr size_t MiB = 1u << 20;
constexpr size_t WS_CTL = 0;
constexpr size_t WS_MOD = 1 * MiB;
constexpr size_t WS_LB = 1 * MiB + 512 * 1024;
constexpr size_t WS_EID = 2 * MiB;
constexpr size_t WS_EW = 2 * MiB + 256 * 1024;
constexpr size_t WS_IDX = 3 * MiB;
constexpr size_t WS_XC = 8 * MiB;
constexpr size_t WS_WIN = 16 * MiB;
constexpr size_t WIN_STRIDE = (size_t)DIN * DM * 2;
constexpr size_t WS_WOUT = 28 * MiB;
constexpr size_t WOUT_STRIDE = 2 * MiB;
constexpr size_t WS_WGU = 32 * MiB;
constexpr size_t WGU_STRIDE = 32 * MiB;
constexpr size_t WS_WD = 96 * MiB;
constexpr size_t WD_STRIDE = 16 * MiB;
constexpr size_t WS_H = 128 * MiB;
constexpr size_t WS_MIX = 164 * MiB;
constexpr size_t WS_P = 200 * MiB;
constexpr size_t WS_Y0 = 200 * MiB;
constexpr size_t WS_Y1 = 236 * MiB;
constexpr size_t WS_HID = 272 * MiB;
constexpr size_t WS_SCR = 300 * MiB;
constexpr size_t WS_END = 340 * MiB;

constexpr int NT = 512, NWAVES = 8;
constexpr int LDS_BYTES = 147456;
namespace pg8 {
#define PG8_LAS __attribute__((address_space(3)))
typedef unsigned short bf16_t;
typedef short bf16x8 __attribute__((ext_vector_type(8)));
typedef float f32x4 __attribute__((ext_vector_type(4)));
typedef unsigned u32x4 __attribute__((ext_vector_type(4)));
constexpr int BM = 256, BK = 64, HALF = 128, HTB = HALF * BK * 2  , STAGE_BYTES = 8 * HTB, NXCD = 8, WGM = 8;

__host__ __device__ __forceinline__ int lds_byte(int r, int c) { const int st = (r >> 4) * 2 + (c >> 5), rr = r & 15, cc = c & 31, ob = rr * 64 + cc * 2; return st * 1024 + (ob ^ (((ob >> 9) & 1) << 5)); }
__host__ __device__ __forceinline__ void stage_rc(int b, int& R, int& C) { const int st = b / 1024, sb = b % 1024, swz = sb ^ (((sb >> 9) & 1) << 5); R = (st >> 1) * 16 + swz / 64; C = (st & 1) * 32 + (swz % 64) / 2; }
__host__ __device__ __forceinline__ int perm32(int rho) { const int n = rho >> 4, i = rho & 15; return 8 * (i >> 2) + 4 * n + (i & 3); }

struct Unit { int pm, pn, aux; };
struct Gemm { const bf16_t* A; const bf16_t* Bt; int M, N, K; };

struct StaticOrder {
    int nM, nN, nwg, G, c;
    __host__ __device__ void init(int M, int N, int G_, int c_) { nM = M / BM; nN = N / BM; nwg = nM * nN; G = G_; c = c_; }
    __host__ __device__ bool next(int i, Unit& u) const {
        const long L = (long)i * G + c; if (L >= nwg) return false;
        int wgid = (int)L; { const int q = nwg / NXCD, r = nwg % NXCD, xcd = wgid % NXCD, off = wgid / NXCD; wgid = (xcd < r ? xcd * (q + 1) : r * (q + 1) + (xcd - r) * q) + off; }
        const int nig = WGM * nN, gid = wgid / nig, fm = gid * WGM, gsz = (nM - fm) < WGM ? (nM - fm) : WGM;
        u.pm = fm + ((wgid % nig) % gsz); u.pn = (wgid % nig) / gsz; return true;
    }
    __device__ __forceinline__ void a_ready(const Unit&) const {}
    __device__ __forceinline__ void done(const Unit&) const {}
};

__device__ __forceinline__ unsigned cvt_pk_bf16(float lo, float hi) { unsigned r; asm volatile("v_cvt_pk_bf16_f32 %0, %1, %2" : "=v"(r) : "v"(lo), "v"(hi)); return r; }
typedef float f32x2 __attribute__((ext_vector_type(2)));
__device__ __forceinline__ f32x2 gelu_pk(f32x2 v) {
    const f32x2 av = __builtin_elementwise_abs(v), d = av * 0.2316418882f + 1.0f;
    f32x2 t; t.x = __builtin_amdgcn_rcpf(d.x); t.y = __builtin_amdgcn_rcpf(d.y);
    f32x2 q = t * 0.5307027145f + (-0.7265760135f); q = q * t + 0.7107068705f; q = q * t + (-0.142248368f); q = q * t + 0.127414796f; q = q * t;
    const f32x2 s = (v * v) * (-0.72134752044f);
    f32x2 e; e.x = __builtin_amdgcn_exp2f(s.x); e.y = __builtin_amdgcn_exp2f(s.y);
    const f32x2 m = v * (q * e), r = v - m;
    f32x2 o; o.x = v.x < 0.f ? m.x : r.x; o.y = v.y < 0.f ? m.y : r.y; return o;
}

template <int ACT  > struct EpiBf16 {
    static constexpr bool PERM = true, AFTER_DRAIN = false; static_assert(ACT == 0 || ACT == 1, "EpiBf16: ACT is 0 (none) or 1 (gelu_pk)");
    bf16_t* O; int ldc; const float* bias; int split_cols; size_t split_stride; float scale0;
    __device__ __forceinline__ void operator()(const f32x4 (&acc)[2][2][4][2], const Unit& u, int wr, int wc, int fr, int fq) const {
        const int row0 = u.pm * BM + wr * 64 + fr; int colt = u.pn * BM; bf16_t* base = O;
        float sc = 1.f; if (split_cols) { const int t = colt / split_cols; base += (size_t)t * split_stride; colt -= t * split_cols; if (t == 0) sc = scale0; }
        const int col0 = colt + wc * 32 + 8 * fq, bcol0 = u.pn * BM + wc * 32 + 8 * fq;
        f32x4 bv[2][2];
#pragma unroll
        for (int bj = 0; bj < 2; ++bj)
#pragma unroll
            for (int n = 0; n < 2; ++n) bv[bj][n] = bias ? *(const f32x4*)(bias + bcol0 + bj * HALF + 4 * n) : (f32x4){0.f, 0.f, 0.f, 0.f};
#pragma unroll
        for (int ai = 0; ai < 2; ++ai)
#pragma unroll
            for (int m = 0; m < 4; ++m) { bf16_t* rowp = base + (size_t)(row0 + ai * HALF + m * 16) * ldc + col0;
#pragma unroll
                for (int bj = 0; bj < 2; ++bj) { f32x4 v0 = acc[ai][bj][m][0] + bv[bj][0], v1 = acc[ai][bj][m][1] + bv[bj][1];
                    if (ACT == 1) { f32x2 a = gelu_pk((f32x2){v0[0], v0[1]}), b = gelu_pk((f32x2){v0[2], v0[3]}), c = gelu_pk((f32x2){v1[0], v1[1]}), d = gelu_pk((f32x2){v1[2], v1[3]});
                        v0 = (f32x4){a.x, a.y, b.x, b.y}; v1 = (f32x4){c.x, c.y, d.x, d.y}; }
                    v0 = v0 * sc; v1 = v1 * sc; u32x4 w; w.x = cvt_pk_bf16(v0[0], v0[1]); w.y = cvt_pk_bf16(v0[2], v0[3]); w.z = cvt_pk_bf16(v1[0], v1[1]); w.w = cvt_pk_bf16(v1[2], v1[3]);
                    *(u32x4*)(rowp + bj * HALF) = w; } }
    }
};

template <class Epi, class Sched, bool ALIGN_EPI = false, bool SP2 = false, bool GATHER = false>
__device__ __forceinline__ void gemm_phase(PG8_LAS unsigned char* lds, const Gemm g, const Sched& S, const Epi& E, int wv, const PG8_LAS int* gidx = nullptr) {
    static_assert(SP2 || !GATHER, "GATHER is wired into the SP2 loop only");
    int tid_ = otid(wv);
    const int tid = tid_, wid = __builtin_amdgcn_readfirstlane(tid >> 6), lane = tid & 63, wr = wid >> 2, wc = wid & 3, fr = lane & 15, fq = lane >> 4;
    const int K = g.K, nt = K / BK;
    unsigned voffA[2][2], nvoffA[2][2], voffB[2]; int RA[2], CA[2];
#pragma unroll
    for (int i = 0; i < 2; ++i) { int R, C; stage_rc(tid * 16 + i * 8192, R, C); const int Rb = Epi::PERM ? ((R & ~31) + perm32(R & 31)) : R; RA[i] = R; CA[i] = C;
        voffA[0][i] = voffA[1][i] = nvoffA[0][i] = nvoffA[1][i] = (unsigned)(R * K + C) * 2u; voffB[i] = (unsigned)(Rb * K + C) * 2u; }
#define PG8_GVOFF(dst, uidx) do { if constexpr (GATHER) { _Pragma("unroll") for (int _h = 0; _h < 2; ++_h) _Pragma("unroll") for (int _i = 0; _i < 2; ++_i) dst[_h][_i] = (unsigned)(gidx[(uidx) * 256 + _h * 128 + RA[_i]] * K + CA[_i]) * 2u; } } while (0)
    const size_t kstep = (size_t)(BK * 2);
    const size_t hstep = (size_t)HALF * K * 2;
    const size_t hstepA = GATHER ? (size_t)0 : hstep;
    const size_t tstep = 2 * hstep;
    const unsigned ldsw = (unsigned)wid * 1024u;
    const int aoff = lds_byte(wr * 64 + fr, fq * 8), boff = lds_byte(wc * 32 + fr, fq * 8);
#define PG8_SA(b, h) (((b) * 2 + (h)) * HTB)
#define PG8_SB(b, h) ((4 + (b) * 2 + (h)) * HTB)
#define PG8_STAGE(bufoff, gbase, voff) do { _Pragma("unroll") for (int _i = 0; _i < 2; ++_i) \
        __builtin_amdgcn_global_load_lds((const unsigned*)((const char*)(gbase) + (voff)[_i]), (PG8_LAS unsigned*)(lds + (bufoff) + ldsw + _i * 8192), 16, 0, 0); } while (0)
#define PG8_LDA(dst, b, h) do { _Pragma("unroll") for (int m = 0; m < 4; ++m) _Pragma("unroll") for (int k = 0; k < 2; ++k) dst[m][k] = *(const PG8_LAS bf16x8*)(lds + PG8_SA(b, h) + aoff + m * 2048 + k * 1024); } while (0)
#define PG8_LDB(dst, b, h) do { _Pragma("unroll") for (int n = 0; n < 2; ++n) _Pragma("unroll") for (int k = 0; k < 2; ++k) dst[n][k] = *(const PG8_LAS bf16x8*)(lds + PG8_SB(b, h) + boff + n * 2048 + k * 1024); } while (0)
#define PG8_MMA(ai, bj, At, Bt) do { __builtin_amdgcn_s_setprio(1); _Pragma("unroll") for (int m = 0; m < 4; ++m) _Pragma("unroll") for (int n = 0; n < 2; ++n) _Pragma("unroll") for (int k = 0; k < 2; ++k) \
        acc[ai][bj][m][n] = __builtin_amdgcn_mfma_f32_16x16x32_bf16(Bt[n][k], At[m][k], acc[ai][bj][m][n], 0, 0, 0); __builtin_amdgcn_s_setprio(0); } while (0)
#define PG8_WAIT_V(n) asm volatile("s_waitcnt vmcnt(" #n ")" ::: "memory")
#define PG8_WAIT_L(n) asm volatile("s_waitcnt lgkmcnt(" #n ")" ::: "memory")
#define PG8_BAR __builtin_amdgcn_s_barrier()
#define PG8_SCHED __builtin_amdgcn_sched_barrier(0)
    Unit cur, nxt; int ui = 0;
    if (!S.next(0, cur)) return;
    f32x4 acc[2][2][4][2];
#pragma unroll
    for (int a = 0; a < 2; ++a)
#pragma unroll
        for (int b = 0; b < 2; ++b)
#pragma unroll
            for (int m = 0; m < 4; ++m)
#pragma unroll
                for (int n = 0; n < 2; ++n) acc[a][b][m][n] = (f32x4){0.f, 0.f, 0.f, 0.f};
    bf16x8 At[4][2], B0[2][2], B1[2][2];
    const char* cA = (const char*)g.A + (GATHER ? (size_t)0 : (size_t)cur.pm * tstep); PG8_GVOFF(voffA, 0); const char* cB = (const char*)g.Bt + (size_t)cur.pn * tstep;
    S.a_ready(cur);
    if constexpr (SP2) {
        PG8_STAGE(PG8_SB(0, 0), cB, voffB); PG8_STAGE(PG8_SB(0, 1), cB + hstep, voffB); PG8_STAGE(PG8_SA(0, 0), cA, voffA[0]); PG8_STAGE(PG8_SA(0, 1), cA + hstepA, voffA[1]);
        if (wr == 1) PG8_BAR;
        PG8_WAIT_V(2); PG8_BAR;
        PG8_STAGE(PG8_SB(1, 0), cB + kstep, voffB); PG8_STAGE(PG8_SA(1, 0), cA + kstep, voffA[0]); PG8_STAGE(PG8_SB(1, 1), cB + hstep + kstep, voffB);
        PG8_WAIT_V(6); PG8_BAR;
    } else {
        PG8_STAGE(PG8_SB(0, 0), cB, voffB); PG8_STAGE(PG8_SA(0, 0), cA, voffA[0]); PG8_STAGE(PG8_SB(0, 1), cB + hstep, voffB); PG8_STAGE(PG8_SA(0, 1), cA + hstep, voffA[0]);
        if (wr == 1) PG8_BAR;
        PG8_WAIT_V(4); PG8_BAR;
        PG8_STAGE(PG8_SB(1, 0), cB + kstep, voffB); PG8_STAGE(PG8_SA(1, 0), cA + kstep, voffA[0]); PG8_STAGE(PG8_SB(1, 1), cB + hstep + kstep, voffB);
        PG8_WAIT_V(6); PG8_BAR;
    }
    for (;;) {
        const bool has_next = S.next(ui + 1, nxt);
        const char* nA = (has_next && !GATHER) ? (const char*)g.A + (size_t)nxt.pm * tstep : cA; if (has_next) PG8_GVOFF(nvoffA, ui + 1); const char* nB = has_next ? (const char*)g.Bt + (size_t)nxt.pn * tstep : cB;
        for (int t = 0; t < nt; t += 2) {
            const bool last = (t == nt - 2);
            const char* a1 = cA + (size_t)(t + 1) * kstep;
            const char* a2 = last ? nA : cA + (size_t)(t + 2) * kstep; const char* b2 = last ? nB : cB + (size_t)(t + 2) * kstep;
            const char* a3 = a2 + kstep; const char* b3 = b2 + kstep;
            if (last && has_next) S.a_ready(nxt);
            unsigned vs2[2][2];
#pragma unroll
            for (int _h = 0; _h < 2; ++_h)
#pragma unroll
                for (int _i = 0; _i < 2; ++_i) vs2[_h][_i] = last ? nvoffA[_h][_i] : voffA[_h][_i];
            if constexpr (SP2) {
            PG8_LDB(B0, 0, 0); PG8_LDB(B1, 0, 1); PG8_SCHED; PG8_LDA(At, 0, 0); PG8_STAGE(PG8_SA(1, 1), a1 + hstepA, voffA[1]);
            PG8_WAIT_V(8); PG8_WAIT_L(0); PG8_BAR; PG8_MMA(0, 0, At, B0); PG8_MMA(0, 1, At, B1); PG8_BAR; PG8_SCHED;
            PG8_LDA(At, 0, 1); PG8_STAGE(PG8_SB(0, 0), b2, voffB); PG8_STAGE(PG8_SB(0, 1), b2 + hstep, voffB); PG8_STAGE(PG8_SA(0, 0), a2, vs2[0]);
            PG8_WAIT_V(8); PG8_WAIT_L(0); PG8_BAR; PG8_MMA(1, 0, At, B0); PG8_MMA(1, 1, At, B1); PG8_BAR; PG8_SCHED;
            PG8_LDB(B0, 1, 0); PG8_LDB(B1, 1, 1); PG8_SCHED; PG8_LDA(At, 1, 0); PG8_STAGE(PG8_SA(0, 1), a2 + hstepA, vs2[1]);
            PG8_WAIT_V(8); PG8_WAIT_L(0); PG8_BAR; PG8_MMA(0, 0, At, B0); PG8_MMA(0, 1, At, B1); PG8_BAR; PG8_SCHED;
            PG8_LDA(At, 1, 1); PG8_STAGE(PG8_SB(1, 0), b3, voffB); PG8_STAGE(PG8_SB(1, 1), b3 + hstep, voffB); PG8_STAGE(PG8_SA(1, 0), a3, vs2[0]);
            PG8_WAIT_V(8); PG8_WAIT_L(0); PG8_BAR; PG8_MMA(1, 0, At, B0); PG8_MMA(1, 1, At, B1); PG8_BAR; PG8_SCHED;
            } else {
            PG8_LDB(B0, 0, 0); PG8_SCHED; PG8_LDA(At, 0, 0); PG8_STAGE(PG8_SA(1, 1), a1 + hstep, voffA[0]);
            PG8_WAIT_L(8); PG8_BAR; PG8_WAIT_L(0); PG8_MMA(0, 0, At, B0); PG8_BAR; PG8_SCHED;
            PG8_LDB(B1, 0, 1); PG8_STAGE(PG8_SB(0, 0), b2, voffB);
            PG8_BAR; PG8_WAIT_L(0); PG8_MMA(0, 1, At, B1); PG8_BAR;
            PG8_LDA(At, 0, 1); PG8_STAGE(PG8_SA(0, 0), a2, voffA[0]);
            PG8_BAR; PG8_WAIT_L(0); PG8_MMA(1, 0, At, B0); PG8_BAR; PG8_SCHED;
            PG8_STAGE(PG8_SB(0, 1), b2 + hstep, voffB);
            PG8_WAIT_V(6); PG8_BAR; PG8_MMA(1, 1, At, B1); PG8_BAR;
            PG8_LDB(B0, 1, 0); PG8_SCHED; PG8_LDA(At, 1, 0); PG8_STAGE(PG8_SA(0, 1), a2 + hstep, voffA[0]);
            PG8_WAIT_L(8); PG8_BAR; PG8_WAIT_L(0); PG8_MMA(0, 0, At, B0); PG8_BAR; PG8_SCHED;
            PG8_LDB(B1, 1, 1); PG8_STAGE(PG8_SB(1, 0), b3, voffB);
            PG8_BAR; PG8_WAIT_L(0); PG8_MMA(0, 1, At, B1); PG8_BAR;
            PG8_LDA(At, 1, 1); PG8_STAGE(PG8_SA(1, 0), a3, voffA[0]);
            PG8_BAR; PG8_WAIT_L(0); PG8_MMA(1, 0, At, B0); PG8_BAR; PG8_SCHED;
            PG8_STAGE(PG8_SB(1, 1), b3 + hstep, voffB);
            PG8_WAIT_V(6); PG8_BAR; PG8_MMA(1, 1, At, B1); PG8_BAR;
            }
        }
        if constexpr (ALIGN_EPI) { if (wr == 0) PG8_BAR; }
        if constexpr (!Epi::AFTER_DRAIN) { E(acc, cur, wr, wc, fr, fq); S.done(cur); }
        if (!has_next) break;
#pragma unroll
        for (int a = 0; a < 2; ++a)
#pragma unroll
            for (int b = 0; b < 2; ++b)
#pragma unroll
                for (int m = 0; m < 4; ++m)
#pragma unroll
                    for (int n = 0; n < 2; ++n) acc[a][b][m][n] = (f32x4){0.f, 0.f, 0.f, 0.f};
        cur = nxt; cA = nA; cB = nB; ++ui;
#pragma unroll
        for (int _h = 0; _h < 2; ++_h)
#pragma unroll
            for (int _i = 0; _i < 2; ++_i) voffA[_h][_i] = nvoffA[_h][_i];
        if constexpr (ALIGN_EPI) { if (wr == 1) PG8_BAR; }
    }
    PG8_WAIT_V(0);
    if constexpr (!ALIGN_EPI) { if (wr == 0) PG8_BAR; }
    PG8_BAR;
    if constexpr (Epi::AFTER_DRAIN) { E.fused(acc, cur, wr, wc, fr, fq, lds, wid, lane); S.done(cur); }
#undef PG8_SA
#undef PG8_GVOFF
#undef PG8_SB
#undef PG8_STAGE
#undef PG8_LDA
#undef PG8_LDB
#undef PG8_MMA
#undef PG8_WAIT_V
#undef PG8_WAIT_L
#undef PG8_BAR
#undef PG8_SCHED
}
}


struct Ptrs { const float* in[24]; float* out; unsigned char* ws; int layer; int pad; };
enum { I_X = 0, I_C, I_CTX, I_CCTX, I_WADA, I_BADA, I_N1G, I_WIN, I_NAQN, I_NAKN, I_RPB, I_GQQN, I_GQKN, I_LB, I_HGON, I_WOUT, I_N2G, I_WRG, I_BRG, I_WRE, I_BRE, I_WEG, I_WEU, I_WED };

namespace pg8 {
struct EpiResid {
    static constexpr bool PERM = false, AFTER_DRAIN = false;
    const float* xin_lat; const float* xin_ctx; float* xout_lat; float* xout_ctx; const float* modl; int chunk;
    __device__ __forceinline__ void operator()(const f32x4 (&acc)[2][2][4][2], const Unit& u, int wr, int wc, int fr, int fq) const {
        const int rowt = u.pm * BM; const bool isctx = rowt >= NLAT;
        const float* xin = isctx ? xin_ctx + (size_t)(rowt - NLAT) * DM : xin_lat + (size_t)rowt * DM;
        float* xo = isctx ? xout_ctx + (size_t)(rowt - NLAT) * DM : xout_lat + (size_t)rowt * DM;
        const int mrow = isctx ? 8 : (rowt >> 11);
        const float* gate = modl + (size_t)mrow * MODW + chunk * DM;
        const int col0 = u.pn * BM + wc * 32 + 4 * fq;
#pragma unroll
        for (int bj = 0; bj < 2; ++bj)
#pragma unroll
            for (int n = 0; n < 2; ++n) {
                const int col = col0 + bj * HALF + n * 16;
                const f32x4 gv = *(const f32x4*)(gate + col);
#pragma unroll
                for (int ai = 0; ai < 2; ++ai)
#pragma unroll
                    for (int m = 0; m < 4; ++m) {
                        const size_t off = (size_t)(ai * HALF + wr * 64 + m * 16 + fr) * DM + col;
                        const f32x4 xi = *(const f32x4*)(xin + off);
                        *(f32x4*)(xo + off) = xi + gv * acc[ai][bj][m][n];
                    }
            }
    }
};
}

__device__ __forceinline__ void phase_mod(const Ptrs& p, LAS unsigned char* lds, int wv) {
    if (blockIdx.x >= 192) return;
    LAS float* sc = (LAS float*)lds;
    LAS float* red = (LAS float*)(lds + 36864);
    const int tid = otid(wv);
    const float* c = p.in[I_C]; const float* cc = p.in[I_CCTX];
    for (int i = tid; i < 9 * DM; i += NT) { float v = (i < 8 * DM) ? c[i] : cc[i - 8 * DM]; sc[i] = silu_f(v); }
    __syncthreads();
    float* mod = (float*)(p.ws + WS_MOD);
    for (int u = blockIdx.x; u < 192; u += gridDim.x) {
        const int layer = u / 96, cb = u % 96, cq = tid & 15, kg = tid >> 4;
        const float* w = p.in[I_WADA] + (size_t)layer * DM * MODW + cb * 64 + cq * 4;
        v4f acc[9];
#pragma unroll
        for (int r = 0; r < 9; ++r) acc[r] = (v4f){0.f, 0.f, 0.f, 0.f};
        for (int i = 0; i < 32; ++i) {
            const int k = kg + 32 * i;
            const v4f wv = *(const v4f*)(w + (size_t)k * MODW);
#pragma unroll
            for (int r = 0; r < 9; ++r) acc[r] += sc[r * DM + k] * wv;
        }
#pragma unroll
        for (int r = 0; r < 9; ++r) *(LAS v4f*)(red + (kg * 9 + r) * 64 + cq * 4) = acc[r];
        __syncthreads();
        for (int o = tid; o < 576; o += NT) {
            const int r = o >> 6, c2 = o & 63; float s = 0.f;
            for (int k2 = 0; k2 < 32; ++k2) s += red[(k2 * 9 + r) * 64 + c2];
            mod[((size_t)layer * 9 + r) * MODW + cb * 64 + c2] = s + p.in[I_BADA][layer * MODW + cb * 64 + c2];
        }
        __syncthreads();
    }
}
__device__ __forceinline__ void phase_lb(const Ptrs& p, int wv) {
    if (blockIdx.x == 255 % gridDim.x) {
        const int i = otid(wv);
        const float* raw = p.in[I_LB]; float* lb = (float*)(p.ws + WS_LB);
        float l0 = raw[i], l1 = raw[512 + i];
        lb[i] = 0.f; lb[512 + i] = 1.f / (1.f + __expf(l0 - l1));
    }
}
__device__ __forceinline__ void transpose_item(const float* W, int K, int N, bf16* WT, int row_off, LAS float* scr, int item, int lane) {
    const int nblk = N / 32, kb = item / nblk, nb = item % nblk, k0 = 64 * kb, n0 = 32 * nb;
#pragma unroll 8
    for (int i = 0; i < 32; ++i) { const int kk = 2 * i + (lane >> 5); scr[kk * 33 + (lane & 31)] = W[(size_t)(k0 + kk) * N + n0 + (lane & 31)]; }
    LDS_WAIT(); asm volatile("" ::: "memory");
    const int c = lane & 7;
#pragma unroll
    for (int j = 0; j < 4; ++j) { const int n = (lane >> 3) + 8 * j; const LAS float* s = scr + (8 * c) * 33 + n;
        v4u o; o.x = pk2(s[0 * 33], s[1 * 33]); o.y = pk2(s[2 * 33], s[3 * 33]); o.z = pk2(s[4 * 33], s[5 * 33]); o.w = pk2(s[6 * 33], s[7 * 33]);
        *(v4u*)(WT + (size_t)(row_off + n0 + n) * K + k0 + 8 * c) = o; }
    LDS_WAIT(); asm volatile("" ::: "memory");
}
constexpr int CI_IN = 16 * 88, CI_OUT = 16 * 32, CI_G = 32 * 128, CI_U = 32 * 128, CI_D = 32 * 128, CI_LAYER = CI_IN + CI_OUT + CI_G + CI_U + CI_D;
__device__ __forceinline__ void phase_convert(const Ptrs& p, LAS unsigned char* lds, int layer_lo, int layer_hi, int wv) {
    const int lane = otid(wv) & 63, wave = wv;
    LAS float* scr = (LAS float*)(lds + wave * 16384);
    const int gw = blockIdx.x * NWAVES + wave, NGW = gridDim.x * NWAVES;
    const int n_items = (layer_hi - layer_lo) * CI_LAYER;
    for (int it = gw; it < n_items; it += NGW) {
        const int layer = layer_lo + it / CI_LAYER; int r = it % CI_LAYER;
        if (r < CI_IN) {
            const int n0 = 32 * (r % 88), pn_ = n0 >> 8, w_ = (n0 >> 6) & 3, bj_ = (n0 >> 5) & 1;
            transpose_item(p.in[I_WIN] + (size_t)layer * DM * DIN, DM, DIN, (bf16*)(p.ws + WS_WIN + layer * WIN_STRIDE), (256 * pn_ + 128 * bj_ + 32 * w_) - n0, scr, r, lane); continue; } r -= CI_IN;
        if (r < CI_OUT) { transpose_item(p.in[I_WOUT] + (size_t)layer * DM * DM, DM, DM, (bf16*)(p.ws + WS_WOUT + layer * WOUT_STRIDE), 0, scr, r, lane); continue; } r -= CI_OUT;
        if (r < CI_G + CI_U) {
            const int up = r >= CI_G; if (up) r -= CI_G;
            const int e = r >> 7, rem = r & 127, nb = rem & 7, n0 = 32 * nb;
            const int mapped = (n0 >> 7) * 256 + (n0 & 127) + (up ? 128 : 0);
            transpose_item(p.in[up ? I_WEU : I_WEG] + ((size_t)layer * 32 + e) * DM * 256, DM, 256, (bf16*)(p.ws + WS_WGU + layer * WGU_STRIDE) + (size_t)e * 512 * DM, mapped - n0, scr, rem, lane);
            continue;
        }
        r -= CI_G + CI_U;
        { const int e = r >> 7, rem = r & 127;
          transpose_item(p.in[I_WED] + ((size_t)layer * 32 + e) * 256 * DM, 256, DM, (bf16*)(p.ws + WS_WD + layer * WD_STRIDE) + (size_t)e * DM * 256, 0, scr, rem, lane); }
    }
}
__device__ __forceinline__ void phase_norm(const float* xlat, const float* xctx, const float* g, const float* modl, int ch_shift, int ch_scale, bf16* H, int nrows, int wv) {
    const int lane = otid(wv) & 63, wave = wv;
    const int gw = blockIdx.x * NWAVES + wave, NGW = gridDim.x * NWAVES;
    const int per = (nrows + NGW - 1) / NGW;
    const int r0 = gw * per, r1 = min(r0 + per, nrows);
    const unsigned lc = 4 * lane;
    int cur = -1; v4f gs[4], sh[4], xn[4];
    if (r0 < r1) { const float* xr = (r0 < NLAT) ? xlat + (size_t)r0 * DM : xctx + (size_t)(r0 - NLAT) * DM;
#pragma unroll
        for (int j = 0; j < 4; ++j) xn[j] = *(const v4f*)(xr + lc + 256 * j); }
    for (int r = r0; r < r1; ++r) {
        const int mrow = (r < NLAT) ? (r >> 11) : 8;
        if (mrow != cur) {
            cur = mrow; const float* m = modl + (size_t)mrow * MODW;
#pragma unroll
            for (int j = 0; j < 4; ++j) { const unsigned c = lc + 256 * j; const v4f gg = *(const v4f*)(g + c), sc = *(const v4f*)(m + ch_scale * DM + c);
                gs[j] = gg * (1.f + sc); sh[j] = *(const v4f*)(m + ch_shift * DM + c); }
        }
        v4f v[4]; float s = 0.f;
#pragma unroll
        for (int j = 0; j < 4; ++j) { v[j] = xn[j]; s += (v[j].x * v[j].x + v[j].y * v[j].y) + (v[j].z * v[j].z + v[j].w * v[j].w); }
        if (r + 1 < r1) { const float* xq = (r + 1 < NLAT) ? xlat + (size_t)(r + 1) * DM : xctx + (size_t)(r + 1 - NLAT) * DM;
#pragma unroll
            for (int j = 0; j < 4; ++j) xn[j] = *(const v4f*)(xq + lc + 256 * j); }
        const float rstd = rsqrtf(wave_sum(s, lane) * (1.f / DM) + 1e-6f);
        bf16* orow = H + (size_t)r * DM;
#pragma unroll
        for (int j = 0; j < 4; ++j) { const v4f o = v[j] * rstd * gs[j] + sh[j]; v2u w; w.x = pk2(o.x, o.y); w.y = pk2(o.z, o.w); *(v2u*)(orow + lc + 256 * j) = w; }
    }
}

constexpr size_t WS_RSS = 6 * MiB;
constexpr size_t WS_WR = 7 * MiB + 512 * 1024;
constexpr int CW_CNT = 1024;
constexpr int LDS_TTAB = 131072;
constexpr int LDS_GIDX = 131072 + 4096;
constexpr int LDS_RT = 131072;

namespace pg8 {
struct EpiResidSS {
    static constexpr bool PERM = false, AFTER_DRAIN = false;
    const float* xin_lat; const float* xin_ctx; float* xout_lat; float* xout_ctx; const float* modl; int chunk; float* rss; int wv;
    __device__ __forceinline__ void operator()(const f32x4 (&acc)[2][2][4][2], const Unit& u, int, int, int, int) const {
        const int l_ = otid(wv) & 63, fr = l_ & 15, fq = l_ >> 4, wr = wv >> 2, wc = wv & 3;
        const int rowt = u.pm * BM; const bool isctx = rowt >= NLAT;
        const float* xin = isctx ? xin_ctx + (size_t)(rowt - NLAT) * DM : xin_lat + (size_t)rowt * DM;
        float* xo = isctx ? xout_ctx + (size_t)(rowt - NLAT) * DM : xout_lat + (size_t)rowt * DM;
        const int mrow = isctx ? 8 : (rowt >> 11);
        const float* gate = modl + (size_t)mrow * MODW + chunk * DM;
        const int col0 = u.pn * BM + wc * 32 + 4 * fq;
        f32x4 gv[2][2];
#pragma unroll
        for (int bj = 0; bj < 2; ++bj)
#pragma unroll
            for (int n = 0; n < 2; ++n) gv[bj][n] = *(const f32x4*)(gate + col0 + bj * HALF + n * 16);
#pragma unroll
        for (int ai = 0; ai < 2; ++ai)
#pragma unroll
            for (int m = 0; m < 4; ++m) {
                const int rl = ai * HALF + wr * 64 + m * 16 + fr; float ss = 0.f;
#pragma unroll
                for (int bj = 0; bj < 2; ++bj)
#pragma unroll
                    for (int n = 0; n < 2; ++n) {
                        const size_t off = (size_t)rl * DM + col0 + bj * HALF + n * 16;
                        const f32x4 xi = *(const f32x4*)(xin + off);
                        const f32x4 o = xi + gv[bj][n] * acc[ai][bj][m][n];
                        *(f32x4*)(xo + off) = o;
                        ss += (o[0] * o[0] + o[1] * o[1]) + (o[2] * o[2] + o[3] * o[3]);
                    }
                ss += shx(ss, 16, l_); ss += shx(ss, 32, l_);
                if (fq == 0) rss[(size_t)(rowt + rl) * 16 + u.pn * 4 + wc] = ss;
            }
    }
};
struct EpiGU {
    static constexpr bool PERM = true, AFTER_DRAIN = false;
    bf16_t* HID; int wv;
    __device__ __forceinline__ void operator()(const f32x4 (&acc)[2][2][4][2], const Unit& u, int, int, int, int) const {
        const int l_ = otid(wv) & 63, fr = l_ & 15, fq = l_ >> 4, wr = wv >> 2, wc = wv & 3;
        const int pnl = u.pn & 1, row0 = u.pm * BM + wr * 64 + fr, col0 = pnl * 128 + wc * 32 + 8 * fq;
#pragma unroll
        for (int ai = 0; ai < 2; ++ai)
#pragma unroll
            for (int m = 0; m < 4; ++m) {
                bf16_t* rowp = HID + (size_t)(row0 + ai * HALF + m * 16) * 256 + col0;
                float hv[8];
#pragma unroll
                for (int n = 0; n < 2; ++n)
#pragma unroll
                    for (int i = 0; i < 4; ++i) { const float g = acc[ai][0][m][n][i], uu = acc[ai][1][m][n][i]; hv[n * 4 + i] = g / (1.f + __expf(-g)) * uu; }
                u32x4 w; w.x = cvt_pk_bf16(hv[0], hv[1]); w.y = cvt_pk_bf16(hv[2], hv[3]); w.z = cvt_pk_bf16(hv[4], hv[5]); w.w = cvt_pk_bf16(hv[6], hv[7]);
                *(u32x4*)rowp = w;
            }
    }
};
struct EpiDown {
    static constexpr bool PERM = true, AFTER_DRAIN = false;
    bf16_t* Y0; bf16_t* Y1; const PG8_LAS int* rowinfo; int wv;
    __device__ __forceinline__ void operator()(const f32x4 (&acc)[2][2][4][2], const Unit& u, int, int, int, int) const {
        const int l_ = otid(wv) & 63, fr_ = l_ & 15, fq = l_ >> 4, wr = wv >> 2, wc = wv & 3;
        const int col0 = (u.pn & 3) * BM + wc * 32 + 8 * fq;
        const PG8_LAS int* ri = rowinfo + (u.aux * 256 + wr * 64 + fr_) * 2;
#pragma unroll
        for (int ai = 0; ai < 2; ++ai)
#pragma unroll
            for (int m = 0; m < 4; ++m) {
                const int ent = ri[(ai * HALF + m * 16) * 2]; const float w = __builtin_bit_cast(float, ri[(ai * HALF + m * 16) * 2 + 1]);
                if (ent >= 0) {
                    bf16_t* rowp = Y0 + ((size_t)(ent & 1) * ((WS_Y1 - WS_Y0) / 2) + (size_t)(ent >> 1) * DM + col0);
#pragma unroll
                    for (int bj = 0; bj < 2; ++bj) {
                        const f32x4 v0 = acc[ai][bj][m][0] * w, v1 = acc[ai][bj][m][1] * w;
                        u32x4 o; o.x = cvt_pk_bf16(v0[0], v0[1]); o.y = cvt_pk_bf16(v0[2], v0[3]); o.z = cvt_pk_bf16(v1[0], v1[1]); o.w = cvt_pk_bf16(v1[2], v1[3]);
                        *(u32x4*)(rowp + bj * HALF) = o;
                    }
                }
                asm volatile("" ::: "memory");
            }
    }
};
struct MoeOrder {
    const PG8_LAS int* ttab; int ntile, npn, G, c;
    __device__ __forceinline__ bool next(int i, Unit& u) const {
        const int L = i * G + c; if (L >= ntile * npn) return false;
        const int t = L / npn, pl = L % npn; u.pm = t; u.pn = ttab[t * 4] * npn + pl; u.aux = i; return true;
    }
    __device__ __forceinline__ void a_ready(const Unit&) const {}
    __device__ __forceinline__ void done(const Unit&) const {}
};
}

__device__ __forceinline__ void phase_router_w(const Ptrs& p, int wv) {
    const int gt = blockIdx.x * NT + otid(wv), NG = gridDim.x * NT;
    for (int idx = gt; idx < 2 * 48 * DM; idx += NG) {
        const int layer = idx / (48 * DM), r = idx % (48 * DM), n = r >> 10, k = r & 1023;
        float w;
        if (n < 16) w = p.in[I_WRG][((size_t)layer * DM + k) * 4 + (n & 3)];
        else { const int g = ((n - 16) & 15) >> 2, i = n & 3, e = 8 * g + i + (n >= 32 ? 4 : 0); w = p.in[I_WRE][((size_t)layer * DM + k) * 32 + e]; }
        const unsigned hi = f2bf(w); const float lo = w - __builtin_bit_cast(float, hi << 16);
        bf16* base = (bf16*)(p.ws + WS_WR) + (size_t)layer * 2 * 48 * DM;
        base[r] = (bf16)hi; base[48 * DM + r] = (bf16)f2bf(lo);
    }
}

typedef short s8v __attribute__((ext_vector_type(8)));
constexpr size_t WS_GS2 = WS_LB + 64 * 1024;
__device__ __forceinline__ void phase_gs2(const Ptrs& p, int wv) {
    const int gt = blockIdx.x * NT + otid(wv), NG = gridDim.x * NT;
    for (int idx = gt; idx < 2 * 9 * DM; idx += NG) {
        const int layer = idx / (9 * DM), m = (idx / DM) % 9, c = idx & (DM - 1);
        const float* md = (const float*)(p.ws + WS_MOD) + ((size_t)layer * 9 + m) * MODW;
        float* o = (float*)(p.ws + WS_GS2) + ((size_t)(layer * 9 + m) * 2) * DM;
        o[c] = p.in[I_N2G][layer * DM + c] * (1.f + md[4 * DM + c]); o[DM + c] = md[3 * DM + c];
    }
}
__device__ __forceinline__ void phase_route(const Ptrs& p, LAS unsigned char* lds, int layer, int nrows, int wv) {
    const int tid = otid(wv), lane = tid & 63, wave = wv;
    LAS int* lcnt = (LAS int*)(lds + LDS_RT); LAS int* gb = lcnt + 32;
    if (tid < 32) lcnt[tid] = 0;
    __syncthreads();
    const int ntiles = nrows / 16, t = wave * gridDim.x + blockIdx.x;
    int e0 = -1, e1 = -1, lp0 = 0, lp1 = 0, ent0 = 0;
    if (t < ntiles) {
        const int row0 = t * 16, r = row0 + (lane & 15), kq = lane >> 4;
        const int mrow = (row0 < NLAT) ? (row0 >> 11) : 8;
        const float* xr = ((r < NLAT) ? p.out + (size_t)r * DM : (const float*)(p.ws + WS_XC) + (size_t)(r - NLAT) * DM) + 8 * kq;
        const float* gsp = (const float*)(p.ws + WS_GS2) + ((size_t)(layer * 9 + mrow) * 2) * DM + 8 * kq;
        bf16* hrow = (bf16*)(p.ws + WS_H) + (size_t)r * DM + 8 * kq;
        const bf16* wr_hi = (const bf16*)(p.ws + WS_WR) + (size_t)layer * 2 * 48 * DM + (size_t)(lane & 15) * DM + 8 * kq;
        float ss;
        { const v4f* rs = (const v4f*)((const float*)(p.ws + WS_RSS) + (size_t)r * 16); const v4f a = rs[0], b = rs[1], c = rs[2], d = rs[3];
          ss = ((a.x + a.y) + (a.z + a.w)) + ((b.x + b.y) + (b.z + b.w)) + ((c.x + c.y) + (c.z + c.w)) + ((d.x + d.y) + (d.z + d.w)); }
        const float rstd = rsqrtf(ss * (1.f / DM) + 1e-6f);
        v4f acc[3];
#pragma unroll
        for (int i = 0; i < 3; ++i) acc[i] = (v4f){0.f, 0.f, 0.f, 0.f};
#pragma unroll 1
        for (int s4 = 0; s4 < 32; s4 += 4) {
            v4f xa[4], xb[4], ga[4], gbv[4], ha[4], hb[4]; s8v wf[4][3];
#pragma unroll
            for (int u = 0; u < 4; ++u) {
                const int c0 = 32 * (s4 + u);
                xa[u] = *(const v4f*)(xr + c0); xb[u] = *(const v4f*)(xr + c0 + 4);
                ga[u] = *(const v4f*)(gsp + c0); gbv[u] = *(const v4f*)(gsp + c0 + 4);
                ha[u] = *(const v4f*)(gsp + DM + c0); hb[u] = *(const v4f*)(gsp + DM + c0 + 4);
#pragma unroll
                for (int nt = 0; nt < 3; ++nt) wf[u][nt] = *(const s8v*)(wr_hi + (size_t)nt * 16 * DM + c0);
            }
#pragma unroll
            for (int u = 0; u < 4; ++u) {
                const v4f h0 = xa[u] * rstd * ga[u] + ha[u], h1 = xb[u] * rstd * gbv[u] + hb[u];
                v4u hw; hw.x = pk2(h0.x, h0.y); hw.y = pk2(h0.z, h0.w); hw.z = pk2(h1.x, h1.y); hw.w = pk2(h1.z, h1.w);
                *(v4u*)(hrow + 32 * (s4 + u)) = hw;
                const s8v bh = __builtin_bit_cast(s8v, hw);
#pragma unroll
                for (int nt = 0; nt < 3; ++nt) acc[nt] = __builtin_amdgcn_mfma_f32_16x16x32_bf16(wf[u][nt], bh, acc[nt], 0, 0, 0);
            }
        }
        const float* brg = p.in[I_BRG] + layer * 4; const float* bre = p.in[I_BRE] + layer * 32;
        float gl[4];
#pragma unroll
        for (int i = 0; i < 4; ++i) gl[i] = acc[0][i] + brg[i];
        int gi = 0; float gm = gl[0];
#pragma unroll
        for (int i = 1; i < 4; ++i) if (gl[i] > gm) { gm = gl[i]; gi = i; }
        float den = 0.f;
#pragma unroll
        for (int i = 0; i < 4; ++i) den += __expf(gl[i] - gm);
        const float gtop = 1.f / den;
        if (kq == gi) {
            float el[8];
#pragma unroll
            for (int i = 0; i < 4; ++i) { el[i] = acc[1][i] + bre[8 * kq + i]; el[4 + i] = acc[2][i] + bre[8 * kq + 4 + i]; }
            int i0 = 0; float v0 = el[0];
#pragma unroll
            for (int i = 1; i < 8; ++i) if (el[i] > v0) { v0 = el[i]; i0 = i; }
            int i1 = -1; float v1 = -3.0e38f;
#pragma unroll
            for (int i = 0; i < 8; ++i) if (i != i0 && el[i] > v1) { v1 = el[i]; i1 = i; }
            const float p1 = __expf(v1 - v0), sden = 1.f / (1.f + p1);
            e0 = gi * 8 + i0; e1 = gi * 8 + i1; ent0 = r * 2;
            float* ew = (float*)(p.ws + WS_EW);
            ew[ent0] = gtop * sden; ew[ent0 + 1] = gtop * p1 * sden;
            lp0 = __hip_atomic_fetch_add(lcnt + e0, 1, __ATOMIC_RELAXED, __HIP_MEMORY_SCOPE_WORKGROUP); lp1 = __hip_atomic_fetch_add(lcnt + e1, 1, __ATOMIC_RELAXED, __HIP_MEMORY_SCOPE_WORKGROUP);
        }
    }
    __syncthreads();
    int* cnt = (int*)(p.ws + WS_CTL) + CW_CNT + layer * 64;
    if (tid < 32) gb[tid] = atomicAdd(&cnt[tid], lcnt[tid]);
    __syncthreads();
    if (e0 >= 0) {
        int* IDX = (int*)(p.ws + WS_IDX);
        IDX[(size_t)e0 * MROWS + gb[e0] + lp0] = ent0;
        IDX[(size_t)e1 * MROWS + gb[e1] + lp1] = ent0 + 1;
    }
}
__device__ __forceinline__ int moe_build_ttab(const Ptrs& p, LAS unsigned char* lds, int layer, int wv) {
    LAS int* ttab = (LAS int*)(lds + LDS_TTAB);
    const int* cnt = (const int*)(p.ws + WS_CTL) + CW_CNT + layer * 64;
    __syncthreads();
    if (otid(wv) == 0) {
        int t = 0;
        for (int e = 0; e < 32; ++e) { const int c = __hip_atomic_load(cnt + e, __ATOMIC_RELAXED, __HIP_MEMORY_SCOPE_AGENT); for (int fp = 0; fp < c; fp += 256) { ttab[t * 4] = e; ttab[t * 4 + 1] = fp; ttab[t * 4 + 2] = c; ++t; } }
        ttab[176 * 4] = t;
    }
    __syncthreads();
    return ttab[176 * 4];
}
__device__ __forceinline__ void phase_moe_gu(const Ptrs& p, LAS unsigned char* lds, int layer, int wv) {
    const int ntile = moe_build_ttab(p, lds, layer, wv);
    LAS int* ttab = (LAS int*)(lds + LDS_TTAB); LAS int* gidx = (LAS int*)(lds + LDS_GIDX);
    pg8::MoeOrder S{ttab, ntile, 2, (int)gridDim.x, (int)blockIdx.x};
    const int* IDX = (const int*)(p.ws + WS_IDX);
    for (int i = 0; i < 3; ++i) {
        pg8::Unit u; if (!S.next(i, u)) break;
        const int e = ttab[u.pm * 4], fp = ttab[u.pm * 4 + 1], c = ttab[u.pm * 4 + 2];
        for (int r = otid(wv); r < 256; r += NT) gidx[i * 256 + r] = (fp + r < c) ? (IDX[(size_t)e * MROWS + fp + r] >> 1) : 0;
    }
    __syncthreads();
    pg8::Gemm g{(const bf16*)(p.ws + WS_H), (const bf16*)(p.ws + WS_WGU + layer * WGU_STRIDE), ntile * 256, 32 * 512, DM};
    pg8::EpiGU E{(bf16*)(p.ws + WS_HID), wv};
    pg8::gemm_phase<pg8::EpiGU, pg8::MoeOrder, true, true, true>(lds, g, S, E, wv, gidx);
}
__device__ __forceinline__ void phase_moe_down(const Ptrs& p, LAS unsigned char* lds, int layer, int wv) {
    const int ntile = moe_build_ttab(p, lds, layer, wv);
    LAS int* ttab = (LAS int*)(lds + LDS_TTAB); LAS int* rowinfo = (LAS int*)(lds + LDS_GIDX);
    pg8::MoeOrder S{ttab, ntile, 4, (int)gridDim.x, (int)blockIdx.x};
    const int* IDX = (const int*)(p.ws + WS_IDX); const float* EW = (const float*)(p.ws + WS_EW);
    for (int i = 0; i < 3; ++i) {
        pg8::Unit u; if (!S.next(i, u)) break;
        const int e = ttab[u.pm * 4], fp = ttab[u.pm * 4 + 1], c = ttab[u.pm * 4 + 2];
        for (int r = otid(wv); r < 256; r += NT) {
            int ent = -1; float w = 0.f;
            if (fp + r < c) { ent = IDX[(size_t)e * MROWS + fp + r]; w = EW[ent]; }
            rowinfo[(i * 256 + r) * 2] = ent; rowinfo[(i * 256 + r) * 2 + 1] = __builtin_bit_cast(int, w);
        }
    }
    __syncthreads();
    pg8::Gemm g{(const bf16*)(p.ws + WS_HID), (const bf16*)(p.ws + WS_WD + layer * WD_STRIDE), ntile * 256, 32 * 1024, 256};
    pg8::EpiDown E{(bf16*)(p.ws + WS_Y0), (bf16*)(p.ws + WS_Y1), rowinfo, wv};
    pg8::gemm_phase<pg8::EpiDown, pg8::MoeOrder, true, true, false>(lds, g, S, E, wv);
}
__device__ __forceinline__ void phase_combine(const Ptrs& p, int layer, int nrows, bool do_norm, int wv) {
    const int lane = otid(wv) & 63, wave = wv;
    const int gw = blockIdx.x * NWAVES + wave, NGW = gridDim.x * NWAVES;
    const int per = (nrows + NGW - 1) / NGW;
    const int r0 = gw * per, r1 = min(r0 + per, nrows);
    const float* modl = (const float*)(p.ws + WS_MOD) + (size_t)layer * 9 * MODW;
    const float* modn = (const float*)(p.ws + WS_MOD) + (size_t)(layer + 1) * 9 * MODW;
    const float* g = p.in[I_N1G] + (layer + 1) * DM;
    const bf16* Y0 = (const bf16*)(p.ws + WS_Y0); const bf16* Y1 = (const bf16*)(p.ws + WS_Y1); bf16* H = (bf16*)(p.ws + WS_H);
    const unsigned lc = 4 * lane;
    int cur = -1; v4f m5v[4], gs[4], sh[4];
    v4f xn[4]; v2u an[4], bn[4];
    auto rowptr = [&](int r) -> float* { return (r < NLAT) ? p.out + (size_t)r * DM : (float*)(p.ws + WS_XC) + (size_t)(r - NLAT) * DM; };
    if (r0 < r1) {
        const float* xr = rowptr(r0);
#pragma unroll
        for (int j = 0; j < 4; ++j) { xn[j] = *(const v4f*)(xr + lc + 256 * j); an[j] = *(const v2u*)(Y0 + (size_t)r0 * DM + lc + 256 * j); bn[j] = *(const v2u*)(Y1 + (size_t)r0 * DM + lc + 256 * j); }
    }
    for (int r = r0; r < r1; ++r) {
        const int mrow = (r < NLAT) ? (r >> 11) : 8;
        if (mrow != cur) {
            cur = mrow; const float* m5 = modl + (size_t)mrow * MODW + 5 * DM; const float* mn = modn + (size_t)mrow * MODW;
#pragma unroll
            for (int j = 0; j < 4; ++j) { const unsigned c = lc + 256 * j; m5v[j] = *(const v4f*)(m5 + c);
                if (do_norm) { const v4f gg = *(const v4f*)(g + c), sc = *(const v4f*)(mn + DM + c); gs[j] = gg * (1.f + sc); sh[j] = *(const v4f*)(mn + c); } }
        }
        v4f x[4]; v2u a[4], b[4];
#pragma unroll
        for (int j = 0; j < 4; ++j) { x[j] = xn[j]; a[j] = an[j]; b[j] = bn[j]; }
        float* xr = rowptr(r);
        if (r + 1 < r1) {
            const float* xq = rowptr(r + 1);
#pragma unroll
            for (int j = 0; j < 4; ++j) { xn[j] = *(const v4f*)(xq + lc + 256 * j); an[j] = *(const v2u*)(Y0 + (size_t)(r + 1) * DM + lc + 256 * j); bn[j] = *(const v2u*)(Y1 + (size_t)(r + 1) * DM + lc + 256 * j); }
        }
        v4f v[4]; float s = 0.f;
#pragma unroll
        for (int j = 0; j < 4; ++j) {
            v4f y; y.x = bflo(a[j].x) + bflo(b[j].x); y.y = bfhi(a[j].x) + bfhi(b[j].x); y.z = bflo(a[j].y) + bflo(b[j].y); y.w = bfhi(a[j].y) + bfhi(b[j].y);
            v[j] = x[j] + m5v[j] * y;
            *(v4f*)(xr + lc + 256 * j) = v[j];
            s += (v[j].x * v[j].x + v[j].y * v[j].y) + (v[j].z * v[j].z + v[j].w * v[j].w);
        }
        if (do_norm) {
            const float rstd = rsqrtf(wave_sum(s, lane) * (1.f / DM) + 1e-6f);
#pragma unroll
            for (int j = 0; j < 4; ++j) { const v4f o = v[j] * rstd * gs[j] + sh[j]; v2u w; w.x = pk2(o.x, o.y); w.y = pk2(o.z, o.w); *(v2u*)(H + (size_t)r * DM + lc + 256 * j) = w; }
        }
    }
}

namespace hg {
typedef short s4v __attribute__((ext_vector_type(4)));
typedef short s8v __attribute__((ext_vector_type(8)));
typedef short v4i16_t __attribute__((ext_vector_type(4)));
constexpr int TS = 160;
constexpr int TILE_B = 16 * TS;
constexpr int WAVE_LDS = 2 * TILE_B;
constexpr int NSEG = 18;
constexpr size_t SEGU_B = 64 * 64 * 4, SEGA_B = 16 * 64 * 4;
constexpr size_t WS_SEGU = WS_SCR;
constexpr size_t WS_SEGA = WS_SEGU + (size_t)NBATCH * 4 * 2 * NSEG * SEGU_B;
static_assert(WS_SEGA + (size_t)NBATCH * 4 * 2 * NSEG * SEGA_B <= WS_END && 8 * WAVE_LDS <= 40960 && 40960 + 6 * 16384 <= LDS_BYTES - 64, "hgrn scratch");
template <int CTRL> __device__ __forceinline__ float dppf(float x) { return __builtin_bit_cast(float, __builtin_amdgcn_update_dpp(0, __builtin_bit_cast(int, x), CTRL, 0xf, 0xf, true)); }
__device__ __forceinline__ s4v trd(const LAS unsigned char* p) { return __builtin_bit_cast(s4v, __builtin_amdgcn_ds_read_tr16_b64_v4i16((LAS v4i16_t*)p)); }
typedef float f32x2_t __attribute__((ext_vector_type(2))); typedef __bf16 bf16x2_t __attribute__((ext_vector_type(2)));
__device__ __forceinline__ unsigned pkbf(float lo, float hi) { f32x2_t v = {lo, hi}; bf16x2_t b = __builtin_convertvector(v, bf16x2_t); return __builtin_bit_cast(unsigned, b); }
__device__ __forceinline__ float silu_r(float x) { return x * __builtin_amdgcn_rcpf(1.f + __expf(-x)); }
__device__ __forceinline__ s8v mk8(unsigned a, unsigned b, unsigned c, unsigned d) { v4u t; t.x = a; t.y = b; t.z = c; t.w = d; return __builtin_bit_cast(s8v, t); }

template <bool BWD, int OUT>
__device__ __forceinline__ void chunk(const bf16* __restrict__ P, int row0, int h, const float* __restrict__ lbh, v4f (&S)[4][4], float (&Atot)[16],
                                      LAS unsigned char* vt, LAS unsigned char* kt, int lane_, LAS v4f* OFL, int cidx, bf16* __restrict__ MIX, const float* __restrict__ on) {
    int lane = lane_; asm volatile("" : "+v"(lane));
    const int tok = lane & 15, kq = lane >> 4;
    const bf16* pb = P + (size_t)row0 * DIN + h * 64;
    const unsigned lo = (unsigned)(tok * DIN + 4 * kq);
    v2u zr[4], qr[4]; v4f lbq[4];
#pragma unroll
    for (int m = 0; m < 4; ++m) lbq[m] = *(const v4f*)(lbh + (unsigned)(16 * m + 4 * kq));
#pragma unroll
    for (int m = 0; m < 4; ++m) { zr[m] = *(const v2u*)(pb + (lo + (BWD ? C_FB : C_FF) + 16 * m)); if (OUT != 0) qr[m] = *(const v2u*)(pb + (lo + C_Q + 16 * m)); }
#pragma unroll
    for (int i = 0; i < 2; ++i) { const int pc = lane + 64 * i, r = pc >> 3, ch = pc & 7;
        const v4u vv = *(const v4u*)(pb + (unsigned)(r * DIN + C_I + 8 * ch)); *(LAS v4u*)(vt + r * TS + 16 * ch) = vv; }
    unsigned qf[8], kf[8];
    float A[16];
#pragma unroll
    for (int m = 0; m < 4; ++m)
#pragma unroll
        for (int jp = 0; jp < 2; ++jp) {
            const unsigned zw = jp ? zr[m].y : zr[m].x;
            float kt2[2], qt2[2], kh2[2];
#pragma unroll
            for (int i = 0; i < 2; ++i) {
                const int e = 4 * m + 2 * jp + i;
                const float z = i ? bfhi(zw) : bflo(zw);
                const float sg = __builtin_amdgcn_rcpf(1.f + __expf(-z)), lb = lbq[m][2 * jp + i];
                const float f = lb + (1.f - lb) * sg, kk = (1.f - lb) * (1.f - sg);
                const float lf = __logf(f);
                float c = lf, t = lf;
                if (!BWD) { c += dppf<0x111>(c); c += dppf<0x112>(c); c += dppf<0x114>(c); c += dppf<0x118>(c); }
                else      { c += dppf<0x101>(c); c += dppf<0x102>(c); c += dppf<0x104>(c); c += dppf<0x108>(c); }
                t += dppf<0x128>(t); t += dppf<0x124>(t); t += dppf<0x122>(t); t += dppf<0x121>(t);
                const float Ei = __expf(-fmaxf(c, -80.f)); A[e] = __expf(t);
                kt2[i] = kk * Ei; kh2[i] = kt2[i] * A[e];
                if (OUT != 0) { const unsigned qw = jp ? qr[m].y : qr[m].x; const float q = i ? bfhi(qw) : bflo(qw); qt2[i] = q * 0.125f * __expf(c); } else qt2[i] = 0.f;
            }
            kf[2 * m + jp] = pkbf(kt2[0], kt2[1]); if (OUT != 0) qf[2 * m + jp] = pkbf(qt2[0], qt2[1]);
            *(LAS unsigned*)(kt + tok * TS + (16 * m + 4 * kq + 2 * jp) * 2) = pkbf(kh2[0], kh2[1]);
            __builtin_amdgcn_sched_barrier(0);
        }
    asm volatile("s_waitcnt lgkmcnt(0)" ::: "memory");
    s8v vfr[4], khf[4];
    { const int i4 = tok >> 2, p4 = tok & 3; const LAS unsigned char* va = vt + (4 * kq + i4) * TS + 8 * p4; const LAS unsigned char* ka = kt + (4 * kq + i4) * TS + 8 * p4;
#pragma unroll
      for (int c = 0; c < 4; ++c) { const s4v a = trd(va + 32 * c), b = trd(ka + 32 * c);
          vfr[c] = (s8v){a[0], a[1], a[2], a[3], 0, 0, 0, 0}; khf[c] = (s8v){b[0], b[1], b[2], b[3], 0, 0, 0, 0}; } }
    if (OUT != 0) {
        const s8v q0 = mk8(qf[0], qf[1], qf[2], qf[3]), q1 = mk8(qf[4], qf[5], qf[6], qf[7]);
        const s8v k0 = mk8(kf[0], kf[1], kf[2], kf[3]), k1 = mk8(kf[4], kf[5], kf[6], kf[7]);
        v4f at = (v4f){0.f, 0.f, 0.f, 0.f};
        at = __builtin_amdgcn_mfma_f32_16x16x32_bf16(k0, q0, at, 0, 0, 0);
        at = __builtin_amdgcn_mfma_f32_16x16x32_bf16(k1, q1, at, 0, 0, 0);
#pragma unroll
        for (int j = 0; j < 4; ++j) { const int s = 4 * kq + j; const bool keep = BWD ? (s >= tok) : (s <= tok); at[j] = keep ? at[j] : 0.f; }
        const s8v af = mk8(pkbf(at[0], at[1]), pkbf(at[2], at[3]), 0u, 0u);
        v4f o[4];
#pragma unroll
        for (int vb = 0; vb < 4; ++vb) {
            o[vb] = __builtin_amdgcn_mfma_f32_16x16x32_bf16(vfr[vb], af, (v4f){0.f, 0.f, 0.f, 0.f}, 0, 0, 0);
            const s8v s0 = mk8(pkbf(S[0][vb][0], S[0][vb][1]), pkbf(S[0][vb][2], S[0][vb][3]), pkbf(S[1][vb][0], S[1][vb][1]), pkbf(S[1][vb][2], S[1][vb][3]));
            const s8v s1 = mk8(pkbf(S[2][vb][0], S[2][vb][1]), pkbf(S[2][vb][2], S[2][vb][3]), pkbf(S[3][vb][0], S[3][vb][1]), pkbf(S[3][vb][2], S[3][vb][3]));
            o[vb] = __builtin_amdgcn_mfma_f32_16x16x32_bf16(s0, q0, o[vb], 0, 0, 0);
            o[vb] = __builtin_amdgcn_mfma_f32_16x16x32_bf16(s1, q1, o[vb], 0, 0, 0);
            __builtin_amdgcn_sched_barrier(0);
        }
        LAS v4f* ofl = OFL + (cidx * 4) * 64 + lane;
        if (OUT == 1) {
#pragma unroll
            for (int vb = 0; vb < 4; ++vb) ofl[vb * 64] = o[vb];
        } else {
            float ss = 0.f;
#pragma unroll
            for (int vb = 0; vb < 4; ++vb) { o[vb] += ofl[vb * 64]; ss += (o[vb].x * o[vb].x + o[vb].y * o[vb].y) + (o[vb].z * o[vb].z + o[vb].w * o[vb].w); }
            ss += shx(ss, 16, lane); ss += shx(ss, 32, lane);
            const float rstd = rsqrtf(ss * (1.f / 64.f) + 1e-6f);
            bf16* mb = MIX + (size_t)row0 * DM + 768 + h * 64; const unsigned lom = (unsigned)(tok * DM + 4 * kq);
#pragma unroll
            for (int vb = 0; vb < 4; ++vb) {
                const v2u gw = *(const v2u*)(pb + (lo + C_G + 16 * vb)); const v4f gn = *(const v4f*)(on + (unsigned)(16 * vb + 4 * kq));
                const float g0 = bflo(gw.x), g1 = bfhi(gw.x), g2 = bflo(gw.y), g3 = bfhi(gw.y);
                v2u w; w.x = pkbf(o[vb].x * rstd * gn.x * silu_r(g0), o[vb].y * rstd * gn.y * silu_r(g1)); w.y = pkbf(o[vb].z * rstd * gn.z * silu_r(g2), o[vb].w * rstd * gn.w * silu_r(g3));
                *(v2u*)(mb + (lom + 16 * vb)) = w;
            }
        }
    }
#pragma unroll
    for (int db = 0; db < 4; ++db) {
        const v4f av = (v4f){A[4 * db], A[4 * db + 1], A[4 * db + 2], A[4 * db + 3]};
#pragma unroll
        for (int vb = 0; vb < 4; ++vb) S[db][vb] = __builtin_amdgcn_mfma_f32_16x16x32_bf16(khf[db], vfr[vb], S[db][vb] * av, 0, 0, 0);
        __builtin_amdgcn_sched_barrier(0);
    }
    if (OUT == 0) {
#pragma unroll
        for (int e = 0; e < 16; ++e) Atot[e] *= A[e];
    }
    asm volatile("s_waitcnt lgkmcnt(0)" ::: "memory");
}
__device__ __forceinline__ int seg_row0(int b, int seg) { return seg < 2 ? NLAT + b * CTXL + 128 * seg : b * SEQ + 128 * (seg - 2); }
__device__ __forceinline__ int scan_idx(int seg, int dir) { return dir == 0 ? seg : (seg < 2 ? 1 - seg : 19 - seg); }

__device__ __forceinline__ void unit_pass1(const Ptrs& p, int layer, int u, LAS unsigned char* wl, int lane) {
    const int dir = u & 1, bhs = u >> 1, seg = bhs % NSEG, bh = bhs / NSEG, h = bh & 3, b = bh >> 2;
    const bf16* P = (const bf16*)(p.ws + WS_P);
    const int row0 = seg_row0(b, seg);
    float Atot[16]; v4f S[4][4];
    const float* lbv = (const float*)(p.ws + WS_LB) + layer * 512 + dir * 256 + h * 64;
#pragma unroll
    for (int e = 0; e < 16; ++e) Atot[e] = 1.f;
#pragma unroll
    for (int i = 0; i < 4; ++i)
#pragma unroll
        for (int j = 0; j < 4; ++j) S[i][j] = (v4f){0.f, 0.f, 0.f, 0.f};
    if (dir == 0) {
#pragma unroll 1
        for (int c = 0; c < 8; ++c) chunk<false, 0>(P, row0 + 16 * c, h, lbv, S, Atot, wl, wl + TILE_B, lane, nullptr, c, nullptr, nullptr);
    } else {
#pragma unroll 1
        for (int c = 7; c >= 0; --c) chunk<true, 0>(P, row0 + 16 * c, h, lbv, S, Atot, wl, wl + TILE_B, lane, nullptr, c, nullptr, nullptr);
    }
    const size_t si = ((size_t)(bh * 2 + dir)) * NSEG + scan_idx(seg, dir);
    float* su = (float*)(p.ws + WS_SEGU + si * SEGU_B) + lane; float* sa = (float*)(p.ws + WS_SEGA + si * SEGA_B) + lane;
#pragma unroll
    for (int i = 0; i < 4; ++i)
#pragma unroll
        for (int j = 0; j < 4; ++j)
#pragma unroll
            for (int r = 0; r < 4; ++r) su[((i * 4 + j) * 4 + r) * 64] = S[i][j][r];
#pragma unroll
    for (int e = 0; e < 16; ++e) sa[e * 64] = Atot[e];
}
template <bool BWD>
__device__ __forceinline__ void unit_pass2(const Ptrs& p, int layer, int pu, LAS unsigned char* wl, LAS v4f* ofl_own, LAS v4f* ofl_partner, int lane, bool active) {
    const int seg = pu % NSEG, bh = pu / NSEG, h = bh & 3, b = bh >> 2;
    const bf16* P = (const bf16*)(p.ws + WS_P); bf16* MIX = (bf16*)(p.ws + WS_MIX);
    const float* on = p.in[I_HGON] + layer * 64;
    const int row0 = seg_row0(b, seg);
    constexpr int dir = BWD ? 1 : 0;
    float Atot[16]; v4f S[4][4];
    const float* lbv = (const float*)(p.ws + WS_LB) + layer * 512 + dir * 256 + h * 64;
    if (active) {
        {
            const size_t si = ((size_t)(bh * 2 + dir)) * NSEG + scan_idx(seg, dir);
            int ln = lane; asm volatile("" : "+v"(ln));
            const float* su = (const float*)(p.ws + WS_SEGU + si * SEGU_B) + ln;
#pragma unroll
            for (int i = 0; i < 4; ++i)
#pragma unroll
                for (int j = 0; j < 4; ++j) S[i][j] = (v4f){su[((i * 4 + j) * 4 + 0) * 64], su[((i * 4 + j) * 4 + 1) * 64], su[((i * 4 + j) * 4 + 2) * 64], su[((i * 4 + j) * 4 + 3) * 64]};
        }
#pragma unroll 1
        for (int k = 0; k < 4; ++k) { const int c = BWD ? 7 - k : k; chunk<BWD, 1>(P, row0 + 16 * c, h, lbv, S, Atot, wl, wl + TILE_B, lane, ofl_own, k, MIX, on); }
    }
    __syncthreads();
    if (active) {
#pragma unroll 1
        for (int k = 4; k < 8; ++k) { const int c = BWD ? 7 - k : k; chunk<BWD, 2>(P, row0 + 16 * c, h, lbv, S, Atot, wl, wl + TILE_B, lane, ofl_partner, 7 - k, MIX, on); }
    }
}
}
constexpr int LDS_HG_OFL = 40960, HG_OFL_B = 16384;
__device__ __forceinline__ void phase_hgrn1(const Ptrs& p, LAS unsigned char* lds, int layer, int wv) {
    const int lane = otid(wv) & 63; const int u = wv * gridDim.x + blockIdx.x;
    if (u < 2 * 32 * hg::NSEG) hg::unit_pass1(p, layer, u, lds + wv * hg::WAVE_LDS, lane);
}
__device__ __forceinline__ void phase_hgrn2(const Ptrs& p, LAS unsigned char* lds, int layer, int wv) {
    const int lane = otid(wv) & 63; const int pu = (wv >> 1) * gridDim.x + blockIdx.x;
    const bool active = pu < 32 * hg::NSEG && (layer == 0 || (pu % hg::NSEG) >= 2) && wv < 6;
    LAS v4f* own = (LAS v4f*)(lds + LDS_HG_OFL + (wv < 6 ? wv : 0) * HG_OFL_B); LAS v4f* partner = (LAS v4f*)(lds + LDS_HG_OFL + (wv < 6 ? (wv ^ 1) : 0) * HG_OFL_B);
    if (wv & 1) hg::unit_pass2<true>(p, layer, pu, lds + wv * hg::WAVE_LDS, own, partner, lane, active);
    else        hg::unit_pass2<false>(p, layer, pu, lds + wv * hg::WAVE_LDS, own, partner, lane, active);
}

__device__ __forceinline__ void phase_hgrn_scan(const Ptrs& p, int wv) {
    const int t = blockIdx.x * NT + otid(wv);
#pragma unroll 1
    for (int half = 0; half < 2; ++half) {
        const int e = t + half * (int)(gridDim.x * NT);
        if (e >= 64 * 4096) break;
        const int bhd = e >> 12, r = (e >> 6) & 63, l = e & 63;
        float* su = (float*)(p.ws + hg::WS_SEGU + (size_t)bhd * hg::NSEG * hg::SEGU_B) + r * 64 + l;
        const float* sa = (const float*)(p.ws + hg::WS_SEGA + (size_t)bhd * hg::NSEG * hg::SEGA_B) + (4 * (r >> 4) + (r & 3)) * 64 + l;
        float u[hg::NSEG], a[hg::NSEG];
#pragma unroll
        for (int j = 0; j < hg::NSEG; ++j) { u[j] = su[(size_t)j * 4096]; a[j] = sa[(size_t)j * 1024]; }
        float st = 0.f;
#pragma unroll
        for (int j = 0; j < hg::NSEG; ++j) { su[(size_t)j * 4096] = st; st = a[j] * st + u[j]; }
    }
}
namespace att {
using bf16=unsigned short;
using bf16x8=__attribute__((ext_vector_type(8)))short;
using s16x4=__attribute__((ext_vector_type(4)))short;
using f32x16=__attribute__((ext_vector_type(16)))float;
using u32x4=__attribute__((ext_vector_type(4)))unsigned;
constexpr int D=64,PIN_=DIN,POUT=DM;
constexpr int NW=8,QBLK=32,QB=QBLK*NW,KVBLK=64;
__device__ __forceinline__ int crow(int r,int hi){return (r&3)+8*(r>>2)+4*hi;}
#define SBAR() __builtin_amdgcn_sched_barrier(0)
constexpr int NSLOT=3, SLOTB=8192;
constexpr int LDS_K=0, LDS_V=NSLOT*SLOTB, LDS_WS=2*NSLOT*SLOTB, LDS_OST=LDS_WS+NW*64*4, LDS_BYTES=LDS_OST+NW*4096;
constexpr float C2=0.125f*1.4426950408889634f;
__device__ __forceinline__ void glds16(const void*gsrc,unsigned lds_dst){unsigned keep;
  asm volatile("s_mov_b32 %0, m0\n\ts_mov_b32 m0, %2\n\ts_nop 0\n\tglobal_load_lds_dwordx4 %1, off\n\ts_mov_b32 m0, %0":"=&s"(keep):"v"(gsrc),"s"(lds_dst):"memory");}
__device__ __forceinline__ float max3f(float a,float b,float c){float r;asm("v_max3_f32 %0, %1, %2, %3":"=v"(r):"v"(a),"v"(b),"v"(c));return r;}
__device__ __forceinline__ float max2f(float a,float b){float r;asm("v_max_f32_e32 %0, %1, %2":"=v"(r):"v"(a),"v"(b));return r;}
__device__ __forceinline__ float fadd_s(float a,float b){float r;asm("v_add_f32_e32 %0, %1, %2":"=v"(r):"v"(a),"v"(b));return r;}
__device__ __forceinline__ float fsub_s(float a,float b){float r;asm("v_sub_f32_e32 %0, %1, %2":"=v"(r):"v"(a),"v"(b));return r;}
typedef float f32x2_t __attribute__((ext_vector_type(2))); typedef __bf16 bf16x2_t __attribute__((ext_vector_type(2)));
__device__ __forceinline__ unsigned cvtpk_s(float lo,float hi){f32x2_t v={lo,hi};bf16x2_t b=__builtin_convertvector(v,bf16x2_t);return __builtin_bit_cast(unsigned,b);}
#define WAIT_BAR(N) asm volatile("s_waitcnt vmcnt(" #N ") lgkmcnt(0)\n\ts_barrier":::"memory")

__device__ __forceinline__ void qkt(f32x16&p0,f32x16&p1,const char*Kslot,const bf16x8*qr,const f32x16&negm,int r32,int hi){
  const char*kb=Kslot+hi*1024+r32*16;
  #pragma unroll
  for(int d0=0;d0<4;++d0){
    const bf16x8 b0=*reinterpret_cast<const bf16x8*>(kb+d0*2048);
    const bf16x8 b1=*reinterpret_cast<const bf16x8*>(kb+d0*2048+512);
    if(d0==0){p0=__builtin_amdgcn_mfma_f32_32x32x16_bf16(b0,qr[0],negm,0,0,0);p1=__builtin_amdgcn_mfma_f32_32x32x16_bf16(b1,qr[0],negm,0,0,0);}
    else{p0=__builtin_amdgcn_mfma_f32_32x32x16_bf16(b0,qr[d0],p0,0,0,0);p1=__builtin_amdgcn_mfma_f32_32x32x16_bf16(b1,qr[d0],p1,0,0,0);}}
}
typedef __attribute__((address_space(3))) const char* lds_cptr;
typedef short v4i16_t __attribute__((ext_vector_type(4)));
__device__ __forceinline__ void kload8(bf16x8*kf,lds_cptr kp){
  kf[0]=*(const __attribute__((address_space(3))) bf16x8*)(kp);      kf[1]=*(const __attribute__((address_space(3))) bf16x8*)(kp+512);
  kf[2]=*(const __attribute__((address_space(3))) bf16x8*)(kp+2048); kf[3]=*(const __attribute__((address_space(3))) bf16x8*)(kp+2560);
  kf[4]=*(const __attribute__((address_space(3))) bf16x8*)(kp+4096); kf[5]=*(const __attribute__((address_space(3))) bf16x8*)(kp+4608);
  kf[6]=*(const __attribute__((address_space(3))) bf16x8*)(kp+6144); kf[7]=*(const __attribute__((address_space(3))) bf16x8*)(kp+6656);
}
__device__ __forceinline__ void kload2(bf16x8*kf,lds_cptr kp,int j){ kf[2*j]=*(const __attribute__((address_space(3))) bf16x8*)(kp+j*2048); kf[2*j+1]=*(const __attribute__((address_space(3))) bf16x8*)(kp+j*2048+512); }
__device__ __forceinline__ s16x4 vtr(lds_cptr p){ return __builtin_bit_cast(s16x4,__builtin_amdgcn_ds_read_tr16_b64_v4i16((__attribute__((address_space(3))) v4i16_t*)p)); }
__device__ __forceinline__ float rowmax(const f32x16&p0,const f32x16&p1){
  float a=max3f(p0[0],p0[1],p1[0]),b=max3f(p0[2],p0[3],p1[1]);a=max3f(a,p1[2],p1[3]);
  #pragma unroll
  for(int r=4;r<16;r+=4){a=max3f(a,p0[r],p0[r+1]);b=max3f(b,p0[r+2],p0[r+3]);a=max3f(a,p1[r],p1[r+1]);b=max3f(b,p1[r+2],p1[r+3]);}
  const float m=max2f(a,b);
  auto rr=__builtin_amdgcn_permlane32_swap(__float_as_uint(m),__float_as_uint(m),false,false);
  return max2f(__uint_as_float(rr[0]),__uint_as_float(rr[1]));
}
__device__ __forceinline__ void pv(f32x16*o,int vb,bf16x8 pa0,bf16x8 pa1,bf16x8 pa2,bf16x8 pa3){
  #pragma unroll
  for(int d0=0;d0<2;++d0){s16x4 lo[4],hi[4];
    #pragma unroll
    for(int ks=0;ks<4;++ks){
      asm volatile("ds_read_b64_tr_b16 %0,%1 offset:%c2":"=&v"(lo[ks]):"v"(vb),"i"(d0*4096+ks*1024):"memory");
      asm volatile("ds_read_b64_tr_b16 %0,%1 offset:%c2":"=&v"(hi[ks]):"v"(vb),"i"(d0*4096+ks*1024+512):"memory");}
    asm volatile("s_waitcnt lgkmcnt(0)":::"memory");SBAR();
    #define PK(k) (bf16x8){lo[k][0],lo[k][1],lo[k][2],lo[k][3],hi[k][0],hi[k][1],hi[k][2],hi[k][3]}
    o[d0]=__builtin_amdgcn_mfma_f32_32x32x16_bf16(pa0,PK(0),o[d0],0,0,0);
    o[d0]=__builtin_amdgcn_mfma_f32_32x32x16_bf16(pa1,PK(1),o[d0],0,0,0);
    o[d0]=__builtin_amdgcn_mfma_f32_32x32x16_bf16(pa2,PK(2),o[d0],0,0,0);
    o[d0]=__builtin_amdgcn_mfma_f32_32x32x16_bf16(pa3,PK(3),o[d0],0,0,0);
    #undef PK
  }
}

#ifndef ATTN_STORE16
#define ATTN_STORE16(p,v) (*(u32x4*)(p)=(v))
#endif
template<int THRL,class Hook> __device__ __forceinline__ void attn_unit(const bf16*Q0,const bf16*__restrict__ Kh,const bf16*__restrict__ Vh,int rowa,int na,int rowb,int NT,bf16*O0,const Hook&hook,char*shm,int wid){
  const int lane=otid(wid)&63,r32=lane&31,hi=lane>>5;
  const bf16*Qw=Q0+(long)(wid*QBLK)*PIN_;
  #define TROW(t) ((long)(((t)<na)?(rowa+64*(t)):(rowb+64*((t)-na))))
  const unsigned lds0=(unsigned)(uintptr_t)shm;
  float*wsf=(float*)(shm+LDS_WS)+wid*64;
  const bf16*ksrc=Kh+(long)lane*PIN_+wid*8;
  const bf16*vsrc=Vh+(long)(16*(wid&3)+(lane>>2))*PIN_+(wid>>2)*32+(lane&3)*8;
  const unsigned kdst=lds0+LDS_K+wid*1024, vdst=lds0+LDS_V+wid*1024;
  #define DMA_K(t,slot) glds16(ksrc+TROW(t)*PIN_,(unsigned)__builtin_amdgcn_readfirstlane(kdst+(slot)))
  #define DMA_V(t,slot) glds16(vsrc+TROW(t)*PIN_,(unsigned)__builtin_amdgcn_readfirstlane(vdst+(slot)))
  const int vb0=(int)(lds0+LDS_V)+((lane>>4)&1)*32+(lane&3)*8+(4*hi+((lane&15)>>2))*64;
  const char*Kbase=shm+LDS_K; bf16x8 kf[8];
  const lds_cptr shm3=(lds_cptr)shm; const lds_cptr kp0=shm3+LDS_K+hi*1024+r32*16; const lds_cptr vp0=shm3+LDS_V+((lane>>4)&1)*32+(lane&3)*8+(4*hi+((lane&15)>>2))*64;
  DMA_K(0,0);DMA_V(0,0);DMA_K(1,SLOTB);
  bf16x8 qr[4];
  #pragma unroll
  for(int d0=0;d0<4;++d0)qr[d0]=*reinterpret_cast<const bf16x8*>(&Qw[(long)r32*PIN_+d0*16+hi*8]);
  float zz_=0.f; asm volatile("":"+v"(zz_));
  float mhat=zz_,l_reg=zz_;f32x16 o[2],negm;
  #pragma unroll
  for(int r=0;r<16;++r){o[0][r]=zz_;o[1][r]=zz_;negm[r]=zz_;}
  asm volatile("":"+v"(negm));
  #define CMASK(P0,P1,t) hook(P0,P1,(t),wid,r32,hi)
  bool resc=false;
  #define START(P0,P1) do{ const float rm=rowmax(P0,P1); resc=false; \
    { const float dl=rm; mhat=fadd_s(mhat,dl); \
      _Pragma("unroll") for(int r=0;r<16;++r){P0[r]=fsub_s(P0[r],dl);P1[r]=fsub_s(P1[r],dl);} \
      _Pragma("unroll") for(int r=0;r<16;++r)negm[r]=-mhat; asm volatile("":"+v"(negm)); } \
    _Pragma("unroll") for(int r=0;r<16;++r)P0[r]=__builtin_amdgcn_exp2f(P0[r]); }while(0)
  #define RESC() do{ if(resc){ asm volatile("s_waitcnt lgkmcnt(0)":::"memory"); \
      _Pragma("unroll") for(int d_=0;d_<2;++d_) _Pragma("unroll") for(int r=0;r<16;++r)o[d_][r]*=wsf[crow(r,hi)]; } }while(0)
  f32x16 pA0,pA1,pB0,pB1;
  int sl_prev=0,sl_cur=0,sl_next=SLOTB;
  #define ROT() do{sl_prev=sl_cur;sl_cur=sl_next;sl_next=(sl_next==(NSLOT-1)*SLOTB)?0:sl_next+SLOTB;}while(0)
  DMA_K(2,2*SLOTB);
  WAIT_BAR(3);
  qkt(pA0,pA1,Kbase,qr,negm,r32,hi);asm volatile("s_nop 15\n\ts_nop 7":"+v"(pA0),"+v"(pA1));
  START(pA0,pA1);
  _Pragma("unroll") for(int r=0;r<16;++r)pA1[r]=__builtin_amdgcn_exp2f(pA1[r]);
  WAIT_BAR(0);
  DMA_K(3,0);DMA_V(1,SLOTB);
  ROT();
  kload8(kf,kp0+sl_cur);
  WAIT_BAR(2);
  s16x4 vlo[8],vhi[8]; u32x4 pw0,pw1,pw2,pw3;
  #define PKW(P,B) cvtpk_s(P[B],P[B+1])
  #define PAF(k) __builtin_bit_cast(bf16x8,pw##k)
  #define VFR(i) (bf16x8){vlo[i][0],vlo[i][1],vlo[i][2],vlo[i][3],vhi[i][0],vhi[i][1],vhi[i][2],vhi[i][3]}
  #define PIN(x) asm volatile("":"+v"(x))
  #define MX3(a,b,c) __builtin_fmaxf(__builtin_fmaxf((a),(b)),(c))
  #define GAPA(MF,A0,A1,A2,A3,W0,W1,PW) do{ MF; sacc+=A0; sacc+=A1; sacc+=A2; sacc+=A3; PIN(sacc); W0; W1; PIN(PW); SBAR(); }while(0)
  #define EX(v) __builtin_amdgcn_exp2f(v)
  #define GAPB(MF,X,B) do{ MF; X[B]=EX(X[B]); X[B+1]=EX(X[B+1]); X[B+2]=EX(X[B+2]); X[B+3]=EX(X[B+3]); PIN(X); SBAR(); }while(0)
  #define VRD(i) do{ vlo[i]=vtr(vp_+(((i)>>2)*4096+((i)&3)*1024)); vhi[i]=vtr(vp_+(((i)>>2)*4096+((i)&3)*1024+512)); }while(0)
  #define KRD(G,j) do{ if(G){ kload2(kf,kp0+sl_next,j); SBAR(); } }while(0)
  #define STEP(C0,C1,P0,P1,t,GK,GV,GL) do{ SBAR(); \
    const lds_cptr vp_=vp0+sl_prev; \
    VRD(0); SBAR(); float sacc=(P0[0]+P0[1]); \
    GAPA(C0=__builtin_amdgcn_mfma_f32_32x32x16_bf16(kf[0],qr[0],negm,0,0,0), P0[2],P0[3],P0[4],P0[5],     pw0[0]=PKW(P0,0), pw0[1]=PKW(P0,2), pw0); \
    VRD(4); SBAR(); GAPA(C1=__builtin_amdgcn_mfma_f32_32x32x16_bf16(kf[1],qr[0],negm,0,0,0), P0[6],P0[7],P0[8],P0[9],     pw0[2]=PKW(P0,4), pw0[3]=PKW(P0,6), pw0); \
    VRD(1); SBAR(); GAPA(C0=__builtin_amdgcn_mfma_f32_32x32x16_bf16(kf[2],qr[1],C0,0,0,0),   P0[10],P0[11],P0[12],P0[13], pw1[0]=PKW(P0,8), pw1[1]=PKW(P0,10), pw1); \
    VRD(5); SBAR(); GAPA(C1=__builtin_amdgcn_mfma_f32_32x32x16_bf16(kf[3],qr[1],C1,0,0,0),   P0[14],P0[15],P1[0],P1[1],   pw1[2]=PKW(P0,12),pw1[3]=PKW(P0,14), pw1); \
    VRD(2); SBAR(); GAPA(C0=__builtin_amdgcn_mfma_f32_32x32x16_bf16(kf[4],qr[2],C0,0,0,0),   P1[2],P1[3],P1[4],P1[5],     pw2[0]=PKW(P1,0), pw2[1]=PKW(P1,2), pw2); \
    VRD(6); SBAR(); GAPA(C1=__builtin_amdgcn_mfma_f32_32x32x16_bf16(kf[5],qr[2],C1,0,0,0),   P1[6],P1[7],P1[8],P1[9],     pw2[2]=PKW(P1,4), pw2[3]=PKW(P1,6), pw2); \
    VRD(3); SBAR(); GAPA(C0=__builtin_amdgcn_mfma_f32_32x32x16_bf16(kf[6],qr[3],C0,0,0,0),   P1[10],P1[11],P1[12],P1[13], pw3[0]=PKW(P1,8), pw3[1]=PKW(P1,10), pw3); \
    VRD(7); SBAR(); GAPA(C1=__builtin_amdgcn_mfma_f32_32x32x16_bf16(kf[7],qr[3],C1,0,0,0),   P1[14],P1[15],0.f,0.f,       pw3[2]=PKW(P1,12),pw3[3]=PKW(P1,14), pw3); \
    l_reg+=sacc; \
    if(GK){DMA_K((t)+3,sl_cur);} if(GV){DMA_V((t)+1,sl_next);} \
    CMASK(C0,C1,t); \
    { float a=MX3(C0[0],C0[1],C1[0]),b=MX3(C0[2],C0[3],C1[1]); a=MX3(a,C1[2],C1[3]); \
      _Pragma("unroll") for(int r=4;r<16;r+=4){a=MX3(a,C0[r],C0[r+1]);b=MX3(b,C0[r+2],C0[r+3]);a=MX3(a,C1[r],C1[r+1]);b=MX3(b,C1[r+2],C1[r+3]);} \
      float rm=__builtin_fmaxf(a,b); { auto rr=__builtin_amdgcn_permlane32_swap(__float_as_uint(rm),__float_as_uint(rm),false,false); rm=__builtin_fmaxf(__uint_as_float(rr[0]),__uint_as_float(rr[1])); } \
      resc=false; \
      if(__builtin_expect(__any(rm>(float)THRL),0)){ const float dl=__builtin_fmaxf(rm,0.f); mhat+=dl; \
        _Pragma("unroll") for(int r=0;r<16;++r){C0[r]-=dl;C1[r]-=dl;} \
        _Pragma("unroll") for(int r=0;r<16;++r)negm[r]=-mhat; asm volatile("":"+v"(negm)); \
        const float f=__builtin_amdgcn_exp2f(-dl); l_reg*=f; if(hi==0)wsf[r32]=f; resc=true; } } \
    SBAR(); \
    GAPB(o[0]=__builtin_amdgcn_mfma_f32_32x32x16_bf16(PAF(0),VFR(0),o[0],0,0,0), C0,0); \
    GAPB(o[1]=__builtin_amdgcn_mfma_f32_32x32x16_bf16(PAF(0),VFR(4),o[1],0,0,0), C0,4); \
    KRD(GL,0); GAPB(o[0]=__builtin_amdgcn_mfma_f32_32x32x16_bf16(PAF(1),VFR(1),o[0],0,0,0), C0,8); \
    KRD(GL,1); GAPB(o[1]=__builtin_amdgcn_mfma_f32_32x32x16_bf16(PAF(1),VFR(5),o[1],0,0,0), C0,12); \
    KRD(GL,2); GAPB(o[0]=__builtin_amdgcn_mfma_f32_32x32x16_bf16(PAF(2),VFR(2),o[0],0,0,0), C1,0); \
    KRD(GL,3); GAPB(o[1]=__builtin_amdgcn_mfma_f32_32x32x16_bf16(PAF(2),VFR(6),o[1],0,0,0), C1,4); \
    GAPB(o[0]=__builtin_amdgcn_mfma_f32_32x32x16_bf16(PAF(3),VFR(3),o[0],0,0,0), C1,8); \
    GAPB(o[1]=__builtin_amdgcn_mfma_f32_32x32x16_bf16(PAF(3),VFR(7),o[1],0,0,0), C1,12); \
    }while(0)
  int t=1;
  for(;t+5<NT;t+=2){
    STEP(pB0,pB1,pA0,pA1,t,true,true,true);     WAIT_BAR(2); RESC(); ROT();
    STEP(pA0,pA1,pB0,pB1,t+1,true,true,true);   WAIT_BAR(2); RESC(); ROT();
  }
  #define ENDW(tt) do{ if((tt)+3<NT){WAIT_BAR(2);} else if((tt)+2<NT){WAIT_BAR(1);} else {WAIT_BAR(0);} }while(0)
  for(;t+1<NT;t+=2){
    STEP(pB0,pB1,pA0,pA1,t,(t+3<NT),(t+1<NT),(t+1<NT));       ENDW(t);   RESC(); ROT();
    STEP(pA0,pA1,pB0,pB1,t+1,(t+4<NT),(t+2<NT),(t+2<NT));     ENDW(t+1); RESC(); ROT();
  }
  STEP(pB0,pB1,pA0,pA1,NT-1,false,false,false); RESC();
  { float sacc=pB0[0]+pB0[1]; _Pragma("unroll") for(int r=2;r<16;++r)sacc+=pB0[r]; _Pragma("unroll") for(int r=0;r<16;++r)sacc+=pB1[r]; l_reg+=sacc;
    pw0=(u32x4){PKW(pB0,0),PKW(pB0,2),PKW(pB0,4),PKW(pB0,6)};pw1=(u32x4){PKW(pB0,8),PKW(pB0,10),PKW(pB0,12),PKW(pB0,14)};pw2=(u32x4){PKW(pB1,0),PKW(pB1,2),PKW(pB1,4),PKW(pB1,6)};pw3=(u32x4){PKW(pB1,8),PKW(pB1,10),PKW(pB1,12),PKW(pB1,14)};
    SBAR(); pv(o,vb0+sl_cur,PAF(0),PAF(1),PAF(2),PAF(3)); }
  #undef PKW
  #undef PAF
  #undef VFR
  #undef PIN
  #undef MX3
  #undef GAPA
  #undef GAPB
  #undef EX
  #undef VRD
  #undef KRD
  #undef STEP
  #undef ENDW
  {auto rr=__builtin_amdgcn_permlane32_swap(__float_as_uint(l_reg),__float_as_uint(l_reg),false,false);l_reg=__uint_as_float(rr[0])+__uint_as_float(rr[1]);}
  if(hi==0)wsf[32+r32]=l_reg;asm volatile("s_waitcnt lgkmcnt(0)":::"memory");
  float rli[16];
  #pragma unroll
  for(int r=0;r<16;++r)rli[r]=__builtin_amdgcn_rcpf(wsf[32+crow(r,hi)]);
  bf16*Ow=O0+(long)(wid*QBLK)*POUT;
  { bf16*stg=(bf16*)(shm+LDS_OST)+wid*2048;
    #pragma unroll
    for(int r=0;r<16;++r){const int orow=crow(r,hi);
      #pragma unroll
      for(int d0=0;d0<2;++d0)stg[orow*64+d0*32+r32]=(bf16)f2bf(o[d0][r]*rli[r]);}
    asm volatile("s_waitcnt lgkmcnt(0)":::"memory");
    #pragma unroll
    for(int i=0;i<4;++i){const int row=i*8+(lane>>3),ch=lane&7; const u32x4 v=*(const u32x4*)(stg+row*64+ch*8); ATTN_STORE16(Ow+(long)row*POUT+ch*8,v);} }
  asm volatile("s_waitcnt lgkmcnt(0)\n\ts_barrier":::"memory");
  #undef DMA_K
  #undef DMA_V
  #undef TROW
  #undef CMASK
  #undef START
  #undef RESC
  #undef ROT
}
constexpr int ATTN_LDS_BYTES=LDS_BYTES;
#undef SBAR
#undef WAIT_BAR
}

namespace pg8 {
struct EpiInProj {
    static constexpr bool PERM = true, AFTER_DRAIN = false;
    bf16_t* P; const float* na_qn; const float* na_kn; const float* gq_qn; const float* gq_kn; int wv;
    __device__ __forceinline__ void operator()(const f32x4 (&acc)[2][2][4][2], const Unit& u, int, int, int, int) const {
        const int l_ = otid(wv) & 63, fr = l_ & 15, fq = l_ >> 4, wr = wv >> 2, wc = wv & 3;
        const int pn = u.pn, rowt = u.pm * BM;
        int mode = 0; const float* gain = na_qn; float qs = 1.f;
        if (pn == 0) { mode = 1; gain = na_qn; qs = att::C2; }
        else if (pn == 1) { mode = 1; gain = na_kn; }
        else if (pn == 3 || pn == 4) { mode = 2; gain = gq_qn; qs = att::C2; }
        else if (pn == 5 && wc < 2) { mode = 2; gain = gq_kn; }
        if (mode == 2 && rowt >= NLAT) mode = 1;
        bf16_t* pcol = P + pn * BM + 64 * wc + 8 * fq;
        if (mode == 0) {
#pragma unroll
            for (int ai = 0; ai < 2; ++ai)
#pragma unroll
                for (int m = 0; m < 4; ++m) { bf16_t* rowp = pcol + (size_t)(rowt + ai * HALF + wr * 64 + m * 16 + fr) * DIN;
#pragma unroll
                    for (int bj = 0; bj < 2; ++bj) { const f32x4 v0 = acc[ai][bj][m][0], v1 = acc[ai][bj][m][1];
                        u32x4 w; w.x = cvt_pk_bf16(v0[0], v0[1]); w.y = cvt_pk_bf16(v0[2], v0[3]); w.z = cvt_pk_bf16(v1[0], v1[1]); w.w = cvt_pk_bf16(v1[2], v1[3]);
                        *(u32x4*)(rowp + 32 * bj) = w; } }
            return;
        }
        f32x4 g[2][2]; float invf[2][2];
#pragma unroll
        for (int bj = 0; bj < 2; ++bj)
#pragma unroll
            for (int n = 0; n < 2; ++n) g[bj][n] = *(const f32x4*)(gain + 32 * bj + 8 * fq + 4 * n) * qs;
#pragma unroll
        for (int n = 0; n < 2; ++n)
#pragma unroll
            for (int pp = 0; pp < 2; ++pp) invf[n][pp] = exp2f(-(float)(4 * fq + 2 * n + pp) * (13.287712379549449f / 16.f));
#pragma unroll
        for (int ai = 0; ai < 2; ++ai)
#pragma unroll
            for (int m = 0; m < 4; ++m) {
                const int row = rowt + ai * HALF + wr * 64 + m * 16 + fr;
                f32x4 v[2][2]; float ss = 0.f;
#pragma unroll
                for (int bj = 0; bj < 2; ++bj)
#pragma unroll
                    for (int n = 0; n < 2; ++n) { v[bj][n] = acc[ai][bj][m][n]; ss += (v[bj][n][0] * v[bj][n][0] + v[bj][n][1] * v[bj][n][1]) + (v[bj][n][2] * v[bj][n][2] + v[bj][n][3] * v[bj][n][3]); }
                ss += shx(ss, 16, l_); ss += shx(ss, 32, l_);
                const float rstd = rsqrtf(ss * (1.f / 64.f) + 1e-6f);
#pragma unroll
                for (int bj = 0; bj < 2; ++bj)
#pragma unroll
                    for (int n = 0; n < 2; ++n) {
                        if (mode == 2) {
                        }
                        v[bj][n] = v[bj][n] * rstd * g[bj][n];
                    }
                if (mode == 2) {
                    const int t = row & (SEQ - 1); const float pos[2] = {(float)(t >> 6), (float)(t & 63)};
#pragma unroll
                    for (int bj = 0; bj < 2; ++bj)
#pragma unroll
                        for (int n = 0; n < 2; ++n)
#pragma unroll
                            for (int pp = 0; pp < 2; ++pp) {
                                const float ang = pos[bj] * invf[n][pp], cs = __cosf(ang), sn = __sinf(ang);
                                const float x1 = v[bj][n][2 * pp], x2 = v[bj][n][2 * pp + 1];
                                v[bj][n][2 * pp] = x1 * cs - x2 * sn; v[bj][n][2 * pp + 1] = x1 * sn + x2 * cs;
                            }
                }
                bf16_t* rowp = pcol + (size_t)row * DIN;
#pragma unroll
                for (int bj = 0; bj < 2; ++bj) { const f32x4 v0 = v[bj][0], v1 = v[bj][1];
                    u32x4 w; w.x = cvt_pk_bf16(v0[0], v0[1]); w.y = cvt_pk_bf16(v0[2], v0[3]); w.z = cvt_pk_bf16(v1[0], v1[1]); w.w = cvt_pk_bf16(v1[2], v1[3]);
                    *(u32x4*)(rowp + 32 * bj) = w; }
                asm volatile("" ::: "memory");
            }
    }
};
}

__device__ __forceinline__ void w_qknorm_rope(const Ptrs& p, int layer, int unit, int d) {
    const int row = unit / 18, slot = unit % 18;
    int col; const float* gain; bool rope;
    if (slot < 4) { col = A_Q + slot * 64; gain = p.in[I_NAQN] + layer * 64; rope = false; }
    else if (slot < 8) { col = A_K + (slot - 4) * 64; gain = p.in[I_NAKN] + layer * 64; rope = false; }
    else if (slot < 16) { col = B_Q + (slot - 8) * 64; gain = p.in[I_GQQN] + layer * 64; rope = true; }
    else { col = B_K + (slot - 16) * 64; gain = p.in[I_GQKN] + layer * 64; rope = true; }
    bf16* pp = (bf16*)(p.ws + WS_P) + (size_t)row * DIN + col;
    float x = bf2f(pp[d]);
    float ss = wave_sum(x * x, d);
    float y = x * rsqrtf(ss * (1.f / 64.f) + 1e-6f) * gain[d];
    if (rope && row < NLAT) {
        int t = row & (SEQ - 1);
        float partner = shx(y, 1, d);
        int pi = d >> 1;
        float pos = (pi < 16) ? (float)(t >> 6) : (float)(t & 63);
        float inv = exp2f(-(float)(pi & 15) * (13.287712379549449f / 16.f));
        float ang = pos * inv;
        float cs = __cosf(ang), sn = __sinf(ang);
        y = (d & 1) ? (partner * sn + y * cs) : (y * cs - partner * sn);
    }
    if (slot < 4 || (slot >= 8 && slot < 16)) y *= att::C2;
    pp[d] = (bf16)f2bf(y);
}
struct NoHook { __device__ __forceinline__ void operator()(att::f32x16&, att::f32x16&, int, int, int, int) const {} };
struct NaHook {
    const LAS float* tab; int r0, kr0;
    __device__ __forceinline__ void operator()(att::f32x16& p0, att::f32x16& p1, int t, int wid, int r32, int hi) const {
        if (t < 4) return;
        const int r = r0 + (wid >> 1), kr = kr0 + t - 4, rs = min(max(r - 4, 0), 24);
        const float NEG = -INFINITY;
        if ((unsigned)(kr - rs) >= 8u) {
#pragma unroll
            for (int i = 0; i < 16; ++i) { p0[i] = NEG; p1[i] = NEG; }
            return;
        }
        const int qc = 32 * (wid & 1) + r32, cs = min(max(qc - 8, 0), 48), kb = 4 * hi - cs;
        const LAS float* tp = tab + (kr - r + 7) * 31 + (4 * hi - qc + 15);
#pragma unroll
        for (int i = 0; i < 16; ++i) {
            const int c = (i & 3) + 8 * (i >> 2);
            const float b0 = tp[c], b1 = tp[c + 32];
            p0[i] = ((unsigned)(kb + c) < 16u) ? p0[i] + b0 : NEG;
            p1[i] = ((unsigned)(kb + c + 32) < 16u) ? p1[i] + b1 : NEG;
        }
    }
};
constexpr int LDS_NATAB = 88064;
__device__ __forceinline__ void phase_attn(const Ptrs& p, unsigned char* lds_gen, int layer, int wv) {
    const bf16* P = (const bf16*)(p.ws + WS_P); bf16* MIX = (bf16*)(p.ws + WS_MIX);
    char* shm = (char*)lds_gen;
    const int c = blockIdx.x, x = c & 7, ci = (c >> 3) & 31;
    for (int i = 0; i < 2; ++i) {
        const int grp = 2 * x + i, b = grp >> 1, kvh = grp & 1, g = ci >> 3, qb = ci & 7, hq = kvh * 4 + g;
        const size_t qrow = (size_t)b * SEQ + qb * 256;
        att::attn_unit<8, NoHook>(P + qrow * DIN + B_Q + hq * 64, P + B_K + kvh * 64, P + B_V + kvh * 64, b * SEQ, 32, NLAT + b * CTXL, 36,
                                  MIX + qrow * DM + 256 + hq * 64, NoHook{}, shm, wv);
    }
    {
        const int grp = 4 * x + (ci >> 3), b = grp >> 2, h = grp & 3, r0 = 4 * (ci & 7);
        const int kr0 = (r0 == 0) ? 0 : (r0 == 28 ? 24 : r0 - 4), nr = (r0 == 0 || r0 == 28) ? 8 : 12;
        LAS float* tab = (LAS float*)((LAS unsigned char*)lds_gen + LDS_NATAB);
        const float* rpb = p.in[I_RPB] + ((size_t)layer * 4 + h) * 15 * 31;
        for (int i = otid(wv); i < 15 * 31; i += NT) tab[i] = rpb[i] * 1.4426950408889634f;
        __syncthreads();
        const size_t qrow = (size_t)b * SEQ + r0 * 64;
        NaHook hook{tab, r0, kr0};
        att::attn_unit<8, NaHook>(P + qrow * DIN + A_Q + h * 64, P + A_K + h * 64, P + A_V + h * 64, NLAT + b * CTXL, 4, b * SEQ + kr0 * 64, 4 + nr,
                                  MIX + qrow * DM + h * 64, hook, shm, wv);
    }
    if (layer == 0 && c < 96) {
        if (c < 32) {
            const int b = c >> 2, h = c & 3; const size_t qrow = (size_t)NLAT + b * CTXL;
            att::attn_unit<8, NoHook>(P + qrow * DIN + A_Q + h * 64, P + A_K + h * 64, P + A_V + h * 64, NLAT + b * CTXL, 4, 0, 4, MIX + qrow * DM + h * 64, NoHook{}, shm, wv);
        } else {
            const int cc = c - 32, b = cc >> 3, hq = cc & 7, kvh = hq >> 2; const size_t qrow = (size_t)NLAT + b * CTXL;
            att::attn_unit<8, NoHook>(P + qrow * DIN + B_Q + hq * 64, P + B_K + kvh * 64, P + B_V + kvh * 64, NLAT + b * CTXL, 4, 0, 4, MIX + qrow * DM + 256 + hq * 64, NoHook{}, shm, wv);
        }
    }
}


#define XB_TMO      128
#define XB_XCNT(j)  (256  + 64 * (j))
#define XB_XSUB(j)  (1280 + 64 * (j))
#define XB_XGEN(j)  (2304 + 64 * (j))
#define XB_TOP      3328
#define XB_TOPGEN   3392
#define XCD_BAR_WORDS 3456
#define XB_SPIN_CAP (1u << 18)
constexpr int CW_BAR = 4096;
constexpr int LDS_XB = LDS_BYTES - 64;
__device__ __forceinline__ unsigned xb_ld(unsigned* p)              { return __hip_atomic_load(p, __ATOMIC_RELAXED, __HIP_MEMORY_SCOPE_AGENT); }
__device__ __forceinline__ unsigned xb_add(unsigned* p, unsigned v) { return __hip_atomic_fetch_add(p, v, __ATOMIC_RELAXED, __HIP_MEMORY_SCOPE_AGENT); }
__device__ __forceinline__ unsigned xb_xcc_id() { return (unsigned)__builtin_amdgcn_s_getreg((3 << 11) | 20) & 0xFu; }
#define XB_SPIN(cond, bar) do { unsigned _sp = 0; while (cond) { __builtin_amdgcn_s_sleep(1); \
    if ((++_sp & 255u) == 0u) { if (xb_ld(&(bar)[XB_TMO])) break; if (_sp > XB_SPIN_CAP) { atomicAdd(&(bar)[XB_TMO], 1u); break; } } } } while (0)
struct XcdBarrier { unsigned* bar; unsigned x; volatile LAS unsigned* st; };
__device__ __forceinline__ XcdBarrier xcd_barrier_post(unsigned* bar, volatile LAS unsigned* st, int wv) {
    XcdBarrier b; b.bar = bar; b.x = xb_xcc_id(); b.st = st;
    if (otid(wv) == 0) (void)xb_add(&bar[XB_XCNT(b.x)], 1u);
    return b;
}
__device__ __forceinline__ void xcd_barrier_complete(unsigned* bar, unsigned x, unsigned& nloc, unsigned& nx) {
    const unsigned G = gridDim.x * gridDim.y * gridDim.z;
    unsigned sum, cnt, mine, sp = 0u;
    for (;;) {
        sum = 0u; cnt = 0u; mine = 0u;
#pragma unroll
        for (unsigned j = 0; j < 16; ++j) { const unsigned c = xb_ld(&bar[XB_XCNT(j)]); sum += c; cnt += (c > 0u) ? 1u : 0u; mine = (j == x) ? c : mine; }
        if (sum == G) break;
        __builtin_amdgcn_s_sleep(1);
        if ((++sp & 255u) == 0u) { if (xb_ld(&bar[XB_TMO])) break; if (sp > XB_SPIN_CAP) { atomicAdd(&bar[XB_TMO], 1u); break; } }
    }
    nloc = mine > 0u ? mine : 1u; nx = cnt > 0u ? cnt : 1u;
}
__device__ __forceinline__ void xcd_barrier(const XcdBarrier& b, int wv) {
    asm volatile("s_waitcnt vmcnt(0)" ::: "memory");
    __syncthreads();
    if (otid(wv) == 0) {
        unsigned* bar = b.bar; unsigned bx = b.x; asm volatile("" : "+s"(bx));
        __builtin_amdgcn_s_waitcnt(0);
        unsigned nloc = b.st[0], nx = b.st[1];
        if (nloc == 0u) { xcd_barrier_complete(bar, bx, nloc, nx); b.st[0] = nloc; b.st[1] = nx; }
        const unsigned old = xb_add(&bar[XB_XSUB(bx)], 1u);
        const unsigned gen = old / nloc;
        if (old + 1u == (gen + 1u) * nloc) {
            __builtin_amdgcn_fence(__ATOMIC_RELEASE, "agent");
            asm volatile("s_waitcnt vmcnt(0)" ::: "memory");
            const unsigned og = xb_add(&bar[XB_TOP], 1u);
            const unsigned tg = og / nx;
            if (og + 1u == (tg + 1u) * nx) xb_add(&bar[XB_TOPGEN], 1u);
            else XB_SPIN(xb_ld(&bar[XB_TOPGEN]) == tg, bar);
            __builtin_amdgcn_fence(__ATOMIC_ACQUIRE, "agent");
            xb_add(&bar[XB_XGEN(bx)], 1u);
            asm volatile("s_waitcnt vmcnt(0)" ::: "memory");
        } else {
            XB_SPIN(xb_ld(&bar[XB_XGEN(bx)]) == gen, bar);
            __builtin_amdgcn_fence(__ATOMIC_ACQUIRE, "agent");
            asm volatile("s_waitcnt vmcnt(0)" ::: "memory");
        }
    }
    __syncthreads();
}

__global__ void __launch_bounds__(NT, 2) k_mega(Ptrs p) {
    extern __shared__ __attribute__((aligned(16))) unsigned char lds_raw[];
    LAS unsigned char* lds = (LAS unsigned char*)lds_raw;
    cg::grid_group grid = cg::this_grid();
    const int wv = __builtin_amdgcn_readfirstlane(threadIdx.x >> 6);
#define CG_SYNC() do { asm volatile("s_waitcnt vmcnt(0)" ::: "memory"); grid.sync(); __builtin_amdgcn_fence(__ATOMIC_ACQUIRE, "agent"); asm volatile("s_waitcnt vmcnt(0)" ::: "memory"); } while (0)
#define GRID_SYNC() xcd_barrier(xbar, wv)
    if (otid(wv) < 16) ((LAS unsigned*)(lds + LDS_XB))[otid(wv)] = 0u;
    __syncthreads();
    const XcdBarrier xbar = xcd_barrier_post((unsigned*)(p.ws + WS_CTL) + CW_BAR, (volatile LAS unsigned*)(lds + LDS_XB), wv);
    const int NGW = gridDim.x * NWAVES;
    phase_mod(p, lds, wv);
    phase_lb(p, wv);
    __syncthreads();
    phase_convert(p, lds, 0, 2, wv);
    phase_router_w(p, wv);
    CG_SYNC();
    phase_gs2(p, wv);
    phase_norm(p.in[I_X], p.in[I_CTX], p.in[I_N1G], (const float*)(p.ws + WS_MOD), 0, 1, (bf16*)(p.ws + WS_H), MROWS, wv);
    GRID_SYNC();
    for (int layer = 0; layer < 2; ++layer) {
        const int M = (layer == 0) ? MROWS : NLAT;
        const float* modl = (const float*)(p.ws + WS_MOD) + (size_t)layer * 9 * MODW;
        {
            pg8::Gemm g{(const bf16*)(p.ws + WS_H), (const bf16*)(p.ws + WS_WIN + layer * WIN_STRIDE), MROWS, DIN, DM};
            pg8::StaticOrder S; S.init(MROWS, DIN, gridDim.x, (int)blockIdx.x);
            pg8::EpiInProj E{(bf16*)(p.ws + WS_P), p.in[I_NAQN] + layer * 64, p.in[I_NAKN] + layer * 64, p.in[I_GQQN] + layer * 64, p.in[I_GQKN] + layer * 64, wv};
            pg8::gemm_phase<pg8::EpiInProj, pg8::StaticOrder, true, true>(lds, g, S, E, wv);
        }
        GRID_SYNC();
        phase_hgrn1(p, lds, layer, wv);
        GRID_SYNC();
        phase_hgrn_scan(p, wv);
        GRID_SYNC();
        phase_hgrn2(p, lds, layer, wv);
        __syncthreads();
        phase_attn(p, lds_raw, layer, wv);
        GRID_SYNC();
        {
            pg8::Gemm g{(const bf16*)(p.ws + WS_MIX), (const bf16*)(p.ws + WS_WOUT + layer * WOUT_STRIDE), M, DM, DM};
            pg8::StaticOrder S; S.init(M, DM, gridDim.x, (int)blockIdx.x);
            pg8::EpiResidSS E{layer == 0 ? p.in[I_X] : p.out, p.in[I_CTX], p.out, (float*)(p.ws + WS_XC), modl, 2, (float*)(p.ws + WS_RSS), wv};
            pg8::gemm_phase<pg8::EpiResidSS, pg8::StaticOrder, true, true>(lds, g, S, E, wv);
        }
        GRID_SYNC();
        phase_route(p, lds, layer, M, wv);
        GRID_SYNC();
        phase_moe_gu(p, lds, layer, wv);
        GRID_SYNC();
        phase_moe_down(p, lds, layer, wv);
        GRID_SYNC();
        phase_combine(p, layer, M, layer == 0, wv);
        if (layer == 0) GRID_SYNC();
    }
}

extern "C" void kernel_launch(void* const* d_in, const int* in_sizes, int n_in, void* d_out, int out_size, void* d_ws, size_t ws_size, hipStream_t stream) {
    static int grid = 0;
    if (grid == 0) {
        if (n_in != 24 || ws_size < WS_END) { fprintf(stderr, "kernel_launch: bad n_in %d or ws_size %zu < %zu\n", n_in, ws_size, (size_t)WS_END); grid = -1; return; }
        int dev = 0, cus = 0, per_cu = 0;
        hipGetDevice(&dev); hipDeviceGetAttribute(&cus, hipDeviceAttributeMultiprocessorCount, dev);
        hipFuncSetAttribute((const void*)k_mega, hipFuncAttributeMaxDynamicSharedMemorySize, LDS_BYTES);
        hipOccupancyMaxActiveBlocksPerMultiprocessor(&per_cu, (const void*)k_mega, NT, LDS_BYTES);
        if (per_cu < 1) { fprintf(stderr, "kernel_launch: occupancy query says %d blocks/CU\n", per_cu); grid = -1; return; }
        grid = cus;
        (void)hipGetLastError();
    }
    if (grid < 0) return;
    Ptrs p{};
    for (int i = 0; i < 24; ++i) p.in[i] = (const float*)d_in[i];
    p.out = (float*)d_out; p.ws = (unsigned char*)d_ws; p.layer = 0; p.pad = 0;
    hipMemsetAsync((unsigned char*)d_ws + WS_CTL, 0, 1 * MiB, stream);
    void* args[] = {&p};
    hipError_t e = hipLaunchCooperativeKernel((const void*)k_mega, dim3(grid), dim3(NT), args, LDS_BYTES, stream);
    if (e != hipSuccess) fprintf(stderr, "cooperative launch failed: %s\n", hipGetErrorString(e));
}
```

```cpp
#include <hip/hip_runtime.h>
#include <hip/hip_cooperative_groups.h>
#include <cstdio>
#include <cstdint>
#include <math.h>
namespace cg = cooperative_groups;

#define DM 1024
#define SEQ 2048
#define CTXL 256
#define NBATCH 8
#define NLAT (NBATCH * SEQ)
#define NCTX (NBATCH * CTXL)
#define MROWS (NLAT + NCTX)
#define DIN 2816
#define NMOD 6
#define MODW (NMOD * DM)
#define A_Q 0
#define A_K 256
#define A_V 512
#define B_Q 768
#define B_K 1280
#define B_V 1408
#define C_Q 1536
#define C_I 1792
#define C_FF 2048
#define C_FB 2304
#define C_G 2560

typedef unsigned short bf16;
#define LAS __attribute__((address_space(3)))
#define GAS __attribute__((address_space(1)))
typedef unsigned v4u __attribute__((ext_vector_type(4)));
typedef unsigned v2u __attribute__((ext_vector_type(2)));
typedef float v4f __attribute__((ext_vector_type(4)));

__device__ __forceinline__ unsigned f2bf(float f) { unsigned u = __builtin_bit_cast(unsigned, f); return (u + 0x7fffu + ((u >> 16) & 1u)) >> 16; }
__device__ __forceinline__ unsigned pk2(float lo, float hi) { return f2bf(lo) | (f2bf(hi) << 16); }
__device__ __forceinline__ float bf2f(unsigned short v) { return __builtin_bit_cast(float, (unsigned)v << 16); }
__device__ __forceinline__ float bflo(unsigned v) { return __builtin_bit_cast(float, v << 16); }
__device__ __forceinline__ float bfhi(unsigned v) { return __builtin_bit_cast(float, v & 0xffff0000u); }
__device__ __forceinline__ float silu_f(float x) { return x / (1.f + __expf(-x)); }
__device__ __forceinline__ float shx(float v, int mask, int lane) { return __builtin_bit_cast(float, __builtin_amdgcn_ds_bpermute((lane ^ mask) << 2, __builtin_bit_cast(int, v))); }
__device__ __forceinline__ float wave_sum(float v, int lane) {
#pragma unroll
    for (int o = 1; o < 64; o <<= 1) v += shx(v, o, lane);
    return v;
}
__device__ __forceinline__ int otid(int wv) { unsigned m = ~0u; asm volatile("" : "+s"(m)); asm volatile("" : "+s"(wv)); return wv * 64 + (int)__builtin_amdgcn_mbcnt_hi(m, __builtin_amdgcn_mbcnt_lo(m, 0u)); }
#define LDS_WAIT() asm volatile("s_waitcnt lgkmcnt(0)" ::: "memory")

constexpr size_t MiB = 1u << 20;
constexpr size_t WS_CTL = 0;
constexpr size_t WS_MOD = 1 * MiB;
constexpr size_t WS_LB = 1 * MiB + 512 * 1024;
constexpr size_t WS_EID = 2 * MiB;
constexpr size_t WS_EW = 2 * MiB + 256 * 1024;
constexpr size_t WS_IDX = 3 * MiB;
constexpr size_t WS_XC = 8 * MiB;
constexpr size_t WS_WIN = 16 * MiB;
constexpr size_t WIN_STRIDE = (size_t)DIN * DM * 2;
constexpr size_t WS_WOUT = 28 * MiB;
constexpr size_t WOUT_STRIDE = 2 * MiB;
constexpr size_t WS_WGU = 32 * MiB;
constexpr size_t WGU_STRIDE = 32 * MiB;
constexpr size_t WS_WD = 96 * MiB;
constexpr size_t WD_STRIDE = 16 * MiB;
constexpr size_t WS_H = 128 * MiB;
constexpr size_t WS_MIX = 164 * MiB;
constexpr size_t WS_P = 200 * MiB;
constexpr size_t WS_Y0 = 200 * MiB;
constexpr size_t WS_Y1 = 236 * MiB;
constexpr size_t WS_HID = 272 * MiB;
constexpr size_t WS_SCR = 300 * MiB;
constexpr size_t WS_END = 340 * MiB;

constexpr int NT = 512, NWAVES = 8;
constexpr int LDS_BYTES = 147456;
namespace pg8 {
#define PG8_LAS __attribute__((address_space(3)))
typedef unsigned short bf16_t;
typedef short bf16x8 __attribute__((ext_vector_type(8)));
typedef float f32x4 __attribute__((ext_vector_type(4)));
typedef unsigned u32x4 __attribute__((ext_vector_type(4)));
constexpr int BM = 256, BK = 64, HALF = 128, HTB = HALF * BK * 2  , STAGE_BYTES = 8 * HTB, NXCD = 8, WGM = 8;

__host__ __device__ __forceinline__ int lds_byte(int r, int c) { const int st = (r >> 4) * 2 + (c >> 5), rr = r & 15, cc = c & 31, ob = rr * 64 + cc * 2; return st * 1024 + (ob ^ (((ob >> 9) & 1) << 5)); }
__host__ __device__ __forceinline__ void stage_rc(int b, int& R, int& C) { const int st = b / 1024, sb = b % 1024, swz = sb ^ (((sb >> 9) & 1) << 5); R = (st >> 1) * 16 + swz / 64; C = (st & 1) * 32 + (swz % 64) / 2; }
__host__ __device__ __forceinline__ int perm32(int rho) { const int n = rho >> 4, i = rho & 15; return 8 * (i >> 2) + 4 * n + (i & 3); }

struct Unit { int pm, pn, aux; };
struct Gemm { const bf16_t* A; const bf16_t* Bt; int M, N, K; };

struct StaticOrder {
    int nM, nN, nwg, G, c;
    __host__ __device__ void init(int M, int N, int G_, int c_) { nM = M / BM; nN = N / BM; nwg = nM * nN; G = G_; c = c_; }
    __host__ __device__ bool next(int i, Unit& u) const {
        const long L = (long)i * G + c; if (L >= nwg) return false;
        int wgid = (int)L; { const int q = nwg / NXCD, r = nwg % NXCD, xcd = wgid % NXCD, off = wgid / NXCD; wgid = (xcd < r ? xcd * (q + 1) : r * (q + 1) + (xcd - r) * q) + off; }
        const int nig = WGM * nN, gid = wgid / nig, fm = gid * WGM, gsz = (nM - fm) < WGM ? (nM - fm) : WGM;
        u.pm = fm + ((wgid % nig) % gsz); u.pn = (wgid % nig) / gsz; return true;
    }
    __device__ __forceinline__ void a_ready(const Unit&) const {}
    __device__ __forceinline__ void done(const Unit&) const {}
};

__device__ __forceinline__ unsigned cvt_pk_bf16(float lo, float hi) { unsigned r; asm volatile("v_cvt_pk_bf16_f32 %0, %1, %2" : "=v"(r) : "v"(lo), "v"(hi)); return r; }
typedef float f32x2 __attribute__((ext_vector_type(2)));
__device__ __forceinline__ f32x2 gelu_pk(f32x2 v) {
    const f32x2 av = __builtin_elementwise_abs(v), d = av * 0.2316418882f + 1.0f;
    f32x2 t; t.x = __builtin_amdgcn_rcpf(d.x); t.y = __builtin_amdgcn_rcpf(d.y);
    f32x2 q = t * 0.5307027145f + (-0.7265760135f); q = q * t + 0.7107068705f; q = q * t + (-0.142248368f); q = q * t + 0.127414796f; q = q * t;
    const f32x2 s = (v * v) * (-0.72134752044f);
    f32x2 e; e.x = __builtin_amdgcn_exp2f(s.x); e.y = __builtin_amdgcn_exp2f(s.y);
    const f32x2 m = v * (q * e), r = v - m;
    f32x2 o; o.x = v.x < 0.f ? m.x : r.x; o.y = v.y < 0.f ? m.y : r.y; return o;
}

template <int ACT  > struct EpiBf16 {
    static constexpr bool PERM = true, AFTER_DRAIN = false; static_assert(ACT == 0 || ACT == 1, "EpiBf16: ACT is 0 (none) or 1 (gelu_pk)");
    bf16_t* O; int ldc; const float* bias; int split_cols; size_t split_stride; float scale0;
    __device__ __forceinline__ void operator()(const f32x4 (&acc)[2][2][4][2], const Unit& u, int wr, int wc, int fr, int fq) const {
        const int row0 = u.pm * BM + wr * 64 + fr; int colt = u.pn * BM; bf16_t* base = O;
        float sc = 1.f; if (split_cols) { const int t = colt / split_cols; base += (size_t)t * split_stride; colt -= t * split_cols; if (t == 0) sc = scale0; }
        const int col0 = colt + wc * 32 + 8 * fq, bcol0 = u.pn * BM + wc * 32 + 8 * fq;
        f32x4 bv[2][2];
#pragma unroll
        for (int bj = 0; bj < 2; ++bj)
#pragma unroll
            for (int n = 0; n < 2; ++n) bv[bj][n] = bias ? *(const f32x4*)(bias + bcol0 + bj * HALF + 4 * n) : (f32x4){0.f, 0.f, 0.f, 0.f};
#pragma unroll
        for (int ai = 0; ai < 2; ++ai)
#pragma unroll
            for (int m = 0; m < 4; ++m) { bf16_t* rowp = base + (size_t)(row0 + ai * HALF + m * 16) * ldc + col0;
#pragma unroll
                for (int bj = 0; bj < 2; ++bj) { f32x4 v0 = acc[ai][bj][m][0] + bv[bj][0], v1 = acc[ai][bj][m][1] + bv[bj][1];
                    if (ACT == 1) { f32x2 a = gelu_pk((f32x2){v0[0], v0[1]}), b = gelu_pk((f32x2){v0[2], v0[3]}), c = gelu_pk((f32x2){v1[0], v1[1]}), d = gelu_pk((f32x2){v1[2], v1[3]});
                        v0 = (f32x4){a.x, a.y, b.x, b.y}; v1 = (f32x4){c.x, c.y, d.x, d.y}; }
                    v0 = v0 * sc; v1 = v1 * sc; u32x4 w; w.x = cvt_pk_bf16(v0[0], v0[1]); w.y = cvt_pk_bf16(v0[2], v0[3]); w.z = cvt_pk_bf16(v1[0], v1[1]); w.w = cvt_pk_bf16(v1[2], v1[3]);
                    *(u32x4*)(rowp + bj * HALF) = w; } }
    }
};

template <class Epi, class Sched, bool ALIGN_EPI = false, bool SP2 = false, bool GATHER = false>
__device__ __forceinline__ void gemm_phase(PG8_LAS unsigned char* lds, const Gemm g, const Sched& S, const Epi& E, int wv, const PG8_LAS int* gidx = nullptr) {
    static_assert(SP2 || !GATHER, "GATHER is wired into the SP2 loop only");
    int tid_ = otid(wv);
    const int tid = tid_, wid = __builtin_amdgcn_readfirstlane(tid >> 6), lane = tid & 63, wr = wid >> 2, wc = wid & 3, fr = lane & 15, fq = lane >> 4;
    const int K = g.K, nt = K / BK;
    unsigned voffA[2][2], nvoffA[2][2], voffB[2]; int RA[2], CA[2];
#pragma unroll
    for (int i = 0; i < 2; ++i) { int R, C; stage_rc(tid * 16 + i * 8192, R, C); const int Rb = Epi::PERM ? ((R & ~31) + perm32(R & 31)) : R; RA[i] = R; CA[i] = C;
        voffA[0][i] = voffA[1][i] = nvoffA[0][i] = nvoffA[1][i] = (unsigned)(R * K + C) * 2u; voffB[i] = (unsigned)(Rb * K + C) * 2u; }
#define PG8_GVOFF(dst, uidx) do { if constexpr (GATHER) { _Pragma("unroll") for (int _h = 0; _h < 2; ++_h) _Pragma("unroll") for (int _i = 0; _i < 2; ++_i) dst[_h][_i] = (unsigned)(gidx[(uidx) * 256 + _h * 128 + RA[_i]] * K + CA[_i]) * 2u; } } while (0)
    const size_t kstep = (size_t)(BK * 2);
    const size_t hstep = (size_t)HALF * K * 2;
    const size_t hstepA = GATHER ? (size_t)0 : hstep;
    const size_t tstep = 2 * hstep;
    const unsigned ldsw = (unsigned)wid * 1024u;
    const int aoff = lds_byte(wr * 64 + fr, fq * 8), boff = lds_byte(wc * 32 + fr, fq * 8);
#define PG8_SA(b, h) (((b) * 2 + (h)) * HTB)
#define PG8_SB(b, h) ((4 + (b) * 2 + (h)) * HTB)
#define PG8_STAGE(bufoff, gbase, voff) do { _Pragma("unroll") for (int _i = 0; _i < 2; ++_i) \
        __builtin_amdgcn_global_load_lds((const unsigned*)((const char*)(gbase) + (voff)[_i]), (PG8_LAS unsigned*)(lds + (bufoff) + ldsw + _i * 8192), 16, 0, 0); } while (0)
#define PG8_LDA(dst, b, h) do { _Pragma("unroll") for (int m = 0; m < 4; ++m) _Pragma("unroll") for (int k = 0; k < 2; ++k) dst[m][k] = *(const PG8_LAS bf16x8*)(lds + PG8_SA(b, h) + aoff + m * 2048 + k * 1024); } while (0)
#define PG8_LDB(dst, b, h) do { _Pragma("unroll") for (int n = 0; n < 2; ++n) _Pragma("unroll") for (int k = 0; k < 2; ++k) dst[n][k] = *(const PG8_LAS bf16x8*)(lds + PG8_SB(b, h) + boff + n * 2048 + k * 1024); } while (0)
#define PG8_MMA(ai, bj, At, Bt) do { __builtin_amdgcn_s_setprio(1); _Pragma("unroll") for (int m = 0; m < 4; ++m) _Pragma("unroll") for (int n = 0; n < 2; ++n) _Pragma("unroll") for (int k = 0; k < 2; ++k) \
        acc[ai][bj][m][n] = __builtin_amdgcn_mfma_f32_16x16x32_bf16(Bt[n][k], At[m][k], acc[ai][bj][m][n], 0, 0, 0); __builtin_amdgcn_s_setprio(0); } while (0)
#define PG8_WAIT_V(n) asm volatile("s_waitcnt vmcnt(" #n ")" ::: "memory")
#define PG8_WAIT_L(n) asm volatile("s_waitcnt lgkmcnt(" #n ")" ::: "memory")
#define PG8_BAR __builtin_amdgcn_s_barrier()
#define PG8_SCHED __builtin_amdgcn_sched_barrier(0)
    Unit cur, nxt; int ui = 0;
    if (!S.next(0, cur)) return;
    f32x4 acc[2][2][4][2];
#pragma unroll
    for (int a = 0; a < 2; ++a)
#pragma unroll
        for (int b = 0; b < 2; ++b)
#pragma unroll
            for (int m = 0; m < 4; ++m)
#pragma unroll
                for (int n = 0; n < 2; ++n) acc[a][b][m][n] = (f32x4){0.f, 0.f, 0.f, 0.f};
    bf16x8 At[4][2], B0[2][2], B1[2][2];
    const char* cA = (const char*)g.A + (GATHER ? (size_t)0 : (size_t)cur.pm * tstep); PG8_GVOFF(voffA, 0); const char* cB = (const char*)g.Bt + (size_t)cur.pn * tstep;
    S.a_ready(cur);
    if constexpr (SP2) {
        PG8_STAGE(PG8_SB(0, 0), cB, voffB); PG8_STAGE(PG8_SB(0, 1), cB + hstep, voffB); PG8_STAGE(PG8_SA(0, 0), cA, voffA[0]); PG8_STAGE(PG8_SA(0, 1), cA + hstepA, voffA[1]);
        if (wr == 1) PG8_BAR;
        PG8_WAIT_V(2); PG8_BAR;
        PG8_STAGE(PG8_SB(1, 0), cB + kstep, voffB); PG8_STAGE(PG8_SA(1, 0), cA + kstep, voffA[0]); PG8_STAGE(PG8_SB(1, 1), cB + hstep + kstep, voffB);
        PG8_WAIT_V(6); PG8_BAR;
    } else {
        PG8_STAGE(PG8_SB(0, 0), cB, voffB); PG8_STAGE(PG8_SA(0, 0), cA, voffA[0]); PG8_STAGE(PG8_SB(0, 1), cB + hstep, voffB); PG8_STAGE(PG8_SA(0, 1), cA + hstep, voffA[0]);
        if (wr == 1) PG8_BAR;
        PG8_WAIT_V(4); PG8_BAR;
        PG8_STAGE(PG8_SB(1, 0), cB + kstep, voffB); PG8_STAGE(PG8_SA(1, 0), cA + kstep, voffA[0]); PG8_STAGE(PG8_SB(1, 1), cB + hstep + kstep, voffB);
        PG8_WAIT_V(6); PG8_BAR;
    }
    for (;;) {
        const bool has_next = S.next(ui + 1, nxt);
        const char* nA = (has_next && !GATHER) ? (const char*)g.A + (size_t)nxt.pm * tstep : cA; if (has_next) PG8_GVOFF(nvoffA, ui + 1); const char* nB = has_next ? (const char*)g.Bt + (size_t)nxt.pn * tstep : cB;
        for (int t = 0; t < nt; t += 2) {
            const bool last = (t == nt - 2);
            const char* a1 = cA + (size_t)(t + 1) * kstep;
            const char* a2 = last ? nA : cA + (size_t)(t + 2) * kstep; const char* b2 = last ? nB : cB + (size_t)(t + 2) * kstep;
            const char* a3 = a2 + kstep; const char* b3 = b2 + kstep;
            if (last && has_next) S.a_ready(nxt);
            unsigned vs2[2][2];
#pragma unroll
            for (int _h = 0; _h < 2; ++_h)
#pragma unroll
                for (int _i = 0; _i < 2; ++_i) vs2[_h][_i] = last ? nvoffA[_h][_i] : voffA[_h][_i];
            if constexpr (SP2) {
            PG8_LDB(B0, 0, 0); PG8_LDB(B1, 0, 1); PG8_SCHED; PG8_LDA(At, 0, 0); PG8_STAGE(PG8_SA(1, 1), a1 + hstepA, voffA[1]);
            PG8_WAIT_V(8); PG8_WAIT_L(0); PG8_BAR; PG8_MMA(0, 0, At, B0); PG8_MMA(0, 1, At, B1); PG8_BAR; PG8_SCHED;
            PG8_LDA(At, 0, 1); PG8_STAGE(PG8_SB(0, 0), b2, voffB); PG8_STAGE(PG8_SB(0, 1), b2 + hstep, voffB); PG8_STAGE(PG8_SA(0, 0), a2, vs2[0]);
            PG8_WAIT_V(8); PG8_WAIT_L(0); PG8_BAR; PG8_MMA(1, 0, At, B0); PG8_MMA(1, 1, At, B1); PG8_BAR; PG8_SCHED;
            PG8_LDB(B0, 1, 0); PG8_LDB(B1, 1, 1); PG8_SCHED; PG8_LDA(At, 1, 0); PG8_STAGE(PG8_SA(0, 1), a2 + hstepA, vs2[1]);
            PG8_WAIT_V(8); PG8_WAIT_L(0); PG8_BAR; PG8_MMA(0, 0, At, B0); PG8_MMA(0, 1, At, B1); PG8_BAR; PG8_SCHED;
            PG8_LDA(At, 1, 1); PG8_STAGE(PG8_SB(1, 0), b3, voffB); PG8_STAGE(PG8_SB(1, 1), b3 + hstep, voffB); PG8_STAGE(PG8_SA(1, 0), a3, vs2[0]);
            PG8_WAIT_V(8); PG8_WAIT_L(0); PG8_BAR; PG8_MMA(1, 0, At, B0); PG8_MMA(1, 1, At, B1); PG8_BAR; PG8_SCHED;
            } else {
            PG8_LDB(B0, 0, 0); PG8_SCHED; PG8_LDA(At, 0, 0); PG8_STAGE(PG8_SA(1, 1), a1 + hstep, voffA[0]);
            PG8_WAIT_L(8); PG8_BAR; PG8_WAIT_L(0); PG8_MMA(0, 0, At, B0); PG8_BAR; PG8_SCHED;
            PG8_LDB(B1, 0, 1); PG8_STAGE(PG8_SB(0, 0), b2, voffB);
            PG8_BAR; PG8_WAIT_L(0); PG8_MMA(0, 1, At, B1); PG8_BAR;
            PG8_LDA(At, 0, 1); PG8_STAGE(PG8_SA(0, 0), a2, voffA[0]);
            PG8_BAR; PG8_WAIT_L(0); PG8_MMA(1, 0, At, B0); PG8_BAR; PG8_SCHED;
            PG8_STAGE(PG8_SB(0, 1), b2 + hstep, voffB);
            PG8_WAIT_V(6); PG8_BAR; PG8_MMA(1, 1, At, B1); PG8_BAR;
            PG8_LDB(B0, 1, 0); PG8_SCHED; PG8_LDA(At, 1, 0); PG8_STAGE(PG8_SA(0, 1), a2 + hstep, voffA[0]);
            PG8_WAIT_L(8); PG8_BAR; PG8_WAIT_L(0); PG8_MMA(0, 0, At, B0); PG8_BAR; PG8_SCHED;
            PG8_LDB(B1, 1, 1); PG8_STAGE(PG8_SB(1, 0), b3, voffB);
            PG8_BAR; PG8_WAIT_L(0); PG8_MMA(0, 1, At, B1); PG8_BAR;
            PG8_LDA(At, 1, 1); PG8_STAGE(PG8_SA(1, 0), a3, voffA[0]);
            PG8_BAR; PG8_WAIT_L(0); PG8_MMA(1, 0, At, B0); PG8_BAR; PG8_SCHED;
            PG8_STAGE(PG8_SB(1, 1), b3 + hstep, voffB);
            PG8_WAIT_V(6); PG8_BAR; PG8_MMA(1, 1, At, B1); PG8_BAR;
            }
        }
        if constexpr (ALIGN_EPI) { if (wr == 0) PG8_BAR; }
        if constexpr (!Epi::AFTER_DRAIN) { E(acc, cur, wr, wc, fr, fq); S.done(cur); }
        if (!has_next) break;
#pragma unroll
        for (int a = 0; a < 2; ++a)
#pragma unroll
            for (int b = 0; b < 2; ++b)
#pragma unroll
                for (int m = 0; m < 4; ++m)
#pragma unroll
                    for (int n = 0; n < 2; ++n) acc[a][b][m][n] = (f32x4){0.f, 0.f, 0.f, 0.f};
        cur = nxt; cA = nA; cB = nB; ++ui;
#pragma unroll
        for (int _h = 0; _h < 2; ++_h)
#pragma unroll
            for (int _i = 0; _i < 2; ++_i) voffA[_h][_i] = nvoffA[_h][_i];
        if constexpr (ALIGN_EPI) { if (wr == 1) PG8_BAR; }
    }
    PG8_WAIT_V(0);
    if constexpr (!ALIGN_EPI) { if (wr == 0) PG8_BAR; }
    PG8_BAR;
    if constexpr (Epi::AFTER_DRAIN) { E.fused(acc, cur, wr, wc, fr, fq, lds, wid, lane); S.done(cur); }
#undef PG8_SA
#undef PG8_GVOFF
#undef PG8_SB
#undef PG8_STAGE
#undef PG8_LDA
#undef PG8_LDB
#undef PG8_MMA
#undef PG8_WAIT_V
#undef PG8_WAIT_L
#undef PG8_BAR
#undef PG8_SCHED
}
}


struct Ptrs { const float* in[24]; float* out; unsigned char* ws; int layer; int pad; };
enum { I_X = 0, I_C, I_CTX, I_CCTX, I_WADA, I_BADA, I_N1G, I_WIN, I_NAQN, I_NAKN, I_RPB, I_GQQN, I_GQKN, I_LB, I_HGON, I_WOUT, I_N2G, I_WRG, I_BRG, I_WRE, I_BRE, I_WEG, I_WEU, I_WED };

namespace pg8 {
struct EpiResid {
    static constexpr bool PERM = false, AFTER_DRAIN = false;
    const float* xin_lat; const float* xin_ctx; float* xout_lat; float* xout_ctx; const float* modl; int chunk;
    __device__ __forceinline__ void operator()(const f32x4 (&acc)[2][2][4][2], const Unit& u, int wr, int wc, int fr, int fq) const {
        const int rowt = u.pm * BM; const bool isctx = rowt >= NLAT;
        const float* xin = isctx ? xin_ctx + (size_t)(rowt - NLAT) * DM : xin_lat + (size_t)rowt * DM;
        float* xo = isctx ? xout_ctx + (size_t)(rowt - NLAT) * DM : xout_lat + (size_t)rowt * DM;
        const int mrow = isctx ? 8 : (rowt >> 11);
        const float* gate = modl + (size_t)mrow * MODW + chunk * DM;
        const int col0 = u.pn * BM + wc * 32 + 4 * fq;
#pragma unroll
        for (int bj = 0; bj < 2; ++bj)
#pragma unroll
            for (int n = 0; n < 2; ++n) {
                const int col = col0 + bj * HALF + n * 16;
                const f32x4 gv = *(const f32x4*)(gate + col);
#pragma unroll
                for (int ai = 0; ai < 2; ++ai)
#pragma unroll
                    for (int m = 0; m < 4; ++m) {
                        const size_t off = (size_t)(ai * HALF + wr * 64 + m * 16 + fr) * DM + col;
                        const f32x4 xi = *(const f32x4*)(xin + off);
                        *(f32x4*)(xo + off) = xi + gv * acc[ai][bj][m][n];
                    }
            }
    }
};
}

__device__ __forceinline__ void phase_mod(const Ptrs& p, LAS unsigned char* lds, int wv) {
    if (blockIdx.x >= 192) return;
    LAS float* sc = (LAS float*)lds;
    LAS float* red = (LAS float*)(lds + 36864);
    const int tid = otid(wv);
    const float* c = p.in[I_C]; const float* cc = p.in[I_CCTX];
    for (int i = tid; i < 9 * DM; i += NT) { float v = (i < 8 * DM) ? c[i] : cc[i - 8 * DM]; sc[i] = silu_f(v); }
    __syncthreads();
    float* mod = (float*)(p.ws + WS_MOD);
    for (int u = blockIdx.x; u < 192; u += gridDim.x) {
        const int layer = u / 96, cb = u % 96, cq = tid & 15, kg = tid >> 4;
        const float* w = p.in[I_WADA] + (size_t)layer * DM * MODW + cb * 64 + cq * 4;
        v4f acc[9];
#pragma unroll
        for (int r = 0; r < 9; ++r) acc[r] = (v4f){0.f, 0.f, 0.f, 0.f};
        for (int i = 0; i < 32; ++i) {
            const int k = kg + 32 * i;
            const v4f wv = *(const v4f*)(w + (size_t)k * MODW);
#pragma unroll
            for (int r = 0; r < 9; ++r) acc[r] += sc[r * DM + k] * wv;
        }
#pragma unroll
        for (int r = 0; r < 9; ++r) *(LAS v4f*)(red + (kg * 9 + r) * 64 + cq * 4) = acc[r];
        __syncthreads();
        for (int o = tid; o < 576; o += NT) {
            const int r = o >> 6, c2 = o & 63; float s = 0.f;
            for (int k2 = 0; k2 < 32; ++k2) s += red[(k2 * 9 + r) * 64 + c2];
            mod[((size_t)layer * 9 + r) * MODW + cb * 64 + c2] = s + p.in[I_BADA][layer * MODW + cb * 64 + c2];
        }
        __syncthreads();
    }
}
__device__ __forceinline__ void phase_lb(const Ptrs& p, int wv) {
    if (blockIdx.x == 255 % gridDim.x) {
        const int i = otid(wv);
        const float* raw = p.in[I_LB]; float* lb = (float*)(p.ws + WS_LB);
        float l0 = raw[i], l1 = raw[512 + i];
        lb[i] = 0.f; lb[512 + i] = 1.f / (1.f + __expf(l0 - l1));
    }
}
__device__ __forceinline__ void transpose_item(const float* W, int K, int N, bf16* WT, int row_off, LAS float* scr, int item, int lane) {
    const int nblk = N / 32, kb = item / nblk, nb = item % nblk, k0 = 64 * kb, n0 = 32 * nb;
#pragma unroll 8
    for (int i = 0; i < 32; ++i) { const int kk = 2 * i + (lane >> 5); scr[kk * 33 + (lane & 31)] = W[(size_t)(k0 + kk) * N + n0 + (lane & 31)]; }
    LDS_WAIT(); asm volatile("" ::: "memory");
    const int c = lane & 7;
#pragma unroll
    for (int j = 0; j < 4; ++j) { const int n = (lane >> 3) + 8 * j; const LAS float* s = scr + (8 * c) * 33 + n;
        v4u o; o.x = pk2(s[0 * 33], s[1 * 33]); o.y = pk2(s[2 * 33], s[3 * 33]); o.z = pk2(s[4 * 33], s[5 * 33]); o.w = pk2(s[6 * 33], s[7 * 33]);
        *(v4u*)(WT + (size_t)(row_off + n0 + n) * K + k0 + 8 * c) = o; }
    LDS_WAIT(); asm volatile("" ::: "memory");
}
constexpr int CI_IN = 16 * 88, CI_OUT = 16 * 32, CI_G = 32 * 128, CI_U = 32 * 128, CI_D = 32 * 128, CI_LAYER = CI_IN + CI_OUT + CI_G + CI_U + CI_D;
__device__ __forceinline__ void phase_convert(const Ptrs& p, LAS unsigned char* lds, int layer_lo, int layer_hi, int wv) {
    const int lane = otid(wv) & 63, wave = wv;
    LAS float* scr = (LAS float*)(lds + wave * 16384);
    const int gw = blockIdx.x * NWAVES + wave, NGW = gridDim.x * NWAVES;
    const int n_items = (layer_hi - layer_lo) * CI_LAYER;
    for (int it = gw; it < n_items; it += NGW) {
        const int layer = layer_lo + it / CI_LAYER; int r = it % CI_LAYER;
        if (r < CI_IN) {
            const int n0 = 32 * (r % 88), pn_ = n0 >> 8, w_ = (n0 >> 6) & 3, bj_ = (n0 >> 5) & 1;
            transpose_item(p.in[I_WIN] + (size_t)layer * DM * DIN, DM, DIN, (bf16*)(p.ws + WS_WIN + layer * WIN_STRIDE), (256 * pn_ + 128 * bj_ + 32 * w_) - n0, scr, r, lane); continue; } r -= CI_IN;
        if (r < CI_OUT) { transpose_item(p.in[I_WOUT] + (size_t)layer * DM * DM, DM, DM, (bf16*)(p.ws + WS_WOUT + layer * WOUT_STRIDE), 0, scr, r, lane); continue; } r -= CI_OUT;
        if (r < CI_G + CI_U) {
            const int up = r >= CI_G; if (up) r -= CI_G;
            const int e = r >> 7, rem = r & 127, nb = rem & 7, n0 = 32 * nb;
            const int mapped = (n0 >> 7) * 256 + (n0 & 127) + (up ? 128 : 0);
            transpose_item(p.in[up ? I_WEU : I_WEG] + ((size_t)layer * 32 + e) * DM * 256, DM, 256, (bf16*)(p.ws + WS_WGU + layer * WGU_STRIDE) + (size_t)e * 512 * DM, mapped - n0, scr, rem, lane);
            continue;
        }
        r -= CI_G + CI_U;
        { const int e = r >> 7, rem = r & 127;
          transpose_item(p.in[I_WED] + ((size_t)layer * 32 + e) * 256 * DM, 256, DM, (bf16*)(p.ws + WS_WD + layer * WD_STRIDE) + (size_t)e * DM * 256, 0, scr, rem, lane); }
    }
}
__device__ __forceinline__ void phase_norm(const float* xlat, const float* xctx, const float* g, const float* modl, int ch_shift, int ch_scale, bf16* H, int nrows, int wv) {
    const int lane = otid(wv) & 63, wave = wv;
    const int gw = blockIdx.x * NWAVES + wave, NGW = gridDim.x * NWAVES;
    const int per = (nrows + NGW - 1) / NGW;
    const int r0 = gw * per, r1 = min(r0 + per, nrows);
    const unsigned lc = 4 * lane;
    int cur = -1; v4f gs[4], sh[4], xn[4];
    if (r0 < r1) { const float* xr = (r0 < NLAT) ? xlat + (size_t)r0 * DM : xctx + (size_t)(r0 - NLAT) * DM;
#pragma unroll
        for (int j = 0; j < 4; ++j) xn[j] = *(const v4f*)(xr + lc + 256 * j); }
    for (int r = r0; r < r1; ++r) {
        const int mrow = (r < NLAT) ? (r >> 11) : 8;
        if (mrow != cur) {
            cur = mrow; const float* m = modl + (size_t)mrow * MODW;
#pragma unroll
            for (int j = 0; j < 4; ++j) { const unsigned c = lc + 256 * j; const v4f gg = *(const v4f*)(g + c), sc = *(const v4f*)(m + ch_scale * DM + c);
                gs[j] = gg * (1.f + sc); sh[j] = *(const v4f*)(m + ch_shift * DM + c); }
        }
        v4f v[4]; float s = 0.f;
#pragma unroll
        for (int j = 0; j < 4; ++j) { v[j] = xn[j]; s += (v[j].x * v[j].x + v[j].y * v[j].y) + (v[j].z * v[j].z + v[j].w * v[j].w); }
        if (r + 1 < r1) { const float* xq = (r + 1 < NLAT) ? xlat + (size_t)(r + 1) * DM : xctx + (size_t)(r + 1 - NLAT) * DM;
#pragma unroll
            for (int j = 0; j < 4; ++j) xn[j] = *(const v4f*)(xq + lc + 256 * j); }
        const float rstd = rsqrtf(wave_sum(s, lane) * (1.f / DM) + 1e-6f);
        bf16* orow = H + (size_t)r * DM;
#pragma unroll
        for (int j = 0; j < 4; ++j) { const v4f o = v[j] * rstd * gs[j] + sh[j]; v2u w; w.x = pk2(o.x, o.y); w.y = pk2(o.z, o.w); *(v2u*)(orow + lc + 256 * j) = w; }
    }
}

constexpr size_t WS_RSS = 6 * MiB;
constexpr size_t WS_WR = 7 * MiB + 512 * 1024;
constexpr int CW_CNT = 1024;
constexpr int LDS_TTAB = 131072;
constexpr int LDS_GIDX = 131072 + 4096;
constexpr int LDS_RT = 131072;

namespace pg8 {
struct EpiResidSS {
    static constexpr bool PERM = false, AFTER_DRAIN = false;
    const float* xin_lat; const float* xin_ctx; float* xout_lat; float* xout_ctx; const float* modl; int chunk; float* rss; int wv;
    __device__ __forceinline__ void operator()(const f32x4 (&acc)[2][2][4][2], const Unit& u, int, int, int, int) const {
        const int l_ = otid(wv) & 63, fr = l_ & 15, fq = l_ >> 4, wr = wv >> 2, wc = wv & 3;
        const int rowt = u.pm * BM; const bool isctx = rowt >= NLAT;
        const float* xin = isctx ? xin_ctx + (size_t)(rowt - NLAT) * DM : xin_lat + (size_t)rowt * DM;
        float* xo = isctx ? xout_ctx + (size_t)(rowt - NLAT) * DM : xout_lat + (size_t)rowt * DM;
        const int mrow = isctx ? 8 : (rowt >> 11);
        const float* gate = modl + (size_t)mrow * MODW + chunk * DM;
        const int col0 = u.pn * BM + wc * 32 + 4 * fq;
        f32x4 gv[2][2];
#pragma unroll
        for (int bj = 0; bj < 2; ++bj)
#pragma unroll
            for (int n = 0; n < 2; ++n) gv[bj][n] = *(const f32x4*)(gate + col0 + bj * HALF + n * 16);
#pragma unroll
        for (int ai = 0; ai < 2; ++ai)
#pragma unroll
            for (int m = 0; m < 4; ++m) {
                const int rl = ai * HALF + wr * 64 + m * 16 + fr; float ss = 0.f;
#pragma unroll
                for (int bj = 0; bj < 2; ++bj)
#pragma unroll
                    for (int n = 0; n < 2; ++n) {
                        const size_t off = (size_t)rl * DM + col0 + bj * HALF + n * 16;
                        const f32x4 xi = *(const f32x4*)(xin + off);
                        const f32x4 o = xi + gv[bj][n] * acc[ai][bj][m][n];
                        *(f32x4*)(xo + off) = o;
                        ss += (o[0] * o[0] + o[1] * o[1]) + (o[2] * o[2] + o[3] * o[3]);
                    }
                ss += shx(ss, 16, l_); ss += shx(ss, 32, l_);
                if (fq == 0) rss[(size_t)(rowt + rl) * 16 + u.pn * 4 + wc] = ss;
            }
    }
};
struct EpiGU {
    static constexpr bool PERM = true, AFTER_DRAIN = false;
    bf16_t* HID; int wv;
    __device__ __forceinline__ void operator()(const f32x4 (&acc)[2][2][4][2], const Unit& u, int, int, int, int) const {
        const int l_ = otid(wv) & 63, fr = l_ & 15, fq = l_ >> 4, wr = wv >> 2, wc = wv & 3;
        const int pnl = u.pn & 1, row0 = u.pm * BM + wr * 64 + fr, col0 = pnl * 128 + wc * 32 + 8 * fq;
#pragma unroll
        for (int ai = 0; ai < 2; ++ai)
#pragma unroll
            for (int m = 0; m < 4; ++m) {
                bf16_t* rowp = HID + (size_t)(row0 + ai * HALF + m * 16) * 256 + col0;
                float hv[8];
#pragma unroll
                for (int n = 0; n < 2; ++n)
#pragma unroll
                    for (int i = 0; i < 4; ++i) { const float g = acc[ai][0][m][n][i], uu = acc[ai][1][m][n][i]; hv[n * 4 + i] = g / (1.f + __expf(-g)) * uu; }
                u32x4 w; w.x = cvt_pk_bf16(hv[0], hv[1]); w.y = cvt_pk_bf16(hv[2], hv[3]); w.z = cvt_pk_bf16(hv[4], hv[5]); w.w = cvt_pk_bf16(hv[6], hv[7]);
                *(u32x4*)rowp = w;
            }
    }
};
struct EpiDown {
    static constexpr bool PERM = true, AFTER_DRAIN = false;
    bf16_t* Y0; bf16_t* Y1; const PG8_LAS int* rowinfo; int wv;
    __device__ __forceinline__ void operator()(const f32x4 (&acc)[2][2][4][2], const Unit& u, int, int, int, int) const {
        const int l_ = otid(wv) & 63, fr_ = l_ & 15, fq = l_ >> 4, wr = wv >> 2, wc = wv & 3;
        const int col0 = (u.pn & 3) * BM + wc * 32 + 8 * fq;
        const PG8_LAS int* ri = rowinfo + (u.aux * 256 + wr * 64 + fr_) * 2;
#pragma unroll
        for (int ai = 0; ai < 2; ++ai)
#pragma unroll
            for (int m = 0; m < 4; ++m) {
                const int ent = ri[(ai * HALF + m * 16) * 2]; const float w = __builtin_bit_cast(float, ri[(ai * HALF + m * 16) * 2 + 1]);
                if (ent >= 0) {
                    bf16_t* rowp = Y0 + ((size_t)(ent & 1) * ((WS_Y1 - WS_Y0) / 2) + (size_t)(ent >> 1) * DM + col0);
#pragma unroll
                    for (int bj = 0; bj < 2; ++bj) {
                        const f32x4 v0 = acc[ai][bj][m][0] * w, v1 = acc[ai][bj][m][1] * w;
                        u32x4 o; o.x = cvt_pk_bf16(v0[0], v0[1]); o.y = cvt_pk_bf16(v0[2], v0[3]); o.z = cvt_pk_bf16(v1[0], v1[1]); o.w = cvt_pk_bf16(v1[2], v1[3]);
                        *(u32x4*)(rowp + bj * HALF) = o;
                    }
                }
                asm volatile("" ::: "memory");
            }
    }
};
struct MoeOrder {
    const PG8_LAS int* ttab; int ntile, npn, G, c;
    __device__ __forceinline__ bool next(int i, Unit& u) const {
        const int L = i * G + c; if (L >= ntile * npn) return false;
        const int t = L / npn, pl = L % npn; u.pm = t; u.pn = ttab[t * 4] * npn + pl; u.aux = i; return true;
    }
    __device__ __forceinline__ void a_ready(const Unit&) const {}
    __device__ __forceinline__ void done(const Unit&) const {}
};
}

__device__ __forceinline__ void phase_router_w(const Ptrs& p, int wv) {
    const int gt = blockIdx.x * NT + otid(wv), NG = gridDim.x * NT;
    for (int idx = gt; idx < 2 * 48 * DM; idx += NG) {
        const int layer = idx / (48 * DM), r = idx % (48 * DM), n = r >> 10, k = r & 1023;
        float w;
        if (n < 16) w = p.in[I_WRG][((size_t)layer * DM + k) * 4 + (n & 3)];
        else { const int g = ((n - 16) & 15) >> 2, i = n & 3, e = 8 * g + i + (n >= 32 ? 4 : 0); w = p.in[I_WRE][((size_t)layer * DM + k) * 32 + e]; }
        const unsigned hi = f2bf(w); const float lo = w - __builtin_bit_cast(float, hi << 16);
        bf16* base = (bf16*)(p.ws + WS_WR) + (size_t)layer * 2 * 48 * DM;
        base[r] = (bf16)hi; base[48 * DM + r] = (bf16)f2bf(lo);
    }
}

typedef short s8v __attribute__((ext_vector_type(8)));
constexpr size_t WS_GS2 = WS_LB + 64 * 1024;
__device__ __forceinline__ void phase_gs2(const Ptrs& p, int wv) {
    const int gt = blockIdx.x * NT + otid(wv), NG = gridDim.x * NT;
    for (int idx = gt; idx < 2 * 9 * DM; idx += NG) {
        const int layer = idx / (9 * DM), m = (idx / DM) % 9, c = idx & (DM - 1);
        const float* md = (const float*)(p.ws + WS_MOD) + ((size_t)layer * 9 + m) * MODW;
        float* o = (float*)(p.ws + WS_GS2) + ((size_t)(layer * 9 + m) * 2) * DM;
        o[c] = p.in[I_N2G][layer * DM + c] * (1.f + md[4 * DM + c]); o[DM + c] = md[3 * DM + c];
    }
}
__device__ __forceinline__ void phase_route(const Ptrs& p, LAS unsigned char* lds, int layer, int nrows, int wv) {
    const int tid = otid(wv), lane = tid & 63, wave = wv;
    LAS int* lcnt = (LAS int*)(lds + LDS_RT); LAS int* gb = lcnt + 32;
    if (tid < 32) lcnt[tid] = 0;
    __syncthreads();
    const int ntiles = nrows / 16, t = wave * gridDim.x + blockIdx.x;
    int e0 = -1, e1 = -1, lp0 = 0, lp1 = 0, ent0 = 0;
    if (t < ntiles) {
        const int row0 = t * 16, r = row0 + (lane & 15), kq = lane >> 4;
        const int mrow = (row0 < NLAT) ? (row0 >> 11) : 8;
        const float* xr = ((r < NLAT) ? p.out + (size_t)r * DM : (const float*)(p.ws + WS_XC) + (size_t)(r - NLAT) * DM) + 8 * kq;
        const float* gsp = (const float*)(p.ws + WS_GS2) + ((size_t)(layer * 9 + mrow) * 2) * DM + 8 * kq;
        bf16* hrow = (bf16*)(p.ws + WS_H) + (size_t)r * DM + 8 * kq;
        const bf16* wr_hi = (const bf16*)(p.ws + WS_WR) + (size_t)layer * 2 * 48 * DM + (size_t)(lane & 15) * DM + 8 * kq;
        float ss;
        { const v4f* rs = (const v4f*)((const float*)(p.ws + WS_RSS) + (size_t)r * 16); const v4f a = rs[0], b = rs[1], c = rs[2], d = rs[3];
          ss = ((a.x + a.y) + (a.z + a.w)) + ((b.x + b.y) + (b.z + b.w)) + ((c.x + c.y) + (c.z + c.w)) + ((d.x + d.y) + (d.z + d.w)); }
        const float rstd = rsqrtf(ss * (1.f / DM) + 1e-6f);
        v4f acc[3];
#pragma unroll
        for (int i = 0; i < 3; ++i) acc[i] = (v4f){0.f, 0.f, 0.f, 0.f};
#pragma unroll 1
        for (int s4 = 0; s4 < 32; s4 += 4) {
            v4f xa[4], xb[4], ga[4], gbv[4], ha[4], hb[4]; s8v wf[4][3];
#pragma unroll
            for (int u = 0; u < 4; ++u) {
                const int c0 = 32 * (s4 + u);
                xa[u] = *(const v4f*)(xr + c0); xb[u] = *(const v4f*)(xr + c0 + 4);
                ga[u] = *(const v4f*)(gsp + c0); gbv[u] = *(const v4f*)(gsp + c0 + 4);
                ha[u] = *(const v4f*)(gsp + DM + c0); hb[u] = *(const v4f*)(gsp + DM + c0 + 4);
#pragma unroll
                for (int nt = 0; nt < 3; ++nt) wf[u][nt] = *(const s8v*)(wr_hi + (size_t)nt * 16 * DM + c0);
            }
#pragma unroll
            for (int u = 0; u < 4; ++u) {
                const v4f h0 = xa[u] * rstd * ga[u] + ha[u], h1 = xb[u] * rstd * gbv[u] + hb[u];
                v4u hw; hw.x = pk2(h0.x, h0.y); hw.y = pk2(h0.z, h0.w); hw.z = pk2(h1.x, h1.y); hw.w = pk2(h1.z, h1.w);
                *(v4u*)(hrow + 32 * (s4 + u)) = hw;
                const s8v bh = __builtin_bit_cast(s8v, hw);
#pragma unroll
                for (int nt = 0; nt < 3; ++nt) acc[nt] = __builtin_amdgcn_mfma_f32_16x16x32_bf16(wf[u][nt], bh, acc[nt], 0, 0, 0);
            }
        }
        const float* brg = p.in[I_BRG] + layer * 4; const float* bre = p.in[I_BRE] + layer * 32;
        float gl[4];
#pragma unroll
        for (int i = 0; i < 4; ++i) gl[i] = acc[0][i] + brg[i];
        int gi = 0; float gm = gl[0];
#pragma unroll
        for (int i = 1; i < 4; ++i) if (gl[i] > gm) { gm = gl[i]; gi = i; }
        float den = 0.f;
#pragma unroll
        for (int i = 0; i < 4; ++i) den += __expf(gl[i] - gm);
        const float gtop = 1.f / den;
        if (kq == gi) {
            float el[8];
#pragma unroll
            for (int i = 0; i < 4; ++i) { el[i] = acc[1][i] + bre[8 * kq + i]; el[4 + i] = acc[2][i] + bre[8 * kq + 4 + i]; }
            int i0 = 0; float v0 = el[0];
#pragma unroll
            for (int i = 1; i < 8; ++i) if (el[i] > v0) { v0 = el[i]; i0 = i; }
            int i1 = -1; float v1 = -3.0e38f;
#pragma unroll
            for (int i = 0; i < 8; ++i) if (i != i0 && el[i] > v1) { v1 = el[i]; i1 = i; }
            const float p1 = __expf(v1 - v0), sden = 1.f / (1.f + p1);
            e0 = gi * 8 + i0; e1 = gi * 8 + i1; ent0 = r * 2;
            float* ew = (float*)(p.ws + WS_EW);
            ew[ent0] = gtop * sden; ew[ent0 + 1] = gtop * p1 * sden;
            lp0 = __hip_atomic_fetch_add(lcnt + e0, 1, __ATOMIC_RELAXED, __HIP_MEMORY_SCOPE_WORKGROUP); lp1 = __hip_atomic_fetch_add(lcnt + e1, 1, __ATOMIC_RELAXED, __HIP_MEMORY_SCOPE_WORKGROUP);
        }
    }
    __syncthreads();
    int* cnt = (int*)(p.ws + WS_CTL) + CW_CNT + layer * 64;
    if (tid < 32) gb[tid] = atomicAdd(&cnt[tid], lcnt[tid]);
    __syncthreads();
    if (e0 >= 0) {
        int* IDX = (int*)(p.ws + WS_IDX);
        IDX[(size_t)e0 * MROWS + gb[e0] + lp0] = ent0;
        IDX[(size_t)e1 * MROWS + gb[e1] + lp1] = ent0 + 1;
    }
}
__device__ __forceinline__ int moe_build_ttab(const Ptrs& p, LAS unsigned char* lds, int layer, int wv) {
    LAS int* ttab = (LAS int*)(lds + LDS_TTAB);
    const int* cnt = (const int*)(p.ws + WS_CTL) + CW_CNT + layer * 64;
    __syncthreads();
    if (otid(wv) == 0) {
        int t = 0;
        for (int e = 0; e < 32; ++e) { const int c = __hip_atomic_load(cnt + e, __ATOMIC_RELAXED, __HIP_MEMORY_SCOPE_AGENT); for (int fp = 0; fp < c; fp += 256) { ttab[t * 4] = e; ttab[t * 4 + 1] = fp; ttab[t * 4 + 2] = c; ++t; } }
        ttab[176 * 4] = t;
    }
    __syncthreads();
    return ttab[176 * 4];
}
__device__ __forceinline__ void phase_moe_gu(const Ptrs& p, LAS unsigned char* lds, int layer, int wv) {
    const int ntile = moe_build_ttab(p, lds, layer, wv);
    LAS int* ttab = (LAS int*)(lds + LDS_TTAB); LAS int* gidx = (LAS int*)(lds + LDS_GIDX);
    pg8::MoeOrder S{ttab, ntile, 2, (int)gridDim.x, (int)blockIdx.x};
    const int* IDX = (const int*)(p.ws + WS_IDX);
    for (int i = 0; i < 3; ++i) {
        pg8::Unit u; if (!S.next(i, u)) break;
        const int e = ttab[u.pm * 4], fp = ttab[u.pm * 4 + 1], c = ttab[u.pm * 4 + 2];
        for (int r = otid(wv); r < 256; r += NT) gidx[i * 256 + r] = (fp + r < c) ? (IDX[(size_t)e * MROWS + fp + r] >> 1) : 0;
    }
    __syncthreads();
    pg8::Gemm g{(const bf16*)(p.ws + WS_H), (const bf16*)(p.ws + WS_WGU + layer * WGU_STRIDE), ntile * 256, 32 * 512, DM};
    pg8::EpiGU E{(bf16*)(p.ws + WS_HID), wv};
    pg8::gemm_phase<pg8::EpiGU, pg8::MoeOrder, true, true, true>(lds, g, S, E, wv, gidx);
}
__device__ __forceinline__ void phase_moe_down(const Ptrs& p, LAS unsigned char* lds, int layer, int wv) {
    const int ntile = moe_build_ttab(p, lds, layer, wv);
    LAS int* ttab = (LAS int*)(lds + LDS_TTAB); LAS int* rowinfo = (LAS int*)(lds + LDS_GIDX);
    pg8::MoeOrder S{ttab, ntile, 4, (int)gridDim.x, (int)blockIdx.x};
    const int* IDX = (const int*)(p.ws + WS_IDX); const float* EW = (const float*)(p.ws + WS_EW);
    for (int i = 0; i < 3; ++i) {
        pg8::Unit u; if (!S.next(i, u)) break;
        const int e = ttab[u.pm * 4], fp = ttab[u.pm * 4 + 1], c = ttab[u.pm * 4 + 2];
        for (int r = otid(wv); r < 256; r += NT) {
            int ent = -1; float w = 0.f;
            if (fp + r < c) { ent = IDX[(size_t)e * MROWS + fp + r]; w = EW[ent]; }
            rowinfo[(i * 256 + r) * 2] = ent; rowinfo[(i * 256 + r) * 2 + 1] = __builtin_bit_cast(int, w);
        }
    }
    __syncthreads();
    pg8::Gemm g{(const bf16*)(p.ws + WS_HID), (const bf16*)(p.ws + WS_WD + layer * WD_STRIDE), ntile * 256, 32 * 1024, 256};
    pg8::EpiDown E{(bf16*)(p.ws + WS_Y0), (bf16*)(p.ws + WS_Y1), rowinfo, wv};
    pg8::gemm_phase<pg8::EpiDown, pg8::MoeOrder, true, true, false>(lds, g, S, E, wv);
}
__device__ __forceinline__ void phase_combine(const Ptrs& p, int layer, int nrows, bool do_norm, int wv) {
    const int lane = otid(wv) & 63, wave = wv;
    const int gw = blockIdx.x * NWAVES + wave, NGW = gridDim.x * NWAVES;
    const int per = (nrows + NGW - 1) / NGW;
    const int r0 = gw * per, r1 = min(r0 + per, nrows);
    const float* modl = (const float*)(p.ws + WS_MOD) + (size_t)layer * 9 * MODW;
    const float* modn = (const float*)(p.ws + WS_MOD) + (size_t)(layer + 1) * 9 * MODW;
    const float* g = p.in[I_N1G] + (layer + 1) * DM;
    const bf16* Y0 = (const bf16*)(p.ws + WS_Y0); const bf16* Y1 = (const bf16*)(p.ws + WS_Y1); bf16* H = (bf16*)(p.ws + WS_H);
    const unsigned lc = 4 * lane;
    int cur = -1; v4f m5v[4], gs[4], sh[4];
    v4f xn[4]; v2u an[4], bn[4];
    auto rowptr = [&](int r) -> float* { return (r < NLAT) ? p.out + (size_t)r * DM : (float*)(p.ws + WS_XC) + (size_t)(r - NLAT) * DM; };
    if (r0 < r1) {
        const float* xr = rowptr(r0);
#pragma unroll
        for (int j = 0; j < 4; ++j) { xn[j] = *(const v4f*)(xr + lc + 256 * j); an[j] = *(const v2u*)(Y0 + (size_t)r0 * DM + lc + 256 * j); bn[j] = *(const v2u*)(Y1 + (size_t)r0 * DM + lc + 256 * j); }
    }
    for (int r = r0; r < r1; ++r) {
        const int mrow = (r < NLAT) ? (r >> 11) : 8;
        if (mrow != cur) {
            cur = mrow; const float* m5 = modl + (size_t)mrow * MODW + 5 * DM; const float* mn = modn + (size_t)mrow * MODW;
#pragma unroll
            for (int j = 0; j < 4; ++j) { const unsigned c = lc + 256 * j; m5v[j] = *(const v4f*)(m5 + c);
                if (do_norm) { const v4f gg = *(const v4f*)(g + c), sc = *(const v4f*)(mn + DM + c); gs[j] = gg * (1.f + sc); sh[j] = *(const v4f*)(mn + c); } }
        }
        v4f x[4]; v2u a[4], b[4];
#pragma unroll
        for (int j = 0; j < 4; ++j) { x[j] = xn[j]; a[j] = an[j]; b[j] = bn[j]; }
        float* xr = rowptr(r);
        if (r + 1 < r1) {
            const float* xq = rowptr(r + 1);
#pragma unroll
            for (int j = 0; j < 4; ++j) { xn[j] = *(const v4f*)(xq + lc + 256 * j); an[j] = *(const v2u*)(Y0 + (size_t)(r + 1) * DM + lc + 256 * j); bn[j] = *(const v2u*)(Y1 + (size_t)(r + 1) * DM + lc + 256 * j); }
        }
        v4f v[4]; float s = 0.f;
#pragma unroll
        for (int j = 0; j < 4; ++j) {
            v4f y; y.x = bflo(a[j].x) + bflo(b[j].x); y.y = bfhi(a[j].x) + bfhi(b[j].x); y.z = bflo(a[j].y) + bflo(b[j].y); y.w = bfhi(a[j].y) + bfhi(b[j].y);
            v[j] = x[j] + m5v[j] * y;
            *(v4f*)(xr + lc + 256 * j) = v[j];
            s += (v[j].x * v[j].x + v[j].y * v[j].y) + (v[j].z * v[j].z + v[j].w * v[j].w);
        }
        if (do_norm) {
            const float rstd = rsqrtf(wave_sum(s, lane) * (1.f / DM) + 1e-6f);
#pragma unroll
            for (int j = 0; j < 4; ++j) { const v4f o = v[j] * rstd * gs[j] + sh[j]; v2u w; w.x = pk2(o.x, o.y); w.y = pk2(o.z, o.w); *(v2u*)(H + (size_t)r * DM + lc + 256 * j) = w; }
        }
    }
}

namespace hg {
typedef short s4v __attribute__((ext_vector_type(4)));
typedef short s8v __attribute__((ext_vector_type(8)));
typedef short v4i16_t __attribute__((ext_vector_type(4)));
constexpr int TS = 160;
constexpr int TILE_B = 16 * TS;
constexpr int WAVE_LDS = 2 * TILE_B;
constexpr int NSEG = 18;
constexpr size_t SEGU_B = 64 * 64 * 4, SEGA_B = 16 * 64 * 4;
constexpr size_t WS_SEGU = WS_SCR;
constexpr size_t WS_SEGA = WS_SEGU + (size_t)NBATCH * 4 * 2 * NSEG * SEGU_B;
static_assert(WS_SEGA + (size_t)NBATCH * 4 * 2 * NSEG * SEGA_B <= WS_END && 8 * WAVE_LDS <= 40960 && 40960 + 6 * 16384 <= LDS_BYTES - 64, "hgrn scratch");
template <int CTRL> __device__ __forceinline__ float dppf(float x) { return __builtin_bit_cast(float, __builtin_amdgcn_update_dpp(0, __builtin_bit_cast(int, x), CTRL, 0xf, 0xf, true)); }
__device__ __forceinline__ s4v trd(const LAS unsigned char* p) { return __builtin_bit_cast(s4v, __builtin_amdgcn_ds_read_tr16_b64_v4i16((LAS v4i16_t*)p)); }
typedef float f32x2_t __attribute__((ext_vector_type(2))); typedef __bf16 bf16x2_t __attribute__((ext_vector_type(2)));
__device__ __forceinline__ unsigned pkbf(float lo, float hi) { f32x2_t v = {lo, hi}; bf16x2_t b = __builtin_convertvector(v, bf16x2_t); return __builtin_bit_cast(unsigned, b); }
__device__ __forceinline__ float silu_r(float x) { return x * __builtin_amdgcn_rcpf(1.f + __expf(-x)); }
__device__ __forceinline__ s8v mk8(unsigned a, unsigned b, unsigned c, unsigned d) { v4u t; t.x = a; t.y = b; t.z = c; t.w = d; return __builtin_bit_cast(s8v, t); }

template <bool BWD, int OUT>
__device__ __forceinline__ void chunk(const bf16* __restrict__ P, int row0, int h, const float* __restrict__ lbh, v4f (&S)[4][4], float (&Atot)[16],
                                      LAS unsigned char* vt, LAS unsigned char* kt, int lane_, LAS v4f* OFL, int cidx, bf16* __restrict__ MIX, const float* __restrict__ on) {
    int lane = lane_; asm volatile("" : "+v"(lane));
    const int tok = lane & 15, kq = lane >> 4;
    const bf16* pb = P + (size_t)row0 * DIN + h * 64;
    const unsigned lo = (unsigned)(tok * DIN + 4 * kq);
    v2u zr[4], qr[4]; v4f lbq[4];
#pragma unroll
    for (int m = 0; m < 4; ++m) lbq[m] = *(const v4f*)(lbh + (unsigned)(16 * m + 4 * kq));
#pragma unroll
    for (int m = 0; m < 4; ++m) { zr[m] = *(const v2u*)(pb + (lo + (BWD ? C_FB : C_FF) + 16 * m)); if (OUT != 0) qr[m] = *(const v2u*)(pb + (lo + C_Q + 16 * m)); }
#pragma unroll
    for (int i = 0; i < 2; ++i) { const int pc = lane + 64 * i, r = pc >> 3, ch = pc & 7;
        const v4u vv = *(const v4u*)(pb + (unsigned)(r * DIN + C_I + 8 * ch)); *(LAS v4u*)(vt + r * TS + 16 * ch) = vv; }
    unsigned qf[8], kf[8];
    float A[16];
#pragma unroll
    for (int m = 0; m < 4; ++m)
#pragma unroll
        for (int jp = 0; jp < 2; ++jp) {
            const unsigned zw = jp ? zr[m].y : zr[m].x;
            float kt2[2], qt2[2], kh2[2];
#pragma unroll
            for (int i = 0; i < 2; ++i) {
                const int e = 4 * m + 2 * jp + i;
                const float z = i ? bfhi(zw) : bflo(zw);
                const float sg = __builtin_amdgcn_rcpf(1.f + __expf(-z)), lb = lbq[m][2 * jp + i];
                const float f = lb + (1.f - lb) * sg, kk = (1.f - lb) * (1.f - sg);
                const float lf = __logf(f);
                float c = lf, t = lf;
                if (!BWD) { c += dppf<0x111>(c); c += dppf<0x112>(c); c += dppf<0x114>(c); c += dppf<0x118>(c); }
                else      { c += dppf<0x101>(c); c += dppf<0x102>(c); c += dppf<0x104>(c); c += dppf<0x108>(c); }
                t += dppf<0x128>(t); t += dppf<0x124>(t); t += dppf<0x122>(t); t += dppf<0x121>(t);
                const float Ei = __expf(-fmaxf(c, -80.f)); A[e] = __expf(t);
                kt2[i] = kk * Ei; kh2[i] = kt2[i] * A[e];
                if (OUT != 0) { const unsigned qw = jp ? qr[m].y : qr[m].x; const float q = i ? bfhi(qw) : bflo(qw); qt2[i] = q * 0.125f * __expf(c); } else qt2[i] = 0.f;
            }
            kf[2 * m + jp] = pkbf(kt2[0], kt2[1]); if (OUT != 0) qf[2 * m + jp] = pkbf(qt2[0], qt2[1]);
            *(LAS unsigned*)(kt + tok * TS + (16 * m + 4 * kq + 2 * jp) * 2) = pkbf(kh2[0], kh2[1]);
            __builtin_amdgcn_sched_barrier(0);
        }
    asm volatile("s_waitcnt lgkmcnt(0)" ::: "memory");
    s8v vfr[4], khf[4];
    { const int i4 = tok >> 2, p4 = tok & 3; const LAS unsigned char* va = vt + (4 * kq + i4) * TS + 8 * p4; const LAS unsigned char* ka = kt + (4 * kq + i4) * TS + 8 * p4;
#pragma unroll
      for (int c = 0; c < 4; ++c) { const s4v a = trd(va + 32 * c), b = trd(ka + 32 * c);
          vfr[c] = (s8v){a[0], a[1], a[2], a[3], 0, 0, 0, 0}; khf[c] = (s8v){b[0], b[1], b[2], b[3], 0, 0, 0, 0}; } }
    if (OUT != 0) {
        const s8v q0 = mk8(qf[0], qf[1], qf[2], qf[3]), q1 = mk8(qf[4], qf[5], qf[6], qf[7]);
        const s8v k0 = mk8(kf[0], kf[1], kf[2], kf[3]), k1 = mk8(kf[4], kf[5], kf[6], kf[7]);
        v4f at = (v4f){0.f, 0.f, 0.f, 0.f};
        at = __builtin_amdgcn_mfma_f32_16x16x32_bf16(k0, q0, at, 0, 0, 0);
        at = __builtin_amdgcn_mfma_f32_16x16x32_bf16(k1, q1, at, 0, 0, 0);
#pragma unroll
        for (int j = 0; j < 4; ++j) { const int s = 4 * kq + j; const bool keep = BWD ? (s >= tok) : (s <= tok); at[j] = keep ? at[j] : 0.f; }
        const s8v af = mk8(pkbf(at[0], at[1]), pkbf(at[2], at[3]), 0u, 0u);
        v4f o[4];
#pragma unroll
        for (int vb = 0; vb < 4; ++vb) {
            o[vb] = __builtin_amdgcn_mfma_f32_16x16x32_bf16(vfr[vb], af, (v4f){0.f, 0.f, 0.f, 0.f}, 0, 0, 0);
            const s8v s0 = mk8(pkbf(S[0][vb][0], S[0][vb][1]), pkbf(S[0][vb][2], S[0][vb][3]), pkbf(S[1][vb][0], S[1][vb][1]), pkbf(S[1][vb][2], S[1][vb][3]));
            const s8v s1 = mk8(pkbf(S[2][vb][0], S[2][vb][1]), pkbf(S[2][vb][2], S[2][vb][3]), pkbf(S[3][vb][0], S[3][vb][1]), pkbf(S[3][vb][2], S[3][vb][3]));
            o[vb] = __builtin_amdgcn_mfma_f32_16x16x32_bf16(s0, q0, o[vb], 0, 0, 0);
            o[vb] = __builtin_amdgcn_mfma_f32_16x16x32_bf16(s1, q1, o[vb], 0, 0, 0);
            __builtin_amdgcn_sched_barrier(0);
        }
        LAS v4f* ofl = OFL + (cidx * 4) * 64 + lane;
        if (OUT == 1) {
#pragma unroll
            for (int vb = 0; vb < 4; ++vb) ofl[vb * 64] = o[vb];
        } else {
            float ss = 0.f;
#pragma unroll
            for (int vb = 0; vb < 4; ++vb) { o[vb] += ofl[vb * 64]; ss += (o[vb].x * o[vb].x + o[vb].y * o[vb].y) + (o[vb].z * o[vb].z + o[vb].w * o[vb].w); }
            ss += shx(ss, 16, lane); ss += shx(ss, 32, lane);
            const float rstd = rsqrtf(ss * (1.f / 64.f) + 1e-6f);
            bf16* mb = MIX + (size_t)row0 * DM + 768 + h * 64; const unsigned lom = (unsigned)(tok * DM + 4 * kq);
#pragma unroll
            for (int vb = 0; vb < 4; ++vb) {
                const v2u gw = *(const v2u*)(pb + (lo + C_G + 16 * vb)); const v4f gn = *(const v4f*)(on + (unsigned)(16 * vb + 4 * kq));
                const float g0 = bflo(gw.x), g1 = bfhi(gw.x), g2 = bflo(gw.y), g3 = bfhi(gw.y);
                v2u w; w.x = pkbf(o[vb].x * rstd * gn.x * silu_r(g0), o[vb].y * rstd * gn.y * silu_r(g1)); w.y = pkbf(o[vb].z * rstd * gn.z * silu_r(g2), o[vb].w * rstd * gn.w * silu_r(g3));
                *(v2u*)(mb + (lom + 16 * vb)) = w;
            }
        }
    }
#pragma unroll
    for (int db = 0; db < 4; ++db) {
        const v4f av = (v4f){A[4 * db], A[4 * db + 1], A[4 * db + 2], A[4 * db + 3]};
#pragma unroll
        for (int vb = 0; vb < 4; ++vb) S[db][vb] = __builtin_amdgcn_mfma_f32_16x16x32_bf16(khf[db], vfr[vb], S[db][vb] * av, 0, 0, 0);
        __builtin_amdgcn_sched_barrier(0);
    }
    if (OUT == 0) {
#pragma unroll
        for (int e = 0; e < 16; ++e) Atot[e] *= A[e];
    }
    asm volatile("s_waitcnt lgkmcnt(0)" ::: "memory");
}
__device__ __forceinline__ int seg_row0(int b, int seg) { return seg < 2 ? NLAT + b * CTXL + 128 * seg : b * SEQ + 128 * (seg - 2); }
__device__ __forceinline__ int scan_idx(int seg, int dir) { return dir == 0 ? seg : (seg < 2 ? 1 - seg : 19 - seg); }

__device__ __forceinline__ void unit_pass1(const Ptrs& p, int layer, int u, LAS unsigned char* wl, int lane) {
    const int dir = u & 1, bhs = u >> 1, seg = bhs % NSEG, bh = bhs / NSEG, h = bh & 3, b = bh >> 2;
    const bf16* P = (const bf16*)(p.ws + WS_P);
    const int row0 = seg_row0(b, seg);
    float Atot[16]; v4f S[4][4];
    const float* lbv = (const float*)(p.ws + WS_LB) + layer * 512 + dir * 256 + h * 64;
#pragma unroll
    for (int e = 0; e < 16; ++e) Atot[e] = 1.f;
#pragma unroll
    for (int i = 0; i < 4; ++i)
#pragma unroll
        for (int j = 0; j < 4; ++j) S[i][j] = (v4f){0.f, 0.f, 0.f, 0.f};
    if (dir == 0) {
#pragma unroll 1
        for (int c = 0; c < 8; ++c) chunk<false, 0>(P, row0 + 16 * c, h, lbv, S, Atot, wl, wl + TILE_B, lane, nullptr, c, nullptr, nullptr);
    } else {
#pragma unroll 1
        for (int c = 7; c >= 0; --c) chunk<true, 0>(P, row0 + 16 * c, h, lbv, S, Atot, wl, wl + TILE_B, lane, nullptr, c, nullptr, nullptr);
    }
    const size_t si = ((size_t)(bh * 2 + dir)) * NSEG + scan_idx(seg, dir);
    float* su = (float*)(p.ws + WS_SEGU + si * SEGU_B) + lane; float* sa = (float*)(p.ws + WS_SEGA + si * SEGA_B) + lane;
#pragma unroll
    for (int i = 0; i < 4; ++i)
#pragma unroll
        for (int j = 0; j < 4; ++j)
#pragma unroll
            for (int r = 0; r < 4; ++r) su[((i * 4 + j) * 4 + r) * 64] = S[i][j][r];
#pragma unroll
    for (int e = 0; e < 16; ++e) sa[e * 64] = Atot[e];
}
template <bool BWD>
__device__ __forceinline__ void unit_pass2(const Ptrs& p, int layer, int pu, LAS unsigned char* wl, LAS v4f* ofl_own, LAS v4f* ofl_partner, int lane, bool active) {
    const int seg = pu % NSEG, bh = pu / NSEG, h = bh & 3, b = bh >> 2;
    const bf16* P = (const bf16*)(p.ws + WS_P); bf16* MIX = (bf16*)(p.ws + WS_MIX);
    const float* on = p.in[I_HGON] + layer * 64;
    const int row0 = seg_row0(b, seg);
    constexpr int dir = BWD ? 1 : 0;
    float Atot[16]; v4f S[4][4];
    const float* lbv = (const float*)(p.ws + WS_LB) + layer * 512 + dir * 256 + h * 64;
    if (active) {
        {
            const size_t si = ((size_t)(bh * 2 + dir)) * NSEG + scan_idx(seg, dir);
            int ln = lane; asm volatile("" : "+v"(ln));
            const float* su = (const float*)(p.ws + WS_SEGU + si * SEGU_B) + ln;
#pragma unroll
            for (int i = 0; i < 4; ++i)
#pragma unroll
                for (int j = 0; j < 4; ++j) S[i][j] = (v4f){su[((i * 4 + j) * 4 + 0) * 64], su[((i * 4 + j) * 4 + 1) * 64], su[((i * 4 + j) * 4 + 2) * 64], su[((i * 4 + j) * 4 + 3) * 64]};
        }
#pragma unroll 1
        for (int k = 0; k < 4; ++k) { const int c = BWD ? 7 - k : k; chunk<BWD, 1>(P, row0 + 16 * c, h, lbv, S, Atot, wl, wl + TILE_B, lane, ofl_own, k, MIX, on); }
    }
    __syncthreads();
    if (active) {
#pragma unroll 1
        for (int k = 4; k < 8; ++k) { const int c = BWD ? 7 - k : k; chunk<BWD, 2>(P, row0 + 16 * c, h, lbv, S, Atot, wl, wl + TILE_B, lane, ofl_partner, 7 - k, MIX, on); }
    }
}
}
constexpr int LDS_HG_OFL = 40960, HG_OFL_B = 16384;
__device__ __forceinline__ void phase_hgrn1(const Ptrs& p, LAS unsigned char* lds, int layer, int wv) {
    const int lane = otid(wv) & 63; const int u = wv * gridDim.x + blockIdx.x;
    if (u < 2 * 32 * hg::NSEG) hg::unit_pass1(p, layer, u, lds + wv * hg::WAVE_LDS, lane);
}
__device__ __forceinline__ void phase_hgrn2(const Ptrs& p, LAS unsigned char* lds, int layer, int wv) {
    const int lane = otid(wv) & 63; const int pu = (wv >> 1) * gridDim.x + blockIdx.x;
    const bool active = pu < 32 * hg::NSEG && (layer == 0 || (pu % hg::NSEG) >= 2) && wv < 6;
    LAS v4f* own = (LAS v4f*)(lds + LDS_HG_OFL + (wv < 6 ? wv : 0) * HG_OFL_B); LAS v4f* partner = (LAS v4f*)(lds + LDS_HG_OFL + (wv < 6 ? (wv ^ 1) : 0) * HG_OFL_B);
    if (wv & 1) hg::unit_pass2<true>(p, layer, pu, lds + wv * hg::WAVE_LDS, own, partner, lane, active);
    else        hg::unit_pass2<false>(p, layer, pu, lds + wv * hg::WAVE_LDS, own, partner, lane, active);
}

__device__ __forceinline__ void phase_hgrn_scan(const Ptrs& p, int wv) {
    const int t = blockIdx.x * NT + otid(wv);
#pragma unroll 1
    for (int half = 0; half < 2; ++half) {
        const int e = t + half * (int)(gridDim.x * NT);
        if (e >= 64 * 4096) break;
        const int bhd = e >> 12, r = (e >> 6) & 63, l = e & 63;
        float* su = (float*)(p.ws + hg::WS_SEGU + (size_t)bhd * hg::NSEG * hg::SEGU_B) + r * 64 + l;
        const float* sa = (const float*)(p.ws + hg::WS_SEGA + (size_t)bhd * hg::NSEG * hg::SEGA_B) + (4 * (r >> 4) + (r & 3)) * 64 + l;
        float u[hg::NSEG], a[hg::NSEG];
#pragma unroll
        for (int j = 0; j < hg::NSEG; ++j) { u[j] = su[(size_t)j * 4096]; a[j] = sa[(size_t)j * 1024]; }
        float st = 0.f;
#pragma unroll
        for (int j = 0; j < hg::NSEG; ++j) { su[(size_t)j * 4096] = st; st = a[j] * st + u[j]; }
    }
}
namespace att {
using bf16=unsigned short;
using bf16x8=__attribute__((ext_vector_type(8)))short;
using s16x4=__attribute__((ext_vector_type(4)))short;
using f32x16=__attribute__((ext_vector_type(16)))float;
using u32x4=__attribute__((ext_vector_type(4)))unsigned;
constexpr int D=64,PIN_=DIN,POUT=DM;
constexpr int NW=8,QBLK=32,QB=QBLK*NW,KVBLK=64;
__device__ __forceinline__ int crow(int r,int hi){return (r&3)+8*(r>>2)+4*hi;}
#define SBAR() __builtin_amdgcn_sched_barrier(0)
constexpr int NSLOT=3, SLOTB=8192;
constexpr int LDS_K=0, LDS_V=NSLOT*SLOTB, LDS_WS=2*NSLOT*SLOTB, LDS_OST=LDS_WS+NW*64*4, LDS_BYTES=LDS_OST+NW*4096;
constexpr float C2=0.125f*1.4426950408889634f;
__device__ __forceinline__ void glds16(const void*gsrc,unsigned lds_dst){unsigned keep;
  asm volatile("s_mov_b32 %0, m0\n\ts_mov_b32 m0, %2\n\ts_nop 0\n\tglobal_load_lds_dwordx4 %1, off\n\ts_mov_b32 m0, %0":"=&s"(keep):"v"(gsrc),"s"(lds_dst):"memory");}
__device__ __forceinline__ float max3f(float a,float b,float c){float r;asm("v_max3_f32 %0, %1, %2, %3":"=v"(r):"v"(a),"v"(b),"v"(c));return r;}
__device__ __forceinline__ float max2f(float a,float b){float r;asm("v_max_f32_e32 %0, %1, %2":"=v"(r):"v"(a),"v"(b));return r;}
__device__ __forceinline__ float fadd_s(float a,float b){float r;asm("v_add_f32_e32 %0, %1, %2":"=v"(r):"v"(a),"v"(b));return r;}
__device__ __forceinline__ float fsub_s(float a,float b){float r;asm("v_sub_f32_e32 %0, %1, %2":"=v"(r):"v"(a),"v"(b));return r;}
typedef float f32x2_t __attribute__((ext_vector_type(2))); typedef __bf16 bf16x2_t __attribute__((ext_vector_type(2)));
__device__ __forceinline__ unsigned cvtpk_s(float lo,float hi){f32x2_t v={lo,hi};bf16x2_t b=__builtin_convertvector(v,bf16x2_t);return __builtin_bit_cast(unsigned,b);}
#define WAIT_BAR(N) asm volatile("s_waitcnt vmcnt(" #N ") lgkmcnt(0)\n\ts_barrier":::"memory")

__device__ __forceinline__ void qkt(f32x16&p0,f32x16&p1,const char*Kslot,const bf16x8*qr,const f32x16&negm,int r32,int hi){
  const char*kb=Kslot+hi*1024+r32*16;
  #pragma unroll
  for(int d0=0;d0<4;++d0){
    const bf16x8 b0=*reinterpret_cast<const bf16x8*>(kb+d0*2048);
    const bf16x8 b1=*reinterpret_cast<const bf16x8*>(kb+d0*2048+512);
    if(d0==0){p0=__builtin_amdgcn_mfma_f32_32x32x16_bf16(b0,qr[0],negm,0,0,0);p1=__builtin_amdgcn_mfma_f32_32x32x16_bf16(b1,qr[0],negm,0,0,0);}
    else{p0=__builtin_amdgcn_mfma_f32_32x32x16_bf16(b0,qr[d0],p0,0,0,0);p1=__builtin_amdgcn_mfma_f32_32x32x16_bf16(b1,qr[d0],p1,0,0,0);}}
}
typedef __attribute__((address_space(3))) const char* lds_cptr;
typedef short v4i16_t __attribute__((ext_vector_type(4)));
__device__ __forceinline__ void kload8(bf16x8*kf,lds_cptr kp){
  kf[0]=*(const __attribute__((address_space(3))) bf16x8*)(kp);      kf[1]=*(const __attribute__((address_space(3))) bf16x8*)(kp+512);
  kf[2]=*(const __attribute__((address_space(3))) bf16x8*)(kp+2048); kf[3]=*(const __attribute__((address_space(3))) bf16x8*)(kp+2560);
  kf[4]=*(const __attribute__((address_space(3))) bf16x8*)(kp+4096); kf[5]=*(const __attribute__((address_space(3))) bf16x8*)(kp+4608);
  kf[6]=*(const __attribute__((address_space(3))) bf16x8*)(kp+6144); kf[7]=*(const __attribute__((address_space(3))) bf16x8*)(kp+6656);
}
__device__ __forceinline__ void kload2(bf16x8*kf,lds_cptr kp,int j){ kf[2*j]=*(const __attribute__((address_space(3))) bf16x8*)(kp+j*2048); kf[2*j+1]=*(const __attribute__((address_space(3))) bf16x8*)(kp+j*2048+512); }
__device__ __forceinline__ s16x4 vtr(lds_cptr p){ return __builtin_bit_cast(s16x4,__builtin_amdgcn_ds_read_tr16_b64_v4i16((__attribute__((address_space(3))) v4i16_t*)p)); }
__device__ __forceinline__ float rowmax(const f32x16&p0,const f32x16&p1){
  float a=max3f(p0[0],p0[1],p1[0]),b=max3f(p0[2],p0[3],p1[1]);a=max3f(a,p1[2],p1[3]);
  #pragma unroll
  for(int r=4;r<16;r+=4){a=max3f(a,p0[r],p0[r+1]);b=max3f(b,p0[r+2],p0[r+3]);a=max3f(a,p1[r],p1[r+1]);b=max3f(b,p1[r+2],p1[r+3]);}
  const float m=max2f(a,b);
  auto rr=__builtin_amdgcn_permlane32_swap(__float_as_uint(m),__float_as_uint(m),false,false);
  return max2f(__uint_as_float(rr[0]),__uint_as_float(rr[1]));
}
__device__ __forceinline__ void pv(f32x16*o,int vb,bf16x8 pa0,bf16x8 pa1,bf16x8 pa2,bf16x8 pa3){
  #pragma unroll
  for(int d0=0;d0<2;++d0){s16x4 lo[4],hi[4];
    #pragma unroll
    for(int ks=0;ks<4;++ks){
      asm volatile("ds_read_b64_tr_b16 %0,%1 offset:%c2":"=&v"(lo[ks]):"v"(vb),"i"(d0*4096+ks*1024):"memory");
      asm volatile("ds_read_b64_tr_b16 %0,%1 offset:%c2":"=&v"(hi[ks]):"v"(vb),"i"(d0*4096+ks*1024+512):"memory");}
    asm volatile("s_waitcnt lgkmcnt(0)":::"memory");SBAR();
    #define PK(k) (bf16x8){lo[k][0],lo[k][1],lo[k][2],lo[k][3],hi[k][0],hi[k][1],hi[k][2],hi[k][3]}
    o[d0]=__builtin_amdgcn_mfma_f32_32x32x16_bf16(pa0,PK(0),o[d0],0,0,0);
    o[d0]=__builtin_amdgcn_mfma_f32_32x32x16_bf16(pa1,PK(1),o[d0],0,0,0);
    o[d0]=__builtin_amdgcn_mfma_f32_32x32x16_bf16(pa2,PK(2),o[d0],0,0,0);
    o[d0]=__builtin_amdgcn_mfma_f32_32x32x16_bf16(pa3,PK(3),o[d0],0,0,0);
    #undef PK
  }
}

#ifndef ATTN_STORE16
#define ATTN_STORE16(p,v) (*(u32x4*)(p)=(v))
#endif
template<int THRL,class Hook> __device__ __forceinline__ void attn_unit(const bf16*Q0,const bf16*__restrict__ Kh,const bf16*__restrict__ Vh,int rowa,int na,int rowb,int NT,bf16*O0,const Hook&hook,char*shm,int wid){
  const int lane=otid(wid)&63,r32=lane&31,hi=lane>>5;
  const bf16*Qw=Q0+(long)(wid*QBLK)*PIN_;
  #define TROW(t) ((long)(((t)<na)?(rowa+64*(t)):(rowb+64*((t)-na))))
  const unsigned lds0=(unsigned)(uintptr_t)shm;
  float*wsf=(float*)(shm+LDS_WS)+wid*64;
  const bf16*ksrc=Kh+(long)lane*PIN_+wid*8;
  const bf16*vsrc=Vh+(long)(16*(wid&3)+(lane>>2))*PIN_+(wid>>2)*32+(lane&3)*8;
  const unsigned kdst=lds0+LDS_K+wid*1024, vdst=lds0+LDS_V+wid*1024;
  #define DMA_K(t,slot) glds16(ksrc+TROW(t)*PIN_,(unsigned)__builtin_amdgcn_readfirstlane(kdst+(slot)))
  #define DMA_V(t,slot) glds16(vsrc+TROW(t)*PIN_,(unsigned)__builtin_amdgcn_readfirstlane(vdst+(slot)))
  const int vb0=(int)(lds0+LDS_V)+((lane>>4)&1)*32+(lane&3)*8+(4*hi+((lane&15)>>2))*64;
  const char*Kbase=shm+LDS_K; bf16x8 kf[8];
  const lds_cptr shm3=(lds_cptr)shm; const lds_cptr kp0=shm3+LDS_K+hi*1024+r32*16; const lds_cptr vp0=shm3+LDS_V+((lane>>4)&1)*32+(lane&3)*8+(4*hi+((lane&15)>>2))*64;
  DMA_K(0,0);DMA_V(0,0);DMA_K(1,SLOTB);
  bf16x8 qr[4];
  #pragma unroll
  for(int d0=0;d0<4;++d0)qr[d0]=*reinterpret_cast<const bf16x8*>(&Qw[(long)r32*PIN_+d0*16+hi*8]);
  float zz_=0.f; asm volatile("":"+v"(zz_));
  float mhat=zz_,l_reg=zz_;f32x16 o[2],negm;
  #pragma unroll
  for(int r=0;r<16;++r){o[0][r]=zz_;o[1][r]=zz_;negm[r]=zz_;}
  asm volatile("":"+v"(negm));
  #define CMASK(P0,P1,t) hook(P0,P1,(t),wid,r32,hi)
  bool resc=false;
  #define START(P0,P1) do{ const float rm=rowmax(P0,P1); resc=false; \
    { const float dl=rm; mhat=fadd_s(mhat,dl); \
      _Pragma("unroll") for(int r=0;r<16;++r){P0[r]=fsub_s(P0[r],dl);P1[r]=fsub_s(P1[r],dl);} \
      _Pragma("unroll") for(int r=0;r<16;++r)negm[r]=-mhat; asm volatile("":"+v"(negm)); } \
    _Pragma("unroll") for(int r=0;r<16;++r)P0[r]=__builtin_amdgcn_exp2f(P0[r]); }while(0)
  #define RESC() do{ if(resc){ asm volatile("s_waitcnt lgkmcnt(0)":::"memory"); \
      _Pragma("unroll") for(int d_=0;d_<2;++d_) _Pragma("unroll") for(int r=0;r<16;++r)o[d_][r]*=wsf[crow(r,hi)]; } }while(0)
  f32x16 pA0,pA1,pB0,pB1;
  int sl_prev=0,sl_cur=0,sl_next=SLOTB;
  #define ROT() do{sl_prev=sl_cur;sl_cur=sl_next;sl_next=(sl_next==(NSLOT-1)*SLOTB)?0:sl_next+SLOTB;}while(0)
  DMA_K(2,2*SLOTB);
  WAIT_BAR(3);
  qkt(pA0,pA1,Kbase,qr,negm,r32,hi);asm volatile("s_nop 15\n\ts_nop 7":"+v"(pA0),"+v"(pA1));
  START(pA0,pA1);
  _Pragma("unroll") for(int r=0;r<16;++r)pA1[r]=__builtin_amdgcn_exp2f(pA1[r]);
  WAIT_BAR(0);
  DMA_K(3,0);DMA_V(1,SLOTB);
  ROT();
  kload8(kf,kp0+sl_cur);
  WAIT_BAR(2);
  s16x4 vlo[8],vhi[8]; u32x4 pw0,pw1,pw2,pw3;
  #define PKW(P,B) cvtpk_s(P[B],P[B+1])
  #define PAF(k) __builtin_bit_cast(bf16x8,pw##k)
  #define VFR(i) (bf16x8){vlo[i][0],vlo[i][1],vlo[i][2],vlo[i][3],vhi[i][0],vhi[i][1],vhi[i][2],vhi[i][3]}
  #define PIN(x) asm volatile("":"+v"(x))
  #define MX3(a,b,c) __builtin_fmaxf(__builtin_fmaxf((a),(b)),(c))
  #define GAPA(MF,A0,A1,A2,A3,W0,W1,PW) do{ MF; sacc+=A0; sacc+=A1; sacc+=A2; sacc+=A3; PIN(sacc); W0; W1; PIN(PW); SBAR(); }while(0)
  #define EX(v) __builtin_amdgcn_exp2f(v)
  #define GAPB(MF,X,B) do{ MF; X[B]=EX(X[B]); X[B+1]=EX(X[B+1]); X[B+2]=EX(X[B+2]); X[B+3]=EX(X[B+3]); PIN(X); SBAR(); }while(0)
  #define VRD(i) do{ vlo[i]=vtr(vp_+(((i)>>2)*4096+((i)&3)*1024)); vhi[i]=vtr(vp_+(((i)>>2)*4096+((i)&3)*1024+512)); }while(0)
  #define KRD(G,j) do{ if(G){ kload2(kf,kp0+sl_next,j); SBAR(); } }while(0)
  #define STEP(C0,C1,P0,P1,t,GK,GV,GL) do{ SBAR(); \
    const lds_cptr vp_=vp0+sl_prev; \
    VRD(0); SBAR(); float sacc=(P0[0]+P0[1]); \
    GAPA(C0=__builtin_amdgcn_mfma_f32_32x32x16_bf16(kf[0],qr[0],negm,0,0,0), P0[2],P0[3],P0[4],P0[5],     pw0[0]=PKW(P0,0), pw0[1]=PKW(P0,2), pw0); \
    VRD(4); SBAR(); GAPA(C1=__builtin_amdgcn_mfma_f32_32x32x16_bf16(kf[1],qr[0],negm,0,0,0), P0[6],P0[7],P0[8],P0[9],     pw0[2]=PKW(P0,4), pw0[3]=PKW(P0,6), pw0); \
    VRD(1); SBAR(); GAPA(C0=__builtin_amdgcn_mfma_f32_32x32x16_bf16(kf[2],qr[1],C0,0,0,0),   P0[10],P0[11],P0[12],P0[13], pw1[0]=PKW(P0,8), pw1[1]=PKW(P0,10), pw1); \
    VRD(5); SBAR(); GAPA(C1=__builtin_amdgcn_mfma_f32_32x32x16_bf16(kf[3],qr[1],C1,0,0,0),   P0[14],P0[15],P1[0],P1[1],   pw1[2]=PKW(P0,12),pw1[3]=PKW(P0,14), pw1); \
    VRD(2); SBAR(); GAPA(C0=__builtin_amdgcn_mfma_f32_32x32x16_bf16(kf[4],qr[2],C0,0,0,0),   P1[2],P1[3],P1[4],P1[5],     pw2[0]=PKW(P1,0), pw2[1]=PKW(P1,2), pw2); \
    VRD(6); SBAR(); GAPA(C1=__builtin_amdgcn_mfma_f32_32x32x16_bf16(kf[5],qr[2],C1,0,0,0),   P1[6],P1[7],P1[8],P1[9],     pw2[2]=PKW(P1,4), pw2[3]=PKW(P1,6), pw2); \
    VRD(3); SBAR(); GAPA(C0=__builtin_amdgcn_mfma_f32_32x32x16_bf16(kf[6],qr[3],C0,0,0,0),   P1[10],P1[11],P1[12],P1[13], pw3[0]=PKW(P1,8), pw3[1]=PKW(P1,10), pw3); \
    VRD(7); SBAR(); GAPA(C1=__builtin_amdgcn_mfma_f32_32x32x16_bf16(kf[7],qr[3],C1,0,0,0),   P1[14],P1[15],0.f,0.f,       pw3[2]=PKW(P1,12),pw3[3]=PKW(P1,14), pw3); \
    l_reg+=sacc; \
    if(GK){DMA_K((t)+3,sl_cur);} if(GV){DMA_V((t)+1,sl_next);} \
    CMASK(C0,C1,t); \
    { float a=MX3(C0[0],C0[1],C1[0]),b=MX3(C0[2],C0[3],C1[1]); a=MX3(a,C1[2],C1[3]); \
      _Pragma("unroll") for(int r=4;r<16;r+=4){a=MX3(a,C0[r],C0[r+1]);b=MX3(b,C0[r+2],C0[r+3]);a=MX3(a,C1[r],C1[r+1]);b=MX3(b,C1[r+2],C1[r+3]);} \
      float rm=__builtin_fmaxf(a,b); { auto rr=__builtin_amdgcn_permlane32_swap(__float_as_uint(rm),__float_as_uint(rm),false,false); rm=__builtin_fmaxf(__uint_as_float(rr[0]),__uint_as_float(rr[1])); } \
      resc=false; \
      if(__builtin_expect(__any(rm>(float)THRL),0)){ const float dl=__builtin_fmaxf(rm,0.f); mhat+=dl; \
        _Pragma("unroll") for(int r=0;r<16;++r){C0[r]-=dl;C1[r]-=dl;} \
        _Pragma("unroll") for(int r=0;r<16;++r)negm[r]=-mhat; asm volatile("":"+v"(negm)); \
        const float f=__builtin_amdgcn_exp2f(-dl); l_reg*=f; if(hi==0)wsf[r32]=f; resc=true; } } \
    SBAR(); \
    GAPB(o[0]=__builtin_amdgcn_mfma_f32_32x32x16_bf16(PAF(0),VFR(0),o[0],0,0,0), C0,0); \
    GAPB(o[1]=__builtin_amdgcn_mfma_f32_32x32x16_bf16(PAF(0),VFR(4),o[1],0,0,0), C0,4); \
    KRD(GL,0); GAPB(o[0]=__builtin_amdgcn_mfma_f32_32x32x16_bf16(PAF(1),VFR(1),o[0],0,0,0), C0,8); \
    KRD(GL,1); GAPB(o[1]=__builtin_amdgcn_mfma_f32_32x32x16_bf16(PAF(1),VFR(5),o[1],0,0,0), C0,12); \
    KRD(GL,2); GAPB(o[0]=__builtin_amdgcn_mfma_f32_32x32x16_bf16(PAF(2),VFR(2),o[0],0,0,0), C1,0); \
    KRD(GL,3); GAPB(o[1]=__builtin_amdgcn_mfma_f32_32x32x16_bf16(PAF(2),VFR(6),o[1],0,0,0), C1,4); \
    GAPB(o[0]=__builtin_amdgcn_mfma_f32_32x32x16_bf16(PAF(3),VFR(3),o[0],0,0,0), C1,8); \
    GAPB(o[1]=__builtin_amdgcn_mfma_f32_32x32x16_bf16(PAF(3),VFR(7),o[1],0,0,0), C1,12); \
    }while(0)
  int t=1;
  for(;t+5<NT;t+=2){
    STEP(pB0,pB1,pA0,pA1,t,true,true,true);     WAIT_BAR(2); RESC(); ROT();
    STEP(pA0,pA1,pB0,pB1,t+1,true,true,true);   WAIT_BAR(2); RESC(); ROT();
  }
  #define ENDW(tt) do{ if((tt)+3<NT){WAIT_BAR(2);} else if((tt)+2<NT){WAIT_BAR(1);} else {WAIT_BAR(0);} }while(0)
  for(;t+1<NT;t+=2){
    STEP(pB0,pB1,pA0,pA1,t,(t+3<NT),(t+1<NT),(t+1<NT));       ENDW(t);   RESC(); ROT();
    STEP(pA0,pA1,pB0,pB1,t+1,(t+4<NT),(t+2<NT),(t+2<NT));     ENDW(t+1); RESC(); ROT();
  }
  STEP(pB0,pB1,pA0,pA1,NT-1,false,false,false); RESC();
  { float sacc=pB0[0]+pB0[1]; _Pragma("unroll") for(int r=2;r<16;++r)sacc+=pB0[r]; _Pragma("unroll") for(int r=0;r<16;++r)sacc+=pB1[r]; l_reg+=sacc;
    pw0=(u32x4){PKW(pB0,0),PKW(pB0,2),PKW(pB0,4),PKW(pB0,6)};pw1=(u32x4){PKW(pB0,8),PKW(pB0,10),PKW(pB0,12),PKW(pB0,14)};pw2=(u32x4){PKW(pB1,0),PKW(pB1,2),PKW(pB1,4),PKW(pB1,6)};pw3=(u32x4){PKW(pB1,8),PKW(pB1,10),PKW(pB1,12),PKW(pB1,14)};
    SBAR(); pv(o,vb0+sl_cur,PAF(0),PAF(1),PAF(2),PAF(3)); }
  #undef PKW
  #undef PAF
  #undef VFR
  #undef PIN
  #undef MX3
  #undef GAPA
  #undef GAPB
  #undef EX
  #undef VRD
  #undef KRD
  #undef STEP
  #undef ENDW
  {auto rr=__builtin_amdgcn_permlane32_swap(__float_as_uint(l_reg),__float_as_uint(l_reg),false,false);l_reg=__uint_as_float(rr[0])+__uint_as_float(rr[1]);}
  if(hi==0)wsf[32+r32]=l_reg;asm volatile("s_waitcnt lgkmcnt(0)":::"memory");
  float rli[16];
  #pragma unroll
  for(int r=0;r<16;++r)rli[r]=__builtin_amdgcn_rcpf(wsf[32+crow(r,hi)]);
  bf16*Ow=O0+(long)(wid*QBLK)*POUT;
  { bf16*stg=(bf16*)(shm+LDS_OST)+wid*2048;
    #pragma unroll
    for(int r=0;r<16;++r){const int orow=crow(r,hi);
      #pragma unroll
      for(int d0=0;d0<2;++d0)stg[orow*64+d0*32+r32]=(bf16)f2bf(o[d0][r]*rli[r]);}
    asm volatile("s_waitcnt lgkmcnt(0)":::"memory");
    #pragma unroll
    for(int i=0;i<4;++i){const int row=i*8+(lane>>3),ch=lane&7; const u32x4 v=*(const u32x4*)(stg+row*64+ch*8); ATTN_STORE16(Ow+(long)row*POUT+ch*8,v);} }
  asm volatile("s_waitcnt lgkmcnt(0)\n\ts_barrier":::"memory");
  #undef DMA_K
  #undef DMA_V
  #undef TROW
  #undef CMASK
  #undef START
  #undef RESC
  #undef ROT
}
constexpr int ATTN_LDS_BYTES=LDS_BYTES;
#undef SBAR
#undef WAIT_BAR
}

namespace pg8 {
struct EpiInProj {
    static constexpr bool PERM = true, AFTER_DRAIN = false;
    bf16_t* P; const float* na_qn; const float* na_kn; const float* gq_qn; const float* gq_kn; int wv;
    __device__ __forceinline__ void operator()(const f32x4 (&acc)[2][2][4][2], const Unit& u, int, int, int, int) const {
        const int l_ = otid(wv) & 63, fr = l_ & 15, fq = l_ >> 4, wr = wv >> 2, wc = wv & 3;
        const int pn = u.pn, rowt = u.pm * BM;
        int mode = 0; const float* gain = na_qn; float qs = 1.f;
        if (pn == 0) { mode = 1; gain = na_qn; qs = att::C2; }
        else if (pn == 1) { mode = 1; gain = na_kn; }
        else if (pn == 3 || pn == 4) { mode = 2; gain = gq_qn; qs = att::C2; }
        else if (pn == 5 && wc < 2) { mode = 2; gain = gq_kn; }
        if (mode == 2 && rowt >= NLAT) mode = 1;
        bf16_t* pcol = P + pn * BM + 64 * wc + 8 * fq;
        if (mode == 0) {
#pragma unroll
            for (int ai = 0; ai < 2; ++ai)
#pragma unroll
                for (int m = 0; m < 4; ++m) { bf16_t* rowp = pcol + (size_t)(rowt + ai * HALF + wr * 64 + m * 16 + fr) * DIN;
#pragma unroll
                    for (int bj = 0; bj < 2; ++bj) { const f32x4 v0 = acc[ai][bj][m][0], v1 = acc[ai][bj][m][1];
                        u32x4 w; w.x = cvt_pk_bf16(v0[0], v0[1]); w.y = cvt_pk_bf16(v0[2], v0[3]); w.z = cvt_pk_bf16(v1[0], v1[1]); w.w = cvt_pk_bf16(v1[2], v1[3]);
                        *(u32x4*)(rowp + 32 * bj) = w; } }
            return;
        }
        f32x4 g[2][2]; float invf[2][2];
#pragma unroll
        for (int bj = 0; bj < 2; ++bj)
#pragma unroll
            for (int n = 0; n < 2; ++n) g[bj][n] = *(const f32x4*)(gain + 32 * bj + 8 * fq + 4 * n) * qs;
#pragma unroll
        for (int n = 0; n < 2; ++n)
#pragma unroll
            for (int pp = 0; pp < 2; ++pp) invf[n][pp] = exp2f(-(float)(4 * fq + 2 * n + pp) * (13.287712379549449f / 16.f));
#pragma unroll
        for (int ai = 0; ai < 2; ++ai)
#pragma unroll
            for (int m = 0; m < 4; ++m) {
                const int row = rowt + ai * HALF + wr * 64 + m * 16 + fr;
                f32x4 v[2][2]; float ss = 0.f;
#pragma unroll
                for (int bj = 0; bj < 2; ++bj)
#pragma unroll
                    for (int n = 0; n < 2; ++n) { v[bj][n] = acc[ai][bj][m][n]; ss += (v[bj][n][0] * v[bj][n][0] + v[bj][n][1] * v[bj][n][1]) + (v[bj][n][2] * v[bj][n][2] + v[bj][n][3] * v[bj][n][3]); }
                ss += shx(ss, 16, l_); ss += shx(ss, 32, l_);
                const float rstd = rsqrtf(ss * (1.f / 64.f) + 1e-6f);
#pragma unroll
                for (int bj = 0; bj < 2; ++bj)
#pragma unroll
                    for (int n = 0; n < 2; ++n) {
                        if (mode == 2) {
                        }
                        v[bj][n] = v[bj][n] * rstd * g[bj][n];
                    }
                if (mode == 2) {
                    const int t = row & (SEQ - 1); const float pos[2] = {(float)(t >> 6), (float)(t & 63)};
#pragma unroll
                    for (int bj = 0; bj < 2; ++bj)
#pragma unroll
                        for (int n = 0; n < 2; ++n)
#pragma unroll
                            for (int pp = 0; pp < 2; ++pp) {
                                const float ang = pos[bj] * invf[n][pp], cs = __cosf(ang), sn = __sinf(ang);
                                const float x1 = v[bj][n][2 * pp], x2 = v[bj][n][2 * pp + 1];
                                v[bj][n][2 * pp] = x1 * cs - x2 * sn; v[bj][n][2 * pp + 1] = x1 * sn + x2 * cs;
                            }
                }
                bf16_t* rowp = pcol + (size_t)row * DIN;
#pragma unroll
                for (int bj = 0; bj < 2; ++bj) { const f32x4 v0 = v[bj][0], v1 = v[bj][1];
                    u32x4 w; w.x = cvt_pk_bf16(v0[0], v0[1]); w.y = cvt_pk_bf16(v0[2], v0[3]); w.z = cvt_pk_bf16(v1[0], v1[1]); w.w = cvt_pk_bf16(v1[2], v1[3]);
                    *(u32x4*)(rowp + 32 * bj) = w; }
                asm volatile("" ::: "memory");
            }
    }
};
}

__device__ __forceinline__ void w_qknorm_rope(const Ptrs& p, int layer, int unit, int d) {
    const int row = unit / 18, slot = unit % 18;
    int col; const float* gain; bool rope;
    if (slot < 4) { col = A_Q + slot * 64; gain = p.in[I_NAQN] + layer * 64; rope = false; }
    else if (slot < 8) { col = A_K + (slot - 4) * 64; gain = p.in[I_NAKN] + layer * 64; rope = false; }
    else if (slot < 16) { col = B_Q + (slot - 8) * 64; gain = p.in[I_GQQN] + layer * 64; rope = true; }
    else { col = B_K + (slot - 16) * 64; gain = p.in[I_GQKN] + layer * 64; rope = true; }
    bf16* pp = (bf16*)(p.ws + WS_P) + (size_t)row * DIN + col;
    float x = bf2f(pp[d]);
    float ss = wave_sum(x * x, d);
    float y = x * rsqrtf(ss * (1.f / 64.f) + 1e-6f) * gain[d];
    if (rope && row < NLAT) {
        int t = row & (SEQ - 1);
        float partner = shx(y, 1, d);
        int pi = d >> 1;
        float pos = (pi < 16) ? (float)(t >> 6) : (float)(t & 63);
        float inv = exp2f(-(float)(pi & 15) * (13.287712379549449f / 16.f));
        float ang = pos * inv;
        float cs = __cosf(ang), sn = __sinf(ang);
        y = (d & 1) ? (partner * sn + y * cs) : (y * cs - partner * sn);
    }
    if (slot < 4 || (slot >= 8 && slot < 16)) y *= att::C2;
    pp[d] = (bf16)f2bf(y);
}
struct NoHook { __device__ __forceinline__ void operator()(att::f32x16&, att::f32x16&, int, int, int, int) const {} };
struct NaHook {
    const LAS float* tab; int r0, kr0;
    __device__ __forceinline__ void operator()(att::f32x16& p0, att::f32x16& p1, int t, int wid, int r32, int hi) const {
        if (t < 4) return;
        const int r = r0 + (wid >> 1), kr = kr0 + t - 4, rs = min(max(r - 4, 0), 24);
        const float NEG = -INFINITY;
        if ((unsigned)(kr - rs) >= 8u) {
#pragma unroll
            for (int i = 0; i < 16; ++i) { p0[i] = NEG; p1[i] = NEG; }
            return;
        }
        const int qc = 32 * (wid & 1) + r32, cs = min(max(qc - 8, 0), 48), kb = 4 * hi - cs;
        const LAS float* tp = tab + (kr - r + 7) * 31 + (4 * hi - qc + 15);
#pragma unroll
        for (int i = 0; i < 16; ++i) {
            const int c = (i & 3) + 8 * (i >> 2);
            const float b0 = tp[c], b1 = tp[c + 32];
            p0[i] = ((unsigned)(kb + c) < 16u) ? p0[i] + b0 : NEG;
            p1[i] = ((unsigned)(kb + c + 32) < 16u) ? p1[i] + b1 : NEG;
        }
    }
};
constexpr int LDS_NATAB = 88064;
__device__ __forceinline__ void phase_attn(const Ptrs& p, unsigned char* lds_gen, int layer, int wv) {
    const bf16* P = (const bf16*)(p.ws + WS_P); bf16* MIX = (bf16*)(p.ws + WS_MIX);
    char* shm = (char*)lds_gen;
    const int c = blockIdx.x, x = c & 7, ci = (c >> 3) & 31;
    for (int i = 0; i < 2; ++i) {
        const int grp = 2 * x + i, b = grp >> 1, kvh = grp & 1, g = ci >> 3, qb = ci & 7, hq = kvh * 4 + g;
        const size_t qrow = (size_t)b * SEQ + qb * 256;
        att::attn_unit<8, NoHook>(P + qrow * DIN + B_Q + hq * 64, P + B_K + kvh * 64, P + B_V + kvh * 64, b * SEQ, 32, NLAT + b * CTXL, 36,
                                  MIX + qrow * DM + 256 + hq * 64, NoHook{}, shm, wv);
    }
    {
        const int grp = 4 * x + (ci >> 3), b = grp >> 2, h = grp & 3, r0 = 4 * (ci & 7);
        const int kr0 = (r0 == 0) ? 0 : (r0 == 28 ? 24 : r0 - 4), nr = (r0 == 0 || r0 == 28) ? 8 : 12;
        LAS float* tab = (LAS float*)((LAS unsigned char*)lds_gen + LDS_NATAB);
        const float* rpb = p.in[I_RPB] + ((size_t)layer * 4 + h) * 15 * 31;
        for (int i = otid(wv); i < 15 * 31; i += NT) tab[i] = rpb[i] * 1.4426950408889634f;
        __syncthreads();
        const size_t qrow = (size_t)b * SEQ + r0 * 64;
        NaHook hook{tab, r0, kr0};
        att::attn_unit<8, NaHook>(P + qrow * DIN + A_Q + h * 64, P + A_K + h * 64, P + A_V + h * 64, NLAT + b * CTXL, 4, b * SEQ + kr0 * 64, 4 + nr,
                                  MIX + qrow * DM + h * 64, hook, shm, wv);
    }
    if (layer == 0 && c < 96) {
        if (c < 32) {
            const int b = c >> 2, h = c & 3; const size_t qrow = (size_t)NLAT + b * CTXL;
            att::attn_unit<8, NoHook>(P + qrow * DIN + A_Q + h * 64, P + A_K + h * 64, P + A_V + h * 64, NLAT + b * CTXL, 4, 0, 4, MIX + qrow * DM + h * 64, NoHook{}, shm, wv);
        } else {
            const int cc = c - 32, b = cc >> 3, hq = cc & 7, kvh = hq >> 2; const size_t qrow = (size_t)NLAT + b * CTXL;
            att::attn_unit<8, NoHook>(P + qrow * DIN + B_Q + hq * 64, P + B_K + kvh * 64, P + B_V + kvh * 64, NLAT + b * CTXL, 4, 0, 4, MIX + qrow * DM + 256 + hq * 64, NoHook{}, shm, wv);
        }
    }
}


namespace pg8 {
struct InProjOrder {
    int G, c, nctx; bool trim;
    __device__ __forceinline__ void init(int G_, int c_, bool trim_) { G = G_; c = c_; trim = trim_; nctx = 8 * (trim_ ? 6 : 11); }
    __device__ __forceinline__ bool next(int i, Unit& u) const {
        constexpr int nM = NLAT / BM, nN = DIN / BM, nwg = nM * nN;
        const int L = i * G + c;
        if (L >= nwg + nctx) return false;
        const int wl = (L % NXCD) * (nwg / NXCD) + L / NXCD;
        const int nig = WGM * nN, gid = wl / nig, fm = gid * WGM;
        const int pm_l = fm + ((wl % nig) % WGM), pn_l = (wl % nig) / WGM;
        const int k = L - nwg, t = k >> 3;
        const int pm_c = 64 + (k & 7), pn_c = trim ? (t + 1 + ((t >= 2) ? 2 : 0) + ((t >= 3) ? 1 : 0)) : t;
        const bool lat = L < nwg;
        u.pm = lat ? pm_l : pm_c; u.pn = lat ? pn_l : pn_c; u.aux = 0;
        return true;
    }
    __device__ __forceinline__ void a_ready(const Unit&) const {}
    __device__ __forceinline__ void done(const Unit&) const {}
};
}

#define XB_TMO      128
#define XB_XCNT(j)  (256  + 64 * (j))
#define XB_XSUB(j)  (1280 + 64 * (j))
#define XB_XGEN(j)  (2304 + 64 * (j))
#define XB_TOP      3328
#define XB_TOPGEN   3392
#define XCD_BAR_WORDS 3456
#define XB_SPIN_CAP (1u << 18)
constexpr int CW_BAR = 4096;
constexpr int LDS_XB = LDS_BYTES - 64;
__device__ __forceinline__ unsigned xb_ld(unsigned* p)              { return __hip_atomic_load(p, __ATOMIC_RELAXED, __HIP_MEMORY_SCOPE_AGENT); }
__device__ __forceinline__ unsigned xb_add(unsigned* p, unsigned v) { return __hip_atomic_fetch_add(p, v, __ATOMIC_RELAXED, __HIP_MEMORY_SCOPE_AGENT); }
__device__ __forceinline__ unsigned xb_xcc_id() { return (unsigned)__builtin_amdgcn_s_getreg((3 << 11) | 20) & 0xFu; }
#define XB_SPIN(cond, bar) do { unsigned _sp = 0; while (cond) { __builtin_amdgcn_s_sleep(1); \
    if ((++_sp & 255u) == 0u) { if (xb_ld(&(bar)[XB_TMO])) break; if (_sp > XB_SPIN_CAP) { atomicAdd(&(bar)[XB_TMO], 1u); break; } } } } while (0)
struct XcdBarrier { unsigned* bar; unsigned x; volatile LAS unsigned* st; };
__device__ __forceinline__ XcdBarrier xcd_barrier_post(unsigned* bar, volatile LAS unsigned* st, int wv) {
    XcdBarrier b; b.bar = bar; b.x = xb_xcc_id(); b.st = st;
    if (otid(wv) == 0) (void)xb_add(&bar[XB_XCNT(b.x)], 1u);
    return b;
}
__device__ __forceinline__ void xcd_barrier_complete(unsigned* bar, unsigned x, unsigned& nloc, unsigned& nx) {
    const unsigned G = gridDim.x * gridDim.y * gridDim.z;
    unsigned sum, cnt, mine, sp = 0u;
    for (;;) {
        sum = 0u; cnt = 0u; mine = 0u;
#pragma unroll
        for (unsigned j = 0; j < 16; ++j) { const unsigned c = xb_ld(&bar[XB_XCNT(j)]); sum += c; cnt += (c > 0u) ? 1u : 0u; mine = (j == x) ? c : mine; }
        if (sum == G) break;
        __builtin_amdgcn_s_sleep(1);
        if ((++sp & 255u) == 0u) { if (xb_ld(&bar[XB_TMO])) break; if (sp > XB_SPIN_CAP) { atomicAdd(&bar[XB_TMO], 1u); break; } }
    }
    nloc = mine > 0u ? mine : 1u; nx = cnt > 0u ? cnt : 1u;
}
__device__ __forceinline__ void xcd_barrier(const XcdBarrier& b, int wv) {
    asm volatile("s_waitcnt vmcnt(0)" ::: "memory");
    __syncthreads();
    if (otid(wv) == 0) {
        unsigned* bar = b.bar; unsigned bx = b.x; asm volatile("" : "+s"(bx));
        __builtin_amdgcn_s_waitcnt(0);
        unsigned nloc = b.st[0], nx = b.st[1];
        if (nloc == 0u) { xcd_barrier_complete(bar, bx, nloc, nx); b.st[0] = nloc; b.st[1] = nx; }
        const unsigned old = xb_add(&bar[XB_XSUB(bx)], 1u);
        const unsigned gen = old / nloc;
        if (old + 1u == (gen + 1u) * nloc) {
            __builtin_amdgcn_fence(__ATOMIC_RELEASE, "agent");
            asm volatile("s_waitcnt vmcnt(0)" ::: "memory");
            const unsigned og = xb_add(&bar[XB_TOP], 1u);
            const unsigned tg = og / nx;
            if (og + 1u == (tg + 1u) * nx) xb_add(&bar[XB_TOPGEN], 1u);
            else XB_SPIN(xb_ld(&bar[XB_TOPGEN]) == tg, bar);
            __builtin_amdgcn_fence(__ATOMIC_ACQUIRE, "agent");
            xb_add(&bar[XB_XGEN(bx)], 1u);
            asm volatile("s_waitcnt vmcnt(0)" ::: "memory");
        } else {
            XB_SPIN(xb_ld(&bar[XB_XGEN(bx)]) == gen, bar);
            __builtin_amdgcn_fence(__ATOMIC_ACQUIRE, "agent");
            asm volatile("s_waitcnt vmcnt(0)" ::: "memory");
        }
    }
    __syncthreads();
}

__global__ void __launch_bounds__(NT, 2) k_mega(Ptrs p) {
    extern __shared__ __attribute__((aligned(16))) unsigned char lds_raw[];
    LAS unsigned char* lds = (LAS unsigned char*)lds_raw;
    cg::grid_group grid = cg::this_grid();
    const int wv = __builtin_amdgcn_readfirstlane(threadIdx.x >> 6);
#define CG_SYNC() do { asm volatile("s_waitcnt vmcnt(0)" ::: "memory"); grid.sync(); __builtin_amdgcn_fence(__ATOMIC_ACQUIRE, "agent"); asm volatile("s_waitcnt vmcnt(0)" ::: "memory"); } while (0)
#define GRID_SYNC() xcd_barrier(xbar, wv)
    if (otid(wv) < 16) ((LAS unsigned*)(lds + LDS_XB))[otid(wv)] = 0u;
    __syncthreads();
    const XcdBarrier xbar = xcd_barrier_post((unsigned*)(p.ws + WS_CTL) + CW_BAR, (volatile LAS unsigned*)(lds + LDS_XB), wv);
    const int NGW = gridDim.x * NWAVES;
    phase_mod(p, lds, wv);
    phase_lb(p, wv);
    __syncthreads();
    phase_convert(p, lds, 0, 2, wv);
    phase_router_w(p, wv);
    if (p.pad != 0) CG_SYNC();
    GRID_SYNC();
    phase_gs2(p, wv);
    phase_norm(p.in[I_X], p.in[I_CTX], p.in[I_N1G], (const float*)(p.ws + WS_MOD), 0, 1, (bf16*)(p.ws + WS_H), MROWS, wv);
    GRID_SYNC();
    for (int layer = 0; layer < 2; ++layer) {
        const int M = (layer == 0) ? MROWS : NLAT;
        const float* modl = (const float*)(p.ws + WS_MOD) + (size_t)layer * 9 * MODW;
        {
            pg8::Gemm g{(const bf16*)(p.ws + WS_H), (const bf16*)(p.ws + WS_WIN + layer * WIN_STRIDE), MROWS, DIN, DM};
            pg8::InProjOrder S; S.init(gridDim.x, (int)blockIdx.x, layer == 1);
            pg8::EpiInProj E{(bf16*)(p.ws + WS_P), p.in[I_NAQN] + layer * 64, p.in[I_NAKN] + layer * 64, p.in[I_GQQN] + layer * 64, p.in[I_GQKN] + layer * 64, wv};
            pg8::gemm_phase<pg8::EpiInProj, pg8::InProjOrder, true, true>(lds, g, S, E, wv);
        }
        GRID_SYNC();
        phase_hgrn1(p, lds, layer, wv);
        GRID_SYNC();
        phase_hgrn_scan(p, wv);
        GRID_SYNC();
        phase_hgrn2(p, lds, layer, wv);
        __syncthreads();
        phase_attn(p, lds_raw, layer, wv);
        GRID_SYNC();
        {
            pg8::Gemm g{(const bf16*)(p.ws + WS_MIX), (const bf16*)(p.ws + WS_WOUT + layer * WOUT_STRIDE), M, DM, DM};
            pg8::StaticOrder S; S.init(M, DM, gridDim.x, (int)blockIdx.x);
            pg8::EpiResidSS E{layer == 0 ? p.in[I_X] : p.out, p.in[I_CTX], p.out, (float*)(p.ws + WS_XC), modl, 2, (float*)(p.ws + WS_RSS), wv};
            pg8::gemm_phase<pg8::EpiResidSS, pg8::StaticOrder, true, true>(lds, g, S, E, wv);
        }
        GRID_SYNC();
        phase_route(p, lds, layer, M, wv);
        GRID_SYNC();
        phase_moe_gu(p, lds, layer, wv);
        GRID_SYNC();
        phase_moe_down(p, lds, layer, wv);
        GRID_SYNC();
        phase_combine(p, layer, M, layer == 0, wv);
        if (layer == 0) GRID_SYNC();
    }
}

extern "C" void kernel_launch(void* const* d_in, const int* in_sizes, int n_in, void* d_out, int out_size, void* d_ws, size_t ws_size, hipStream_t stream) {
    static int grid = 0;
    if (grid == 0) {
        if (n_in != 24 || ws_size < WS_END) { fprintf(stderr, "kernel_launch: bad n_in %d or ws_size %zu < %zu\n", n_in, ws_size, (size_t)WS_END); grid = -1; return; }
        int dev = 0, cus = 0, per_cu = 0;
        hipGetDevice(&dev); hipDeviceGetAttribute(&cus, hipDeviceAttributeMultiprocessorCount, dev);
        hipFuncSetAttribute((const void*)k_mega, hipFuncAttributeMaxDynamicSharedMemorySize, LDS_BYTES);
        hipOccupancyMaxActiveBlocksPerMultiprocessor(&per_cu, (const void*)k_mega, NT, LDS_BYTES);
        if (per_cu < 1) { fprintf(stderr, "kernel_launch: occupancy query says %d blocks/CU\n", per_cu); grid = -1; return; }
        grid = cus;
        (void)hipGetLastError();
    }
    if (grid < 0) return;
    Ptrs p{};
    for (int i = 0; i < 24; ++i) p.in[i] = (const float*)d_in[i];
    p.out = (float*)d_out; p.ws = (unsigned char*)d_ws; p.layer = 0; p.pad = 0;
    hipMemsetAsync((unsigned char*)d_ws + WS_CTL, 0, 1 * MiB, stream);
    void* args[] = {&p};
    hipError_t e = hipLaunchCooperativeKernel((const void*)k_mega, dim3(grid), dim3(NT), args, LDS_BYTES, stream);
    if (e != hipSuccess) fprintf(stderr, "cooperative launch failed: %s\n", hipGetErrorString(e));
}
```

```cpp
#include <hip/hip_runtime.h>
#include <hip/hip_cooperative_groups.h>
#include <cstdio>
#include <cstdint>
#include <math.h>
namespace cg = cooperative_groups;

#define DM 1024
#define SEQ 2048
#define CTXL 256
#define NBATCH 8
#define NLAT (NBATCH * SEQ)
#define NCTX (NBATCH * CTXL)
#define MROWS (NLAT + NCTX)
#define DIN 2816
#define NMOD 6
#define MODW (NMOD * DM)
#define A_Q 0
#define A_K 256
#define A_V 512
#define B_Q 768
#define B_K 1280
#define B_V 1408
#define C_Q 1536
#define C_I 1792
#define C_FF 2048
#define C_FB 2304
#define C_G 2560

typedef unsigned short bf16;
#define LAS __attribute__((address_space(3)))
#define GAS __attribute__((address_space(1)))
typedef unsigned v4u __attribute__((ext_vector_type(4)));
typedef unsigned v2u __attribute__((ext_vector_type(2)));
typedef float v4f __attribute__((ext_vector_type(4)));

__device__ __forceinline__ unsigned f2bf(float f) { unsigned u = __builtin_bit_cast(unsigned, f); return (u + 0x7fffu + ((u >> 16) & 1u)) >> 16; }
__device__ __forceinline__ unsigned pk2(float lo, float hi) { return f2bf(lo) | (f2bf(hi) << 16); }
__device__ __forceinline__ float bf2f(unsigned short v) { return __builtin_bit_cast(float, (unsigned)v << 16); }
__device__ __forceinline__ float bflo(unsigned v) { return __builtin_bit_cast(float, v << 16); }
__device__ __forceinline__ float bfhi(unsigned v) { return __builtin_bit_cast(float, v & 0xffff0000u); }
__device__ __forceinline__ float silu_f(float x) { return x / (1.f + __expf(-x)); }
__device__ __forceinline__ float shx(float v, int mask, int lane) { return __builtin_bit_cast(float, __builtin_amdgcn_ds_bpermute((lane ^ mask) << 2, __builtin_bit_cast(int, v))); }
__device__ __forceinline__ float wave_sum(float v, int lane) {
#pragma unroll
    for (int o = 1; o < 64; o <<= 1) v += shx(v, o, lane);
    return v;
}
__device__ __forceinline__ int otid(int wv) { unsigned m = ~0u; asm volatile("" : "+s"(m)); asm volatile("" : "+s"(wv)); return wv * 64 + (int)__builtin_amdgcn_mbcnt_hi(m, __builtin_amdgcn_mbcnt_lo(m, 0u)); }
#define LDS_WAIT() asm volatile("s_waitcnt lgkmcnt(0)" ::: "memory")

constexpr size_t MiB = 1u << 20;
constexpr size_t WS_CTL = 0;
constexpr size_t WS_MOD = 1 * MiB;
constexpr size_t WS_LB = 1 * MiB + 512 * 1024;
constexpr size_t WS_EID = 2 * MiB;
constexpr size_t WS_EW = 2 * MiB + 256 * 1024;
constexpr size_t WS_IDX = 3 * MiB;
constexpr size_t WS_XC = 8 * MiB;
constexpr size_t WS_WIN = 16 * MiB;
constexpr size_t WIN_STRIDE = (size_t)DIN * DM * 2;
constexpr size_t WS_WOUT = 28 * MiB;
constexpr size_t WOUT_STRIDE = 2 * MiB;
constexpr size_t WS_WGU = 32 * MiB;
constexpr size_t WGU_STRIDE = 32 * MiB;
constexpr size_t WS_WD = 96 * MiB;
constexpr size_t WD_STRIDE = 16 * MiB;
constexpr size_t WS_H = 128 * MiB;
constexpr size_t WS_MIX = 164 * MiB;
constexpr size_t WS_P = 200 * MiB;
constexpr size_t WS_Y0 = 200 * MiB;
constexpr size_t WS_Y1 = 236 * MiB;
constexpr size_t WS_HID = 272 * MiB;
constexpr size_t WS_SCR = 300 * MiB;
constexpr size_t WS_END = 340 * MiB;

constexpr int NT = 512, NWAVES = 8;
constexpr int LDS_BYTES = 147456;
namespace pg8 {
#define PG8_LAS __attribute__((address_space(3)))
typedef unsigned short bf16_t;
typedef short bf16x8 __attribute__((ext_vector_type(8)));
typedef float f32x4 __attribute__((ext_vector_type(4)));
typedef unsigned u32x4 __attribute__((ext_vector_type(4)));
constexpr int BM = 256, BK = 64, HALF = 128, HTB = HALF * BK * 2  , STAGE_BYTES = 8 * HTB, NXCD = 8, WGM = 8;

__host__ __device__ __forceinline__ int lds_byte(int r, int c) { const int st = (r >> 4) * 2 + (c >> 5), rr = r & 15, cc = c & 31, ob = rr * 64 + cc * 2; return st * 1024 + (ob ^ (((ob >> 9) & 1) << 5)); }
__host__ __device__ __forceinline__ void stage_rc(int b, int& R, int& C) { const int st = b / 1024, sb = b % 1024, swz = sb ^ (((sb >> 9) & 1) << 5); R = (st >> 1) * 16 + swz / 64; C = (st & 1) * 32 + (swz % 64) / 2; }
__host__ __device__ __forceinline__ int perm32(int rho) { const int n = rho >> 4, i = rho & 15; return 8 * (i >> 2) + 4 * n + (i & 3); }

struct Unit { int pm, pn, aux; };
struct Gemm { const bf16_t* A; const bf16_t* Bt; int M, N, K; };

struct StaticOrder {
    int nM, nN, nwg, G, c;
    __host__ __device__ void init(int M, int N, int G_, int c_) { nM = M / BM; nN = N / BM; nwg = nM * nN; G = G_; c = c_; }
    __host__ __device__ bool next(int i, Unit& u) const {
        const long L = (long)i * G + c; if (L >= nwg) return false;
        int wgid = (int)L; { const int q = nwg / NXCD, r = nwg % NXCD, xcd = wgid % NXCD, off = wgid / NXCD; wgid = (xcd < r ? xcd * (q + 1) : r * (q + 1) + (xcd - r) * q) + off; }
        const int nig = WGM * nN, gid = wgid / nig, fm = gid * WGM, gsz = (nM - fm) < WGM ? (nM - fm) : WGM;
        u.pm = fm + ((wgid % nig) % gsz); u.pn = (wgid % nig) / gsz; return true;
    }
    __device__ __forceinline__ void a_ready(const Unit&) const {}
    __device__ __forceinline__ void done(const Unit&) const {}
};

__device__ __forceinline__ unsigned cvt_pk_bf16(float lo, float hi) { unsigned r; asm volatile("v_cvt_pk_bf16_f32 %0, %1, %2" : "=v"(r) : "v"(lo), "v"(hi)); return r; }
typedef float f32x2 __attribute__((ext_vector_type(2)));
__device__ __forceinline__ f32x2 gelu_pk(f32x2 v) {
    const f32x2 av = __builtin_elementwise_abs(v), d = av * 0.2316418882f + 1.0f;
    f32x2 t; t.x = __builtin_amdgcn_rcpf(d.x); t.y = __builtin_amdgcn_rcpf(d.y);
    f32x2 q = t * 0.5307027145f + (-0.7265760135f); q = q * t + 0.7107068705f; q = q * t + (-0.142248368f); q = q * t + 0.127414796f; q = q * t;
    const f32x2 s = (v * v) * (-0.72134752044f);
    f32x2 e; e.x = __builtin_amdgcn_exp2f(s.x); e.y = __builtin_amdgcn_exp2f(s.y);
    const f32x2 m = v * (q * e), r = v - m;
    f32x2 o; o.x = v.x < 0.f ? m.x : r.x; o.y = v.y < 0.f ? m.y : r.y; return o;
}

template <int ACT  > struct EpiBf16 {
    static constexpr bool PERM = true, AFTER_DRAIN = false; static_assert(ACT == 0 || ACT == 1, "EpiBf16: ACT is 0 (none) or 1 (gelu_pk)");
    bf16_t* O; int ldc; const float* bias; int split_cols; size_t split_stride; float scale0;
    __device__ __forceinline__ void operator()(const f32x4 (&acc)[2][2][4][2], const Unit& u, int wr, int wc, int fr, int fq) const {
        const int row0 = u.pm * BM + wr * 64 + fr; int colt = u.pn * BM; bf16_t* base = O;
        float sc = 1.f; if (split_cols) { const int t = colt / split_cols; base += (size_t)t * split_stride; colt -= t * split_cols; if (t == 0) sc = scale0; }
        const int col0 = colt + wc * 32 + 8 * fq, bcol0 = u.pn * BM + wc * 32 + 8 * fq;
        f32x4 bv[2][2];
#pragma unroll
        for (int bj = 0; bj < 2; ++bj)
#pragma unroll
            for (int n = 0; n < 2; ++n) bv[bj][n] = bias ? *(const f32x4*)(bias + bcol0 + bj * HALF + 4 * n) : (f32x4){0.f, 0.f, 0.f, 0.f};
#pragma unroll
        for (int ai = 0; ai < 2; ++ai)
#pragma unroll
            for (int m = 0; m < 4; ++m) { bf16_t* rowp = base + (size_t)(row0 + ai * HALF + m * 16) * ldc + col0;
#pragma unroll
                for (int bj = 0; bj < 2; ++bj) { f32x4 v0 = acc[ai][bj][m][0] + bv[bj][0], v1 = acc[ai][bj][m][1] + bv[bj][1];
                    if (ACT == 1) { f32x2 a = gelu_pk((f32x2){v0[0], v0[1]}), b = gelu_pk((f32x2){v0[2], v0[3]}), c = gelu_pk((f32x2){v1[0], v1[1]}), d = gelu_pk((f32x2){v1[2], v1[3]});
                        v0 = (f32x4){a.x, a.y, b.x, b.y}; v1 = (f32x4){c.x, c.y, d.x, d.y}; }
                    v0 = v0 * sc; v1 = v1 * sc; u32x4 w; w.x = cvt_pk_bf16(v0[0], v0[1]); w.y = cvt_pk_bf16(v0[2], v0[3]); w.z = cvt_pk_bf16(v1[0], v1[1]); w.w = cvt_pk_bf16(v1[2], v1[3]);
                    *(u32x4*)(rowp + bj * HALF) = w; } }
    }
};

template <class Epi, class Sched, bool ALIGN_EPI = false, bool SP2 = false, bool GATHER = false>
__device__ __forceinline__ void gemm_phase(PG8_LAS unsigned char* lds, const Gemm g, const Sched& S, const Epi& E, int wv, const PG8_LAS int* gidx = nullptr) {
    static_assert(SP2 || !GATHER, "GATHER is wired into the SP2 loop only");
    int tid_ = otid(wv);
    const int tid = tid_, wid = __builtin_amdgcn_readfirstlane(tid >> 6), lane = tid & 63, wr = wid >> 2, wc = wid & 3, fr = lane & 15, fq = lane >> 4;
    const int K = g.K, nt = K / BK;
    unsigned voffA[2][2], nvoffA[2][2], voffB[2]; int RA[2], CA[2];
#pragma unroll
    for (int i = 0; i < 2; ++i) { int R, C; stage_rc(tid * 16 + i * 8192, R, C); const int Rb = Epi::PERM ? ((R & ~31) + perm32(R & 31)) : R; RA[i] = R; CA[i] = C;
        voffA[0][i] = voffA[1][i] = nvoffA[0][i] = nvoffA[1][i] = (unsigned)(R * K + C) * 2u; voffB[i] = (unsigned)(Rb * K + C) * 2u; }
#define PG8_GVOFF(dst, uidx) do { if constexpr (GATHER) { _Pragma("unroll") for (int _h = 0; _h < 2; ++_h) _Pragma("unroll") for (int _i = 0; _i < 2; ++_i) dst[_h][_i] = (unsigned)(gidx[(uidx) * 256 + _h * 128 + RA[_i]] * K + CA[_i]) * 2u; } } while (0)
    const size_t kstep = (size_t)(BK * 2);
    const size_t hstep = (size_t)HALF * K * 2;
    const size_t hstepA = GATHER ? (size_t)0 : hstep;
    const size_t tstep = 2 * hstep;
    const unsigned ldsw = (unsigned)wid * 1024u;
    const int aoff = lds_byte(wr * 64 + fr, fq * 8), boff = lds_byte(wc * 32 + fr, fq * 8);
#define PG8_SA(b, h) (((b) * 2 + (h)) * HTB)
#define PG8_SB(b, h) ((4 + (b) * 2 + (h)) * HTB)
#define PG8_STAGE(bufoff, gbase, voff) do { _Pragma("unroll") for (int _i = 0; _i < 2; ++_i) \
        __builtin_amdgcn_global_load_lds((const unsigned*)((const char*)(gbase) + (voff)[_i]), (PG8_LAS unsigned*)(lds + (bufoff) + ldsw + _i * 8192), 16, 0, 0); } while (0)
#define PG8_LDA(dst, b, h) do { _Pragma("unroll") for (int m = 0; m < 4; ++m) _Pragma("unroll") for (int k = 0; k < 2; ++k) dst[m][k] = *(const PG8_LAS bf16x8*)(lds + PG8_SA(b, h) + aoff + m * 2048 + k * 1024); } while (0)
#define PG8_LDB(dst, b, h) do { _Pragma("unroll") for (int n = 0; n < 2; ++n) _Pragma("unroll") for (int k = 0; k < 2; ++k) dst[n][k] = *(const PG8_LAS bf16x8*)(lds + PG8_SB(b, h) + boff + n * 2048 + k * 1024); } while (0)
#define PG8_MMA(ai, bj, At, Bt) do { __builtin_amdgcn_s_setprio(1); _Pragma("unroll") for (int m = 0; m < 4; ++m) _Pragma("unroll") for (int n = 0; n < 2; ++n) _Pragma("unroll") for (int k = 0; k < 2; ++k) \
        acc[ai][bj][m][n] = __builtin_amdgcn_mfma_f32_16x16x32_bf16(Bt[n][k], At[m][k], acc[ai][bj][m][n], 0, 0, 0); __builtin_amdgcn_s_setprio(0); } while (0)
#define PG8_WAIT_V(n) asm volatile("s_waitcnt vmcnt(" #n ")" ::: "memory")
#define PG8_WAIT_L(n) asm volatile("s_waitcnt lgkmcnt(" #n ")" ::: "memory")
#define PG8_BAR __builtin_amdgcn_s_barrier()
#define PG8_SCHED __builtin_amdgcn_sched_barrier(0)
    Unit cur, nxt; int ui = 0;
    if (!S.next(0, cur)) return;
    f32x4 acc[2][2][4][2];
#pragma unroll
    for (int a = 0; a < 2; ++a)
#pragma unroll
        for (int b = 0; b < 2; ++b)
#pragma unroll
            for (int m = 0; m < 4; ++m)
#pragma unroll
                for (int n = 0; n < 2; ++n) acc[a][b][m][n] = (f32x4){0.f, 0.f, 0.f, 0.f};
    bf16x8 At[4][2], B0[2][2], B1[2][2];
    const char* cA = (const char*)g.A + (GATHER ? (size_t)0 : (size_t)cur.pm * tstep); PG8_GVOFF(voffA, 0); const char* cB = (const char*)g.Bt + (size_t)cur.pn * tstep;
    S.a_ready(cur);
    if constexpr (SP2) {
        PG8_STAGE(PG8_SB(0, 0), cB, voffB); PG8_STAGE(PG8_SB(0, 1), cB + hstep, voffB); PG8_STAGE(PG8_SA(0, 0), cA, voffA[0]); PG8_STAGE(PG8_SA(0, 1), cA + hstepA, voffA[1]);
        if (wr == 1) PG8_BAR;
        PG8_WAIT_V(2); PG8_BAR;
        PG8_STAGE(PG8_SB(1, 0), cB + kstep, voffB); PG8_STAGE(PG8_SA(1, 0), cA + kstep, voffA[0]); PG8_STAGE(PG8_SB(1, 1), cB + hstep + kstep, voffB);
        PG8_WAIT_V(6); PG8_BAR;
    } else {
        PG8_STAGE(PG8_SB(0, 0), cB, voffB); PG8_STAGE(PG8_SA(0, 0), cA, voffA[0]); PG8_STAGE(PG8_SB(0, 1), cB + hstep, voffB); PG8_STAGE(PG8_SA(0, 1), cA + hstep, voffA[0]);
        if (wr == 1) PG8_BAR;
        PG8_WAIT_V(4); PG8_BAR;
        PG8_STAGE(PG8_SB(1, 0), cB + kstep, voffB); PG8_STAGE(PG8_SA(1, 0), cA + kstep, voffA[0]); PG8_STAGE(PG8_SB(1, 1), cB + hstep + kstep, voffB);
        PG8_WAIT_V(6); PG8_BAR;
    }
    for (;;) {
        const bool has_next = S.next(ui + 1, nxt);
        const char* nA = (has_next && !GATHER) ? (const char*)g.A + (size_t)nxt.pm * tstep : cA; if (has_next) PG8_GVOFF(nvoffA, ui + 1); const char* nB = has_next ? (const char*)g.Bt + (size_t)nxt.pn * tstep : cB;
        for (int t = 0; t < nt; t += 2) {
            const bool last = (t == nt - 2);
            const char* a1 = cA + (size_t)(t + 1) * kstep;
            const char* a2 = last ? nA : cA + (size_t)(t + 2) * kstep; const char* b2 = last ? nB : cB + (size_t)(t + 2) * kstep;
            const char* a3 = a2 + kstep; const char* b3 = b2 + kstep;
            if (last && has_next) S.a_ready(nxt);
            unsigned vs2[2][2];
#pragma unroll
            for (int _h = 0; _h < 2; ++_h)
#pragma unroll
                for (int _i = 0; _i < 2; ++_i) vs2[_h][_i] = last ? nvoffA[_h][_i] : voffA[_h][_i];
            if constexpr (SP2) {
            PG8_LDB(B0, 0, 0); PG8_LDB(B1, 0, 1); PG8_SCHED; PG8_LDA(At, 0, 0); PG8_STAGE(PG8_SA(1, 1), a1 + hstepA, voffA[1]);
            PG8_WAIT_V(8); PG8_WAIT_L(0); PG8_BAR; PG8_MMA(0, 0, At, B0); PG8_MMA(0, 1, At, B1); PG8_BAR; PG8_SCHED;
            PG8_LDA(At, 0, 1); PG8_STAGE(PG8_SB(0, 0), b2, voffB); PG8_STAGE(PG8_SB(0, 1), b2 + hstep, voffB); PG8_STAGE(PG8_SA(0, 0), a2, vs2[0]);
            PG8_WAIT_V(8); PG8_WAIT_L(0); PG8_BAR; PG8_MMA(1, 0, At, B0); PG8_MMA(1, 1, At, B1); PG8_BAR; PG8_SCHED;
            PG8_LDB(B0, 1, 0); PG8_LDB(B1, 1, 1); PG8_SCHED; PG8_LDA(At, 1, 0); PG8_STAGE(PG8_SA(0, 1), a2 + hstepA, vs2[1]);
            PG8_WAIT_V(8); PG8_WAIT_L(0); PG8_BAR; PG8_MMA(0, 0, At, B0); PG8_MMA(0, 1, At, B1); PG8_BAR; PG8_SCHED;
            PG8_LDA(At, 1, 1); PG8_STAGE(PG8_SB(1, 0), b3, voffB); PG8_STAGE(PG8_SB(1, 1), b3 + hstep, voffB); PG8_STAGE(PG8_SA(1, 0), a3, vs2[0]);
            PG8_WAIT_V(8); PG8_WAIT_L(0); PG8_BAR; PG8_MMA(1, 0, At, B0); PG8_MMA(1, 1, At, B1); PG8_BAR; PG8_SCHED;
            } else {
            PG8_LDB(B0, 0, 0); PG8_SCHED; PG8_LDA(At, 0, 0); PG8_STAGE(PG8_SA(1, 1), a1 + hstep, voffA[0]);
            PG8_WAIT_L(8); PG8_BAR; PG8_WAIT_L(0); PG8_MMA(0, 0, At, B0); PG8_BAR; PG8_SCHED;
            PG8_LDB(B1, 0, 1); PG8_STAGE(PG8_SB(0, 0), b2, voffB);
            PG8_BAR; PG8_WAIT_L(0); PG8_MMA(0, 1, At, B1); PG8_BAR;
            PG8_LDA(At, 0, 1); PG8_STAGE(PG8_SA(0, 0), a2, voffA[0]);
            PG8_BAR; PG8_WAIT_L(0); PG8_MMA(1, 0, At, B0); PG8_BAR; PG8_SCHED;
            PG8_STAGE(PG8_SB(0, 1), b2 + hstep, voffB);
            PG8_WAIT_V(6); PG8_BAR; PG8_MMA(1, 1, At, B1); PG8_BAR;
            PG8_LDB(B0, 1, 0); PG8_SCHED; PG8_LDA(At, 1, 0); PG8_STAGE(PG8_SA(0, 1), a2 + hstep, voffA[0]);
            PG8_WAIT_L(8); PG8_BAR; PG8_WAIT_L(0); PG8_MMA(0, 0, At, B0); PG8_BAR; PG8_SCHED;
            PG8_LDB(B1, 1, 1); PG8_STAGE(PG8_SB(1, 0), b3, voffB);
            PG8_BAR; PG8_WAIT_L(0); PG8_MMA(0, 1, At, B1); PG8_BAR;
            PG8_LDA(At, 1, 1); PG8_STAGE(PG8_SA(1, 0), a3, voffA[0]);
            PG8_BAR; PG8_WAIT_L(0); PG8_MMA(1, 0, At, B0); PG8_BAR; PG8_SCHED;
            PG8_STAGE(PG8_SB(1, 1), b3 + hstep, voffB);
            PG8_WAIT_V(6); PG8_BAR; PG8_MMA(1, 1, At, B1); PG8_BAR;
            }
        }
        if constexpr (ALIGN_EPI) { if (wr == 0) PG8_BAR; }
        if constexpr (!Epi::AFTER_DRAIN) { E(acc, cur, wr, wc, fr, fq); S.done(cur); }
        if (!has_next) break;
#pragma unroll
        for (int a = 0; a < 2; ++a)
#pragma unroll
            for (int b = 0; b < 2; ++b)
#pragma unroll
                for (int m = 0; m < 4; ++m)
#pragma unroll
                    for (int n = 0; n < 2; ++n) acc[a][b][m][n] = (f32x4){0.f, 0.f, 0.f, 0.f};
        cur = nxt; cA = nA; cB = nB; ++ui;
#pragma unroll
        for (int _h = 0; _h < 2; ++_h)
#pragma unroll
            for (int _i = 0; _i < 2; ++_i) voffA[_h][_i] = nvoffA[_h][_i];
        if constexpr (ALIGN_EPI) { if (wr == 1) PG8_BAR; }
    }
    PG8_WAIT_V(0);
    if constexpr (!ALIGN_EPI) { if (wr == 0) PG8_BAR; }
    PG8_BAR;
    if constexpr (Epi::AFTER_DRAIN) { E.fused(acc, cur, wr, wc, fr, fq, lds, wid, lane); S.done(cur); }
#undef PG8_SA
#undef PG8_GVOFF
#undef PG8_SB
#undef PG8_STAGE
#undef PG8_LDA
#undef PG8_LDB
#undef PG8_MMA
#undef PG8_WAIT_V
#undef PG8_WAIT_L
#undef PG8_BAR
#undef PG8_SCHED
}
}


struct Ptrs { const float* in[24]; float* out; unsigned char* ws; int layer; int pad; };
enum { I_X = 0, I_C, I_CTX, I_CCTX, I_WADA, I_BADA, I_N1G, I_WIN, I_NAQN, I_NAKN, I_RPB, I_GQQN, I_GQKN, I_LB, I_HGON, I_WOUT, I_N2G, I_WRG, I_BRG, I_WRE, I_BRE, I_WEG, I_WEU, I_WED };

namespace pg8 {
struct EpiResid {
    static constexpr bool PERM = false, AFTER_DRAIN = false;
    const float* xin_lat; const float* xin_ctx; float* xout_lat; float* xout_ctx; const float* modl; int chunk;
    __device__ __forceinline__ void operator()(const f32x4 (&acc)[2][2][4][2], const Unit& u, int wr, int wc, int fr, int fq) const {
        const int rowt = u.pm * BM; const bool isctx = rowt >= NLAT;
        const float* xin = isctx ? xin_ctx + (size_t)(rowt - NLAT) * DM : xin_lat + (size_t)rowt * DM;
        float* xo = isctx ? xout_ctx + (size_t)(rowt - NLAT) * DM : xout_lat + (size_t)rowt * DM;
        const int mrow = isctx ? 8 : (rowt >> 11);
        const float* gate = modl + (size_t)mrow * MODW + chunk * DM;
        const int col0 = u.pn * BM + wc * 32 + 4 * fq;
#pragma unroll
        for (int bj = 0; bj < 2; ++bj)
#pragma unroll
            for (int n = 0; n < 2; ++n) {
                const int col = col0 + bj * HALF + n * 16;
                const f32x4 gv = *(const f32x4*)(gate + col);
#pragma unroll
                for (int ai = 0; ai < 2; ++ai)
#pragma unroll
                    for (int m = 0; m < 4; ++m) {
                        const size_t off = (size_t)(ai * HALF + wr * 64 + m * 16 + fr) * DM + col;
                        const f32x4 xi = *(const f32x4*)(xin + off);
                        *(f32x4*)(xo + off) = xi + gv * acc[ai][bj][m][n];
                    }
            }
    }
};
}

__device__ __forceinline__ void phase_mod(const Ptrs& p, LAS unsigned char* lds, int wv) {
    if (blockIdx.x >= 192) return;
    LAS float* sc = (LAS float*)lds;
    LAS float* red = (LAS float*)(lds + 36864);
    const int tid = otid(wv);
    const float* c = p.in[I_C]; const float* cc = p.in[I_CCTX];
    for (int i = tid; i < 9 * DM; i += NT) { float v = (i < 8 * DM) ? c[i] : cc[i - 8 * DM]; sc[i] = silu_f(v); }
    __syncthreads();
    float* mod = (float*)(p.ws + WS_MOD);
    for (int u = blockIdx.x; u < 192; u += gridDim.x) {
        const int layer = u / 96, cb = u % 96, cq = tid & 15, kg = tid >> 4;
        const float* w = p.in[I_WADA] + (size_t)layer * DM * MODW + cb * 64 + cq * 4;
        v4f acc[9];
#pragma unroll
        for (int r = 0; r < 9; ++r) acc[r] = (v4f){0.f, 0.f, 0.f, 0.f};
        for (int i = 0; i < 32; ++i) {
            const int k = kg + 32 * i;
            const v4f wv = *(const v4f*)(w + (size_t)k * MODW);
#pragma unroll
            for (int r = 0; r < 9; ++r) acc[r] += sc[r * DM + k] * wv;
        }
#pragma unroll
        for (int r = 0; r < 9; ++r) *(LAS v4f*)(red + (kg * 9 + r) * 64 + cq * 4) = acc[r];
        __syncthreads();
        for (int o = tid; o < 576; o += NT) {
            const int r = o >> 6, c2 = o & 63; float s = 0.f;
            for (int k2 = 0; k2 < 32; ++k2) s += red[(k2 * 9 + r) * 64 + c2];
            mod[((size_t)layer * 9 + r) * MODW + cb * 64 + c2] = s + p.in[I_BADA][layer * MODW + cb * 64 + c2];
        }
        __syncthreads();
    }
}
__device__ __forceinline__ void phase_lb(const Ptrs& p, int wv) {
    if (blockIdx.x == 255 % gridDim.x) {
        const int i = otid(wv);
        const float* raw = p.in[I_LB]; float* lb = (float*)(p.ws + WS_LB);
        float l0 = raw[i], l1 = raw[512 + i];
        lb[i] = 0.f; lb[512 + i] = 1.f / (1.f + __expf(l0 - l1));
    }
}
__device__ __forceinline__ void transpose_item(const float* W, int K, int N, bf16* WT, int row_off, LAS float* scr, int item, int lane) {
    const int nblk = N / 32, kb = item / nblk, nb = item % nblk, k0 = 64 * kb, n0 = 32 * nb;
#pragma unroll 8
    for (int i = 0; i < 32; ++i) { const int kk = 2 * i + (lane >> 5); scr[kk * 33 + (lane & 31)] = W[(size_t)(k0 + kk) * N + n0 + (lane & 31)]; }
    LDS_WAIT(); asm volatile("" ::: "memory");
    const int c = lane & 7;
#pragma unroll
    for (int j = 0; j < 4; ++j) { const int n = (lane >> 3) + 8 * j; const LAS float* s = scr + (8 * c) * 33 + n;
        v4u o; o.x = pk2(s[0 * 33], s[1 * 33]); o.y = pk2(s[2 * 33], s[3 * 33]); o.z = pk2(s[4 * 33], s[5 * 33]); o.w = pk2(s[6 * 33], s[7 * 33]);
        *(v4u*)(WT + (size_t)(row_off + n0 + n) * K + k0 + 8 * c) = o; }
    LDS_WAIT(); asm volatile("" ::: "memory");
}
constexpr int CI_IN = 16 * 88, CI_OUT = 16 * 32, CI_G = 32 * 128, CI_U = 32 * 128, CI_D = 32 * 128, CI_LAYER = CI_IN + CI_OUT + CI_G + CI_U + CI_D;
__device__ __forceinline__ void phase_convert(const Ptrs& p, LAS unsigned char* lds, int layer_lo, int layer_hi, int wv, int gw, int NGW) {
    const int lane = otid(wv) & 63, wave = wv;
    LAS float* scr = (LAS float*)(lds + wave * 16384);
    const int n_items = (layer_hi - layer_lo) * CI_LAYER;
    for (int it = gw; it < n_items; it += NGW) {
        const int layer = layer_lo + it / CI_LAYER; int r = it % CI_LAYER;
        if (r < CI_IN) {
            const int n0 = 32 * (r % 88), pn_ = n0 >> 8, w_ = (n0 >> 6) & 3, bj_ = (n0 >> 5) & 1;
            transpose_item(p.in[I_WIN] + (size_t)layer * DM * DIN, DM, DIN, (bf16*)(p.ws + WS_WIN + layer * WIN_STRIDE), (256 * pn_ + 128 * bj_ + 32 * w_) - n0, scr, r, lane); continue; } r -= CI_IN;
        if (r < CI_OUT) { transpose_item(p.in[I_WOUT] + (size_t)layer * DM * DM, DM, DM, (bf16*)(p.ws + WS_WOUT + layer * WOUT_STRIDE), 0, scr, r, lane); continue; } r -= CI_OUT;
        if (r < CI_G + CI_U) {
            const int up = r >= CI_G; if (up) r -= CI_G;
            const int e = r >> 7, rem = r & 127, nb = rem & 7, n0 = 32 * nb;
            const int mapped = (n0 >> 7) * 256 + (n0 & 127) + (up ? 128 : 0);
            transpose_item(p.in[up ? I_WEU : I_WEG] + ((size_t)layer * 32 + e) * DM * 256, DM, 256, (bf16*)(p.ws + WS_WGU + layer * WGU_STRIDE) + (size_t)e * 512 * DM, mapped - n0, scr, rem, lane);
            continue;
        }
        r -= CI_G + CI_U;
        { const int e = r >> 7, rem = r & 127;
          transpose_item(p.in[I_WED] + ((size_t)layer * 32 + e) * 256 * DM, 256, DM, (bf16*)(p.ws + WS_WD + layer * WD_STRIDE) + (size_t)e * DM * 256, 0, scr, rem, lane); }
    }
}
__device__ __forceinline__ void phase_norm(const float* xlat, const float* xctx, const float* g, const float* modl, int ch_shift, int ch_scale, bf16* H, int nrows, int wv) {
    const int lane = otid(wv) & 63, wave = wv;
    const int gw = blockIdx.x * NWAVES + wave, NGW = gridDim.x * NWAVES;
    const int per = (nrows + NGW - 1) / NGW;
    const int r0 = gw * per, r1 = min(r0 + per, nrows);
    const unsigned lc = 4 * lane;
    int cur = -1; v4f gs[4], sh[4], xn[4];
    if (r0 < r1) { const float* xr = (r0 < NLAT) ? xlat + (size_t)r0 * DM : xctx + (size_t)(r0 - NLAT) * DM;
#pragma unroll
        for (int j = 0; j < 4; ++j) xn[j] = *(const v4f*)(xr + lc + 256 * j); }
    for (int r = r0; r < r1; ++r) {
        const int mrow = (r < NLAT) ? (r >> 11) : 8;
        if (mrow != cur) {
            cur = mrow; const float* m = modl + (size_t)mrow * MODW;
#pragma unroll
            for (int j = 0; j < 4; ++j) { const unsigned c = lc + 256 * j; const v4f gg = *(const v4f*)(g + c), sc = *(const v4f*)(m + ch_scale * DM + c);
                gs[j] = gg * (1.f + sc); sh[j] = *(const v4f*)(m + ch_shift * DM + c); }
        }
        v4f v[4]; float s = 0.f;
#pragma unroll
        for (int j = 0; j < 4; ++j) { v[j] = xn[j]; s += (v[j].x * v[j].x + v[j].y * v[j].y) + (v[j].z * v[j].z + v[j].w * v[j].w); }
        if (r + 1 < r1) { const float* xq = (r + 1 < NLAT) ? xlat + (size_t)(r + 1) * DM : xctx + (size_t)(r + 1 - NLAT) * DM;
#pragma unroll
            for (int j = 0; j < 4; ++j) xn[j] = *(const v4f*)(xq + lc + 256 * j); }
        const float rstd = rsqrtf(wave_sum(s, lane) * (1.f / DM) + 1e-6f);
        bf16* orow = H + (size_t)r * DM;
#pragma unroll
        for (int j = 0; j < 4; ++j) { const v4f o = v[j] * rstd * gs[j] + sh[j]; v2u w; w.x = pk2(o.x, o.y); w.y = pk2(o.z, o.w); *(v2u*)(orow + lc + 256 * j) = w; }
    }
}

constexpr size_t WS_RSS = 6 * MiB;
constexpr size_t WS_WR = 7 * MiB + 512 * 1024;
constexpr int CW_CNT = 1024;
constexpr int LDS_TTAB = 131072;
constexpr int LDS_GIDX = 131072 + 4096;
constexpr int LDS_RT = 131072;

namespace pg8 {
struct EpiResidSS {
    static constexpr bool PERM = false, AFTER_DRAIN = false;
    const float* xin_lat; const float* xin_ctx; float* xout_lat; float* xout_ctx; const float* modl; int chunk; float* rss; int wv;
    __device__ __forceinline__ void operator()(const f32x4 (&acc)[2][2][4][2], const Unit& u, int, int, int, int) const {
        const int l_ = otid(wv) & 63, fr = l_ & 15, fq = l_ >> 4, wr = wv >> 2, wc = wv & 3;
        const int rowt = u.pm * BM; const bool isctx = rowt >= NLAT;
        const float* xin = isctx ? xin_ctx + (size_t)(rowt - NLAT) * DM : xin_lat + (size_t)rowt * DM;
        float* xo = isctx ? xout_ctx + (size_t)(rowt - NLAT) * DM : xout_lat + (size_t)rowt * DM;
        const int mrow = isctx ? 8 : (rowt >> 11);
        const float* gate = modl + (size_t)mrow * MODW + chunk * DM;
        const int col0 = u.pn * BM + wc * 32 + 4 * fq;
        f32x4 gv[2][2];
#pragma unroll
        for (int bj = 0; bj < 2; ++bj)
#pragma unroll
            for (int n = 0; n < 2; ++n) gv[bj][n] = *(const f32x4*)(gate + col0 + bj * HALF + n * 16);
#pragma unroll
        for (int ai = 0; ai < 2; ++ai)
#pragma unroll
            for (int m = 0; m < 4; ++m) {
                const int rl = ai * HALF + wr * 64 + m * 16 + fr; float ss = 0.f;
#pragma unroll
                for (int bj = 0; bj < 2; ++bj)
#pragma unroll
                    for (int n = 0; n < 2; ++n) {
                        const size_t off = (size_t)rl * DM + col0 + bj * HALF + n * 16;
                        const f32x4 xi = *(const f32x4*)(xin + off);
                        const f32x4 o = xi + gv[bj][n] * acc[ai][bj][m][n];
                        *(f32x4*)(xo + off) = o;
                        ss += (o[0] * o[0] + o[1] * o[1]) + (o[2] * o[2] + o[3] * o[3]);
                    }
                ss += shx(ss, 16, l_); ss += shx(ss, 32, l_);
                if (fq == 0) rss[(size_t)(rowt + rl) * 16 + u.pn * 4 + wc] = ss;
            }
    }
};
struct EpiGU {
    static constexpr bool PERM = true, AFTER_DRAIN = false;
    bf16_t* HID; int wv;
    __device__ __forceinline__ void operator()(const f32x4 (&acc)[2][2][4][2], const Unit& u, int, int, int, int) const {
        const int l_ = otid(wv) & 63, fr = l_ & 15, fq = l_ >> 4, wr = wv >> 2, wc = wv & 3;
        const int pnl = u.pn & 1, row0 = u.pm * BM + wr * 64 + fr, col0 = pnl * 128 + wc * 32 + 8 * fq;
#pragma unroll
        for (int ai = 0; ai < 2; ++ai)
#pragma unroll
            for (int m = 0; m < 4; ++m) {
                bf16_t* rowp = HID + (size_t)(row0 + ai * HALF + m * 16) * 256 + col0;
                float hv[8];
#pragma unroll
                for (int n = 0; n < 2; ++n)
#pragma unroll
                    for (int i = 0; i < 4; ++i) { const float g = acc[ai][0][m][n][i], uu = acc[ai][1][m][n][i]; hv[n * 4 + i] = g / (1.f + __expf(-g)) * uu; }
                u32x4 w; w.x = cvt_pk_bf16(hv[0], hv[1]); w.y = cvt_pk_bf16(hv[2], hv[3]); w.z = cvt_pk_bf16(hv[4], hv[5]); w.w = cvt_pk_bf16(hv[6], hv[7]);
                *(u32x4*)rowp = w;
            }
    }
};
struct EpiDown {
    static constexpr bool PERM = true, AFTER_DRAIN = false;
    bf16_t* Y0; bf16_t* Y1; const PG8_LAS int* rowinfo; int wv;
    __device__ __forceinline__ void operator()(const f32x4 (&acc)[2][2][4][2], const Unit& u, int, int, int, int) const {
        const int l_ = otid(wv) & 63, fr_ = l_ & 15, fq = l_ >> 4, wr = wv >> 2, wc = wv & 3;
        const int col0 = (u.pn & 3) * BM + wc * 32 + 8 * fq;
        const PG8_LAS int* ri = rowinfo + (u.aux * 256 + wr * 64 + fr_) * 2;
#pragma unroll
        for (int ai = 0; ai < 2; ++ai)
#pragma unroll
            for (int m = 0; m < 4; ++m) {
                const int ent = ri[(ai * HALF + m * 16) * 2]; const float w = __builtin_bit_cast(float, ri[(ai * HALF + m * 16) * 2 + 1]);
                if (ent >= 0) {
                    bf16_t* rowp = Y0 + ((size_t)(ent & 1) * ((WS_Y1 - WS_Y0) / 2) + (size_t)(ent >> 1) * DM + col0);
#pragma unroll
                    for (int bj = 0; bj < 2; ++bj) {
                        const f32x4 v0 = acc[ai][bj][m][0] * w, v1 = acc[ai][bj][m][1] * w;
                        u32x4 o; o.x = cvt_pk_bf16(v0[0], v0[1]); o.y = cvt_pk_bf16(v0[2], v0[3]); o.z = cvt_pk_bf16(v1[0], v1[1]); o.w = cvt_pk_bf16(v1[2], v1[3]);
                        *(u32x4*)(rowp + bj * HALF) = o;
                    }
                }
                asm volatile("" ::: "memory");
            }
    }
};
struct MoeOrder {
    const PG8_LAS int* ttab; int ntile, npn, G, c;
    __device__ __forceinline__ bool next(int i, Unit& u) const {
        const int L = i * G + c; if (L >= ntile * npn) return false;
        const int t = L / npn, pl = L % npn; u.pm = t; u.pn = ttab[t * 4] * npn + pl; u.aux = i; return true;
    }
    __device__ __forceinline__ void a_ready(const Unit&) const {}
    __device__ __forceinline__ void done(const Unit&) const {}
};
}

__device__ __forceinline__ void phase_router_w(const Ptrs& p, int wv) {
    const int gt = blockIdx.x * NT + otid(wv), NG = gridDim.x * NT;
    for (int idx = gt; idx < 2 * 48 * DM; idx += NG) {
        const int layer = idx / (48 * DM), r = idx % (48 * DM), n = r >> 10, k = r & 1023;
        float w;
        if (n < 16) w = p.in[I_WRG][((size_t)layer * DM + k) * 4 + (n & 3)];
        else { const int g = ((n - 16) & 15) >> 2, i = n & 3, e = 8 * g + i + (n >= 32 ? 4 : 0); w = p.in[I_WRE][((size_t)layer * DM + k) * 32 + e]; }
        const unsigned hi = f2bf(w); const float lo = w - __builtin_bit_cast(float, hi << 16);
        bf16* base = (bf16*)(p.ws + WS_WR) + (size_t)layer * 2 * 48 * DM;
        base[r] = (bf16)hi; base[48 * DM + r] = (bf16)f2bf(lo);
    }
}

typedef short s8v __attribute__((ext_vector_type(8)));
constexpr size_t WS_GS2 = WS_LB + 64 * 1024;
__device__ __forceinline__ void phase_gs2(const Ptrs& p, int wv) {
    const int gt = blockIdx.x * NT + otid(wv), NG = gridDim.x * NT;
    for (int idx = gt; idx < 2 * 9 * DM; idx += NG) {
        const int layer = idx / (9 * DM), m = (idx / DM) % 9, c = idx & (DM - 1);
        const float* md = (const float*)(p.ws + WS_MOD) + ((size_t)layer * 9 + m) * MODW;
        float* o = (float*)(p.ws + WS_GS2) + ((size_t)(layer * 9 + m) * 2) * DM;
        o[c] = p.in[I_N2G][layer * DM + c] * (1.f + md[4 * DM + c]); o[DM + c] = md[3 * DM + c];
    }
}
__device__ __forceinline__ void phase_route(const Ptrs& p, LAS unsigned char* lds, int layer, int nrows, int wv) {
    const int tid = otid(wv), lane = tid & 63, wave = wv;
    LAS int* lcnt = (LAS int*)(lds + LDS_RT); LAS int* gb = lcnt + 32;
    if (tid < 32) lcnt[tid] = 0;
    __syncthreads();
    const int ntiles = nrows / 16, t = wave * gridDim.x + blockIdx.x;
    int e0 = -1, e1 = -1, lp0 = 0, lp1 = 0, ent0 = 0;
    if (t < ntiles) {
        const int row0 = t * 16, r = row0 + (lane & 15), kq = lane >> 4;
        const int mrow = (row0 < NLAT) ? (row0 >> 11) : 8;
        const float* xr = ((r < NLAT) ? p.out + (size_t)r * DM : (const float*)(p.ws + WS_XC) + (size_t)(r - NLAT) * DM) + 8 * kq;
        const float* gsp = (const float*)(p.ws + WS_GS2) + ((size_t)(layer * 9 + mrow) * 2) * DM + 8 * kq;
        bf16* hrow = (bf16*)(p.ws + WS_H) + (size_t)r * DM + 8 * kq;
        const bf16* wr_hi = (const bf16*)(p.ws + WS_WR) + (size_t)layer * 2 * 48 * DM + (size_t)(lane & 15) * DM + 8 * kq;
        float ss;
        { const v4f* rs = (const v4f*)((const float*)(p.ws + WS_RSS) + (size_t)r * 16); const v4f a = rs[0], b = rs[1], c = rs[2], d = rs[3];
          ss = ((a.x + a.y) + (a.z + a.w)) + ((b.x + b.y) + (b.z + b.w)) + ((c.x + c.y) + (c.z + c.w)) + ((d.x + d.y) + (d.z + d.w)); }
        const float rstd = rsqrtf(ss * (1.f / DM) + 1e-6f);
        v4f acc[3];
#pragma unroll
        for (int i = 0; i < 3; ++i) acc[i] = (v4f){0.f, 0.f, 0.f, 0.f};
#pragma unroll 1
        for (int s4 = 0; s4 < 32; s4 += 4) {
            v4f xa[4], xb[4], ga[4], gbv[4], ha[4], hb[4]; s8v wf[4][3];
#pragma unroll
            for (int u = 0; u < 4; ++u) {
                const int c0 = 32 * (s4 + u);
                xa[u] = *(const v4f*)(xr + c0); xb[u] = *(const v4f*)(xr + c0 + 4);
                ga[u] = *(const v4f*)(gsp + c0); gbv[u] = *(const v4f*)(gsp + c0 + 4);
                ha[u] = *(const v4f*)(gsp + DM + c0); hb[u] = *(const v4f*)(gsp + DM + c0 + 4);
#pragma unroll
                for (int nt = 0; nt < 3; ++nt) wf[u][nt] = *(const s8v*)(wr_hi + (size_t)nt * 16 * DM + c0);
            }
#pragma unroll
            for (int u = 0; u < 4; ++u) {
                const v4f h0 = xa[u] * rstd * ga[u] + ha[u], h1 = xb[u] * rstd * gbv[u] + hb[u];
                v4u hw; hw.x = pk2(h0.x, h0.y); hw.y = pk2(h0.z, h0.w); hw.z = pk2(h1.x, h1.y); hw.w = pk2(h1.z, h1.w);
                *(v4u*)(hrow + 32 * (s4 + u)) = hw;
                const s8v bh = __builtin_bit_cast(s8v, hw);
#pragma unroll
                for (int nt = 0; nt < 3; ++nt) acc[nt] = __builtin_amdgcn_mfma_f32_16x16x32_bf16(wf[u][nt], bh, acc[nt], 0, 0, 0);
            }
        }
        const float* brg = p.in[I_BRG] + layer * 4; const float* bre = p.in[I_BRE] + layer * 32;
        float gl[4];
#pragma unroll
        for (int i = 0; i < 4; ++i) gl[i] = acc[0][i] + brg[i];
        int gi = 0; float gm = gl[0];
#pragma unroll
        for (int i = 1; i < 4; ++i) if (gl[i] > gm) { gm = gl[i]; gi = i; }
        float den = 0.f;
#pragma unroll
        for (int i = 0; i < 4; ++i) den += __expf(gl[i] - gm);
        const float gtop = 1.f / den;
        if (kq == gi) {
            float el[8];
#pragma unroll
            for (int i = 0; i < 4; ++i) { el[i] = acc[1][i] + bre[8 * kq + i]; el[4 + i] = acc[2][i] + bre[8 * kq + 4 + i]; }
            int i0 = 0; float v0 = el[0];
#pragma unroll
            for (int i = 1; i < 8; ++i) if (el[i] > v0) { v0 = el[i]; i0 = i; }
            int i1 = -1; float v1 = -3.0e38f;
#pragma unroll
            for (int i = 0; i < 8; ++i) if (i != i0 && el[i] > v1) { v1 = el[i]; i1 = i; }
            const float p1 = __expf(v1 - v0), sden = 1.f / (1.f + p1);
            e0 = gi * 8 + i0; e1 = gi * 8 + i1; ent0 = r * 2;
            float* ew = (float*)(p.ws + WS_EW);
            ew[ent0] = gtop * sden; ew[ent0 + 1] = gtop * p1 * sden;
            lp0 = __hip_atomic_fetch_add(lcnt + e0, 1, __ATOMIC_RELAXED, __HIP_MEMORY_SCOPE_WORKGROUP); lp1 = __hip_atomic_fetch_add(lcnt + e1, 1, __ATOMIC_RELAXED, __HIP_MEMORY_SCOPE_WORKGROUP);
        }
    }
    __syncthreads();
    int* cnt = (int*)(p.ws + WS_CTL) + CW_CNT + layer * 64;
    if (tid < 32) gb[tid] = atomicAdd(&cnt[tid], lcnt[tid]);
    __syncthreads();
    if (e0 >= 0) {
        int* IDX = (int*)(p.ws + WS_IDX);
        IDX[(size_t)e0 * MROWS + gb[e0] + lp0] = ent0;
        IDX[(size_t)e1 * MROWS + gb[e1] + lp1] = ent0 + 1;
    }
}
__device__ __forceinline__ int moe_build_ttab(const Ptrs& p, LAS unsigned char* lds, int layer, int wv) {
    LAS int* ttab = (LAS int*)(lds + LDS_TTAB);
    const int* cnt = (const int*)(p.ws + WS_CTL) + CW_CNT + layer * 64;
    __syncthreads();
    if (otid(wv) == 0) {
        int t = 0;
        for (int e = 0; e < 32; ++e) { const int c = __hip_atomic_load(cnt + e, __ATOMIC_RELAXED, __HIP_MEMORY_SCOPE_AGENT); for (int fp = 0; fp < c; fp += 256) { ttab[t * 4] = e; ttab[t * 4 + 1] = fp; ttab[t * 4 + 2] = c; ++t; } }
        ttab[176 * 4] = t;
    }
    __syncthreads();
    return ttab[176 * 4];
}
__device__ __forceinline__ void phase_moe_gu(const Ptrs& p, LAS unsigned char* lds, int layer, int wv) {
    const int ntile = moe_build_ttab(p, lds, layer, wv);
    LAS int* ttab = (LAS int*)(lds + LDS_TTAB); LAS int* gidx = (LAS int*)(lds + LDS_GIDX);
    pg8::MoeOrder S{ttab, ntile, 2, (int)gridDim.x, (int)blockIdx.x};
    const int* IDX = (const int*)(p.ws + WS_IDX);
    for (int i = 0; i < 3; ++i) {
        pg8::Unit u; if (!S.next(i, u)) break;
        const int e = ttab[u.pm * 4], fp = ttab[u.pm * 4 + 1], c = ttab[u.pm * 4 + 2];
        for (int r = otid(wv); r < 256; r += NT) gidx[i * 256 + r] = (fp + r < c) ? (IDX[(size_t)e * MROWS + fp + r] >> 1) : 0;
    }
    __syncthreads();
    pg8::Gemm g{(const bf16*)(p.ws + WS_H), (const bf16*)(p.ws + WS_WGU + layer * WGU_STRIDE), ntile * 256, 32 * 512, DM};
    pg8::EpiGU E{(bf16*)(p.ws + WS_HID), wv};
    pg8::gemm_phase<pg8::EpiGU, pg8::MoeOrder, true, true, true>(lds, g, S, E, wv, gidx);
}
__device__ __forceinline__ void phase_moe_down(const Ptrs& p, LAS unsigned char* lds, int layer, int wv) {
    const int ntile = moe_build_ttab(p, lds, layer, wv);
    LAS int* ttab = (LAS int*)(lds + LDS_TTAB); LAS int* rowinfo = (LAS int*)(lds + LDS_GIDX);
    pg8::MoeOrder S{ttab, ntile, 4, (int)gridDim.x, (int)blockIdx.x};
    const int* IDX = (const int*)(p.ws + WS_IDX); const float* EW = (const float*)(p.ws + WS_EW);
    for (int i = 0; i < 3; ++i) {
        pg8::Unit u; if (!S.next(i, u)) break;
        const int e = ttab[u.pm * 4], fp = ttab[u.pm * 4 + 1], c = ttab[u.pm * 4 + 2];
        for (int r = otid(wv); r < 256; r += NT) {
            int ent = -1; float w = 0.f;
            if (fp + r < c) { ent = IDX[(size_t)e * MROWS + fp + r]; w = EW[ent]; }
            rowinfo[(i * 256 + r) * 2] = ent; rowinfo[(i * 256 + r) * 2 + 1] = __builtin_bit_cast(int, w);
        }
    }
    __syncthreads();
    pg8::Gemm g{(const bf16*)(p.ws + WS_HID), (const bf16*)(p.ws + WS_WD + layer * WD_STRIDE), ntile * 256, 32 * 1024, 256};
    pg8::EpiDown E{(bf16*)(p.ws + WS_Y0), (bf16*)(p.ws + WS_Y1), rowinfo, wv};
    pg8::gemm_phase<pg8::EpiDown, pg8::MoeOrder, true, true, false>(lds, g, S, E, wv);
}
__device__ __forceinline__ void phase_combine(const Ptrs& p, int layer, int nrows, bool do_norm, int wv) {
    const int lane = otid(wv) & 63, wave = wv;
    const int gw = blockIdx.x * NWAVES + wave, NGW = gridDim.x * NWAVES;
    const int per = (nrows + NGW - 1) / NGW;
    const int r0 = gw * per, r1 = min(r0 + per, nrows);
    const float* modl = (const float*)(p.ws + WS_MOD) + (size_t)layer * 9 * MODW;
    const float* modn = (const float*)(p.ws + WS_MOD) + (size_t)(layer + 1) * 9 * MODW;
    const float* g = p.in[I_N1G] + (layer + 1) * DM;
    const bf16* Y0 = (const bf16*)(p.ws + WS_Y0); const bf16* Y1 = (const bf16*)(p.ws + WS_Y1); bf16* H = (bf16*)(p.ws + WS_H);
    const unsigned lc = 4 * lane;
    int cur = -1; v4f m5v[4], gs[4], sh[4];
    v4f xn[4]; v2u an[4], bn[4];
    auto rowptr = [&](int r) -> float* { return (r < NLAT) ? p.out + (size_t)r * DM : (float*)(p.ws + WS_XC) + (size_t)(r - NLAT) * DM; };
    if (r0 < r1) {
        const float* xr = rowptr(r0);
#pragma unroll
        for (int j = 0; j < 4; ++j) { xn[j] = *(const v4f*)(xr + lc + 256 * j); an[j] = *(const v2u*)(Y0 + (size_t)r0 * DM + lc + 256 * j); bn[j] = *(const v2u*)(Y1 + (size_t)r0 * DM + lc + 256 * j); }
    }
    for (int r = r0; r < r1; ++r) {
        const int mrow = (r < NLAT) ? (r >> 11) : 8;
        if (mrow != cur) {
            cur = mrow; const float* m5 = modl + (size_t)mrow * MODW + 5 * DM; const float* mn = modn + (size_t)mrow * MODW;
#pragma unroll
            for (int j = 0; j < 4; ++j) { const unsigned c = lc + 256 * j; m5v[j] = *(const v4f*)(m5 + c);
                if (do_norm) { const v4f gg = *(const v4f*)(g + c), sc = *(const v4f*)(mn + DM + c); gs[j] = gg * (1.f + sc); sh[j] = *(const v4f*)(mn + c); } }
        }
        v4f x[4]; v2u a[4], b[4];
#pragma unroll
        for (int j = 0; j < 4; ++j) { x[j] = xn[j]; a[j] = an[j]; b[j] = bn[j]; }
        float* xr = rowptr(r);
        if (r + 1 < r1) {
            const float* xq = rowptr(r + 1);
#pragma unroll
            for (int j = 0; j < 4; ++j) { xn[j] = *(const v4f*)(xq + lc + 256 * j); an[j] = *(const v2u*)(Y0 + (size_t)(r + 1) * DM + lc + 256 * j); bn[j] = *(const v2u*)(Y1 + (size_t)(r + 1) * DM + lc + 256 * j); }
        }
        v4f v[4]; float s = 0.f;
#pragma unroll
        for (int j = 0; j < 4; ++j) {
            v4f y; y.x = bflo(a[j].x) + bflo(b[j].x); y.y = bfhi(a[j].x) + bfhi(b[j].x); y.z = bflo(a[j].y) + bflo(b[j].y); y.w = bfhi(a[j].y) + bfhi(b[j].y);
            v[j] = x[j] + m5v[j] * y;
            *(v4f*)(xr + lc + 256 * j) = v[j];
            s += (v[j].x * v[j].x + v[j].y * v[j].y) + (v[j].z * v[j].z + v[j].w * v[j].w);
        }
        if (do_norm) {
            const float rstd = rsqrtf(wave_sum(s, lane) * (1.f / DM) + 1e-6f);
#pragma unroll
            for (int j = 0; j < 4; ++j) { const v4f o = v[j] * rstd * gs[j] + sh[j]; v2u w; w.x = pk2(o.x, o.y); w.y = pk2(o.z, o.w); *(v2u*)(H + (size_t)r * DM + lc + 256 * j) = w; }
        }
    }
}

namespace hg {
typedef short s4v __attribute__((ext_vector_type(4)));
typedef short s8v __attribute__((ext_vector_type(8)));
typedef short v4i16_t __attribute__((ext_vector_type(4)));
constexpr int TS = 160;
constexpr int TILE_B = 16 * TS;
constexpr int WAVE_LDS = 2 * TILE_B;
constexpr int NSEG = 18;
constexpr size_t SEGU_B = 64 * 64 * 4, SEGA_B = 16 * 64 * 4;
constexpr size_t WS_SEGU = WS_SCR;
constexpr size_t WS_SEGA = WS_SEGU + (size_t)NBATCH * 4 * 2 * NSEG * SEGU_B;
static_assert(WS_SEGA + (size_t)NBATCH * 4 * 2 * NSEG * SEGA_B <= WS_END && 8 * WAVE_LDS <= 40960 && 40960 + 6 * 16384 <= LDS_BYTES - 64, "hgrn scratch");
template <int CTRL> __device__ __forceinline__ float dppf(float x) { return __builtin_bit_cast(float, __builtin_amdgcn_update_dpp(0, __builtin_bit_cast(int, x), CTRL, 0xf, 0xf, true)); }
__device__ __forceinline__ s4v trd(const LAS unsigned char* p) { return __builtin_bit_cast(s4v, __builtin_amdgcn_ds_read_tr16_b64_v4i16((LAS v4i16_t*)p)); }
typedef float f32x2_t __attribute__((ext_vector_type(2))); typedef __bf16 bf16x2_t __attribute__((ext_vector_type(2)));
__device__ __forceinline__ unsigned pkbf(float lo, float hi) { f32x2_t v = {lo, hi}; bf16x2_t b = __builtin_convertvector(v, bf16x2_t); return __builtin_bit_cast(unsigned, b); }
__device__ __forceinline__ float silu_r(float x) { return x * __builtin_amdgcn_rcpf(1.f + __expf(-x)); }
__device__ __forceinline__ s8v mk8(unsigned a, unsigned b, unsigned c, unsigned d) { v4u t; t.x = a; t.y = b; t.z = c; t.w = d; return __builtin_bit_cast(s8v, t); }

template <bool BWD, int OUT>
__device__ __forceinline__ void chunk(const bf16* __restrict__ P, int row0, int h, const float* __restrict__ lbh, v4f (&S)[4][4], float (&Atot)[16],
                                      LAS unsigned char* vt, LAS unsigned char* kt, int lane_, LAS v4f* OFL, int cidx, bf16* __restrict__ MIX, const float* __restrict__ on) {
    int lane = lane_; asm volatile("" : "+v"(lane));
    const int tok = lane & 15, kq = lane >> 4;
    const bf16* pb = P + (size_t)row0 * DIN + h * 64;
    const unsigned lo = (unsigned)(tok * DIN + 4 * kq);
    v2u zr[4], qr[4]; v4f lbq[4];
#pragma unroll
    for (int m = 0; m < 4; ++m) lbq[m] = *(const v4f*)(lbh + (unsigned)(16 * m + 4 * kq));
#pragma unroll
    for (int m = 0; m < 4; ++m) { zr[m] = *(const v2u*)(pb + (lo + (BWD ? C_FB : C_FF) + 16 * m)); if (OUT != 0) qr[m] = *(const v2u*)(pb + (lo + C_Q + 16 * m)); }
#pragma unroll
    for (int i = 0; i < 2; ++i) { const int pc = lane + 64 * i, r = pc >> 3, ch = pc & 7;
        const v4u vv = *(const v4u*)(pb + (unsigned)(r * DIN + C_I + 8 * ch)); *(LAS v4u*)(vt + r * TS + 16 * ch) = vv; }
    unsigned qf[8], kf[8];
    float A[16];
#pragma unroll
    for (int m = 0; m < 4; ++m)
#pragma unroll
        for (int jp = 0; jp < 2; ++jp) {
            const unsigned zw = jp ? zr[m].y : zr[m].x;
            float kt2[2], qt2[2], kh2[2];
#pragma unroll
            for (int i = 0; i < 2; ++i) {
                const int e = 4 * m + 2 * jp + i;
                const float z = i ? bfhi(zw) : bflo(zw);
                const float sg = __builtin_amdgcn_rcpf(1.f + __builtin_amdgcn_exp2f(-1.4426950408889634f * z)), lb = lbq[m][2 * jp + i];
                const float f = lb + (1.f - lb) * sg, kk = (1.f - lb) * (1.f - sg);
                const float lf = __builtin_amdgcn_logf(f);
                float c = lf, t = lf;
                if (!BWD) { c += dppf<0x111>(c); c += dppf<0x112>(c); c += dppf<0x114>(c); c += dppf<0x118>(c); }
                else      { c += dppf<0x101>(c); c += dppf<0x102>(c); c += dppf<0x104>(c); c += dppf<0x108>(c); }
                t += dppf<0x128>(t); t += dppf<0x124>(t); t += dppf<0x122>(t); t += dppf<0x121>(t);
                const float Ei = __builtin_amdgcn_exp2f(-fmaxf(c, -115.f)); A[e] = __builtin_amdgcn_exp2f(t);
                kt2[i] = kk * Ei; kh2[i] = kt2[i] * A[e];
                if (OUT != 0) { const unsigned qw = jp ? qr[m].y : qr[m].x; const float q = i ? bfhi(qw) : bflo(qw); qt2[i] = q * 0.125f * __builtin_amdgcn_exp2f(c); } else qt2[i] = 0.f;
            }
            kf[2 * m + jp] = pkbf(kt2[0], kt2[1]); if (OUT != 0) qf[2 * m + jp] = pkbf(qt2[0], qt2[1]);
            *(LAS unsigned*)(kt + tok * TS + (16 * m + 4 * kq + 2 * jp) * 2) = pkbf(kh2[0], kh2[1]);
            __builtin_amdgcn_sched_barrier(0);
        }
    asm volatile("s_waitcnt lgkmcnt(0)" ::: "memory");
    s8v vfr[4], khf[4];
    { const int i4 = tok >> 2, p4 = tok & 3; const LAS unsigned char* va = vt + (4 * kq + i4) * TS + 8 * p4; const LAS unsigned char* ka = kt + (4 * kq + i4) * TS + 8 * p4;
#pragma unroll
      for (int c = 0; c < 4; ++c) { const s4v a = trd(va + 32 * c), b = trd(ka + 32 * c);
          vfr[c] = (s8v){a[0], a[1], a[2], a[3], 0, 0, 0, 0}; khf[c] = (s8v){b[0], b[1], b[2], b[3], 0, 0, 0, 0}; } }
    if (OUT != 0) {
        const s8v q0 = mk8(qf[0], qf[1], qf[2], qf[3]), q1 = mk8(qf[4], qf[5], qf[6], qf[7]);
        const s8v k0 = mk8(kf[0], kf[1], kf[2], kf[3]), k1 = mk8(kf[4], kf[5], kf[6], kf[7]);
        v4f at = (v4f){0.f, 0.f, 0.f, 0.f};
        at = __builtin_amdgcn_mfma_f32_16x16x32_bf16(k0, q0, at, 0, 0, 0);
        at = __builtin_amdgcn_mfma_f32_16x16x32_bf16(k1, q1, at, 0, 0, 0);
#pragma unroll
        for (int j = 0; j < 4; ++j) { const int s = 4 * kq + j; const bool keep = BWD ? (s >= tok) : (s <= tok); at[j] = keep ? at[j] : 0.f; }
        const s8v af = mk8(pkbf(at[0], at[1]), pkbf(at[2], at[3]), 0u, 0u);
        v4f o[4];
#pragma unroll
        for (int vb = 0; vb < 4; ++vb) {
            o[vb] = __builtin_amdgcn_mfma_f32_16x16x32_bf16(vfr[vb], af, (v4f){0.f, 0.f, 0.f, 0.f}, 0, 0, 0);
            const s8v s0 = mk8(pkbf(S[0][vb][0], S[0][vb][1]), pkbf(S[0][vb][2], S[0][vb][3]), pkbf(S[1][vb][0], S[1][vb][1]), pkbf(S[1][vb][2], S[1][vb][3]));
            const s8v s1 = mk8(pkbf(S[2][vb][0], S[2][vb][1]), pkbf(S[2][vb][2], S[2][vb][3]), pkbf(S[3][vb][0], S[3][vb][1]), pkbf(S[3][vb][2], S[3][vb][3]));
            o[vb] = __builtin_amdgcn_mfma_f32_16x16x32_bf16(s0, q0, o[vb], 0, 0, 0);
            o[vb] = __builtin_amdgcn_mfma_f32_16x16x32_bf16(s1, q1, o[vb], 0, 0, 0);
            __builtin_amdgcn_sched_barrier(0);
        }
        LAS v4f* ofl = OFL + (cidx * 4) * 64 + lane;
        if (OUT == 1) {
#pragma unroll
            for (int vb = 0; vb < 4; ++vb) ofl[vb * 64] = o[vb];
        } else {
            float ss = 0.f;
#pragma unroll
            for (int vb = 0; vb < 4; ++vb) { o[vb] += ofl[vb * 64]; ss += (o[vb].x * o[vb].x + o[vb].y * o[vb].y) + (o[vb].z * o[vb].z + o[vb].w * o[vb].w); }
            ss += shx(ss, 16, lane); ss += shx(ss, 32, lane);
            const float rstd = rsqrtf(ss * (1.f / 64.f) + 1e-6f);
            bf16* mb = MIX + (size_t)row0 * DM + 768 + h * 64; const unsigned lom = (unsigned)(tok * DM + 4 * kq);
#pragma unroll
            for (int vb = 0; vb < 4; ++vb) {
                const v2u gw = *(const v2u*)(pb + (lo + C_G + 16 * vb)); const v4f gn = *(const v4f*)(on + (unsigned)(16 * vb + 4 * kq));
                const float g0 = bflo(gw.x), g1 = bfhi(gw.x), g2 = bflo(gw.y), g3 = bfhi(gw.y);
                v2u w; w.x = pkbf(o[vb].x * rstd * gn.x * silu_r(g0), o[vb].y * rstd * gn.y * silu_r(g1)); w.y = pkbf(o[vb].z * rstd * gn.z * silu_r(g2), o[vb].w * rstd * gn.w * silu_r(g3));
                *(v2u*)(mb + (lom + 16 * vb)) = w;
            }
        }
    }
#pragma unroll
    for (int db = 0; db < 4; ++db) {
        const v4f av = (v4f){A[4 * db], A[4 * db + 1], A[4 * db + 2], A[4 * db + 3]};
#pragma unroll
        for (int vb = 0; vb < 4; ++vb) S[db][vb] = __builtin_amdgcn_mfma_f32_16x16x32_bf16(khf[db], vfr[vb], S[db][vb] * av, 0, 0, 0);
        __builtin_amdgcn_sched_barrier(0);
    }
    if (OUT == 0) {
#pragma unroll
        for (int e = 0; e < 16; ++e) Atot[e] *= A[e];
    }
    asm volatile("s_waitcnt lgkmcnt(0)" ::: "memory");
}
__device__ __forceinline__ int seg_row0(int b, int seg) { return seg < 2 ? NLAT + b * CTXL + 128 * seg : b * SEQ + 128 * (seg - 2); }
__device__ __forceinline__ int scan_idx(int seg, int dir) { return dir == 0 ? seg : (seg < 2 ? 1 - seg : 19 - seg); }

__device__ __forceinline__ void unit_pass1(const Ptrs& p, int layer, int u, LAS unsigned char* wl, int lane) {
    const int dir = u & 1, bhs = u >> 1, seg = bhs % NSEG, bh = bhs / NSEG, h = bh & 3, b = bh >> 2;
    const bf16* P = (const bf16*)(p.ws + WS_P);
    const int row0 = seg_row0(b, seg);
    float Atot[16]; v4f S[4][4];
    const float* lbv = (const float*)(p.ws + WS_LB) + layer * 512 + dir * 256 + h * 64;
#pragma unroll
    for (int e = 0; e < 16; ++e) Atot[e] = 1.f;
#pragma unroll
    for (int i = 0; i < 4; ++i)
#pragma unroll
        for (int j = 0; j < 4; ++j) S[i][j] = (v4f){0.f, 0.f, 0.f, 0.f};
    if (dir == 0) {
#pragma unroll 1
        for (int c = 0; c < 8; ++c) chunk<false, 0>(P, row0 + 16 * c, h, lbv, S, Atot, wl, wl + TILE_B, lane, nullptr, c, nullptr, nullptr);
    } else {
#pragma unroll 1
        for (int c = 7; c >= 0; --c) chunk<true, 0>(P, row0 + 16 * c, h, lbv, S, Atot, wl, wl + TILE_B, lane, nullptr, c, nullptr, nullptr);
    }
    const size_t si = ((size_t)(bh * 2 + dir)) * NSEG + scan_idx(seg, dir);
    float* su = (float*)(p.ws + WS_SEGU + si * SEGU_B) + lane; float* sa = (float*)(p.ws + WS_SEGA + si * SEGA_B) + lane;
#pragma unroll
    for (int i = 0; i < 4; ++i)
#pragma unroll
        for (int j = 0; j < 4; ++j)
#pragma unroll
            for (int r = 0; r < 4; ++r) su[((i * 4 + j) * 4 + r) * 64] = S[i][j][r];
#pragma unroll
    for (int e = 0; e < 16; ++e) sa[e * 64] = Atot[e];
}
template <bool BWD>
__device__ __forceinline__ void unit_pass2(const Ptrs& p, int layer, int pu, LAS unsigned char* wl, LAS v4f* ofl_own, LAS v4f* ofl_partner, int lane, bool active) {
    const int seg = pu % NSEG, bh = pu / NSEG, h = bh & 3, b = bh >> 2;
    const bf16* P = (const bf16*)(p.ws + WS_P); bf16* MIX = (bf16*)(p.ws + WS_MIX);
    const float* on = p.in[I_HGON] + layer * 64;
    const int row0 = seg_row0(b, seg);
    constexpr int dir = BWD ? 1 : 0;
    float Atot[16]; v4f S[4][4];
    const float* lbv = (const float*)(p.ws + WS_LB) + layer * 512 + dir * 256 + h * 64;
    if (active) {
        {
            const size_t si = ((size_t)(bh * 2 + dir)) * NSEG + scan_idx(seg, dir);
            int ln = lane; asm volatile("" : "+v"(ln));
            const float* su = (const float*)(p.ws + WS_SEGU + si * SEGU_B) + ln;
#pragma unroll
            for (int i = 0; i < 4; ++i)
#pragma unroll
                for (int j = 0; j < 4; ++j) S[i][j] = (v4f){su[((i * 4 + j) * 4 + 0) * 64], su[((i * 4 + j) * 4 + 1) * 64], su[((i * 4 + j) * 4 + 2) * 64], su[((i * 4 + j) * 4 + 3) * 64]};
        }
#pragma unroll 1
        for (int k = 0; k < 4; ++k) { const int c = BWD ? 7 - k : k; chunk<BWD, 1>(P, row0 + 16 * c, h, lbv, S, Atot, wl, wl + TILE_B, lane, ofl_own, k, MIX, on); }
    }
    __syncthreads();
    if (active) {
#pragma unroll 1
        for (int k = 4; k < 8; ++k) { const int c = BWD ? 7 - k : k; chunk<BWD, 2>(P, row0 + 16 * c, h, lbv, S, Atot, wl, wl + TILE_B, lane, ofl_partner, 7 - k, MIX, on); }
    }
}
}
constexpr int LDS_HG_OFL = 40960, HG_OFL_B = 16384;
__device__ __forceinline__ void phase_hgrn1(const Ptrs& p, LAS unsigned char* lds, int layer, int wv) {
    const int lane = otid(wv) & 63; const int u = wv * gridDim.x + blockIdx.x;
    if (u < 2 * 32 * hg::NSEG) hg::unit_pass1(p, layer, u, lds + wv * hg::WAVE_LDS, lane);
}
__device__ __forceinline__ void phase_hgrn2(const Ptrs& p, LAS unsigned char* lds, int layer, int wv) {
    const int lane = otid(wv) & 63; const int pu = (wv >> 1) * gridDim.x + blockIdx.x;
    const bool active = pu < 32 * hg::NSEG && (layer == 0 || (pu % hg::NSEG) >= 2) && wv < 6;
    LAS v4f* own = (LAS v4f*)(lds + LDS_HG_OFL + (wv < 6 ? wv : 0) * HG_OFL_B); LAS v4f* partner = (LAS v4f*)(lds + LDS_HG_OFL + (wv < 6 ? (wv ^ 1) : 0) * HG_OFL_B);
    if (wv & 1) hg::unit_pass2<true>(p, layer, pu, lds + wv * hg::WAVE_LDS, own, partner, lane, active);
    else        hg::unit_pass2<false>(p, layer, pu, lds + wv * hg::WAVE_LDS, own, partner, lane, active);
}

__device__ __forceinline__ void phase_hgrn_scan(const Ptrs& p, int wv) {
    const int t = blockIdx.x * NT + otid(wv);
#pragma unroll 1
    for (int half = 0; half < 2; ++half) {
        const int e = t + half * (int)(gridDim.x * NT);
        if (e >= 64 * 4096) break;
        const int bhd = e >> 12, r = (e >> 6) & 63, l = e & 63;
        float* su = (float*)(p.ws + hg::WS_SEGU + (size_t)bhd * hg::NSEG * hg::SEGU_B) + r * 64 + l;
        const float* sa = (const float*)(p.ws + hg::WS_SEGA + (size_t)bhd * hg::NSEG * hg::SEGA_B) + (4 * (r >> 4) + (r & 3)) * 64 + l;
        float u[hg::NSEG], a[hg::NSEG];
#pragma unroll
        for (int j = 0; j < hg::NSEG; ++j) { u[j] = su[(size_t)j * 4096]; a[j] = sa[(size_t)j * 1024]; }
        float st = 0.f;
#pragma unroll
        for (int j = 0; j < hg::NSEG; ++j) { su[(size_t)j * 4096] = st; st = a[j] * st + u[j]; }
    }
}
namespace att {
using bf16=unsigned short;
using bf16x8=__attribute__((ext_vector_type(8)))short;
using s16x4=__attribute__((ext_vector_type(4)))short;
using f32x16=__attribute__((ext_vector_type(16)))float;
using u32x4=__attribute__((ext_vector_type(4)))unsigned;
constexpr int D=64,PIN_=DIN,POUT=DM;
constexpr int NW=8,QBLK=32,QB=QBLK*NW,KVBLK=64;
__device__ __forceinline__ int crow(int r,int hi){return (r&3)+8*(r>>2)+4*hi;}
#define SBAR() __builtin_amdgcn_sched_barrier(0)
constexpr int NSLOT=3, SLOTB=8192;
constexpr int LDS_K=0, LDS_V=NSLOT*SLOTB, LDS_WS=2*NSLOT*SLOTB, LDS_OST=LDS_WS+NW*64*4, LDS_BYTES=LDS_OST+NW*4096;
constexpr float C2=0.125f*1.4426950408889634f;
__device__ __forceinline__ void glds16(const void*gsrc,unsigned lds_dst){unsigned keep;
  asm volatile("s_mov_b32 %0, m0\n\ts_mov_b32 m0, %2\n\ts_nop 0\n\tglobal_load_lds_dwordx4 %1, off\n\ts_mov_b32 m0, %0":"=&s"(keep):"v"(gsrc),"s"(lds_dst):"memory");}
__device__ __forceinline__ float max3f(float a,float b,float c){float r;asm("v_max3_f32 %0, %1, %2, %3":"=v"(r):"v"(a),"v"(b),"v"(c));return r;}
__device__ __forceinline__ float max2f(float a,float b){float r;asm("v_max_f32_e32 %0, %1, %2":"=v"(r):"v"(a),"v"(b));return r;}
__device__ __forceinline__ float fadd_s(float a,float b){float r;asm("v_add_f32_e32 %0, %1, %2":"=v"(r):"v"(a),"v"(b));return r;}
__device__ __forceinline__ float fsub_s(float a,float b){float r;asm("v_sub_f32_e32 %0, %1, %2":"=v"(r):"v"(a),"v"(b));return r;}
typedef float f32x2_t __attribute__((ext_vector_type(2))); typedef __bf16 bf16x2_t __attribute__((ext_vector_type(2)));
__device__ __forceinline__ unsigned cvtpk_s(float lo,float hi){f32x2_t v={lo,hi};bf16x2_t b=__builtin_convertvector(v,bf16x2_t);return __builtin_bit_cast(unsigned,b);}
#define WAIT_BAR(N) asm volatile("s_waitcnt vmcnt(" #N ") lgkmcnt(0)\n\ts_barrier":::"memory")

__device__ __forceinline__ void qkt(f32x16&p0,f32x16&p1,const char*Kslot,const bf16x8*qr,const f32x16&negm,int r32,int hi){
  const char*kb=Kslot+hi*1024+r32*16;
  #pragma unroll
  for(int d0=0;d0<4;++d0){
    const bf16x8 b0=*reinterpret_cast<const bf16x8*>(kb+d0*2048);
    const bf16x8 b1=*reinterpret_cast<const bf16x8*>(kb+d0*2048+512);
    if(d0==0){p0=__builtin_amdgcn_mfma_f32_32x32x16_bf16(b0,qr[0],negm,0,0,0);p1=__builtin_amdgcn_mfma_f32_32x32x16_bf16(b1,qr[0],negm,0,0,0);}
    else{p0=__builtin_amdgcn_mfma_f32_32x32x16_bf16(b0,qr[d0],p0,0,0,0);p1=__builtin_amdgcn_mfma_f32_32x32x16_bf16(b1,qr[d0],p1,0,0,0);}}
}
typedef __attribute__((address_space(3))) const char* lds_cptr;
typedef short v4i16_t __attribute__((ext_vector_type(4)));
__device__ __forceinline__ void kload8(bf16x8*kf,lds_cptr kp){
  kf[0]=*(const __attribute__((address_space(3))) bf16x8*)(kp);      kf[1]=*(const __attribute__((address_space(3))) bf16x8*)(kp+512);
  kf[2]=*(const __attribute__((address_space(3))) bf16x8*)(kp+2048); kf[3]=*(const __attribute__((address_space(3))) bf16x8*)(kp+2560);
  kf[4]=*(const __attribute__((address_space(3))) bf16x8*)(kp+4096); kf[5]=*(const __attribute__((address_space(3))) bf16x8*)(kp+4608);
  kf[6]=*(const __attribute__((address_space(3))) bf16x8*)(kp+6144); kf[7]=*(const __attribute__((address_space(3))) bf16x8*)(kp+6656);
}
__device__ __forceinline__ void kload2(bf16x8*kf,lds_cptr kp,int j){ kf[2*j]=*(const __attribute__((address_space(3))) bf16x8*)(kp+j*2048); kf[2*j+1]=*(const __attribute__((address_space(3))) bf16x8*)(kp+j*2048+512); }
__device__ __forceinline__ s16x4 vtr(lds_cptr p){ return __builtin_bit_cast(s16x4,__builtin_amdgcn_ds_read_tr16_b64_v4i16((__attribute__((address_space(3))) v4i16_t*)p)); }
__device__ __forceinline__ float rowmax(const f32x16&p0,const f32x16&p1){
  float a=max3f(p0[0],p0[1],p1[0]),b=max3f(p0[2],p0[3],p1[1]);a=max3f(a,p1[2],p1[3]);
  #pragma unroll
  for(int r=4;r<16;r+=4){a=max3f(a,p0[r],p0[r+1]);b=max3f(b,p0[r+2],p0[r+3]);a=max3f(a,p1[r],p1[r+1]);b=max3f(b,p1[r+2],p1[r+3]);}
  const float m=max2f(a,b);
  auto rr=__builtin_amdgcn_permlane32_swap(__float_as_uint(m),__float_as_uint(m),false,false);
  return max2f(__uint_as_float(rr[0]),__uint_as_float(rr[1]));
}
__device__ __forceinline__ void pv(f32x16*o,int vb,bf16x8 pa0,bf16x8 pa1,bf16x8 pa2,bf16x8 pa3){
  #pragma unroll
  for(int d0=0;d0<2;++d0){s16x4 lo[4],hi[4];
    #pragma unroll
    for(int ks=0;ks<4;++ks){
      asm volatile("ds_read_b64_tr_b16 %0,%1 offset:%c2":"=&v"(lo[ks]):"v"(vb),"i"(d0*4096+ks*1024):"memory");
      asm volatile("ds_read_b64_tr_b16 %0,%1 offset:%c2":"=&v"(hi[ks]):"v"(vb),"i"(d0*4096+ks*1024+512):"memory");}
    asm volatile("s_waitcnt lgkmcnt(0)":::"memory");SBAR();
    #define PK(k) (bf16x8){lo[k][0],lo[k][1],lo[k][2],lo[k][3],hi[k][0],hi[k][1],hi[k][2],hi[k][3]}
    o[d0]=__builtin_amdgcn_mfma_f32_32x32x16_bf16(pa0,PK(0),o[d0],0,0,0);
    o[d0]=__builtin_amdgcn_mfma_f32_32x32x16_bf16(pa1,PK(1),o[d0],0,0,0);
    o[d0]=__builtin_amdgcn_mfma_f32_32x32x16_bf16(pa2,PK(2),o[d0],0,0,0);
    o[d0]=__builtin_amdgcn_mfma_f32_32x32x16_bf16(pa3,PK(3),o[d0],0,0,0);
    #undef PK
  }
}

#ifndef ATTN_STORE16
#define ATTN_STORE16(p,v) (*(u32x4*)(p)=(v))
#endif
template<int THRL,class Hook> __device__ __forceinline__ void attn_unit(const bf16*Q0,const bf16*__restrict__ Kh,const bf16*__restrict__ Vh,int rowa,int na,int rowb,int NT,bf16*O0,const Hook&hook,char*shm,int wid){
  const int lane=otid(wid)&63,r32=lane&31,hi=lane>>5;
  const bf16*Qw=Q0+(long)(wid*QBLK)*PIN_;
  #define TROW(t) ((long)(((t)<na)?(rowa+64*(t)):(rowb+64*((t)-na))))
  const unsigned lds0=(unsigned)(uintptr_t)shm;
  float*wsf=(float*)(shm+LDS_WS)+wid*64;
  const bf16*ksrc=Kh+(long)lane*PIN_+wid*8;
  const bf16*vsrc=Vh+(long)(16*(wid&3)+(lane>>2))*PIN_+(wid>>2)*32+(lane&3)*8;
  const unsigned kdst=lds0+LDS_K+wid*1024, vdst=lds0+LDS_V+wid*1024;
  #define DMA_K(t,slot) glds16(ksrc+TROW(t)*PIN_,(unsigned)__builtin_amdgcn_readfirstlane(kdst+(slot)))
  #define DMA_V(t,slot) glds16(vsrc+TROW(t)*PIN_,(unsigned)__builtin_amdgcn_readfirstlane(vdst+(slot)))
  const int vb0=(int)(lds0+LDS_V)+((lane>>4)&1)*32+(lane&3)*8+(4*hi+((lane&15)>>2))*64;
  const char*Kbase=shm+LDS_K; bf16x8 kf[8];
  const lds_cptr shm3=(lds_cptr)shm; const lds_cptr kp0=shm3+LDS_K+hi*1024+r32*16; const lds_cptr vp0=shm3+LDS_V+((lane>>4)&1)*32+(lane&3)*8+(4*hi+((lane&15)>>2))*64;
  DMA_K(0,0);DMA_V(0,0);DMA_K(1,SLOTB);
  bf16x8 qr[4];
  #pragma unroll
  for(int d0=0;d0<4;++d0)qr[d0]=*reinterpret_cast<const bf16x8*>(&Qw[(long)r32*PIN_+d0*16+hi*8]);
  float zz_=0.f; asm volatile("":"+v"(zz_));
  float mhat=zz_,l_reg=zz_;f32x16 o[2],negm;
  #pragma unroll
  for(int r=0;r<16;++r){o[0][r]=zz_;o[1][r]=zz_;negm[r]=zz_;}
  asm volatile("":"+v"(negm));
  #define CMASK(P0,P1,t) hook(P0,P1,(t),wid,r32,hi)
  bool resc=false;
  #define START(P0,P1) do{ const float rm=rowmax(P0,P1); resc=false; \
    { const float dl=rm; mhat=fadd_s(mhat,dl); \
      _Pragma("unroll") for(int r=0;r<16;++r){P0[r]=fsub_s(P0[r],dl);P1[r]=fsub_s(P1[r],dl);} \
      _Pragma("unroll") for(int r=0;r<16;++r)negm[r]=-mhat; asm volatile("":"+v"(negm)); } \
    _Pragma("unroll") for(int r=0;r<16;++r)P0[r]=__builtin_amdgcn_exp2f(P0[r]); }while(0)
  #define RESC() do{ if(resc){ asm volatile("s_waitcnt lgkmcnt(0)":::"memory"); \
      _Pragma("unroll") for(int d_=0;d_<2;++d_) _Pragma("unroll") for(int r=0;r<16;++r)o[d_][r]*=wsf[crow(r,hi)]; } }while(0)
  f32x16 pA0,pA1,pB0,pB1;
  int sl_prev=0,sl_cur=0,sl_next=SLOTB;
  #define ROT() do{sl_prev=sl_cur;sl_cur=sl_next;sl_next=(sl_next==(NSLOT-1)*SLOTB)?0:sl_next+SLOTB;}while(0)
  DMA_K(2,2*SLOTB);
  WAIT_BAR(3);
  qkt(pA0,pA1,Kbase,qr,negm,r32,hi);asm volatile("s_nop 15\n\ts_nop 7":"+v"(pA0),"+v"(pA1));
  START(pA0,pA1);
  _Pragma("unroll") for(int r=0;r<16;++r)pA1[r]=__builtin_amdgcn_exp2f(pA1[r]);
  WAIT_BAR(0);
  DMA_K(3,0);DMA_V(1,SLOTB);
  ROT();
  kload8(kf,kp0+sl_cur);
  WAIT_BAR(2);
  s16x4 vlo[8],vhi[8]; u32x4 pw0,pw1,pw2,pw3;
  #define PKW(P,B) cvtpk_s(P[B],P[B+1])
  #define PAF(k) __builtin_bit_cast(bf16x8,pw##k)
  #define VFR(i) (bf16x8){vlo[i][0],vlo[i][1],vlo[i][2],vlo[i][3],vhi[i][0],vhi[i][1],vhi[i][2],vhi[i][3]}
  #define PIN(x) asm volatile("":"+v"(x))
  #define MX3(a,b,c) __builtin_fmaxf(__builtin_fmaxf((a),(b)),(c))
  #define GAPA(MF,A0,A1,A2,A3,W0,W1,PW) do{ MF; sacc+=A0; sacc+=A1; sacc+=A2; sacc+=A3; PIN(sacc); W0; W1; PIN(PW); SBAR(); }while(0)
  #define EX(v) __builtin_amdgcn_exp2f(v)
  #define GAPB(MF,X,B) do{ MF; X[B]=EX(X[B]); X[B+1]=EX(X[B+1]); X[B+2]=EX(X[B+2]); X[B+3]=EX(X[B+3]); PIN(X); SBAR(); }while(0)
  #define VRD(i) do{ vlo[i]=vtr(vp_+(((i)>>2)*4096+((i)&3)*1024)); vhi[i]=vtr(vp_+(((i)>>2)*4096+((i)&3)*1024+512)); }while(0)
  #define KRD(G,j) do{ if(G){ kload2(kf,kp0+sl_next,j); SBAR(); } }while(0)
  #define STEP(C0,C1,P0,P1,t,GK,GV,GL) do{ SBAR(); \
    const lds_cptr vp_=vp0+sl_prev; \
    VRD(0); SBAR(); float sacc=(P0[0]+P0[1]); \
    GAPA(C0=__builtin_amdgcn_mfma_f32_32x32x16_bf16(kf[0],qr[0],negm,0,0,0), P0[2],P0[3],P0[4],P0[5],     pw0[0]=PKW(P0,0), pw0[1]=PKW(P0,2), pw0); \
    VRD(4); SBAR(); GAPA(C1=__builtin_amdgcn_mfma_f32_32x32x16_bf16(kf[1],qr[0],negm,0,0,0), P0[6],P0[7],P0[8],P0[9],     pw0[2]=PKW(P0,4), pw0[3]=PKW(P0,6), pw0); \
    VRD(1); SBAR(); GAPA(C0=__builtin_amdgcn_mfma_f32_32x32x16_bf16(kf[2],qr[1],C0,0,0,0),   P0[10],P0[11],P0[12],P0[13], pw1[0]=PKW(P0,8), pw1[1]=PKW(P0,10), pw1); \
    VRD(5); SBAR(); GAPA(C1=__builtin_amdgcn_mfma_f32_32x32x16_bf16(kf[3],qr[1],C1,0,0,0),   P0[14],P0[15],P1[0],P1[1],   pw1[2]=PKW(P0,12),pw1[3]=PKW(P0,14), pw1); \
    VRD(2); SBAR(); GAPA(C0=__builtin_amdgcn_mfma_f32_32x32x16_bf16(kf[4],qr[2],C0,0,0,0),   P1[2],P1[3],P1[4],P1[5],     pw2[0]=PKW(P1,0), pw2[1]=PKW(P1,2), pw2); \
    VRD(6); SBAR(); GAPA(C1=__builtin_amdgcn_mfma_f32_32x32x16_bf16(kf[5],qr[2],C1,0,0,0),   P1[6],P1[7],P1[8],P1[9],     pw2[2]=PKW(P1,4), pw2[3]=PKW(P1,6), pw2); \
    VRD(3); SBAR(); GAPA(C0=__builtin_amdgcn_mfma_f32_32x32x16_bf16(kf[6],qr[3],C0,0,0,0),   P1[10],P1[11],P1[12],P1[13], pw3[0]=PKW(P1,8), pw3[1]=PKW(P1,10), pw3); \
    VRD(7); SBAR(); GAPA(C1=__builtin_amdgcn_mfma_f32_32x32x16_bf16(kf[7],qr[3],C1,0,0,0),   P1[14],P1[15],0.f,0.f,       pw3[2]=PKW(P1,12),pw3[3]=PKW(P1,14), pw3); \
    l_reg+=sacc; \
    if(GK){DMA_K((t)+3,sl_cur);} if(GV){DMA_V((t)+1,sl_next);} \
    CMASK(C0,C1,t); \
    { float a=MX3(C0[0],C0[1],C1[0]),b=MX3(C0[2],C0[3],C1[1]); a=MX3(a,C1[2],C1[3]); \
      _Pragma("unroll") for(int r=4;r<16;r+=4){a=MX3(a,C0[r],C0[r+1]);b=MX3(b,C0[r+2],C0[r+3]);a=MX3(a,C1[r],C1[r+1]);b=MX3(b,C1[r+2],C1[r+3]);} \
      float rm=__builtin_fmaxf(a,b); { auto rr=__builtin_amdgcn_permlane32_swap(__float_as_uint(rm),__float_as_uint(rm),false,false); rm=__builtin_fmaxf(__uint_as_float(rr[0]),__uint_as_float(rr[1])); } \
      resc=false; \
      if(__builtin_expect(__any(rm>(float)THRL),0)){ const float dl=__builtin_fmaxf(rm,0.f); mhat+=dl; \
        _Pragma("unroll") for(int r=0;r<16;++r){C0[r]-=dl;C1[r]-=dl;} \
        _Pragma("unroll") for(int r=0;r<16;++r)negm[r]=-mhat; asm volatile("":"+v"(negm)); \
        const float f=__builtin_amdgcn_exp2f(-dl); l_reg*=f; if(hi==0)wsf[r32]=f; resc=true; } } \
    SBAR(); \
    GAPB(o[0]=__builtin_amdgcn_mfma_f32_32x32x16_bf16(PAF(0),VFR(0),o[0],0,0,0), C0,0); \
    GAPB(o[1]=__builtin_amdgcn_mfma_f32_32x32x16_bf16(PAF(0),VFR(4),o[1],0,0,0), C0,4); \
    KRD(GL,0); GAPB(o[0]=__builtin_amdgcn_mfma_f32_32x32x16_bf16(PAF(1),VFR(1),o[0],0,0,0), C0,8); \
    KRD(GL,1); GAPB(o[1]=__builtin_amdgcn_mfma_f32_32x32x16_bf16(PAF(1),VFR(5),o[1],0,0,0), C0,12); \
    KRD(GL,2); GAPB(o[0]=__builtin_amdgcn_mfma_f32_32x32x16_bf16(PAF(2),VFR(2),o[0],0,0,0), C1,0); \
    KRD(GL,3); GAPB(o[1]=__builtin_amdgcn_mfma_f32_32x32x16_bf16(PAF(2),VFR(6),o[1],0,0,0), C1,4); \
    GAPB(o[0]=__builtin_amdgcn_mfma_f32_32x32x16_bf16(PAF(3),VFR(3),o[0],0,0,0), C1,8); \
    GAPB(o[1]=__builtin_amdgcn_mfma_f32_32x32x16_bf16(PAF(3),VFR(7),o[1],0,0,0), C1,12); \
    }while(0)
  int t=1;
  for(;t+5<NT;t+=2){
    STEP(pB0,pB1,pA0,pA1,t,true,true,true);     WAIT_BAR(2); RESC(); ROT();
    STEP(pA0,pA1,pB0,pB1,t+1,true,true,true);   WAIT_BAR(2); RESC(); ROT();
  }
  #define ENDW(tt) do{ if((tt)+3<NT){WAIT_BAR(2);} else if((tt)+2<NT){WAIT_BAR(1);} else {WAIT_BAR(0);} }while(0)
  for(;t+1<NT;t+=2){
    STEP(pB0,pB1,pA0,pA1,t,(t+3<NT),(t+1<NT),(t+1<NT));       ENDW(t);   RESC(); ROT();
    STEP(pA0,pA1,pB0,pB1,t+1,(t+4<NT),(t+2<NT),(t+2<NT));     ENDW(t+1); RESC(); ROT();
  }
  STEP(pB0,pB1,pA0,pA1,NT-1,false,false,false); RESC();
  { float sacc=pB0[0]+pB0[1]; _Pragma("unroll") for(int r=2;r<16;++r)sacc+=pB0[r]; _Pragma("unroll") for(int r=0;r<16;++r)sacc+=pB1[r]; l_reg+=sacc;
    pw0=(u32x4){PKW(pB0,0),PKW(pB0,2),PKW(pB0,4),PKW(pB0,6)};pw1=(u32x4){PKW(pB0,8),PKW(pB0,10),PKW(pB0,12),PKW(pB0,14)};pw2=(u32x4){PKW(pB1,0),PKW(pB1,2),PKW(pB1,4),PKW(pB1,6)};pw3=(u32x4){PKW(pB1,8),PKW(pB1,10),PKW(pB1,12),PKW(pB1,14)};
    SBAR(); pv(o,vb0+sl_cur,PAF(0),PAF(1),PAF(2),PAF(3)); }
  #undef PKW
  #undef PAF
  #undef VFR
  #undef PIN
  #undef MX3
  #undef GAPA
  #undef GAPB
  #undef EX
  #undef VRD
  #undef KRD
  #undef STEP
  #undef ENDW
  {auto rr=__builtin_amdgcn_permlane32_swap(__float_as_uint(l_reg),__float_as_uint(l_reg),false,false);l_reg=__uint_as_float(rr[0])+__uint_as_float(rr[1]);}
  if(hi==0)wsf[32+r32]=l_reg;asm volatile("s_waitcnt lgkmcnt(0)":::"memory");
  float rli[16];
  #pragma unroll
  for(int r=0;r<16;++r)rli[r]=__builtin_amdgcn_rcpf(wsf[32+crow(r,hi)]);
  bf16*Ow=O0+(long)(wid*QBLK)*POUT;
  { bf16*stg=(bf16*)(shm+LDS_OST)+wid*2048;
    #pragma unroll
    for(int r=0;r<16;++r){const int orow=crow(r,hi);
      #pragma unroll
      for(int d0=0;d0<2;++d0)stg[orow*64+d0*32+r32]=(bf16)f2bf(o[d0][r]*rli[r]);}
    asm volatile("s_waitcnt lgkmcnt(0)":::"memory");
    #pragma unroll
    for(int i=0;i<4;++i){const int row=i*8+(lane>>3),ch=lane&7; const u32x4 v=*(const u32x4*)(stg+row*64+ch*8); ATTN_STORE16(Ow+(long)row*POUT+ch*8,v);} }
  asm volatile("s_waitcnt lgkmcnt(0)\n\ts_barrier":::"memory");
  #undef DMA_K
  #undef DMA_V
  #undef TROW
  #undef CMASK
  #undef START
  #undef RESC
  #undef ROT
}
constexpr int ATTN_LDS_BYTES=LDS_BYTES;
#undef SBAR
#undef WAIT_BAR
}

namespace pg8 {
struct EpiInProj {
    static constexpr bool PERM = true, AFTER_DRAIN = false;
    bf16_t* P; const float* na_qn; const float* na_kn; const float* gq_qn; const float* gq_kn; int wv;
    __device__ __forceinline__ void operator()(const f32x4 (&acc)[2][2][4][2], const Unit& u, int, int, int, int) const {
        const int l_ = otid(wv) & 63, fr = l_ & 15, fq = l_ >> 4, wr = wv >> 2, wc = wv & 3;
        const int pn = u.pn, rowt = u.pm * BM;
        int mode = 0; const float* gain = na_qn; float qs = 1.f;
        if (pn == 0) { mode = 1; gain = na_qn; qs = att::C2; }
        else if (pn == 1) { mode = 1; gain = na_kn; }
        else if (pn == 3 || pn == 4) { mode = 2; gain = gq_qn; qs = att::C2; }
        else if (pn == 5 && wc < 2) { mode = 2; gain = gq_kn; }
        if (mode == 2 && rowt >= NLAT) mode = 1;
        bf16_t* pcol = P + pn * BM + 64 * wc + 8 * fq;
        if (mode == 0) {
#pragma unroll
            for (int ai = 0; ai < 2; ++ai)
#pragma unroll
                for (int m = 0; m < 4; ++m) { bf16_t* rowp = pcol + (size_t)(rowt + ai * HALF + wr * 64 + m * 16 + fr) * DIN;
#pragma unroll
                    for (int bj = 0; bj < 2; ++bj) { const f32x4 v0 = acc[ai][bj][m][0], v1 = acc[ai][bj][m][1];
                        u32x4 w; w.x = cvt_pk_bf16(v0[0], v0[1]); w.y = cvt_pk_bf16(v0[2], v0[3]); w.z = cvt_pk_bf16(v1[0], v1[1]); w.w = cvt_pk_bf16(v1[2], v1[3]);
                        *(u32x4*)(rowp + 32 * bj) = w; } }
            return;
        }
        f32x4 g[2][2]; float invf[2][2];
#pragma unroll
        for (int bj = 0; bj < 2; ++bj)
#pragma unroll
            for (int n = 0; n < 2; ++n) g[bj][n] = *(const f32x4*)(gain + 32 * bj + 8 * fq + 4 * n) * qs;
#pragma unroll
        for (int n = 0; n < 2; ++n)
#pragma unroll
            for (int pp = 0; pp < 2; ++pp) invf[n][pp] = exp2f(-(float)(4 * fq + 2 * n + pp) * (13.287712379549449f / 16.f));
#pragma unroll
        for (int ai = 0; ai < 2; ++ai)
#pragma unroll
            for (int m = 0; m < 4; ++m) {
                const int row = rowt + ai * HALF + wr * 64 + m * 16 + fr;
                f32x4 v[2][2]; float ss = 0.f;
#pragma unroll
                for (int bj = 0; bj < 2; ++bj)
#pragma unroll
                    for (int n = 0; n < 2; ++n) { v[bj][n] = acc[ai][bj][m][n]; ss += (v[bj][n][0] * v[bj][n][0] + v[bj][n][1] * v[bj][n][1]) + (v[bj][n][2] * v[bj][n][2] + v[bj][n][3] * v[bj][n][3]); }
                ss += shx(ss, 16, l_); ss += shx(ss, 32, l_);
                const float rstd = rsqrtf(ss * (1.f / 64.f) + 1e-6f);
#pragma unroll
                for (int bj = 0; bj < 2; ++bj)
#pragma unroll
                    for (int n = 0; n < 2; ++n) {
                        if (mode == 2) {
                        }
                        v[bj][n] = v[bj][n] * rstd * g[bj][n];
                    }
                if (mode == 2) {
                    const int t = row & (SEQ - 1); const float pos[2] = {(float)(t >> 6), (float)(t & 63)};
#pragma unroll
                    for (int bj = 0; bj < 2; ++bj)
#pragma unroll
                        for (int n = 0; n < 2; ++n)
#pragma unroll
                            for (int pp = 0; pp < 2; ++pp) {
                                const float ang = pos[bj] * invf[n][pp], cs = __cosf(ang), sn = __sinf(ang);
                                const float x1 = v[bj][n][2 * pp], x2 = v[bj][n][2 * pp + 1];
                                v[bj][n][2 * pp] = x1 * cs - x2 * sn; v[bj][n][2 * pp + 1] = x1 * sn + x2 * cs;
                            }
                }
                bf16_t* rowp = pcol + (size_t)row * DIN;
#pragma unroll
                for (int bj = 0; bj < 2; ++bj) { const f32x4 v0 = v[bj][0], v1 = v[bj][1];
                    u32x4 w; w.x = cvt_pk_bf16(v0[0], v0[1]); w.y = cvt_pk_bf16(v0[2], v0[3]); w.z = cvt_pk_bf16(v1[0], v1[1]); w.w = cvt_pk_bf16(v1[2], v1[3]);
                    *(u32x4*)(rowp + 32 * bj) = w; }
                asm volatile("" ::: "memory");
            }
    }
};
}

__device__ __forceinline__ void w_qknorm_rope(const Ptrs& p, int layer, int unit, int d) {
    const int row = unit / 18, slot = unit % 18;
    int col; const float* gain; bool rope;
    if (slot < 4) { col = A_Q + slot * 64; gain = p.in[I_NAQN] + layer * 64; rope = false; }
    else if (slot < 8) { col = A_K + (slot - 4) * 64; gain = p.in[I_NAKN] + layer * 64; rope = false; }
    else if (slot < 16) { col = B_Q + (slot - 8) * 64; gain = p.in[I_GQQN] + layer * 64; rope = true; }
    else { col = B_K + (slot - 16) * 64; gain = p.in[I_GQKN] + layer * 64; rope = true; }
    bf16* pp = (bf16*)(p.ws + WS_P) + (size_t)row * DIN + col;
    float x = bf2f(pp[d]);
    float ss = wave_sum(x * x, d);
    float y = x * rsqrtf(ss * (1.f / 64.f) + 1e-6f) * gain[d];
    if (rope && row < NLAT) {
        int t = row & (SEQ - 1);
        float partner = shx(y, 1, d);
        int pi = d >> 1;
        float pos = (pi < 16) ? (float)(t >> 6) : (float)(t & 63);
        float inv = exp2f(-(float)(pi & 15) * (13.287712379549449f / 16.f));
        float ang = pos * inv;
        float cs = __cosf(ang), sn = __sinf(ang);
        y = (d & 1) ? (partner * sn + y * cs) : (y * cs - partner * sn);
    }
    if (slot < 4 || (slot >= 8 && slot < 16)) y *= att::C2;
    pp[d] = (bf16)f2bf(y);
}
struct NoHook { __device__ __forceinline__ void operator()(att::f32x16&, att::f32x16&, int, int, int, int) const {} };
struct NaHook {
    const LAS float* tab; int r0, kr0;
    __device__ __forceinline__ void operator()(att::f32x16& p0, att::f32x16& p1, int t, int wid, int r32, int hi) const {
        if (t < 4) return;
        const int r = r0 + (wid >> 1), kr = kr0 + t - 4, rs = min(max(r - 4, 0), 24);
        const float NEG = -INFINITY;
        if ((unsigned)(kr - rs) >= 8u) {
#pragma unroll
            for (int i = 0; i < 16; ++i) { p0[i] = NEG; p1[i] = NEG; }
            return;
        }
        const int qc = 32 * (wid & 1) + r32, cs = min(max(qc - 8, 0), 48), kb = 4 * hi - cs;
        const LAS float* tp = tab + (kr - r + 7) * 31 + (4 * hi - qc + 15);
#pragma unroll
        for (int i = 0; i < 16; ++i) {
            const int c = (i & 3) + 8 * (i >> 2);
            const float b0 = tp[c], b1 = tp[c + 32];
            p0[i] = ((unsigned)(kb + c) < 16u) ? p0[i] + b0 : NEG;
            p1[i] = ((unsigned)(kb + c + 32) < 16u) ? p1[i] + b1 : NEG;
        }
    }
};
constexpr int LDS_NATAB = 88064;
__device__ __forceinline__ void phase_attn(const Ptrs& p, unsigned char* lds_gen, int layer, int wv) {
    const bf16* P = (const bf16*)(p.ws + WS_P); bf16* MIX = (bf16*)(p.ws + WS_MIX);
    char* shm = (char*)lds_gen;
    const int c = blockIdx.x, x = c & 7, ci = (c >> 3) & 31;
    for (int i = 0; i < 2; ++i) {
        const int grp = 2 * x + i, b = grp >> 1, kvh = grp & 1, g = ci >> 3, qb = ci & 7, hq = kvh * 4 + g;
        const size_t qrow = (size_t)b * SEQ + qb * 256;
        att::attn_unit<8, NoHook>(P + qrow * DIN + B_Q + hq * 64, P + B_K + kvh * 64, P + B_V + kvh * 64, b * SEQ, 32, NLAT + b * CTXL, 36,
                                  MIX + qrow * DM + 256 + hq * 64, NoHook{}, shm, wv);
    }
    {
        const int grp = 4 * x + (ci >> 3), b = grp >> 2, h = grp & 3, r0 = 4 * (ci & 7);
        const int kr0 = (r0 == 0) ? 0 : (r0 == 28 ? 24 : r0 - 4), nr = (r0 == 0 || r0 == 28) ? 8 : 12;
        LAS float* tab = (LAS float*)((LAS unsigned char*)lds_gen + LDS_NATAB);
        const float* rpb = p.in[I_RPB] + ((size_t)layer * 4 + h) * 15 * 31;
        for (int i = otid(wv); i < 15 * 31; i += NT) tab[i] = rpb[i] * 1.4426950408889634f;
        __syncthreads();
        const size_t qrow = (size_t)b * SEQ + r0 * 64;
        NaHook hook{tab, r0, kr0};
        att::attn_unit<8, NaHook>(P + qrow * DIN + A_Q + h * 64, P + A_K + h * 64, P + A_V + h * 64, NLAT + b * CTXL, 4, b * SEQ + kr0 * 64, 4 + nr,
                                  MIX + qrow * DM + h * 64, hook, shm, wv);
    }
    if (layer == 0 && c < 96) {
        if (c < 32) {
            const int b = c >> 2, h = c & 3; const size_t qrow = (size_t)NLAT + b * CTXL;
            att::attn_unit<8, NoHook>(P + qrow * DIN + A_Q + h * 64, P + A_K + h * 64, P + A_V + h * 64, NLAT + b * CTXL, 4, 0, 4, MIX + qrow * DM + h * 64, NoHook{}, shm, wv);
        } else {
            const int cc = c - 32, b = cc >> 3, hq = cc & 7, kvh = hq >> 2; const size_t qrow = (size_t)NLAT + b * CTXL;
            att::attn_unit<8, NoHook>(P + qrow * DIN + B_Q + hq * 64, P + B_K + kvh * 64, P + B_V + kvh * 64, NLAT + b * CTXL, 4, 0, 4, MIX + qrow * DM + 256 + hq * 64, NoHook{}, shm, wv);
        }
    }
}


namespace pg8 {
struct InProjOrder {
    int G, c, nctx; bool trim;
    __device__ __forceinline__ void init(int G_, int c_, bool trim_) { G = G_; c = c_; trim = trim_; nctx = 8 * (trim_ ? 6 : 11); }
    __device__ __forceinline__ bool next(int i, Unit& u) const {
        constexpr int nM = NLAT / BM, nN = DIN / BM, nwg = nM * nN;
        const int L = i * G + c;
        if (L >= nwg + nctx) return false;
        const int wl = (L % NXCD) * (nwg / NXCD) + L / NXCD;
        const int nig = WGM * nN, gid = wl / nig, fm = gid * WGM;
        const int pm_l = fm + ((wl % nig) % WGM), pn_l = (wl % nig) / WGM;
        const int k = L - nwg, t = k >> 3;
        const int pm_c = 64 + (k & 7), pn_c = trim ? (t + 1 + ((t >= 2) ? 2 : 0) + ((t >= 3) ? 1 : 0)) : t;
        const bool lat = L < nwg;
        u.pm = lat ? pm_l : pm_c; u.pn = lat ? pn_l : pn_c; u.aux = 0;
        return true;
    }
    __device__ __forceinline__ void a_ready(const Unit&) const {}
    __device__ __forceinline__ void done(const Unit&) const {}
};
}

#define XB_TMO      128
#define XB_XCNT(j)  (256  + 64 * (j))
#define XB_XSUB(j)  (1280 + 64 * (j))
#define XB_XGEN(j)  (2304 + 64 * (j))
#define XB_TOP      3328
#define XB_TOPGEN   3392
#define XCD_BAR_WORDS 3456
#define XB_SPIN_CAP (1u << 18)
constexpr int CW_BAR = 4096;
constexpr int LDS_XB = LDS_BYTES - 64;
__device__ __forceinline__ unsigned xb_ld(unsigned* p)              { return __hip_atomic_load(p, __ATOMIC_RELAXED, __HIP_MEMORY_SCOPE_AGENT); }
__device__ __forceinline__ unsigned xb_add(unsigned* p, unsigned v) { return __hip_atomic_fetch_add(p, v, __ATOMIC_RELAXED, __HIP_MEMORY_SCOPE_AGENT); }
__device__ __forceinline__ unsigned xb_xcc_id() { return (unsigned)__builtin_amdgcn_s_getreg((3 << 11) | 20) & 0xFu; }
#define XB_SPIN(cond, bar) do { unsigned _sp = 0; while (cond) { __builtin_amdgcn_s_sleep(1); \
    if ((++_sp & 255u) == 0u) { if (xb_ld(&(bar)[XB_TMO])) break; if (_sp > XB_SPIN_CAP) { atomicAdd(&(bar)[XB_TMO], 1u); break; } } } } while (0)
struct XcdBarrier { unsigned* bar; unsigned x; volatile LAS unsigned* st; };
__device__ __forceinline__ XcdBarrier xcd_barrier_post(unsigned* bar, volatile LAS unsigned* st, int wv) {
    XcdBarrier b; b.bar = bar; b.x = xb_xcc_id(); b.st = st;
    if (otid(wv) == 0) (void)xb_add(&bar[XB_XCNT(b.x)], 1u);
    return b;
}
__device__ __forceinline__ void xcd_barrier_complete(unsigned* bar, unsigned x, unsigned& nloc, unsigned& nx) {
    const unsigned G = gridDim.x * gridDim.y * gridDim.z;
    unsigned sum, cnt, mine, sp = 0u;
    for (;;) {
        sum = 0u; cnt = 0u; mine = 0u;
#pragma unroll
        for (unsigned j = 0; j < 16; ++j) { const unsigned c = xb_ld(&bar[XB_XCNT(j)]); sum += c; cnt += (c > 0u) ? 1u : 0u; mine = (j == x) ? c : mine; }
        if (sum == G) break;
        __builtin_amdgcn_s_sleep(1);
        if ((++sp & 255u) == 0u) { if (xb_ld(&bar[XB_TMO])) break; if (sp > XB_SPIN_CAP) { atomicAdd(&bar[XB_TMO], 1u); break; } }
    }
    nloc = mine > 0u ? mine : 1u; nx = cnt > 0u ? cnt : 1u;
}
__device__ __forceinline__ void xcd_barrier(const XcdBarrier& b, int wv) {
    asm volatile("s_waitcnt vmcnt(0)" ::: "memory");
    __syncthreads();
    if (otid(wv) == 0) {
        unsigned* bar = b.bar; unsigned bx = b.x; asm volatile("" : "+s"(bx));
        __builtin_amdgcn_s_waitcnt(0);
        unsigned nloc = b.st[0], nx = b.st[1];
        if (nloc == 0u) { xcd_barrier_complete(bar, bx, nloc, nx); b.st[0] = nloc; b.st[1] = nx; }
        const unsigned old = xb_add(&bar[XB_XSUB(bx)], 1u);
        const unsigned gen = old / nloc;
        if (old + 1u == (gen + 1u) * nloc) {
            __builtin_amdgcn_fence(__ATOMIC_RELEASE, "agent");
            asm volatile("s_waitcnt vmcnt(0)" ::: "memory");
            const unsigned og = xb_add(&bar[XB_TOP], 1u);
            const unsigned tg = og / nx;
            if (og + 1u == (tg + 1u) * nx) xb_add(&bar[XB_TOPGEN], 1u);
            else XB_SPIN(xb_ld(&bar[XB_TOPGEN]) == tg, bar);
            __builtin_amdgcn_fence(__ATOMIC_ACQUIRE, "agent");
            xb_add(&bar[XB_XGEN(bx)], 1u);
            asm volatile("s_waitcnt vmcnt(0)" ::: "memory");
        } else {
            XB_SPIN(xb_ld(&bar[XB_XGEN(bx)]) == gen, bar);
            __builtin_amdgcn_fence(__ATOMIC_ACQUIRE, "agent");
            asm volatile("s_waitcnt vmcnt(0)" ::: "memory");
        }
    }
    __syncthreads();
}

__global__ void __launch_bounds__(NT, 2) k_mega(Ptrs p) {
    extern __shared__ __attribute__((aligned(16))) unsigned char lds_raw[];
    LAS unsigned char* lds = (LAS unsigned char*)lds_raw;
    cg::grid_group grid = cg::this_grid();
    const int wv = __builtin_amdgcn_readfirstlane(threadIdx.x >> 6);
#define CG_SYNC() do { asm volatile("s_waitcnt vmcnt(0)" ::: "memory"); grid.sync(); __builtin_amdgcn_fence(__ATOMIC_ACQUIRE, "agent"); asm volatile("s_waitcnt vmcnt(0)" ::: "memory"); } while (0)
#define GRID_SYNC() xcd_barrier(xbar, wv)
    if (otid(wv) < 16) ((LAS unsigned*)(lds + LDS_XB))[otid(wv)] = 0u;
    __syncthreads();
    const XcdBarrier xbar = xcd_barrier_post((unsigned*)(p.ws + WS_CTL) + CW_BAR, (volatile LAS unsigned*)(lds + LDS_XB), wv);
    const int NGW = gridDim.x * NWAVES;
    phase_mod(p, lds, wv);
    phase_lb(p, wv);
    __syncthreads();
    phase_convert(p, lds, 0, 1, wv, blockIdx.x * NWAVES + wv, gridDim.x * NWAVES);
    phase_router_w(p, wv);
    if (p.pad != 0) CG_SYNC();
    GRID_SYNC();
    phase_gs2(p, wv);
    phase_norm(p.in[I_X], p.in[I_CTX], p.in[I_N1G], (const float*)(p.ws + WS_MOD), 0, 1, (bf16*)(p.ws + WS_H), MROWS, wv);
    GRID_SYNC();
    for (int layer = 0; layer < 2; ++layer) {
        const int M = (layer == 0) ? MROWS : NLAT;
        const float* modl = (const float*)(p.ws + WS_MOD) + (size_t)layer * 9 * MODW;
        {
            pg8::Gemm g{(const bf16*)(p.ws + WS_H), (const bf16*)(p.ws + WS_WIN + layer * WIN_STRIDE), MROWS, DIN, DM};
            pg8::InProjOrder S; S.init(gridDim.x, (int)blockIdx.x, layer == 1);
            pg8::EpiInProj E{(bf16*)(p.ws + WS_P), p.in[I_NAQN] + layer * 64, p.in[I_NAKN] + layer * 64, p.in[I_GQQN] + layer * 64, p.in[I_GQKN] + layer * 64, wv};
            pg8::gemm_phase<pg8::EpiInProj, pg8::InProjOrder, true, true>(lds, g, S, E, wv);
        }
        GRID_SYNC();
        phase_hgrn1(p, lds, layer, wv);
        GRID_SYNC();
        phase_hgrn_scan(p, wv);
        GRID_SYNC();
        phase_hgrn2(p, lds, layer, wv);
        __syncthreads();
        phase_attn(p, lds_raw, layer, wv);
        GRID_SYNC();
        {
            pg8::Gemm g{(const bf16*)(p.ws + WS_MIX), (const bf16*)(p.ws + WS_WOUT + layer * WOUT_STRIDE), M, DM, DM};
            pg8::StaticOrder S; S.init(M, DM, gridDim.x, (int)blockIdx.x);
            pg8::EpiResidSS E{layer == 0 ? p.in[I_X] : p.out, p.in[I_CTX], p.out, (float*)(p.ws + WS_XC), modl, 2, (float*)(p.ws + WS_RSS), wv};
            pg8::gemm_phase<pg8::EpiResidSS, pg8::StaticOrder, true, true>(lds, g, S, E, wv);
            const int extra = (MROWS / 256) * (DM / 256) - (int)gridDim.x;
            if (layer == 0) { if (extra <= 0) phase_convert(p, lds, 1, 2, wv, blockIdx.x * NWAVES + wv, gridDim.x * NWAVES);
                              else if ((int)blockIdx.x >= extra) phase_convert(p, lds, 1, 2, wv, ((int)blockIdx.x - extra) * NWAVES + wv, ((int)gridDim.x - extra) * NWAVES); }
        }
        GRID_SYNC();
        phase_route(p, lds, layer, M, wv);
        GRID_SYNC();
        phase_moe_gu(p, lds, layer, wv);
        GRID_SYNC();
        phase_moe_down(p, lds, layer, wv);
        GRID_SYNC();
        phase_combine(p, layer, M, layer == 0, wv);
        if (layer == 0) GRID_SYNC();
    }
}

extern "C" void kernel_launch(void* const* d_in, const int* in_sizes, int n_in, void* d_out, int out_size, void* d_ws, size_t ws_size, hipStream_t stream) {
    static int grid = 0;
    if (grid == 0) {
        if (n_in != 24 || ws_size < WS_END) { fprintf(stderr, "kernel_launch: bad n_in %d or ws_size %zu < %zu\n", n_in, ws_size, (size_t)WS_END); grid = -1; return; }
        int dev = 0, cus = 0, per_cu = 0;
        hipGetDevice(&dev); hipDeviceGetAttribute(&cus, hipDeviceAttributeMultiprocessorCount, dev);
        hipFuncSetAttribute((const void*)k_mega, hipFuncAttributeMaxDynamicSharedMemorySize, LDS_BYTES);
        hipOccupancyMaxActiveBlocksPerMultiprocessor(&per_cu, (const void*)k_mega, NT, LDS_BYTES);
        if (per_cu < 1) { fprintf(stderr, "kernel_launch: occupancy query says %d blocks/CU\n", per_cu); grid = -1; return; }
        grid = cus;
        (void)hipGetLastError();
    }
    if (grid < 0) return;
    Ptrs p{};
    for (int i = 0; i < 24; ++i) p.in[i] = (const float*)d_in[i];
    p.out = (float*)d_out; p.ws = (unsigned char*)d_ws; p.layer = 0; p.pad = 0;
    hipMemsetAsync((unsigned char*)d_ws + WS_CTL, 0, 1 * MiB, stream);
    void* args[] = {&p};
    hipError_t e = hipLaunchCooperativeKernel((const void*)k_mega, dim3(grid), dim3(NT), args, LDS_BYTES, stream);
    if (e != hipSuccess) fprintf(stderr, "cooperative launch failed: %s\n", hipGetErrorString(e));
}
```

```cpp
#include <hip/hip_runtime.h>
#include <hip/hip_cooperative_groups.h>
#include <cstdio>
#include <cstdint>
#include <math.h>
namespace cg = cooperative_groups;

#define DM 1024
#define SEQ 2048
#define CTXL 256
#define NBATCH 8
#define NLAT (NBATCH * SEQ)
#define NCTX (NBATCH * CTXL)
#define MROWS (NLAT + NCTX)
#define DIN 2816
#define NMOD 6
#define MODW (NMOD * DM)
#define A_Q 0
#define A_K 256
#define A_V 512
#define B_Q 768
#define B_K 1280
#define B_V 1408
#define C_Q 1536
#define C_I 1792
#define C_FF 2048
#define C_FB 2304
#define C_G 2560

typedef unsigned short bf16;
#define LAS __attribute__((address_space(3)))
#define GAS __attribute__((address_space(1)))
typedef unsigned v4u __attribute__((ext_vector_type(4)));
typedef unsigned v2u __attribute__((ext_vector_type(2)));
typedef float v4f __attribute__((ext_vector_type(4)));

__device__ __forceinline__ unsigned f2bf(float f) { unsigned u = __builtin_bit_cast(unsigned, f); return (u + 0x7fffu + ((u >> 16) & 1u)) >> 16; }
__device__ __forceinline__ unsigned pk2(float lo, float hi) { return f2bf(lo) | (f2bf(hi) << 16); }
__device__ __forceinline__ float bf2f(unsigned short v) { return __builtin_bit_cast(float, (unsigned)v << 16); }
__device__ __forceinline__ float bflo(unsigned v) { return __builtin_bit_cast(float, v << 16); }
__device__ __forceinline__ float bfhi(unsigned v) { return __builtin_bit_cast(float, v & 0xffff0000u); }
__device__ __forceinline__ float silu_f(float x) { return x / (1.f + __expf(-x)); }
__device__ __forceinline__ float shx(float v, int mask, int lane) { return __builtin_bit_cast(float, __builtin_amdgcn_ds_bpermute((lane ^ mask) << 2, __builtin_bit_cast(int, v))); }
__device__ __forceinline__ float wave_sum(float v, int lane) {
#pragma unroll
    for (int o = 1; o < 64; o <<= 1) v += shx(v, o, lane);
    return v;
}
__device__ __forceinline__ int otid(int wv) { unsigned m = ~0u; asm volatile("" : "+s"(m)); asm volatile("" : "+s"(wv)); return wv * 64 + (int)__builtin_amdgcn_mbcnt_hi(m, __builtin_amdgcn_mbcnt_lo(m, 0u)); }
#define LDS_WAIT() asm volatile("s_waitcnt lgkmcnt(0)" ::: "memory")

constexpr size_t MiB = 1u << 20;
constexpr size_t WS_CTL = 0;
constexpr size_t WS_MOD = 1 * MiB;
constexpr size_t WS_LB = 1 * MiB + 512 * 1024;
constexpr size_t WS_EID = 2 * MiB;
constexpr size_t WS_EW = 2 * MiB + 256 * 1024;
constexpr size_t WS_IDX = 3 * MiB;
constexpr size_t WS_XC = 8 * MiB;
constexpr size_t WS_WIN = 16 * MiB;
constexpr size_t WIN_STRIDE = (size_t)DIN * DM * 2;
constexpr size_t WS_WOUT = 28 * MiB;
constexpr size_t WOUT_STRIDE = 2 * MiB;
constexpr size_t WS_WGU = 32 * MiB;
constexpr size_t WGU_STRIDE = 32 * MiB;
constexpr size_t WS_WD = 96 * MiB;
constexpr size_t WD_STRIDE = 16 * MiB;
constexpr size_t WS_H = 128 * MiB;
constexpr size_t WS_MIX = 164 * MiB;
constexpr size_t WS_P = 200 * MiB;
constexpr size_t WS_Y0 = 200 * MiB;
constexpr size_t WS_Y1 = 236 * MiB;
constexpr size_t WS_HID = 272 * MiB;
constexpr size_t WS_SCR = 300 * MiB;
constexpr size_t WS_END = 340 * MiB;

constexpr int NT = 512, NWAVES = 8;
constexpr int LDS_BYTES = 147456;
namespace pg8 {
#define PG8_LAS __attribute__((address_space(3)))
typedef unsigned short bf16_t;
typedef short bf16x8 __attribute__((ext_vector_type(8)));
typedef float f32x4 __attribute__((ext_vector_type(4)));
typedef unsigned u32x4 __attribute__((ext_vector_type(4)));
constexpr int BM = 256, BK = 64, HALF = 128, HTB = HALF * BK * 2  , STAGE_BYTES = 8 * HTB, NXCD = 8, WGM = 8;

__host__ __device__ __forceinline__ int lds_byte(int r, int c) { const int st = (r >> 4) * 2 + (c >> 5), rr = r & 15, cc = c & 31, ob = rr * 64 + cc * 2; return st * 1024 + (ob ^ (((ob >> 9) & 1) << 5)); }
__host__ __device__ __forceinline__ void stage_rc(int b, int& R, int& C) { const int st = b / 1024, sb = b % 1024, swz = sb ^ (((sb >> 9) & 1) << 5); R = (st >> 1) * 16 + swz / 64; C = (st & 1) * 32 + (swz % 64) / 2; }
__host__ __device__ __forceinline__ int perm32(int rho) { const int n = rho >> 4, i = rho & 15; return 8 * (i >> 2) + 4 * n + (i & 3); }

struct Unit { int pm, pn, aux; };
struct Gemm { const bf16_t* A; const bf16_t* Bt; int M, N, K; };

struct StaticOrder {
    int nM, nN, nwg, G, c;
    __host__ __device__ void init(int M, int N, int G_, int c_) { nM = M / BM; nN = N / BM; nwg = nM * nN; G = G_; c = c_; }
    __host__ __device__ bool next(int i, Unit& u) const {
        const long L = (long)i * G + c; if (L >= nwg) return false;
        int wgid = (int)L; { const int q = nwg / NXCD, r = nwg % NXCD, xcd = wgid % NXCD, off = wgid / NXCD; wgid = (xcd < r ? xcd * (q + 1) : r * (q + 1) + (xcd - r) * q) + off; }
        const int nig = WGM * nN, gid = wgid / nig, fm = gid * WGM, gsz = (nM - fm) < WGM ? (nM - fm) : WGM;
        u.pm = fm + ((wgid % nig) % gsz); u.pn = (wgid % nig) / gsz; return true;
    }
    __device__ __forceinline__ void a_ready(const Unit&) const {}
    __device__ __forceinline__ void done(const Unit&) const {}
};

__device__ __forceinline__ unsigned cvt_pk_bf16(float lo, float hi) { unsigned r; asm volatile("v_cvt_pk_bf16_f32 %0, %1, %2" : "=v"(r) : "v"(lo), "v"(hi)); return r; }
typedef float f32x2 __attribute__((ext_vector_type(2)));
__device__ __forceinline__ f32x2 gelu_pk(f32x2 v) {
    const f32x2 av = __builtin_elementwise_abs(v), d = av * 0.2316418882f + 1.0f;
    f32x2 t; t.x = __builtin_amdgcn_rcpf(d.x); t.y = __builtin_amdgcn_rcpf(d.y);
    f32x2 q = t * 0.5307027145f + (-0.7265760135f); q = q * t + 0.7107068705f; q = q * t + (-0.142248368f); q = q * t + 0.127414796f; q = q * t;
    const f32x2 s = (v * v) * (-0.72134752044f);
    f32x2 e; e.x = __builtin_amdgcn_exp2f(s.x); e.y = __builtin_amdgcn_exp2f(s.y);
    const f32x2 m = v * (q * e), r = v - m;
    f32x2 o; o.x = v.x < 0.f ? m.x : r.x; o.y = v.y < 0.f ? m.y : r.y; return o;
}

template <int ACT  > struct EpiBf16 {
    static constexpr bool PERM = true, AFTER_DRAIN = false; static_assert(ACT == 0 || ACT == 1, "EpiBf16: ACT is 0 (none) or 1 (gelu_pk)");
    bf16_t* O; int ldc; const float* bias; int split_cols; size_t split_stride; float scale0;
    __device__ __forceinline__ void operator()(const f32x4 (&acc)[2][2][4][2], const Unit& u, int wr, int wc, int fr, int fq) const {
        const int row0 = u.pm * BM + wr * 64 + fr; int colt = u.pn * BM; bf16_t* base = O;
        float sc = 1.f; if (split_cols) { const int t = colt / split_cols; base += (size_t)t * split_stride; colt -= t * split_cols; if (t == 0) sc = scale0; }
        const int col0 = colt + wc * 32 + 8 * fq, bcol0 = u.pn * BM + wc * 32 + 8 * fq;
        f32x4 bv[2][2];
#pragma unroll
        for (int bj = 0; bj < 2; ++bj)
#pragma unroll
            for (int n = 0; n < 2; ++n) bv[bj][n] = bias ? *(const f32x4*)(bias + bcol0 + bj * HALF + 4 * n) : (f32x4){0.f, 0.f, 0.f, 0.f};
#pragma unroll
        for (int ai = 0; ai < 2; ++ai)
#pragma unroll
            for (int m = 0; m < 4; ++m) { bf16_t* rowp = base + (size_t)(row0 + ai * HALF + m * 16) * ldc + col0;
#pragma unroll
                for (int bj = 0; bj < 2; ++bj) { f32x4 v0 = acc[ai][bj][m][0] + bv[bj][0], v1 = acc[ai][bj][m][1] + bv[bj][1];
                    if (ACT == 1) { f32x2 a = gelu_pk((f32x2){v0[0], v0[1]}), b = gelu_pk((f32x2){v0[2], v0[3]}), c = gelu_pk((f32x2){v1[0], v1[1]}), d = gelu_pk((f32x2){v1[2], v1[3]});
                        v0 = (f32x4){a.x, a.y, b.x, b.y}; v1 = (f32x4){c.x, c.y, d.x, d.y}; }
                    v0 = v0 * sc; v1 = v1 * sc; u32x4 w; w.x = cvt_pk_bf16(v0[0], v0[1]); w.y = cvt_pk_bf16(v0[2], v0[3]); w.z = cvt_pk_bf16(v1[0], v1[1]); w.w = cvt_pk_bf16(v1[2], v1[3]);
                    *(u32x4*)(rowp + bj * HALF) = w; } }
    }
};

template <class Epi, class Sched, bool ALIGN_EPI = false, bool SP2 = false, bool GATHER = false>
__device__ __forceinline__ void gemm_phase(PG8_LAS unsigned char* lds, const Gemm g, const Sched& S, const Epi& E, int wv, const PG8_LAS int* gidx = nullptr) {
    static_assert(SP2 || !GATHER, "GATHER is wired into the SP2 loop only");
    int tid_ = otid(wv);
    const int tid = tid_, wid = __builtin_amdgcn_readfirstlane(tid >> 6), lane = tid & 63, wr = wid >> 2, wc = wid & 3, fr = lane & 15, fq = lane >> 4;
    const int K = g.K, nt = K / BK;
    unsigned voffA[2][2], nvoffA[2][2], voffB[2]; int RA[2], CA[2];
#pragma unroll
    for (int i = 0; i < 2; ++i) { int R, C; stage_rc(tid * 16 + i * 8192, R, C); const int Rb = Epi::PERM ? ((R & ~31) + perm32(R & 31)) : R; RA[i] = R; CA[i] = C;
        voffA[0][i] = voffA[1][i] = nvoffA[0][i] = nvoffA[1][i] = (unsigned)(R * K + C) * 2u; voffB[i] = (unsigned)(Rb * K + C) * 2u; }
#define PG8_GVOFF(dst, uidx) do { if constexpr (GATHER) { _Pragma("unroll") for (int _h = 0; _h < 2; ++_h) _Pragma("unroll") for (int _i = 0; _i < 2; ++_i) dst[_h][_i] = (unsigned)(gidx[(uidx) * 256 + _h * 128 + RA[_i]] * K + CA[_i]) * 2u; } } while (0)
    const size_t kstep = (size_t)(BK * 2);
    const size_t hstep = (size_t)HALF * K * 2;
    const size_t hstepA = GATHER ? (size_t)0 : hstep;
    const size_t tstep = 2 * hstep;
    const unsigned ldsw = (unsigned)wid * 1024u;
    const int aoff = lds_byte(wr * 64 + fr, fq * 8), boff = lds_byte(wc * 32 + fr, fq * 8);
#define PG8_SA(b, h) (((b) * 2 + (h)) * HTB)
#define PG8_SB(b, h) ((4 + (b) * 2 + (h)) * HTB)
#define PG8_STAGE(bufoff, gbase, voff) do { _Pragma("unroll") for (int _i = 0; _i < 2; ++_i) \
        __builtin_amdgcn_global_load_lds((const unsigned*)((const char*)(gbase) + (voff)[_i]), (PG8_LAS unsigned*)(lds + (bufoff) + ldsw + _i * 8192), 16, 0, 0); } while (0)
#define PG8_LDA(dst, b, h) do { _Pragma("unroll") for (int m = 0; m < 4; ++m) _Pragma("unroll") for (int k = 0; k < 2; ++k) dst[m][k] = *(const PG8_LAS bf16x8*)(lds + PG8_SA(b, h) + aoff + m * 2048 + k * 1024); } while (0)
#define PG8_LDB(dst, b, h) do { _Pragma("unroll") for (int n = 0; n < 2; ++n) _Pragma("unroll") for (int k = 0; k < 2; ++k) dst[n][k] = *(const PG8_LAS bf16x8*)(lds + PG8_SB(b, h) + boff + n * 2048 + k * 1024); } while (0)
#define PG8_MMA(ai, bj, At, Bt) do { __builtin_amdgcn_s_setprio(1); _Pragma("unroll") for (int m = 0; m < 4; ++m) _Pragma("unroll") for (int n = 0; n < 2; ++n) _Pragma("unroll") for (int k = 0; k < 2; ++k) \
        acc[ai][bj][m][n] = __builtin_amdgcn_mfma_f32_16x16x32_bf16(Bt[n][k], At[m][k], acc[ai][bj][m][n], 0, 0, 0); __builtin_amdgcn_s_setprio(0); } while (0)
#define PG8_WAIT_V(n) asm volatile("s_waitcnt vmcnt(" #n ")" ::: "memory")
#define PG8_WAIT_L(n) asm volatile("s_waitcnt lgkmcnt(" #n ")" ::: "memory")
#define PG8_BAR __builtin_amdgcn_s_barrier()
#define PG8_SCHED __builtin_amdgcn_sched_barrier(0)
    Unit cur, nxt; int ui = 0;
    if (!S.next(0, cur)) return;
    f32x4 acc[2][2][4][2];
#pragma unroll
    for (int a = 0; a < 2; ++a)
#pragma unroll
        for (int b = 0; b < 2; ++b)
#pragma unroll
            for (int m = 0; m < 4; ++m)
#pragma unroll
                for (int n = 0; n < 2; ++n) acc[a][b][m][n] = (f32x4){0.f, 0.f, 0.f, 0.f};
    bf16x8 At[4][2], B0[2][2], B1[2][2];
    const char* cA = (const char*)g.A + (GATHER ? (size_t)0 : (size_t)cur.pm * tstep); PG8_GVOFF(voffA, 0); const char* cB = (const char*)g.Bt + (size_t)cur.pn * tstep;
    S.a_ready(cur);
    if constexpr (SP2) {
        PG8_STAGE(PG8_SB(0, 0), cB, voffB); PG8_STAGE(PG8_SB(0, 1), cB + hstep, voffB); PG8_STAGE(PG8_SA(0, 0), cA, voffA[0]); PG8_STAGE(PG8_SA(0, 1), cA + hstepA, voffA[1]);
        if (wr == 1) PG8_BAR;
        PG8_WAIT_V(2); PG8_BAR;
        PG8_STAGE(PG8_SB(1, 0), cB + kstep, voffB); PG8_STAGE(PG8_SA(1, 0), cA + kstep, voffA[0]); PG8_STAGE(PG8_SB(1, 1), cB + hstep + kstep, voffB);
        PG8_WAIT_V(6); PG8_BAR;
    } else {
        PG8_STAGE(PG8_SB(0, 0), cB, voffB); PG8_STAGE(PG8_SA(0, 0), cA, voffA[0]); PG8_STAGE(PG8_SB(0, 1), cB + hstep, voffB); PG8_STAGE(PG8_SA(0, 1), cA + hstep, voffA[0]);
        if (wr == 1) PG8_BAR;
        PG8_WAIT_V(4); PG8_BAR;
        PG8_STAGE(PG8_SB(1, 0), cB + kstep, voffB); PG8_STAGE(PG8_SA(1, 0), cA + kstep, voffA[0]); PG8_STAGE(PG8_SB(1, 1), cB + hstep + kstep, voffB);
        PG8_WAIT_V(6); PG8_BAR;
    }
    for (;;) {
        const bool has_next = S.next(ui + 1, nxt);
        const char* nA = (has_next && !GATHER) ? (const char*)g.A + (size_t)nxt.pm * tstep : cA; if (has_next) PG8_GVOFF(nvoffA, ui + 1); const char* nB = has_next ? (const char*)g.Bt + (size_t)nxt.pn * tstep : cB;
        for (int t = 0; t < nt; t += 2) {
            const bool last = (t == nt - 2);
            const char* a1 = cA + (size_t)(t + 1) * kstep;
            const char* a2 = last ? nA : cA + (size_t)(t + 2) * kstep; const char* b2 = last ? nB : cB + (size_t)(t + 2) * kstep;
            const char* a3 = a2 + kstep; const char* b3 = b2 + kstep;
            if (last && has_next) S.a_ready(nxt);
            unsigned vs2[2][2];
#pragma unroll
            for (int _h = 0; _h < 2; ++_h)
#pragma unroll
                for (int _i = 0; _i < 2; ++_i) vs2[_h][_i] = last ? nvoffA[_h][_i] : voffA[_h][_i];
            if constexpr (SP2) {
            PG8_LDB(B0, 0, 0); PG8_LDB(B1, 0, 1); PG8_SCHED; PG8_LDA(At, 0, 0); PG8_STAGE(PG8_SA(1, 1), a1 + hstepA, voffA[1]);
            PG8_WAIT_V(8); PG8_WAIT_L(0); PG8_BAR; PG8_MMA(0, 0, At, B0); PG8_MMA(0, 1, At, B1); PG8_BAR; PG8_SCHED;
            PG8_LDA(At, 0, 1); PG8_STAGE(PG8_SB(0, 0), b2, voffB); PG8_STAGE(PG8_SB(0, 1), b2 + hstep, voffB); PG8_STAGE(PG8_SA(0, 0), a2, vs2[0]);
            PG8_WAIT_V(8); PG8_WAIT_L(0); PG8_BAR; PG8_MMA(1, 0, At, B0); PG8_MMA(1, 1, At, B1); PG8_BAR; PG8_SCHED;
            PG8_LDB(B0, 1, 0); PG8_LDB(B1, 1, 1); PG8_SCHED; PG8_LDA(At, 1, 0); PG8_STAGE(PG8_SA(0, 1), a2 + hstepA, vs2[1]);
            PG8_WAIT_V(8); PG8_WAIT_L(0); PG8_BAR; PG8_MMA(0, 0, At, B0); PG8_MMA(0, 1, At, B1); PG8_BAR; PG8_SCHED;
            PG8_LDA(At, 1, 1); PG8_STAGE(PG8_SB(1, 0), b3, voffB); PG8_STAGE(PG8_SB(1, 1), b3 + hstep, voffB); PG8_STAGE(PG8_SA(1, 0), a3, vs2[0]);
            PG8_WAIT_V(8); PG8_WAIT_L(0); PG8_BAR; PG8_MMA(1, 0, At, B0); PG8_MMA(1, 1, At, B1); PG8_BAR; PG8_SCHED;
            } else {
            PG8_LDB(B0, 0, 0); PG8_SCHED; PG8_LDA(At, 0, 0); PG8_STAGE(PG8_SA(1, 1), a1 + hstep, voffA[0]);
            PG8_WAIT_L(8); PG8_BAR; PG8_WAIT_L(0); PG8_MMA(0, 0, At, B0); PG8_BAR; PG8_SCHED;
            PG8_LDB(B1, 0, 1); PG8_STAGE(PG8_SB(0, 0), b2, voffB);
            PG8_BAR; PG8_WAIT_L(0); PG8_MMA(0, 1, At, B1); PG8_BAR;
            PG8_LDA(At, 0, 1); PG8_STAGE(PG8_SA(0, 0), a2, voffA[0]);
            PG8_BAR; PG8_WAIT_L(0); PG8_MMA(1, 0, At, B0); PG8_BAR; PG8_SCHED;
            PG8_STAGE(PG8_SB(0, 1), b2 + hstep, voffB);
            PG8_WAIT_V(6); PG8_BAR; PG8_MMA(1, 1, At, B1); PG8_BAR;
            PG8_LDB(B0, 1, 0); PG8_SCHED; PG8_LDA(At, 1, 0); PG8_STAGE(PG8_SA(0, 1), a2 + hstep, voffA[0]);
            PG8_WAIT_L(8); PG8_BAR; PG8_WAIT_L(0); PG8_MMA(0, 0, At, B0); PG8_BAR; PG8_SCHED;
            PG8_LDB(B1, 1, 1); PG8_STAGE(PG8_SB(1, 0), b3, voffB);
            PG8_BAR; PG8_WAIT_L(0); PG8_MMA(0, 1, At, B1); PG8_BAR;
            PG8_LDA(At, 1, 1); PG8_STAGE(PG8_SA(1, 0), a3, voffA[0]);
            PG8_BAR; PG8_WAIT_L(0); PG8_MMA(1, 0, At, B0); PG8_BAR; PG8_SCHED;
            PG8_STAGE(PG8_SB(1, 1), b3 + hstep, voffB);
            PG8_WAIT_V(6); PG8_BAR; PG8_MMA(1, 1, At, B1); PG8_BAR;
            }
        }
        if constexpr (ALIGN_EPI) { if (wr == 0) PG8_BAR; }
        if constexpr (!Epi::AFTER_DRAIN) { E(acc, cur, wr, wc, fr, fq); S.done(cur); }
        if (!has_next) break;
#pragma unroll
        for (int a = 0; a < 2; ++a)
#pragma unroll
            for (int b = 0; b < 2; ++b)
#pragma unroll
                for (int m = 0; m < 4; ++m)
#pragma unroll
                    for (int n = 0; n < 2; ++n) acc[a][b][m][n] = (f32x4){0.f, 0.f, 0.f, 0.f};
        cur = nxt; cA = nA; cB = nB; ++ui;
#pragma unroll
        for (int _h = 0; _h < 2; ++_h)
#pragma unroll
            for (int _i = 0; _i < 2; ++_i) voffA[_h][_i] = nvoffA[_h][_i];
        if constexpr (ALIGN_EPI) { if (wr == 1) PG8_BAR; }
    }
    PG8_WAIT_V(0);
    if constexpr (!ALIGN_EPI) { if (wr == 0) PG8_BAR; }
    PG8_BAR;
    if constexpr (Epi::AFTER_DRAIN) { E.fused(acc, cur, wr, wc, fr, fq, lds, wid, lane); S.done(cur); }
#undef PG8_SA
#undef PG8_GVOFF
#undef PG8_SB
#undef PG8_STAGE
#undef PG8_LDA
#undef PG8_LDB
#undef PG8_MMA
#undef PG8_WAIT_V
#undef PG8_WAIT_L
#undef PG8_BAR
#undef PG8_SCHED
}
}


struct Ptrs { const float* in[24]; float* out; unsigned char* ws; int layer; int pad; };
enum { I_X = 0, I_C, I_CTX, I_CCTX, I_WADA, I_BADA, I_N1G, I_WIN, I_NAQN, I_NAKN, I_RPB, I_GQQN, I_GQKN, I_LB, I_HGON, I_WOUT, I_N2G, I_WRG, I_BRG, I_WRE, I_BRE, I_WEG, I_WEU, I_WED };

namespace pg8 {
struct EpiResid {
    static constexpr bool PERM = false, AFTER_DRAIN = false;
    const float* xin_lat; const float* xin_ctx; float* xout_lat; float* xout_ctx; const float* modl; int chunk;
    __device__ __forceinline__ void operator()(const f32x4 (&acc)[2][2][4][2], const Unit& u, int wr, int wc, int fr, int fq) const {
        const int rowt = u.pm * BM; const bool isctx = rowt >= NLAT;
        const float* xin = isctx ? xin_ctx + (size_t)(rowt - NLAT) * DM : xin_lat + (size_t)rowt * DM;
        float* xo = isctx ? xout_ctx + (size_t)(rowt - NLAT) * DM : xout_lat + (size_t)rowt * DM;
        const int mrow = isctx ? 8 : (rowt >> 11);
        const float* gate = modl + (size_t)mrow * MODW + chunk * DM;
        const int col0 = u.pn * BM + wc * 32 + 4 * fq;
#pragma unroll
        for (int bj = 0; bj < 2; ++bj)
#pragma unroll
            for (int n = 0; n < 2; ++n) {
                const int col = col0 + bj * HALF + n * 16;
                const f32x4 gv = *(const f32x4*)(gate + col);
#pragma unroll
                for (int ai = 0; ai < 2; ++ai)
#pragma unroll
                    for (int m = 0; m < 4; ++m) {
                        const size_t off = (size_t)(ai * HALF + wr * 64 + m * 16 + fr) * DM + col;
                        const f32x4 xi = *(const f32x4*)(xin + off);
                        *(f32x4*)(xo + off) = xi + gv * acc[ai][bj][m][n];
                    }
            }
    }
};
}

__device__ __forceinline__ void phase_mod(const Ptrs& p, LAS unsigned char* lds, int wv) {
    if (blockIdx.x >= 192) return;
    LAS float* sc = (LAS float*)lds;
    LAS float* red = (LAS float*)(lds + 36864);
    const int tid = otid(wv);
    const float* c = p.in[I_C]; const float* cc = p.in[I_CCTX];
    for (int i = tid; i < 9 * DM; i += NT) { float v = (i < 8 * DM) ? c[i] : cc[i - 8 * DM]; sc[i] = silu_f(v); }
    __syncthreads();
    float* mod = (float*)(p.ws + WS_MOD);
    for (int u = blockIdx.x; u < 192; u += gridDim.x) {
        const int layer = u / 96, cb = u % 96, cq = tid & 15, kg = tid >> 4;
        const float* w = p.in[I_WADA] + (size_t)layer * DM * MODW + cb * 64 + cq * 4;
        v4f acc[9];
#pragma unroll
        for (int r = 0; r < 9; ++r) acc[r] = (v4f){0.f, 0.f, 0.f, 0.f};
        for (int i = 0; i < 32; ++i) {
            const int k = kg + 32 * i;
            const v4f wv = *(const v4f*)(w + (size_t)k * MODW);
#pragma unroll
            for (int r = 0; r < 9; ++r) acc[r] += sc[r * DM + k] * wv;
        }
#pragma unroll
        for (int r = 0; r < 9; ++r) *(LAS v4f*)(red + (kg * 9 + r) * 64 + cq * 4) = acc[r];
        __syncthreads();
        for (int o = tid; o < 576; o += NT) {
            const int r = o >> 6, c2 = o & 63; float s = 0.f;
            for (int k2 = 0; k2 < 32; ++k2) s += red[(k2 * 9 + r) * 64 + c2];
            mod[((size_t)layer * 9 + r) * MODW + cb * 64 + c2] = s + p.in[I_BADA][layer * MODW + cb * 64 + c2];
        }
        __syncthreads();
    }
}
__device__ __forceinline__ void phase_lb(const Ptrs& p, int wv) {
    if (blockIdx.x == 255 % gridDim.x) {
        const int i = otid(wv);
        const float* raw = p.in[I_LB]; float* lb = (float*)(p.ws + WS_LB);
        float l0 = raw[i], l1 = raw[512 + i];
        lb[i] = 0.f; lb[512 + i] = 1.f / (1.f + __expf(l0 - l1));
    }
}
__device__ __forceinline__ void transpose_item(const float* W, int K, int N, bf16* WT, int row_off, LAS float* scr, int item, int lane) {
    const int nblk = N / 32, kb = item / nblk, nb = item % nblk, k0 = 64 * kb, n0 = 32 * nb;
#pragma unroll 8
    for (int i = 0; i < 32; ++i) { const int kk = 2 * i + (lane >> 5); scr[kk * 33 + (lane & 31)] = W[(size_t)(k0 + kk) * N + n0 + (lane & 31)]; }
    LDS_WAIT(); asm volatile("" ::: "memory");
    const int c = lane & 7;
#pragma unroll
    for (int j = 0; j < 4; ++j) { const int n = (lane >> 3) + 8 * j; const LAS float* s = scr + (8 * c) * 33 + n;
        v4u o; o.x = pk2(s[0 * 33], s[1 * 33]); o.y = pk2(s[2 * 33], s[3 * 33]); o.z = pk2(s[4 * 33], s[5 * 33]); o.w = pk2(s[6 * 33], s[7 * 33]);
        *(v4u*)(WT + (size_t)(row_off + n0 + n) * K + k0 + 8 * c) = o; }
    LDS_WAIT(); asm volatile("" ::: "memory");
}
constexpr int CI_IN = 16 * 88, CI_OUT = 16 * 32, CI_G = 32 * 128, CI_U = 32 * 128, CI_D = 32 * 128, CI_LAYER = CI_IN + CI_OUT + CI_G + CI_U + CI_D;
__device__ __forceinline__ void phase_convert(const Ptrs& p, LAS unsigned char* lds, int layer_lo, int layer_hi, int wv) {
    const int lane = otid(wv) & 63, wave = wv;
    LAS float* scr = (LAS float*)(lds + wave * 16384);
    const int gw = blockIdx.x * NWAVES + wave, NGW = gridDim.x * NWAVES;
    const int n_items = (layer_hi - layer_lo) * CI_LAYER;
    for (int it = gw; it < n_items; it += NGW) {
        const int layer = layer_lo + it / CI_LAYER; int r = it % CI_LAYER;
        if (r < CI_IN) {
            const int n0 = 32 * (r % 88), pn_ = n0 >> 8, w_ = (n0 >> 6) & 3, bj_ = (n0 >> 5) & 1;
            transpose_item(p.in[I_WIN] + (size_t)layer * DM * DIN, DM, DIN, (bf16*)(p.ws + WS_WIN + layer * WIN_STRIDE), (256 * pn_ + 128 * bj_ + 32 * w_) - n0, scr, r, lane); continue; } r -= CI_IN;
        if (r < CI_OUT) { transpose_item(p.in[I_WOUT] + (size_t)layer * DM * DM, DM, DM, (bf16*)(p.ws + WS_WOUT + layer * WOUT_STRIDE), 0, scr, r, lane); continue; } r -= CI_OUT;
        if (r < CI_G + CI_U) {
            const int up = r >= CI_G; if (up) r -= CI_G;
            const int e = r >> 7, rem = r & 127, nb = rem & 7, n0 = 32 * nb;
            const int mapped = (n0 >> 7) * 256 + (n0 & 127) + (up ? 128 : 0);
            transpose_item(p.in[up ? I_WEU : I_WEG] + ((size_t)layer * 32 + e) * DM * 256, DM, 256, (bf16*)(p.ws + WS_WGU + layer * WGU_STRIDE) + (size_t)e * 512 * DM, mapped - n0, scr, rem, lane);
            continue;
        }
        r -= CI_G + CI_U;
        { const int e = r >> 7, rem = r & 127;
          transpose_item(p.in[I_WED] + ((size_t)layer * 32 + e) * 256 * DM, 256, DM, (bf16*)(p.ws + WS_WD + layer * WD_STRIDE) + (size_t)e * DM * 256, 0, scr, rem, lane); }
    }
}
__device__ __forceinline__ void phase_norm(const float* xlat, const float* xctx, const float* g, const float* modl, int ch_shift, int ch_scale, bf16* H, int nrows, int wv) {
    const int lane = otid(wv) & 63, wave = wv;
    const int gw = blockIdx.x * NWAVES + wave, NGW = gridDim.x * NWAVES;
    const int per = (nrows + NGW - 1) / NGW;
    const int r0 = gw * per, r1 = min(r0 + per, nrows);
    const unsigned lc = 4 * lane;
    int cur = -1; v4f gs[4], sh[4], xn[4];
    if (r0 < r1) { const float* xr = (r0 < NLAT) ? xlat + (size_t)r0 * DM : xctx + (size_t)(r0 - NLAT) * DM;
#pragma unroll
        for (int j = 0; j < 4; ++j) xn[j] = *(const v4f*)(xr + lc + 256 * j); }
    for (int r = r0; r < r1; ++r) {
        const int mrow = (r < NLAT) ? (r >> 11) : 8;
        if (mrow != cur) {
            cur = mrow; const float* m = modl + (size_t)mrow * MODW;
#pragma unroll
            for (int j = 0; j < 4; ++j) { const unsigned c = lc + 256 * j; const v4f gg = *(const v4f*)(g + c), sc = *(const v4f*)(m + ch_scale * DM + c);
                gs[j] = gg * (1.f + sc); sh[j] = *(const v4f*)(m + ch_shift * DM + c); }
        }
        v4f v[4]; float s = 0.f;
#pragma unroll
        for (int j = 0; j < 4; ++j) { v[j] = xn[j]; s += (v[j].x * v[j].x + v[j].y * v[j].y) + (v[j].z * v[j].z + v[j].w * v[j].w); }
        if (r + 1 < r1) { const float* xq = (r + 1 < NLAT) ? xlat + (size_t)(r + 1) * DM : xctx + (size_t)(r + 1 - NLAT) * DM;
#pragma unroll
            for (int j = 0; j < 4; ++j) xn[j] = *(const v4f*)(xq + lc + 256 * j); }
        const float rstd = rsqrtf(wave_sum(s, lane) * (1.f / DM) + 1e-6f);
        bf16* orow = H + (size_t)r * DM;
#pragma unroll
        for (int j = 0; j < 4; ++j) { const v4f o = v[j] * rstd * gs[j] + sh[j]; v2u w; w.x = pk2(o.x, o.y); w.y = pk2(o.z, o.w); *(v2u*)(orow + lc + 256 * j) = w; }
    }
}

constexpr size_t WS_RSS = 6 * MiB;
constexpr size_t WS_WR = 7 * MiB + 512 * 1024;
constexpr int CW_CNT = 1024;
constexpr int LDS_TTAB = 131072;
constexpr int LDS_GIDX = 131072 + 4096;
constexpr int LDS_RT = 131072;

namespace pg8 {
struct EpiResidSS {
    static constexpr bool PERM = true, AFTER_DRAIN = false;
    const float* xin_lat; const float* xin_ctx; float* xout_lat; float* xout_ctx; const float* modl; int chunk; float* rss; int wv;
    __device__ __forceinline__ void operator()(const f32x4 (&acc)[2][2][4][2], const Unit& u, int, int, int, int) const {
        const int l_ = otid(wv) & 63, fr = l_ & 15, fq = l_ >> 4, wr = wv >> 2, wc = wv & 3;
        const int rowt = u.pm * BM; const bool isctx = rowt >= NLAT;
        const float* xin = isctx ? xin_ctx + (size_t)(rowt - NLAT) * DM : xin_lat + (size_t)rowt * DM;
        float* xo = isctx ? xout_ctx + (size_t)(rowt - NLAT) * DM : xout_lat + (size_t)rowt * DM;
        const int mrow = isctx ? 8 : (rowt >> 11);
        const float* gate = modl + (size_t)mrow * MODW + chunk * DM;
        const int col0 = u.pn * BM + wc * 32 + 8 * fq;
        f32x4 gv[2][2];
#pragma unroll
        for (int bj = 0; bj < 2; ++bj)
#pragma unroll
            for (int n = 0; n < 2; ++n) gv[bj][n] = *(const f32x4*)(gate + col0 + bj * HALF + n * 4);
#pragma unroll
        for (int ai = 0; ai < 2; ++ai)
#pragma unroll
            for (int m = 0; m < 4; ++m) {
                const int rl = ai * HALF + wr * 64 + m * 16 + fr; float ss = 0.f;
                f32x4 xi[2][2];
#pragma unroll
                for (int bj = 0; bj < 2; ++bj)
#pragma unroll
                    for (int n = 0; n < 2; ++n) xi[bj][n] = *(const f32x4*)(xin + (size_t)rl * DM + col0 + bj * HALF + n * 4);
#pragma unroll
                for (int bj = 0; bj < 2; ++bj)
#pragma unroll
                    for (int n = 0; n < 2; ++n) {
                        const f32x4 o = xi[bj][n] + gv[bj][n] * acc[ai][bj][m][n];
                        *(f32x4*)(xo + (size_t)rl * DM + col0 + bj * HALF + n * 4) = o;
                        ss += (o[0] * o[0] + o[1] * o[1]) + (o[2] * o[2] + o[3] * o[3]);
                    }
                ss += shx(ss, 16, l_); ss += shx(ss, 32, l_);
                if (fq == 0) rss[(size_t)(rowt + rl) * 16 + u.pn * 4 + wc] = ss;
                asm volatile("" ::: "memory");
            }
    }
};
struct EpiGU {
    static constexpr bool PERM = true, AFTER_DRAIN = false;
    bf16_t* HID; int wv;
    __device__ __forceinline__ void operator()(const f32x4 (&acc)[2][2][4][2], const Unit& u, int, int, int, int) const {
        const int l_ = otid(wv) & 63, fr = l_ & 15, fq = l_ >> 4, wr = wv >> 2, wc = wv & 3;
        const int pnl = u.pn & 1, row0 = u.pm * BM + wr * 64 + fr, col0 = pnl * 128 + wc * 32 + 8 * fq;
#pragma unroll
        for (int ai = 0; ai < 2; ++ai)
#pragma unroll
            for (int m = 0; m < 4; ++m) {
                bf16_t* rowp = HID + (size_t)(row0 + ai * HALF + m * 16) * 256 + col0;
                float hv[8];
#pragma unroll
                for (int n = 0; n < 2; ++n)
#pragma unroll
                    for (int i = 0; i < 4; ++i) { const float g = acc[ai][0][m][n][i], uu = acc[ai][1][m][n][i]; hv[n * 4 + i] = g / (1.f + __expf(-g)) * uu; }
                u32x4 w; w.x = cvt_pk_bf16(hv[0], hv[1]); w.y = cvt_pk_bf16(hv[2], hv[3]); w.z = cvt_pk_bf16(hv[4], hv[5]); w.w = cvt_pk_bf16(hv[6], hv[7]);
                *(u32x4*)rowp = w;
            }
    }
};
struct EpiDown {
    static constexpr bool PERM = true, AFTER_DRAIN = false;
    bf16_t* Y0; bf16_t* Y1; const PG8_LAS int* rowinfo; int wv;
    __device__ __forceinline__ void operator()(const f32x4 (&acc)[2][2][4][2], const Unit& u, int, int, int, int) const {
        const int l_ = otid(wv) & 63, fr_ = l_ & 15, fq = l_ >> 4, wr = wv >> 2, wc = wv & 3;
        const int col0 = (u.pn & 3) * BM + wc * 32 + 8 * fq;
        const PG8_LAS int* ri = rowinfo + (u.aux * 256 + wr * 64 + fr_) * 2;
#pragma unroll
        for (int ai = 0; ai < 2; ++ai)
#pragma unroll
            for (int m = 0; m < 4; ++m) {
                const int ent = ri[(ai * HALF + m * 16) * 2]; const float w = __builtin_bit_cast(float, ri[(ai * HALF + m * 16) * 2 + 1]);
                if (ent >= 0) {
                    bf16_t* rowp = Y0 + ((size_t)(ent & 1) * ((WS_Y1 - WS_Y0) / 2) + (size_t)(ent >> 1) * DM + col0);
#pragma unroll
                    for (int bj = 0; bj < 2; ++bj) {
                        const f32x4 v0 = acc[ai][bj][m][0] * w, v1 = acc[ai][bj][m][1] * w;
                        u32x4 o; o.x = cvt_pk_bf16(v0[0], v0[1]); o.y = cvt_pk_bf16(v0[2], v0[3]); o.z = cvt_pk_bf16(v1[0], v1[1]); o.w = cvt_pk_bf16(v1[2], v1[3]);
                        *(u32x4*)(rowp + bj * HALF) = o;
                    }
                }
                asm volatile("" ::: "memory");
            }
    }
};
struct MoeOrder {
    const PG8_LAS int* ttab; int ntile, npn, G, c;
    __device__ __forceinline__ bool next(int i, Unit& u) const {
        const int L = i * G + c; if (L >= ntile * npn) return false;
        const int t = L / npn, pl = L % npn; u.pm = t; u.pn = ttab[t * 4] * npn + pl; u.aux = i; return true;
    }
    __device__ __forceinline__ void a_ready(const Unit&) const {}
    __device__ __forceinline__ void done(const Unit&) const {}
};
}

__device__ __forceinline__ void phase_router_w(const Ptrs& p, int wv) {
    const int gt = blockIdx.x * NT + otid(wv), NG = gridDim.x * NT;
    for (int idx = gt; idx < 2 * 48 * DM; idx += NG) {
        const int layer = idx / (48 * DM), r = idx % (48 * DM), n = r >> 10, k = r & 1023;
        float w;
        if (n < 16) w = p.in[I_WRG][((size_t)layer * DM + k) * 4 + (n & 3)];
        else { const int g = ((n - 16) & 15) >> 2, i = n & 3, e = 8 * g + i + (n >= 32 ? 4 : 0); w = p.in[I_WRE][((size_t)layer * DM + k) * 32 + e]; }
        const unsigned hi = f2bf(w); const float lo = w - __builtin_bit_cast(float, hi << 16);
        bf16* base = (bf16*)(p.ws + WS_WR) + (size_t)layer * 2 * 48 * DM;
        base[r] = (bf16)hi; base[48 * DM + r] = (bf16)f2bf(lo);
    }
}

typedef short s8v __attribute__((ext_vector_type(8)));
constexpr size_t WS_GS2 = WS_LB + 64 * 1024;
__device__ __forceinline__ void phase_gs2(const Ptrs& p, int wv) {
    const int gt = blockIdx.x * NT + otid(wv), NG = gridDim.x * NT;
    for (int idx = gt; idx < 2 * 9 * DM; idx += NG) {
        const int layer = idx / (9 * DM), m = (idx / DM) % 9, c = idx & (DM - 1);
        const float* md = (const float*)(p.ws + WS_MOD) + ((size_t)layer * 9 + m) * MODW;
        float* o = (float*)(p.ws + WS_GS2) + ((size_t)(layer * 9 + m) * 2) * DM;
        o[c] = p.in[I_N2G][layer * DM + c] * (1.f + md[4 * DM + c]); o[DM + c] = md[3 * DM + c];
    }
}
__device__ __forceinline__ void phase_route(const Ptrs& p, LAS unsigned char* lds, int layer, int nrows, int wv) {
    const int tid = otid(wv), lane = tid & 63, wave = wv;
    LAS int* lcnt = (LAS int*)(lds + LDS_RT); LAS int* gb = lcnt + 32;
    if (tid < 32) lcnt[tid] = 0;
    __syncthreads();
    const int ntiles = nrows / 16, t = wave * gridDim.x + blockIdx.x;
    int e0 = -1, e1 = -1, lp0 = 0, lp1 = 0, ent0 = 0;
    if (t < ntiles) {
        const int row0 = t * 16, r = row0 + (lane & 15), kq = lane >> 4;
        const int mrow = (row0 < NLAT) ? (row0 >> 11) : 8;
        const float* xr = ((r < NLAT) ? p.out + (size_t)r * DM : (const float*)(p.ws + WS_XC) + (size_t)(r - NLAT) * DM) + 8 * kq;
        const float* gsp = (const float*)(p.ws + WS_GS2) + ((size_t)(layer * 9 + mrow) * 2) * DM + 8 * kq;
        bf16* hrow = (bf16*)(p.ws + WS_H) + (size_t)r * DM + 8 * kq;
        const bf16* wr_hi = (const bf16*)(p.ws + WS_WR) + (size_t)layer * 2 * 48 * DM + (size_t)(lane & 15) * DM + 8 * kq;
        float ss;
        { const v4f* rs = (const v4f*)((const float*)(p.ws + WS_RSS) + (size_t)r * 16); const v4f a = rs[0], b = rs[1], c = rs[2], d = rs[3];
          ss = ((a.x + a.y) + (a.z + a.w)) + ((b.x + b.y) + (b.z + b.w)) + ((c.x + c.y) + (c.z + c.w)) + ((d.x + d.y) + (d.z + d.w)); }
        const float rstd = rsqrtf(ss * (1.f / DM) + 1e-6f);
        v4f acc[3];
#pragma unroll
        for (int i = 0; i < 3; ++i) acc[i] = (v4f){0.f, 0.f, 0.f, 0.f};
#pragma unroll 1
        for (int s4 = 0; s4 < 32; s4 += 4) {
            v4f xa[4], xb[4], ga[4], gbv[4], ha[4], hb[4]; s8v wf[4][3];
#pragma unroll
            for (int u = 0; u < 4; ++u) {
                const int c0 = 32 * (s4 + u);
                xa[u] = *(const v4f*)(xr + c0); xb[u] = *(const v4f*)(xr + c0 + 4);
                ga[u] = *(const v4f*)(gsp + c0); gbv[u] = *(const v4f*)(gsp + c0 + 4);
                ha[u] = *(const v4f*)(gsp + DM + c0); hb[u] = *(const v4f*)(gsp + DM + c0 + 4);
#pragma unroll
                for (int nt = 0; nt < 3; ++nt) wf[u][nt] = *(const s8v*)(wr_hi + (size_t)nt * 16 * DM + c0);
            }
#pragma unroll
            for (int u = 0; u < 4; ++u) {
                const v4f h0 = xa[u] * rstd * ga[u] + ha[u], h1 = xb[u] * rstd * gbv[u] + hb[u];
                v4u hw; hw.x = pk2(h0.x, h0.y); hw.y = pk2(h0.z, h0.w); hw.z = pk2(h1.x, h1.y); hw.w = pk2(h1.z, h1.w);
                *(v4u*)(hrow + 32 * (s4 + u)) = hw;
                const s8v bh = __builtin_bit_cast(s8v, hw);
#pragma unroll
                for (int nt = 0; nt < 3; ++nt) acc[nt] = __builtin_amdgcn_mfma_f32_16x16x32_bf16(wf[u][nt], bh, acc[nt], 0, 0, 0);
            }
        }
        const float* brg = p.in[I_BRG] + layer * 4; const float* bre = p.in[I_BRE] + layer * 32;
        float gl[4];
#pragma unroll
        for (int i = 0; i < 4; ++i) gl[i] = acc[0][i] + brg[i];
        int gi = 0; float gm = gl[0];
#pragma unroll
        for (int i = 1; i < 4; ++i) if (gl[i] > gm) { gm = gl[i]; gi = i; }
        float den = 0.f;
#pragma unroll
        for (int i = 0; i < 4; ++i) den += __expf(gl[i] - gm);
        const float gtop = 1.f / den;
        if (kq == gi) {
            float el[8];
#pragma unroll
            for (int i = 0; i < 4; ++i) { el[i] = acc[1][i] + bre[8 * kq + i]; el[4 + i] = acc[2][i] + bre[8 * kq + 4 + i]; }
            int i0 = 0; float v0 = el[0];
#pragma unroll
            for (int i = 1; i < 8; ++i) if (el[i] > v0) { v0 = el[i]; i0 = i; }
            int i1 = -1; float v1 = -3.0e38f;
#pragma unroll
            for (int i = 0; i < 8; ++i) if (i != i0 && el[i] > v1) { v1 = el[i]; i1 = i; }
            const float p1 = __expf(v1 - v0), sden = 1.f / (1.f + p1);
            e0 = gi * 8 + i0; e1 = gi * 8 + i1; ent0 = r * 2;
            float* ew = (float*)(p.ws + WS_EW);
            ew[ent0] = gtop * sden; ew[ent0 + 1] = gtop * p1 * sden;
            lp0 = __hip_atomic_fetch_add(lcnt + e0, 1, __ATOMIC_RELAXED, __HIP_MEMORY_SCOPE_WORKGROUP); lp1 = __hip_atomic_fetch_add(lcnt + e1, 1, __ATOMIC_RELAXED, __HIP_MEMORY_SCOPE_WORKGROUP);
        }
    }
    __syncthreads();
    int* cnt = (int*)(p.ws + WS_CTL) + CW_CNT + layer * 64;
    if (tid < 32) gb[tid] = atomicAdd(&cnt[tid], lcnt[tid]);
    __syncthreads();
    if (e0 >= 0) {
        int* IDX = (int*)(p.ws + WS_IDX);
        IDX[(size_t)e0 * MROWS + gb[e0] + lp0] = ent0;
        IDX[(size_t)e1 * MROWS + gb[e1] + lp1] = ent0 + 1;
    }
}
__device__ __forceinline__ int moe_build_ttab(const Ptrs& p, LAS unsigned char* lds, int layer, int wv) {
    LAS int* ttab = (LAS int*)(lds + LDS_TTAB);
    const int* cnt = (const int*)(p.ws + WS_CTL) + CW_CNT + layer * 64;
    __syncthreads();
    if (otid(wv) == 0) {
        int t = 0;
        for (int e = 0; e < 32; ++e) { const int c = __hip_atomic_load(cnt + e, __ATOMIC_RELAXED, __HIP_MEMORY_SCOPE_AGENT); for (int fp = 0; fp < c; fp += 256) { ttab[t * 4] = e; ttab[t * 4 + 1] = fp; ttab[t * 4 + 2] = c; ++t; } }
        ttab[176 * 4] = t;
    }
    __syncthreads();
    return ttab[176 * 4];
}
__device__ __forceinline__ void phase_moe_gu(const Ptrs& p, LAS unsigned char* lds, int layer, int wv) {
    const int ntile = moe_build_ttab(p, lds, layer, wv);
    LAS int* ttab = (LAS int*)(lds + LDS_TTAB); LAS int* gidx = (LAS int*)(lds + LDS_GIDX);
    pg8::MoeOrder S{ttab, ntile, 2, (int)gridDim.x, (int)blockIdx.x};
    const int* IDX = (const int*)(p.ws + WS_IDX);
    for (int i = 0; i < 3; ++i) {
        pg8::Unit u; if (!S.next(i, u)) break;
        const int e = ttab[u.pm * 4], fp = ttab[u.pm * 4 + 1], c = ttab[u.pm * 4 + 2];
        for (int r = otid(wv); r < 256; r += NT) gidx[i * 256 + r] = (fp + r < c) ? (IDX[(size_t)e * MROWS + fp + r] >> 1) : 0;
    }
    __syncthreads();
    pg8::Gemm g{(const bf16*)(p.ws + WS_H), (const bf16*)(p.ws + WS_WGU + layer * WGU_STRIDE), ntile * 256, 32 * 512, DM};
    pg8::EpiGU E{(bf16*)(p.ws + WS_HID), wv};
    pg8::gemm_phase<pg8::EpiGU, pg8::MoeOrder, true, true, true>(lds, g, S, E, wv, gidx);
}
__device__ __forceinline__ void phase_moe_down(const Ptrs& p, LAS unsigned char* lds, int layer, int wv) {
    const int ntile = moe_build_ttab(p, lds, layer, wv);
    LAS int* ttab = (LAS int*)(lds + LDS_TTAB); LAS int* rowinfo = (LAS int*)(lds + LDS_GIDX);
    pg8::MoeOrder S{ttab, ntile, 4, (int)gridDim.x, (int)blockIdx.x};
    const int* IDX = (const int*)(p.ws + WS_IDX); const float* EW = (const float*)(p.ws + WS_EW);
    for (int i = 0; i < 3; ++i) {
        pg8::Unit u; if (!S.next(i, u)) break;
        const int e = ttab[u.pm * 4], fp = ttab[u.pm * 4 + 1], c = ttab[u.pm * 4 + 2];
        for (int r = otid(wv); r < 256; r += NT) {
            int ent = -1; float w = 0.f;
            if (fp + r < c) { ent = IDX[(size_t)e * MROWS + fp + r]; w = EW[ent]; }
            rowinfo[(i * 256 + r) * 2] = ent; rowinfo[(i * 256 + r) * 2 + 1] = __builtin_bit_cast(int, w);
        }
    }
    __syncthreads();
    pg8::Gemm g{(const bf16*)(p.ws + WS_HID), (const bf16*)(p.ws + WS_WD + layer * WD_STRIDE), ntile * 256, 32 * 1024, 256};
    pg8::EpiDown E{(bf16*)(p.ws + WS_Y0), (bf16*)(p.ws + WS_Y1), rowinfo, wv};
    pg8::gemm_phase<pg8::EpiDown, pg8::MoeOrder, true, true, false>(lds, g, S, E, wv);
}
__device__ __forceinline__ void phase_combine(const Ptrs& p, int layer, int nrows, bool do_norm, int wv) {
    const int lane = otid(wv) & 63, wave = wv;
    const int gw = blockIdx.x * NWAVES + wave, NGW = gridDim.x * NWAVES;
    const int per = (nrows + NGW - 1) / NGW;
    const int r0 = gw * per, r1 = min(r0 + per, nrows);
    const float* modl = (const float*)(p.ws + WS_MOD) + (size_t)layer * 9 * MODW;
    const float* modn = (const float*)(p.ws + WS_MOD) + (size_t)(layer + 1) * 9 * MODW;
    const float* g = p.in[I_N1G] + (layer + 1) * DM;
    const bf16* Y0 = (const bf16*)(p.ws + WS_Y0); const bf16* Y1 = (const bf16*)(p.ws + WS_Y1); bf16* H = (bf16*)(p.ws + WS_H);
    const unsigned lc = 4 * lane;
    int cur = -1; v4f m5v[4], gs[4], sh[4];
    v4f xn[4]; v2u an[4], bn[4];
    auto rowptr = [&](int r) -> float* { return (r < NLAT) ? p.out + (size_t)r * DM : (float*)(p.ws + WS_XC) + (size_t)(r - NLAT) * DM; };
    if (r0 < r1) {
        const float* xr = rowptr(r0);
#pragma unroll
        for (int j = 0; j < 4; ++j) { xn[j] = *(const v4f*)(xr + lc + 256 * j); an[j] = *(const v2u*)(Y0 + (size_t)r0 * DM + lc + 256 * j); bn[j] = *(const v2u*)(Y1 + (size_t)r0 * DM + lc + 256 * j); }
    }
    for (int r = r0; r < r1; ++r) {
        const int mrow = (r < NLAT) ? (r >> 11) : 8;
        if (mrow != cur) {
            cur = mrow; const float* m5 = modl + (size_t)mrow * MODW + 5 * DM; const float* mn = modn + (size_t)mrow * MODW;
#pragma unroll
            for (int j = 0; j < 4; ++j) { const unsigned c = lc + 256 * j; m5v[j] = *(const v4f*)(m5 + c);
                if (do_norm) { const v4f gg = *(const v4f*)(g + c), sc = *(const v4f*)(mn + DM + c); gs[j] = gg * (1.f + sc); sh[j] = *(const v4f*)(mn + c); } }
        }
        v4f x[4]; v2u a[4], b[4];
#pragma unroll
        for (int j = 0; j < 4; ++j) { x[j] = xn[j]; a[j] = an[j]; b[j] = bn[j]; }
        float* xr = rowptr(r);
        if (r + 1 < r1) {
            const float* xq = rowptr(r + 1);
#pragma unroll
            for (int j = 0; j < 4; ++j) { xn[j] = *(const v4f*)(xq + lc + 256 * j); an[j] = *(const v2u*)(Y0 + (size_t)(r + 1) * DM + lc + 256 * j); bn[j] = *(const v2u*)(Y1 + (size_t)(r + 1) * DM + lc + 256 * j); }
        }
        v4f v[4]; float s = 0.f;
#pragma unroll
        for (int j = 0; j < 4; ++j) {
            v4f y; y.x = bflo(a[j].x) + bflo(b[j].x); y.y = bfhi(a[j].x) + bfhi(b[j].x); y.z = bflo(a[j].y) + bflo(b[j].y); y.w = bfhi(a[j].y) + bfhi(b[j].y);
            v[j] = x[j] + m5v[j] * y;
            *(v4f*)(xr + lc + 256 * j) = v[j];
            s += (v[j].x * v[j].x + v[j].y * v[j].y) + (v[j].z * v[j].z + v[j].w * v[j].w);
        }
        if (do_norm) {
            const float rstd = rsqrtf(wave_sum(s, lane) * (1.f / DM) + 1e-6f);
#pragma unroll
            for (int j = 0; j < 4; ++j) { const v4f o = v[j] * rstd * gs[j] + sh[j]; v2u w; w.x = pk2(o.x, o.y); w.y = pk2(o.z, o.w); *(v2u*)(H + (size_t)r * DM + lc + 256 * j) = w; }
        }
    }
}

namespace hg {
typedef short s4v __attribute__((ext_vector_type(4)));
typedef short s8v __attribute__((ext_vector_type(8)));
typedef short v4i16_t __attribute__((ext_vector_type(4)));
constexpr int TS = 160;
constexpr int TILE_B = 16 * TS;
constexpr int WAVE_LDS = 2 * TILE_B;
constexpr int NSEG = 18;
constexpr size_t SEGU_B = 64 * 64 * 4, SEGA_B = 16 * 64 * 4;
constexpr size_t WS_SEGU = WS_SCR;
constexpr size_t WS_SEGA = WS_SEGU + (size_t)NBATCH * 4 * 2 * NSEG * SEGU_B;
static_assert(WS_SEGA + (size_t)NBATCH * 4 * 2 * NSEG * SEGA_B <= WS_END && 8 * WAVE_LDS <= 40960 && 40960 + 6 * 16384 <= LDS_BYTES - 64, "hgrn scratch");
template <int CTRL> __device__ __forceinline__ float dppf(float x) { return __builtin_bit_cast(float, __builtin_amdgcn_update_dpp(0, __builtin_bit_cast(int, x), CTRL, 0xf, 0xf, true)); }
__device__ __forceinline__ s4v trd(const LAS unsigned char* p) { return __builtin_bit_cast(s4v, __builtin_amdgcn_ds_read_tr16_b64_v4i16((LAS v4i16_t*)p)); }
typedef float f32x2_t __attribute__((ext_vector_type(2))); typedef __bf16 bf16x2_t __attribute__((ext_vector_type(2)));
__device__ __forceinline__ unsigned pkbf(float lo, float hi) { f32x2_t v = {lo, hi}; bf16x2_t b = __builtin_convertvector(v, bf16x2_t); return __builtin_bit_cast(unsigned, b); }
__device__ __forceinline__ float silu_r(float x) { return x * __builtin_amdgcn_rcpf(1.f + __expf(-x)); }
__device__ __forceinline__ s8v mk8(unsigned a, unsigned b, unsigned c, unsigned d) { v4u t; t.x = a; t.y = b; t.z = c; t.w = d; return __builtin_bit_cast(s8v, t); }

template <bool BWD, int OUT>
__device__ __forceinline__ void chunk(const bf16* __restrict__ P, int row0, int h, const float* __restrict__ lbh, v4f (&S)[4][4], float (&Atot)[16],
                                      LAS unsigned char* vt, LAS unsigned char* kt, int lane_, LAS v4f* OFL, int cidx, bf16* __restrict__ MIX, const float* __restrict__ on) {
    int lane = lane_; asm volatile("" : "+v"(lane));
    const int tok = lane & 15, kq = lane >> 4;
    const bf16* pb = P + (size_t)row0 * DIN + h * 64;
    const unsigned lo = (unsigned)(tok * DIN + 4 * kq);
    v2u zr[4], qr[4]; v4f lbq[4];
#pragma unroll
    for (int m = 0; m < 4; ++m) lbq[m] = *(const v4f*)(lbh + (unsigned)(16 * m + 4 * kq));
#pragma unroll
    for (int m = 0; m < 4; ++m) { zr[m] = *(const v2u*)(pb + (lo + (BWD ? C_FB : C_FF) + 16 * m)); if (OUT != 0) qr[m] = *(const v2u*)(pb + (lo + C_Q + 16 * m)); }
#pragma unroll
    for (int i = 0; i < 2; ++i) { const int pc = lane + 64 * i, r = pc >> 3, ch = pc & 7;
        const v4u vv = *(const v4u*)(pb + (unsigned)(r * DIN + C_I + 8 * ch)); *(LAS v4u*)(vt + r * TS + 16 * ch) = vv; }
    unsigned qf[8], kf[8];
    float A[16];
#pragma unroll
    for (int m = 0; m < 4; ++m)
#pragma unroll
        for (int jp = 0; jp < 2; ++jp) {
            const unsigned zw = jp ? zr[m].y : zr[m].x;
            float kt2[2], qt2[2], kh2[2];
#pragma unroll
            for (int i = 0; i < 2; ++i) {
                const int e = 4 * m + 2 * jp + i;
                const float z = i ? bfhi(zw) : bflo(zw);
                const float sg = __builtin_amdgcn_rcpf(1.f + __builtin_amdgcn_exp2f(-1.4426950408889634f * z)), lb = lbq[m][2 * jp + i];
                const float f = lb + (1.f - lb) * sg, kk = (1.f - lb) * (1.f - sg);
                const float lf = __builtin_amdgcn_logf(f);
                float c = lf, t = lf;
                if (!BWD) { c += dppf<0x111>(c); c += dppf<0x112>(c); c += dppf<0x114>(c); c += dppf<0x118>(c); }
                else      { c += dppf<0x101>(c); c += dppf<0x102>(c); c += dppf<0x104>(c); c += dppf<0x108>(c); }
                t += dppf<0x128>(t); t += dppf<0x124>(t); t += dppf<0x122>(t); t += dppf<0x121>(t);
                const float Ei = __builtin_amdgcn_exp2f(-fmaxf(c, -115.f)); A[e] = __builtin_amdgcn_exp2f(t);
                kt2[i] = kk * Ei; kh2[i] = kt2[i] * A[e];
                if (OUT != 0) { const unsigned qw = jp ? qr[m].y : qr[m].x; const float q = i ? bfhi(qw) : bflo(qw); qt2[i] = q * 0.125f * __builtin_amdgcn_exp2f(c); } else qt2[i] = 0.f;
            }
            kf[2 * m + jp] = pkbf(kt2[0], kt2[1]); if (OUT != 0) qf[2 * m + jp] = pkbf(qt2[0], qt2[1]);
            *(LAS unsigned*)(kt + tok * TS + (16 * m + 4 * kq + 2 * jp) * 2) = pkbf(kh2[0], kh2[1]);
            __builtin_amdgcn_sched_barrier(0);
        }
    asm volatile("s_waitcnt lgkmcnt(0)" ::: "memory");
    s8v vfr[4], khf[4];
    { const int i4 = tok >> 2, p4 = tok & 3; const LAS unsigned char* va = vt + (4 * kq + i4) * TS + 8 * p4; const LAS unsigned char* ka = kt + (4 * kq + i4) * TS + 8 * p4;
#pragma unroll
      for (int c = 0; c < 4; ++c) { const s4v a = trd(va + 32 * c), b = trd(ka + 32 * c);
          vfr[c] = (s8v){a[0], a[1], a[2], a[3], 0, 0, 0, 0}; khf[c] = (s8v){b[0], b[1], b[2], b[3], 0, 0, 0, 0}; } }
    if (OUT != 0) {
        const s8v q0 = mk8(qf[0], qf[1], qf[2], qf[3]), q1 = mk8(qf[4], qf[5], qf[6], qf[7]);
        const s8v k0 = mk8(kf[0], kf[1], kf[2], kf[3]), k1 = mk8(kf[4], kf[5], kf[6], kf[7]);
        v4f at = (v4f){0.f, 0.f, 0.f, 0.f};
        at = __builtin_amdgcn_mfma_f32_16x16x32_bf16(k0, q0, at, 0, 0, 0);
        at = __builtin_amdgcn_mfma_f32_16x16x32_bf16(k1, q1, at, 0, 0, 0);
#pragma unroll
        for (int j = 0; j < 4; ++j) { const int s = 4 * kq + j; const bool keep = BWD ? (s >= tok) : (s <= tok); at[j] = keep ? at[j] : 0.f; }
        const s8v af = mk8(pkbf(at[0], at[1]), pkbf(at[2], at[3]), 0u, 0u);
        v4f o[4];
#pragma unroll
        for (int vb = 0; vb < 4; ++vb) {
            o[vb] = __builtin_amdgcn_mfma_f32_16x16x32_bf16(vfr[vb], af, (v4f){0.f, 0.f, 0.f, 0.f}, 0, 0, 0);
            const s8v s0 = mk8(pkbf(S[0][vb][0], S[0][vb][1]), pkbf(S[0][vb][2], S[0][vb][3]), pkbf(S[1][vb][0], S[1][vb][1]), pkbf(S[1][vb][2], S[1][vb][3]));
            const s8v s1 = mk8(pkbf(S[2][vb][0], S[2][vb][1]), pkbf(S[2][vb][2], S[2][vb][3]), pkbf(S[3][vb][0], S[3][vb][1]), pkbf(S[3][vb][2], S[3][vb][3]));
            o[vb] = __builtin_amdgcn_mfma_f32_16x16x32_bf16(s0, q0, o[vb], 0, 0, 0);
            o[vb] = __builtin_amdgcn_mfma_f32_16x16x32_bf16(s1, q1, o[vb], 0, 0, 0);
            __builtin_amdgcn_sched_barrier(0);
        }
        LAS v4f* ofl = OFL + (cidx * 4) * 64 + lane;
        if (OUT == 1) {
#pragma unroll
            for (int vb = 0; vb < 4; ++vb) ofl[vb * 64] = o[vb];
        } else {
            float ss = 0.f;
#pragma unroll
            for (int vb = 0; vb < 4; ++vb) { o[vb] += ofl[vb * 64]; ss += (o[vb].x * o[vb].x + o[vb].y * o[vb].y) + (o[vb].z * o[vb].z + o[vb].w * o[vb].w); }
            ss += shx(ss, 16, lane); ss += shx(ss, 32, lane);
            const float rstd = rsqrtf(ss * (1.f / 64.f) + 1e-6f);
            bf16* mb = MIX + (size_t)row0 * DM + 768 + h * 64; const unsigned lom = (unsigned)(tok * DM + 4 * kq);
#pragma unroll
            for (int vb = 0; vb < 4; ++vb) {
                const v2u gw = *(const v2u*)(pb + (lo + C_G + 16 * vb)); const v4f gn = *(const v4f*)(on + (unsigned)(16 * vb + 4 * kq));
                const float g0 = bflo(gw.x), g1 = bfhi(gw.x), g2 = bflo(gw.y), g3 = bfhi(gw.y);
                v2u w; w.x = pkbf(o[vb].x * rstd * gn.x * silu_r(g0), o[vb].y * rstd * gn.y * silu_r(g1)); w.y = pkbf(o[vb].z * rstd * gn.z * silu_r(g2), o[vb].w * rstd * gn.w * silu_r(g3));
                *(v2u*)(mb + (lom + 16 * vb)) = w;
            }
        }
    }
#pragma unroll
    for (int db = 0; db < 4; ++db) {
        const v4f av = (v4f){A[4 * db], A[4 * db + 1], A[4 * db + 2], A[4 * db + 3]};
#pragma unroll
        for (int vb = 0; vb < 4; ++vb) S[db][vb] = __builtin_amdgcn_mfma_f32_16x16x32_bf16(khf[db], vfr[vb], S[db][vb] * av, 0, 0, 0);
        __builtin_amdgcn_sched_barrier(0);
    }
    if (OUT == 0) {
#pragma unroll
        for (int e = 0; e < 16; ++e) Atot[e] *= A[e];
    }
    asm volatile("s_waitcnt lgkmcnt(0)" ::: "memory");
}
__device__ __forceinline__ int seg_row0(int b, int seg) { return seg < 2 ? NLAT + b * CTXL + 128 * seg : b * SEQ + 128 * (seg - 2); }
__device__ __forceinline__ int scan_idx(int seg, int dir) { return dir == 0 ? seg : (seg < 2 ? 1 - seg : 19 - seg); }

__device__ __forceinline__ void unit_pass1(const Ptrs& p, int layer, int u, LAS unsigned char* wl, int lane) {
    const int dir = u & 1, bhs = u >> 1, seg = bhs % NSEG, bh = bhs / NSEG, h = bh & 3, b = bh >> 2;
    const bf16* P = (const bf16*)(p.ws + WS_P);
    const int row0 = seg_row0(b, seg);
    float Atot[16]; v4f S[4][4];
    const float* lbv = (const float*)(p.ws + WS_LB) + layer * 512 + dir * 256 + h * 64;
#pragma unroll
    for (int e = 0; e < 16; ++e) Atot[e] = 1.f;
#pragma unroll
    for (int i = 0; i < 4; ++i)
#pragma unroll
        for (int j = 0; j < 4; ++j) S[i][j] = (v4f){0.f, 0.f, 0.f, 0.f};
    if (dir == 0) {
#pragma unroll 1
        for (int c = 0; c < 8; ++c) chunk<false, 0>(P, row0 + 16 * c, h, lbv, S, Atot, wl, wl + TILE_B, lane, nullptr, c, nullptr, nullptr);
    } else {
#pragma unroll 1
        for (int c = 7; c >= 0; --c) chunk<true, 0>(P, row0 + 16 * c, h, lbv, S, Atot, wl, wl + TILE_B, lane, nullptr, c, nullptr, nullptr);
    }
    const size_t si = ((size_t)(bh * 2 + dir)) * NSEG + scan_idx(seg, dir);
    float* su = (float*)(p.ws + WS_SEGU + si * SEGU_B) + lane; float* sa = (float*)(p.ws + WS_SEGA + si * SEGA_B) + lane;
#pragma unroll
    for (int i = 0; i < 4; ++i)
#pragma unroll
        for (int j = 0; j < 4; ++j)
#pragma unroll
            for (int r = 0; r < 4; ++r) su[((i * 4 + j) * 4 + r) * 64] = S[i][j][r];
#pragma unroll
    for (int e = 0; e < 16; ++e) sa[e * 64] = Atot[e];
}
template <bool BWD>
__device__ __forceinline__ void unit_pass2(const Ptrs& p, int layer, int pu, LAS unsigned char* wl, LAS v4f* ofl_own, LAS v4f* ofl_partner, int lane, bool active) {
    const int seg = pu % NSEG, bh = pu / NSEG, h = bh & 3, b = bh >> 2;
    const bf16* P = (const bf16*)(p.ws + WS_P); bf16* MIX = (bf16*)(p.ws + WS_MIX);
    const float* on = p.in[I_HGON] + layer * 64;
    const int row0 = seg_row0(b, seg);
    constexpr int dir = BWD ? 1 : 0;
    float Atot[16]; v4f S[4][4];
    const float* lbv = (const float*)(p.ws + WS_LB) + layer * 512 + dir * 256 + h * 64;
    if (active) {
        {
            const size_t si = ((size_t)(bh * 2 + dir)) * NSEG + scan_idx(seg, dir);
            int ln = lane; asm volatile("" : "+v"(ln));
            const float* su = (const float*)(p.ws + WS_SEGU + si * SEGU_B) + ln;
#pragma unroll
            for (int i = 0; i < 4; ++i)
#pragma unroll
                for (int j = 0; j < 4; ++j) S[i][j] = (v4f){su[((i * 4 + j) * 4 + 0) * 64], su[((i * 4 + j) * 4 + 1) * 64], su[((i * 4 + j) * 4 + 2) * 64], su[((i * 4 + j) * 4 + 3) * 64]};
        }
#pragma unroll 1
        for (int k = 0; k < 4; ++k) { const int c = BWD ? 7 - k : k; chunk<BWD, 1>(P, row0 + 16 * c, h, lbv, S, Atot, wl, wl + TILE_B, lane, ofl_own, k, MIX, on); }
    }
    __syncthreads();
    if (active) {
#pragma unroll 1
        for (int k = 4; k < 8; ++k) { const int c = BWD ? 7 - k : k; chunk<BWD, 2>(P, row0 + 16 * c, h, lbv, S, Atot, wl, wl + TILE_B, lane, ofl_partner, 7 - k, MIX, on); }
    }
}
}
constexpr int LDS_HG_OFL = 40960, HG_OFL_B = 16384;
__device__ __forceinline__ void phase_hgrn1(const Ptrs& p, LAS unsigned char* lds, int layer, int wv) {
    const int lane = otid(wv) & 63; const int u = wv * gridDim.x + blockIdx.x;
    if (u < 2 * 32 * hg::NSEG) hg::unit_pass1(p, layer, u, lds + wv * hg::WAVE_LDS, lane);
}
__device__ __forceinline__ void phase_hgrn2(const Ptrs& p, LAS unsigned char* lds, int layer, int wv) {
    const int lane = otid(wv) & 63; const int pu = (wv >> 1) * gridDim.x + blockIdx.x;
    const bool active = pu < 32 * hg::NSEG && (layer == 0 || (pu % hg::NSEG) >= 2) && wv < 6;
    LAS v4f* own = (LAS v4f*)(lds + LDS_HG_OFL + (wv < 6 ? wv : 0) * HG_OFL_B); LAS v4f* partner = (LAS v4f*)(lds + LDS_HG_OFL + (wv < 6 ? (wv ^ 1) : 0) * HG_OFL_B);
    if (wv & 1) hg::unit_pass2<true>(p, layer, pu, lds + wv * hg::WAVE_LDS, own, partner, lane, active);
    else        hg::unit_pass2<false>(p, layer, pu, lds + wv * hg::WAVE_LDS, own, partner, lane, active);
}

__device__ __forceinline__ void phase_hgrn_scan(const Ptrs& p, int wv) {
    const int t = blockIdx.x * NT + otid(wv);
#pragma unroll 1
    for (int half = 0; half < 2; ++half) {
        const int e = t + half * (int)(gridDim.x * NT);
        if (e >= 64 * 4096) break;
        const int bhd = e >> 12, r = (e >> 6) & 63, l = e & 63;
        float* su = (float*)(p.ws + hg::WS_SEGU + (size_t)bhd * hg::NSEG * hg::SEGU_B) + r * 64 + l;
        const float* sa = (const float*)(p.ws + hg::WS_SEGA + (size_t)bhd * hg::NSEG * hg::SEGA_B) + (4 * (r >> 4) + (r & 3)) * 64 + l;
        float u[hg::NSEG], a[hg::NSEG];
#pragma unroll
        for (int j = 0; j < hg::NSEG; ++j) { u[j] = su[(size_t)j * 4096]; a[j] = sa[(size_t)j * 1024]; }
        float st = 0.f;
#pragma unroll
        for (int j = 0; j < hg::NSEG; ++j) { su[(size_t)j * 4096] = st; st = a[j] * st + u[j]; }
    }
}
namespace att {
using bf16=unsigned short;
using bf16x8=__attribute__((ext_vector_type(8)))short;
using s16x4=__attribute__((ext_vector_type(4)))short;
using f32x16=__attribute__((ext_vector_type(16)))float;
using u32x4=__attribute__((ext_vector_type(4)))unsigned;
constexpr int D=64,PIN_=DIN,POUT=DM;
constexpr int NW=8,QBLK=32,QB=QBLK*NW,KVBLK=64;
__device__ __forceinline__ int crow(int r,int hi){return (r&3)+8*(r>>2)+4*hi;}
#define SBAR() __builtin_amdgcn_sched_barrier(0)
constexpr int NSLOT=3, SLOTB=8192;
constexpr int LDS_K=0, LDS_V=NSLOT*SLOTB, LDS_WS=2*NSLOT*SLOTB, LDS_OST=LDS_WS+NW*64*4, LDS_BYTES=LDS_OST+NW*4096;
constexpr float C2=0.125f*1.4426950408889634f;
__device__ __forceinline__ void glds16(const void*gsrc,unsigned lds_dst){unsigned keep;
  asm volatile("s_mov_b32 %0, m0\n\ts_mov_b32 m0, %2\n\ts_nop 0\n\tglobal_load_lds_dwordx4 %1, off\n\ts_mov_b32 m0, %0":"=&s"(keep):"v"(gsrc),"s"(lds_dst):"memory");}
__device__ __forceinline__ float max3f(float a,float b,float c){float r;asm("v_max3_f32 %0, %1, %2, %3":"=v"(r):"v"(a),"v"(b),"v"(c));return r;}
__device__ __forceinline__ float max2f(float a,float b){float r;asm("v_max_f32_e32 %0, %1, %2":"=v"(r):"v"(a),"v"(b));return r;}
__device__ __forceinline__ float fadd_s(float a,float b){float r;asm("v_add_f32_e32 %0, %1, %2":"=v"(r):"v"(a),"v"(b));return r;}
__device__ __forceinline__ float fsub_s(float a,float b){float r;asm("v_sub_f32_e32 %0, %1, %2":"=v"(r):"v"(a),"v"(b));return r;}
typedef float f32x2_t __attribute__((ext_vector_type(2))); typedef __bf16 bf16x2_t __attribute__((ext_vector_type(2)));
__device__ __forceinline__ unsigned cvtpk_s(float lo,float hi){f32x2_t v={lo,hi};bf16x2_t b=__builtin_convertvector(v,bf16x2_t);return __builtin_bit_cast(unsigned,b);}
#define WAIT_BAR(N) asm volatile("s_waitcnt vmcnt(" #N ") lgkmcnt(0)\n\ts_barrier":::"memory")

__device__ __forceinline__ void qkt(f32x16&p0,f32x16&p1,const char*Kslot,const bf16x8*qr,const f32x16&negm,int r32,int hi){
  const char*kb=Kslot+hi*1024+r32*16;
  #pragma unroll
  for(int d0=0;d0<4;++d0){
    const bf16x8 b0=*reinterpret_cast<const bf16x8*>(kb+d0*2048);
    const bf16x8 b1=*reinterpret_cast<const bf16x8*>(kb+d0*2048+512);
    if(d0==0){p0=__builtin_amdgcn_mfma_f32_32x32x16_bf16(b0,qr[0],negm,0,0,0);p1=__builtin_amdgcn_mfma_f32_32x32x16_bf16(b1,qr[0],negm,0,0,0);}
    else{p0=__builtin_amdgcn_mfma_f32_32x32x16_bf16(b0,qr[d0],p0,0,0,0);p1=__builtin_amdgcn_mfma_f32_32x32x16_bf16(b1,qr[d0],p1,0,0,0);}}
}
typedef __attribute__((address_space(3))) const char* lds_cptr;
typedef short v4i16_t __attribute__((ext_vector_type(4)));
__device__ __forceinline__ void kload8(bf16x8*kf,lds_cptr kp){
  kf[0]=*(const __attribute__((address_space(3))) bf16x8*)(kp);      kf[1]=*(const __attribute__((address_space(3))) bf16x8*)(kp+512);
  kf[2]=*(const __attribute__((address_space(3))) bf16x8*)(kp+2048); kf[3]=*(const __attribute__((address_space(3))) bf16x8*)(kp+2560);
  kf[4]=*(const __attribute__((address_space(3))) bf16x8*)(kp+4096); kf[5]=*(const __attribute__((address_space(3))) bf16x8*)(kp+4608);
  kf[6]=*(const __attribute__((address_space(3))) bf16x8*)(kp+6144); kf[7]=*(const __attribute__((address_space(3))) bf16x8*)(kp+6656);
}
__device__ __forceinline__ void kload2(bf16x8*kf,lds_cptr kp,int j){ kf[2*j]=*(const __attribute__((address_space(3))) bf16x8*)(kp+j*2048); kf[2*j+1]=*(const __attribute__((address_space(3))) bf16x8*)(kp+j*2048+512); }
__device__ __forceinline__ s16x4 vtr(lds_cptr p){ return __builtin_bit_cast(s16x4,__builtin_amdgcn_ds_read_tr16_b64_v4i16((__attribute__((address_space(3))) v4i16_t*)p)); }
__device__ __forceinline__ float rowmax(const f32x16&p0,const f32x16&p1){
  float a=max3f(p0[0],p0[1],p1[0]),b=max3f(p0[2],p0[3],p1[1]);a=max3f(a,p1[2],p1[3]);
  #pragma unroll
  for(int r=4;r<16;r+=4){a=max3f(a,p0[r],p0[r+1]);b=max3f(b,p0[r+2],p0[r+3]);a=max3f(a,p1[r],p1[r+1]);b=max3f(b,p1[r+2],p1[r+3]);}
  const float m=max2f(a,b);
  auto rr=__builtin_amdgcn_permlane32_swap(__float_as_uint(m),__float_as_uint(m),false,false);
  return max2f(__uint_as_float(rr[0]),__uint_as_float(rr[1]));
}
__device__ __forceinline__ void pv(f32x16*o,int vb,bf16x8 pa0,bf16x8 pa1,bf16x8 pa2,bf16x8 pa3){
  #pragma unroll
  for(int d0=0;d0<2;++d0){s16x4 lo[4],hi[4];
    #pragma unroll
    for(int ks=0;ks<4;++ks){
      asm volatile("ds_read_b64_tr_b16 %0,%1 offset:%c2":"=&v"(lo[ks]):"v"(vb),"i"(d0*4096+ks*1024):"memory");
      asm volatile("ds_read_b64_tr_b16 %0,%1 offset:%c2":"=&v"(hi[ks]):"v"(vb),"i"(d0*4096+ks*1024+512):"memory");}
    asm volatile("s_waitcnt lgkmcnt(0)":::"memory");SBAR();
    #define PK(k) (bf16x8){lo[k][0],lo[k][1],lo[k][2],lo[k][3],hi[k][0],hi[k][1],hi[k][2],hi[k][3]}
    o[d0]=__builtin_amdgcn_mfma_f32_32x32x16_bf16(pa0,PK(0),o[d0],0,0,0);
    o[d0]=__builtin_amdgcn_mfma_f32_32x32x16_bf16(pa1,PK(1),o[d0],0,0,0);
    o[d0]=__builtin_amdgcn_mfma_f32_32x32x16_bf16(pa2,PK(2),o[d0],0,0,0);
    o[d0]=__builtin_amdgcn_mfma_f32_32x32x16_bf16(pa3,PK(3),o[d0],0,0,0);
    #undef PK
  }
}

#ifndef ATTN_STORE16
#define ATTN_STORE16(p,v) (*(u32x4*)(p)=(v))
#endif
template<int THRL,class Hook> __device__ __forceinline__ void attn_unit(const bf16*Q0,const bf16*__restrict__ Kh,const bf16*__restrict__ Vh,int rowa,int na,int rowb,int NT,bf16*O0,const Hook&hook,char*shm,int wid){
  const int lane=otid(wid)&63,r32=lane&31,hi=lane>>5;
  const bf16*Qw=Q0+(long)(wid*QBLK)*PIN_;
  #define TROW(t) ((long)(((t)<na)?(rowa+64*(t)):(rowb+64*((t)-na))))
  const unsigned lds0=(unsigned)(uintptr_t)shm;
  float*wsf=(float*)(shm+LDS_WS)+wid*64;
  const bf16*ksrc=Kh+(long)lane*PIN_+wid*8;
  const bf16*vsrc=Vh+(long)(16*(wid&3)+(lane>>2))*PIN_+(wid>>2)*32+(lane&3)*8;
  const unsigned kdst=lds0+LDS_K+wid*1024, vdst=lds0+LDS_V+wid*1024;
  #define DMA_K(t,slot) glds16(ksrc+TROW(t)*PIN_,(unsigned)__builtin_amdgcn_readfirstlane(kdst+(slot)))
  #define DMA_V(t,slot) glds16(vsrc+TROW(t)*PIN_,(unsigned)__builtin_amdgcn_readfirstlane(vdst+(slot)))
  const int vb0=(int)(lds0+LDS_V)+((lane>>4)&1)*32+(lane&3)*8+(4*hi+((lane&15)>>2))*64;
  const char*Kbase=shm+LDS_K; bf16x8 kf[8];
  const lds_cptr shm3=(lds_cptr)shm; const lds_cptr kp0=shm3+LDS_K+hi*1024+r32*16; const lds_cptr vp0=shm3+LDS_V+((lane>>4)&1)*32+(lane&3)*8+(4*hi+((lane&15)>>2))*64;
  DMA_K(0,0);DMA_V(0,0);DMA_K(1,SLOTB);
  bf16x8 qr[4];
  #pragma unroll
  for(int d0=0;d0<4;++d0)qr[d0]=*reinterpret_cast<const bf16x8*>(&Qw[(long)r32*PIN_+d0*16+hi*8]);
  float zz_=0.f; asm volatile("":"+v"(zz_));
  float mhat=zz_,l_reg=zz_;f32x16 o[2],negm;
  #pragma unroll
  for(int r=0;r<16;++r){o[0][r]=zz_;o[1][r]=zz_;negm[r]=zz_;}
  asm volatile("":"+v"(negm));
  #define CMASK(P0,P1,t) hook(P0,P1,(t),wid,r32,hi)
  bool resc=false;
  #define START(P0,P1) do{ const float rm=rowmax(P0,P1); resc=false; \
    { const float dl=rm; mhat=fadd_s(mhat,dl); \
      _Pragma("unroll") for(int r=0;r<16;++r){P0[r]=fsub_s(P0[r],dl);P1[r]=fsub_s(P1[r],dl);} \
      _Pragma("unroll") for(int r=0;r<16;++r)negm[r]=-mhat; asm volatile("":"+v"(negm)); } \
    _Pragma("unroll") for(int r=0;r<16;++r)P0[r]=__builtin_amdgcn_exp2f(P0[r]); }while(0)
  #define RESC() do{ if(resc){ asm volatile("s_waitcnt lgkmcnt(0)":::"memory"); \
      _Pragma("unroll") for(int d_=0;d_<2;++d_) _Pragma("unroll") for(int r=0;r<16;++r)o[d_][r]*=wsf[crow(r,hi)]; } }while(0)
  f32x16 pA0,pA1,pB0,pB1;
  int sl_prev=0,sl_cur=0,sl_next=SLOTB;
  #define ROT() do{sl_prev=sl_cur;sl_cur=sl_next;sl_next=(sl_next==(NSLOT-1)*SLOTB)?0:sl_next+SLOTB;}while(0)
  DMA_K(2,2*SLOTB);
  WAIT_BAR(3);
  qkt(pA0,pA1,Kbase,qr,negm,r32,hi);asm volatile("s_nop 15\n\ts_nop 7":"+v"(pA0),"+v"(pA1));
  START(pA0,pA1);
  _Pragma("unroll") for(int r=0;r<16;++r)pA1[r]=__builtin_amdgcn_exp2f(pA1[r]);
  WAIT_BAR(0);
  DMA_K(3,0);DMA_V(1,SLOTB);
  ROT();
  kload8(kf,kp0+sl_cur);
  WAIT_BAR(2);
  s16x4 vlo[8],vhi[8]; u32x4 pw0,pw1,pw2,pw3;
  #define PKW(P,B) cvtpk_s(P[B],P[B+1])
  #define PAF(k) __builtin_bit_cast(bf16x8,pw##k)
  #define VFR(i) (bf16x8){vlo[i][0],vlo[i][1],vlo[i][2],vlo[i][3],vhi[i][0],vhi[i][1],vhi[i][2],vhi[i][3]}
  #define PIN(x) asm volatile("":"+v"(x))
  #define MX3(a,b,c) __builtin_fmaxf(__builtin_fmaxf((a),(b)),(c))
  #define GAPA(MF,A0,A1,A2,A3,W0,W1,PW) do{ MF; sacc+=A0; sacc+=A1; sacc+=A2; sacc+=A3; PIN(sacc); W0; W1; PIN(PW); SBAR(); }while(0)
  #define EX(v) __builtin_amdgcn_exp2f(v)
  #define GAPB(MF,X,B) do{ MF; X[B]=EX(X[B]); X[B+1]=EX(X[B+1]); X[B+2]=EX(X[B+2]); X[B+3]=EX(X[B+3]); PIN(X); SBAR(); }while(0)
  #define VRD(i) do{ vlo[i]=vtr(vp_+(((i)>>2)*4096+((i)&3)*1024)); vhi[i]=vtr(vp_+(((i)>>2)*4096+((i)&3)*1024+512)); }while(0)
  #define KRD(G,j) do{ if(G){ kload2(kf,kp0+sl_next,j); SBAR(); } }while(0)
  #define STEP(C0,C1,P0,P1,t,GK,GV,GL) do{ SBAR(); \
    const lds_cptr vp_=vp0+sl_prev; \
    VRD(0); SBAR(); float sacc=(P0[0]+P0[1]); \
    GAPA(C0=__builtin_amdgcn_mfma_f32_32x32x16_bf16(kf[0],qr[0],negm,0,0,0), P0[2],P0[3],P0[4],P0[5],     pw0[0]=PKW(P0,0), pw0[1]=PKW(P0,2), pw0); \
    VRD(4); SBAR(); GAPA(C1=__builtin_amdgcn_mfma_f32_32x32x16_bf16(kf[1],qr[0],negm,0,0,0), P0[6],P0[7],P0[8],P0[9],     pw0[2]=PKW(P0,4), pw0[3]=PKW(P0,6), pw0); \
    VRD(1); SBAR(); GAPA(C0=__builtin_amdgcn_mfma_f32_32x32x16_bf16(kf[2],qr[1],C0,0,0,0),   P0[10],P0[11],P0[12],P0[13], pw1[0]=PKW(P0,8), pw1[1]=PKW(P0,10), pw1); \
    VRD(5); SBAR(); GAPA(C1=__builtin_amdgcn_mfma_f32_32x32x16_bf16(kf[3],qr[1],C1,0,0,0),   P0[14],P0[15],P1[0],P1[1],   pw1[2]=PKW(P0,12),pw1[3]=PKW(P0,14), pw1); \
    VRD(2); SBAR(); GAPA(C0=__builtin_amdgcn_mfma_f32_32x32x16_bf16(kf[4],qr[2],C0,0,0,0),   P1[2],P1[3],P1[4],P1[5],     pw2[0]=PKW(P1,0), pw2[1]=PKW(P1,2), pw2); \
    VRD(6); SBAR(); GAPA(C1=__builtin_amdgcn_mfma_f32_32x32x16_bf16(kf[5],qr[2],C1,0,0,0),   P1[6],P1[7],P1[8],P1[9],     pw2[2]=PKW(P1,4), pw2[3]=PKW(P1,6), pw2); \
    VRD(3); SBAR(); GAPA(C0=__builtin_amdgcn_mfma_f32_32x32x16_bf16(kf[6],qr[3],C0,0,0,0),   P1[10],P1[11],P1[12],P1[13], pw3[0]=PKW(P1,8), pw3[1]=PKW(P1,10), pw3); \
    VRD(7); SBAR(); GAPA(C1=__builtin_amdgcn_mfma_f32_32x32x16_bf16(kf[7],qr[3],C1,0,0,0),   P1[14],P1[15],0.f,0.f,       pw3[2]=PKW(P1,12),pw3[3]=PKW(P1,14), pw3); \
    l_reg+=sacc; \
    if(GK){DMA_K((t)+3,sl_cur);} if(GV){DMA_V((t)+1,sl_next);} \
    CMASK(C0,C1,t); \
    { float a=MX3(C0[0],C0[1],C1[0]),b=MX3(C0[2],C0[3],C1[1]); a=MX3(a,C1[2],C1[3]); \
      _Pragma("unroll") for(int r=4;r<16;r+=4){a=MX3(a,C0[r],C0[r+1]);b=MX3(b,C0[r+2],C0[r+3]);a=MX3(a,C1[r],C1[r+1]);b=MX3(b,C1[r+2],C1[r+3]);} \
      float rm=__builtin_fmaxf(a,b); { auto rr=__builtin_amdgcn_permlane32_swap(__float_as_uint(rm),__float_as_uint(rm),false,false); rm=__builtin_fmaxf(__uint_as_float(rr[0]),__uint_as_float(rr[1])); } \
      resc=false; \
      if(__builtin_expect(__any(rm>(float)THRL),0)){ const float dl=__builtin_fmaxf(rm,0.f); mhat+=dl; \
        _Pragma("unroll") for(int r=0;r<16;++r){C0[r]-=dl;C1[r]-=dl;} \
        _Pragma("unroll") for(int r=0;r<16;++r)negm[r]=-mhat; asm volatile("":"+v"(negm)); \
        const float f=__builtin_amdgcn_exp2f(-dl); l_reg*=f; if(hi==0)wsf[r32]=f; resc=true; } } \
    SBAR(); \
    GAPB(o[0]=__builtin_amdgcn_mfma_f32_32x32x16_bf16(PAF(0),VFR(0),o[0],0,0,0), C0,0); \
    GAPB(o[1]=__builtin_amdgcn_mfma_f32_32x32x16_bf16(PAF(0),VFR(4),o[1],0,0,0), C0,4); \
    KRD(GL,0); GAPB(o[0]=__builtin_amdgcn_mfma_f32_32x32x16_bf16(PAF(1),VFR(1),o[0],0,0,0), C0,8); \
    KRD(GL,1); GAPB(o[1]=__builtin_amdgcn_mfma_f32_32x32x16_bf16(PAF(1),VFR(5),o[1],0,0,0), C0,12); \
    KRD(GL,2); GAPB(o[0]=__builtin_amdgcn_mfma_f32_32x32x16_bf16(PAF(2),VFR(2),o[0],0,0,0), C1,0); \
    KRD(GL,3); GAPB(o[1]=__builtin_amdgcn_mfma_f32_32x32x16_bf16(PAF(2),VFR(6),o[1],0,0,0), C1,4); \
    GAPB(o[0]=__builtin_amdgcn_mfma_f32_32x32x16_bf16(PAF(3),VFR(3),o[0],0,0,0), C1,8); \
    GAPB(o[1]=__builtin_amdgcn_mfma_f32_32x32x16_bf16(PAF(3),VFR(7),o[1],0,0,0), C1,12); \
    }while(0)
  int t=1;
  for(;t+5<NT;t+=2){
    STEP(pB0,pB1,pA0,pA1,t,true,true,true);     WAIT_BAR(2); RESC(); ROT();
    STEP(pA0,pA1,pB0,pB1,t+1,true,true,true);   WAIT_BAR(2); RESC(); ROT();
  }
  #define ENDW(tt) do{ if((tt)+3<NT){WAIT_BAR(2);} else if((tt)+2<NT){WAIT_BAR(1);} else {WAIT_BAR(0);} }while(0)
  for(;t+1<NT;t+=2){
    STEP(pB0,pB1,pA0,pA1,t,(t+3<NT),(t+1<NT),(t+1<NT));       ENDW(t);   RESC(); ROT();
    STEP(pA0,pA1,pB0,pB1,t+1,(t+4<NT),(t+2<NT),(t+2<NT));     ENDW(t+1); RESC(); ROT();
  }
  STEP(pB0,pB1,pA0,pA1,NT-1,false,false,false); RESC();
  { float sacc=pB0[0]+pB0[1]; _Pragma("unroll") for(int r=2;r<16;++r)sacc+=pB0[r]; _Pragma("unroll") for(int r=0;r<16;++r)sacc+=pB1[r]; l_reg+=sacc;
    pw0=(u32x4){PKW(pB0,0),PKW(pB0,2),PKW(pB0,4),PKW(pB0,6)};pw1=(u32x4){PKW(pB0,8),PKW(pB0,10),PKW(pB0,12),PKW(pB0,14)};pw2=(u32x4){PKW(pB1,0),PKW(pB1,2),PKW(pB1,4),PKW(pB1,6)};pw3=(u32x4){PKW(pB1,8),PKW(pB1,10),PKW(pB1,12),PKW(pB1,14)};
    SBAR(); pv(o,vb0+sl_cur,PAF(0),PAF(1),PAF(2),PAF(3)); }
  #undef PKW
  #undef PAF
  #undef VFR
  #undef PIN
  #undef MX3
  #undef GAPA
  #undef GAPB
  #undef EX
  #undef VRD
  #undef KRD
  #undef STEP
  #undef ENDW
  {auto rr=__builtin_amdgcn_permlane32_swap(__float_as_uint(l_reg),__float_as_uint(l_reg),false,false);l_reg=__uint_as_float(rr[0])+__uint_as_float(rr[1]);}
  if(hi==0)wsf[32+r32]=l_reg;asm volatile("s_waitcnt lgkmcnt(0)":::"memory");
  float rli[16];
  #pragma unroll
  for(int r=0;r<16;++r)rli[r]=__builtin_amdgcn_rcpf(wsf[32+crow(r,hi)]);
  bf16*Ow=O0+(long)(wid*QBLK)*POUT;
  { bf16*stg=(bf16*)(shm+LDS_OST)+wid*2048;
    #pragma unroll
    for(int r=0;r<16;++r){const int orow=crow(r,hi);
      #pragma unroll
      for(int d0=0;d0<2;++d0)stg[orow*64+d0*32+r32]=(bf16)f2bf(o[d0][r]*rli[r]);}
    asm volatile("s_waitcnt lgkmcnt(0)":::"memory");
    #pragma unroll
    for(int i=0;i<4;++i){const int row=i*8+(lane>>3),ch=lane&7; const u32x4 v=*(const u32x4*)(stg+row*64+ch*8); ATTN_STORE16(Ow+(long)row*POUT+ch*8,v);} }
  asm volatile("s_waitcnt lgkmcnt(0)\n\ts_barrier":::"memory");
  #undef DMA_K
  #undef DMA_V
  #undef TROW
  #undef CMASK
  #undef START
  #undef RESC
  #undef ROT
}
constexpr int ATTN_LDS_BYTES=LDS_BYTES;
#undef SBAR
#undef WAIT_BAR
}

namespace pg8 {
struct EpiInProj {
    static constexpr bool PERM = true, AFTER_DRAIN = false;
    bf16_t* P; const float* na_qn; const float* na_kn; const float* gq_qn; const float* gq_kn; int wv;
    __device__ __forceinline__ void operator()(const f32x4 (&acc)[2][2][4][2], const Unit& u, int, int, int, int) const {
        const int l_ = otid(wv) & 63, fr = l_ & 15, fq = l_ >> 4, wr = wv >> 2, wc = wv & 3;
        const int pn = u.pn, rowt = u.pm * BM;
        int mode = 0; const float* gain = na_qn; float qs = 1.f;
        if (pn == 0) { mode = 1; gain = na_qn; qs = att::C2; }
        else if (pn == 1) { mode = 1; gain = na_kn; }
        else if (pn == 3 || pn == 4) { mode = 2; gain = gq_qn; qs = att::C2; }
        else if (pn == 5 && wc < 2) { mode = 2; gain = gq_kn; }
        if (mode == 2 && rowt >= NLAT) mode = 1;
        bf16_t* pcol = P + pn * BM + 64 * wc + 8 * fq;
        if (mode == 0) {
#pragma unroll
            for (int ai = 0; ai < 2; ++ai)
#pragma unroll
                for (int m = 0; m < 4; ++m) { bf16_t* rowp = pcol + (size_t)(rowt + ai * HALF + wr * 64 + m * 16 + fr) * DIN;
#pragma unroll
                    for (int bj = 0; bj < 2; ++bj) { const f32x4 v0 = acc[ai][bj][m][0], v1 = acc[ai][bj][m][1];
                        u32x4 w; w.x = cvt_pk_bf16(v0[0], v0[1]); w.y = cvt_pk_bf16(v0[2], v0[3]); w.z = cvt_pk_bf16(v1[0], v1[1]); w.w = cvt_pk_bf16(v1[2], v1[3]);
                        *(u32x4*)(rowp + 32 * bj) = w; } }
            return;
        }
        f32x4 g[2][2]; float invf[2][2];
#pragma unroll
        for (int bj = 0; bj < 2; ++bj)
#pragma unroll
            for (int n = 0; n < 2; ++n) g[bj][n] = *(const f32x4*)(gain + 32 * bj + 8 * fq + 4 * n) * qs;
#pragma unroll
        for (int n = 0; n < 2; ++n)
#pragma unroll
            for (int pp = 0; pp < 2; ++pp) invf[n][pp] = exp2f(-(float)(4 * fq + 2 * n + pp) * (13.287712379549449f / 16.f));
#pragma unroll
        for (int ai = 0; ai < 2; ++ai)
#pragma unroll
            for (int m = 0; m < 4; ++m) {
                const int row = rowt + ai * HALF + wr * 64 + m * 16 + fr;
                f32x4 v[2][2]; float ss = 0.f;
#pragma unroll
                for (int bj = 0; bj < 2; ++bj)
#pragma unroll
                    for (int n = 0; n < 2; ++n) { v[bj][n] = acc[ai][bj][m][n]; ss += (v[bj][n][0] * v[bj][n][0] + v[bj][n][1] * v[bj][n][1]) + (v[bj][n][2] * v[bj][n][2] + v[bj][n][3] * v[bj][n][3]); }
                ss += shx(ss, 16, l_); ss += shx(ss, 32, l_);
                const float rstd = rsqrtf(ss * (1.f / 64.f) + 1e-6f);
#pragma unroll
                for (int bj = 0; bj < 2; ++bj)
#pragma unroll
                    for (int n = 0; n < 2; ++n) {
                        if (mode == 2) {
                        }
                        v[bj][n] = v[bj][n] * rstd * g[bj][n];
                    }
                if (mode == 2) {
                    const int t = row & (SEQ - 1); const float pos[2] = {(float)(t >> 6), (float)(t & 63)};
#pragma unroll
                    for (int bj = 0; bj < 2; ++bj)
#pragma unroll
                        for (int n = 0; n < 2; ++n)
#pragma unroll
                            for (int pp = 0; pp < 2; ++pp) {
                                const float ang = pos[bj] * invf[n][pp], cs = __cosf(ang), sn = __sinf(ang);
                                const float x1 = v[bj][n][2 * pp], x2 = v[bj][n][2 * pp + 1];
                                v[bj][n][2 * pp] = x1 * cs - x2 * sn; v[bj][n][2 * pp + 1] = x1 * sn + x2 * cs;
                            }
                }
                bf16_t* rowp = pcol + (size_t)row * DIN;
#pragma unroll
                for (int bj = 0; bj < 2; ++bj) { const f32x4 v0 = v[bj][0], v1 = v[bj][1];
                    u32x4 w; w.x = cvt_pk_bf16(v0[0], v0[1]); w.y = cvt_pk_bf16(v0[2], v0[3]); w.z = cvt_pk_bf16(v1[0], v1[1]); w.w = cvt_pk_bf16(v1[2], v1[3]);
                    *(u32x4*)(rowp + 32 * bj) = w; }
                asm volatile("" ::: "memory");
            }
    }
};
}

__device__ __forceinline__ void w_qknorm_rope(const Ptrs& p, int layer, int unit, int d) {
    const int row = unit / 18, slot = unit % 18;
    int col; const float* gain; bool rope;
    if (slot < 4) { col = A_Q + slot * 64; gain = p.in[I_NAQN] + layer * 64; rope = false; }
    else if (slot < 8) { col = A_K + (slot - 4) * 64; gain = p.in[I_NAKN] + layer * 64; rope = false; }
    else if (slot < 16) { col = B_Q + (slot - 8) * 64; gain = p.in[I_GQQN] + layer * 64; rope = true; }
    else { col = B_K + (slot - 16) * 64; gain = p.in[I_GQKN] + layer * 64; rope = true; }
    bf16* pp = (bf16*)(p.ws + WS_P) + (size_t)row * DIN + col;
    float x = bf2f(pp[d]);
    float ss = wave_sum(x * x, d);
    float y = x * rsqrtf(ss * (1.f / 64.f) + 1e-6f) * gain[d];
    if (rope && row < NLAT) {
        int t = row & (SEQ - 1);
        float partner = shx(y, 1, d);
        int pi = d >> 1;
        float pos = (pi < 16) ? (float)(t >> 6) : (float)(t & 63);
        float inv = exp2f(-(float)(pi & 15) * (13.287712379549449f / 16.f));
        float ang = pos * inv;
        float cs = __cosf(ang), sn = __sinf(ang);
        y = (d & 1) ? (partner * sn + y * cs) : (y * cs - partner * sn);
    }
    if (slot < 4 || (slot >= 8 && slot < 16)) y *= att::C2;
    pp[d] = (bf16)f2bf(y);
}
struct NoHook { __device__ __forceinline__ void operator()(att::f32x16&, att::f32x16&, int, int, int, int) const {} };
struct NaHook {
    const LAS float* tab; int r0, kr0;
    __device__ __forceinline__ void operator()(att::f32x16& p0, att::f32x16& p1, int t, int wid, int r32, int hi) const {
        if (t < 4) return;
        const int r = r0 + (wid >> 1), kr = kr0 + t - 4, rs = min(max(r - 4, 0), 24);
        const float NEG = -INFINITY;
        if ((unsigned)(kr - rs) >= 8u) {
#pragma unroll
            for (int i = 0; i < 16; ++i) { p0[i] = NEG; p1[i] = NEG; }
            return;
        }
        const int qc = 32 * (wid & 1) + r32, cs = min(max(qc - 8, 0), 48), kb = 4 * hi - cs;
        const LAS float* tp = tab + (kr - r + 7) * 31 + (4 * hi - qc + 15);
#pragma unroll
        for (int i = 0; i < 16; ++i) {
            const int c = (i & 3) + 8 * (i >> 2);
            const float b0 = tp[c], b1 = tp[c + 32];
            p0[i] = ((unsigned)(kb + c) < 16u) ? p0[i] + b0 : NEG;
            p1[i] = ((unsigned)(kb + c + 32) < 16u) ? p1[i] + b1 : NEG;
        }
    }
};
constexpr int LDS_NATAB = 88064;
__device__ __forceinline__ void phase_attn(const Ptrs& p, unsigned char* lds_gen, int layer, int wv) {
    const bf16* P = (const bf16*)(p.ws + WS_P); bf16* MIX = (bf16*)(p.ws + WS_MIX);
    char* shm = (char*)lds_gen;
    const int c = blockIdx.x, x = c & 7, ci = (c >> 3) & 31;
    for (int i = 0; i < 2; ++i) {
        const int grp = 2 * x + i, b = grp >> 1, kvh = grp & 1, g = ci >> 3, qb = ci & 7, hq = kvh * 4 + g;
        const size_t qrow = (size_t)b * SEQ + qb * 256;
        att::attn_unit<8, NoHook>(P + qrow * DIN + B_Q + hq * 64, P + B_K + kvh * 64, P + B_V + kvh * 64, b * SEQ, 32, NLAT + b * CTXL, 36,
                                  MIX + qrow * DM + 256 + hq * 64, NoHook{}, shm, wv);
    }
    {
        const int grp = 4 * x + (ci >> 3), b = grp >> 2, h = grp & 3, r0 = 4 * (ci & 7);
        const int kr0 = (r0 == 0) ? 0 : (r0 == 28 ? 24 : r0 - 4), nr = (r0 == 0 || r0 == 28) ? 8 : 12;
        LAS float* tab = (LAS float*)((LAS unsigned char*)lds_gen + LDS_NATAB);
        const float* rpb = p.in[I_RPB] + ((size_t)layer * 4 + h) * 15 * 31;
        for (int i = otid(wv); i < 15 * 31; i += NT) tab[i] = rpb[i] * 1.4426950408889634f;
        __syncthreads();
        const size_t qrow = (size_t)b * SEQ + r0 * 64;
        NaHook hook{tab, r0, kr0};
        att::attn_unit<8, NaHook>(P + qrow * DIN + A_Q + h * 64, P + A_K + h * 64, P + A_V + h * 64, NLAT + b * CTXL, 4, b * SEQ + kr0 * 64, 4 + nr,
                                  MIX + qrow * DM + h * 64, hook, shm, wv);
    }
    if (layer == 0 && c < 96) {
        if (c < 32) {
            const int b = c >> 2, h = c & 3; const size_t qrow = (size_t)NLAT + b * CTXL;
            att::attn_unit<8, NoHook>(P + qrow * DIN + A_Q + h * 64, P + A_K + h * 64, P + A_V + h * 64, NLAT + b * CTXL, 4, 0, 4, MIX + qrow * DM + h * 64, NoHook{}, shm, wv);
        } else {
            const int cc = c - 32, b = cc >> 3, hq = cc & 7, kvh = hq >> 2; const size_t qrow = (size_t)NLAT + b * CTXL;
            att::attn_unit<8, NoHook>(P + qrow * DIN + B_Q + hq * 64, P + B_K + kvh * 64, P + B_V + kvh * 64, NLAT + b * CTXL, 4, 0, 4, MIX + qrow * DM + 256 + hq * 64, NoHook{}, shm, wv);
        }
    }
}


namespace pg8 {
struct InProjOrder {
    int G, c, nctx; bool trim;
    __device__ __forceinline__ void init(int G_, int c_, bool trim_) { G = G_; c = c_; trim = trim_; nctx = 8 * (trim_ ? 6 : 11); }
    __device__ __forceinline__ bool next(int i, Unit& u) const {
        constexpr int nM = NLAT / BM, nN = DIN / BM, nwg = nM * nN;
        const int L = i * G + c;
        if (L >= nwg + nctx) return false;
        const int wl = (L % NXCD) * (nwg / NXCD) + L / NXCD;
        const int nig = WGM * nN, gid = wl / nig, fm = gid * WGM;
        const int pm_l = fm + ((wl % nig) % WGM), pn_l = (wl % nig) / WGM;
        const int k = L - nwg, t = k >> 3;
        const int pm_c = 64 + (k & 7), pn_c = trim ? (t + 1 + ((t >= 2) ? 2 : 0) + ((t >= 3) ? 1 : 0)) : t;
        const bool lat = L < nwg;
        u.pm = lat ? pm_l : pm_c; u.pn = lat ? pn_l : pn_c; u.aux = 0;
        return true;
    }
    __device__ __forceinline__ void a_ready(const Unit&) const {}
    __device__ __forceinline__ void done(const Unit&) const {}
};
}

#define XB_TMO      128
#define XB_XCNT(j)  (256  + 64 * (j))
#define XB_XSUB(j)  (1280 + 64 * (j))
#define XB_XGEN(j)  (2304 + 64 * (j))
#define XB_TOP      3328
#define XB_TOPGEN   3392
#define XCD_BAR_WORDS 3456
#define XB_SPIN_CAP (1u << 18)
constexpr int CW_BAR = 4096;
constexpr int LDS_XB = LDS_BYTES - 64;
__device__ __forceinline__ unsigned xb_ld(unsigned* p)              { return __hip_atomic_load(p, __ATOMIC_RELAXED, __HIP_MEMORY_SCOPE_AGENT); }
__device__ __forceinline__ unsigned xb_add(unsigned* p, unsigned v) { return __hip_atomic_fetch_add(p, v, __ATOMIC_RELAXED, __HIP_MEMORY_SCOPE_AGENT); }
__device__ __forceinline__ unsigned xb_xcc_id() { return (unsigned)__builtin_amdgcn_s_getreg((3 << 11) | 20) & 0xFu; }
#define XB_SPIN(cond, bar) do { unsigned _sp = 0; while (cond) { __builtin_amdgcn_s_sleep(1); \
    if ((++_sp & 255u) == 0u) { if (xb_ld(&(bar)[XB_TMO])) break; if (_sp > XB_SPIN_CAP) { atomicAdd(&(bar)[XB_TMO], 1u); break; } } } } while (0)
struct XcdBarrier { unsigned* bar; unsigned x; volatile LAS unsigned* st; };
__device__ __forceinline__ XcdBarrier xcd_barrier_post(unsigned* bar, volatile LAS unsigned* st, int wv) {
    XcdBarrier b; b.bar = bar; b.x = xb_xcc_id(); b.st = st;
    if (otid(wv) == 0) (void)xb_add(&bar[XB_XCNT(b.x)], 1u);
    return b;
}
__device__ __forceinline__ void xcd_barrier_complete(unsigned* bar, unsigned x, unsigned& nloc, unsigned& nx) {
    const unsigned G = gridDim.x * gridDim.y * gridDim.z;
    unsigned sum, cnt, mine, sp = 0u;
    for (;;) {
        sum = 0u; cnt = 0u; mine = 0u;
#pragma unroll
        for (unsigned j = 0; j < 16; ++j) { const unsigned c = xb_ld(&bar[XB_XCNT(j)]); sum += c; cnt += (c > 0u) ? 1u : 0u; mine = (j == x) ? c : mine; }
        if (sum == G) break;
        __builtin_amdgcn_s_sleep(1);
        if ((++sp & 255u) == 0u) { if (xb_ld(&bar[XB_TMO])) break; if (sp > XB_SPIN_CAP) { atomicAdd(&bar[XB_TMO], 1u); break; } }
    }
    nloc = mine > 0u ? mine : 1u; nx = cnt > 0u ? cnt : 1u;
}
__device__ __forceinline__ void xcd_barrier(const XcdBarrier& b, int wv) {
    asm volatile("s_waitcnt vmcnt(0)" ::: "memory");
    __syncthreads();
    if (otid(wv) == 0) {
        unsigned* bar = b.bar; unsigned bx = b.x; asm volatile("" : "+s"(bx));
        __builtin_amdgcn_s_waitcnt(0);
        unsigned nloc = b.st[0], nx = b.st[1];
        if (nloc == 0u) { xcd_barrier_complete(bar, bx, nloc, nx); b.st[0] = nloc; b.st[1] = nx; }
        const unsigned old = xb_add(&bar[XB_XSUB(bx)], 1u);
        const unsigned gen = old / nloc;
        if (old + 1u == (gen + 1u) * nloc) {
            __builtin_amdgcn_fence(__ATOMIC_RELEASE, "agent");
            asm volatile("s_waitcnt vmcnt(0)" ::: "memory");
            const unsigned og = xb_add(&bar[XB_TOP], 1u);
            const unsigned tg = og / nx;
            if (og + 1u == (tg + 1u) * nx) xb_add(&bar[XB_TOPGEN], 1u);
            else XB_SPIN(xb_ld(&bar[XB_TOPGEN]) == tg, bar);
            __builtin_amdgcn_fence(__ATOMIC_ACQUIRE, "agent");
            xb_add(&bar[XB_XGEN(bx)], 1u);
            asm volatile("s_waitcnt vmcnt(0)" ::: "memory");
        } else {
            XB_SPIN(xb_ld(&bar[XB_XGEN(bx)]) == gen, bar);
            __builtin_amdgcn_fence(__ATOMIC_ACQUIRE, "agent");
            asm volatile("s_waitcnt vmcnt(0)" ::: "memory");
        }
    }
    __syncthreads();
}

__global__ void __launch_bounds__(NT, 2) k_mega(Ptrs p) {
    extern __shared__ __attribute__((aligned(16))) unsigned char lds_raw[];
    LAS unsigned char* lds = (LAS unsigned char*)lds_raw;
    cg::grid_group grid = cg::this_grid();
    const int wv = __builtin_amdgcn_readfirstlane(threadIdx.x >> 6);
#define CG_SYNC() do { asm volatile("s_waitcnt vmcnt(0)" ::: "memory"); grid.sync(); __builtin_amdgcn_fence(__ATOMIC_ACQUIRE, "agent"); asm volatile("s_waitcnt vmcnt(0)" ::: "memory"); } while (0)
#define GRID_SYNC() xcd_barrier(xbar, wv)
    if (otid(wv) < 16) ((LAS unsigned*)(lds + LDS_XB))[otid(wv)] = 0u;
    __syncthreads();
    const XcdBarrier xbar = xcd_barrier_post((unsigned*)(p.ws + WS_CTL) + CW_BAR, (volatile LAS unsigned*)(lds + LDS_XB), wv);
    const int NGW = gridDim.x * NWAVES;
    phase_mod(p, lds, wv);
    phase_lb(p, wv);
    __syncthreads();
    phase_convert(p, lds, 0, 2, wv);
    phase_router_w(p, wv);
    if (p.pad != 0) CG_SYNC();
    GRID_SYNC();
    phase_gs2(p, wv);
    phase_norm(p.in[I_X], p.in[I_CTX], p.in[I_N1G], (const float*)(p.ws + WS_MOD), 0, 1, (bf16*)(p.ws + WS_H), MROWS, wv);
    GRID_SYNC();
    for (int layer = 0; layer < 2; ++layer) {
        const int M = (layer == 0) ? MROWS : NLAT;
        const float* modl = (const float*)(p.ws + WS_MOD) + (size_t)layer * 9 * MODW;
        {
            pg8::Gemm g{(const bf16*)(p.ws + WS_H), (const bf16*)(p.ws + WS_WIN + layer * WIN_STRIDE), MROWS, DIN, DM};
            pg8::InProjOrder S; S.init(gridDim.x, (int)blockIdx.x, layer == 1);
            pg8::EpiInProj E{(bf16*)(p.ws + WS_P), p.in[I_NAQN] + layer * 64, p.in[I_NAKN] + layer * 64, p.in[I_GQQN] + layer * 64, p.in[I_GQKN] + layer * 64, wv};
            pg8::gemm_phase<pg8::EpiInProj, pg8::InProjOrder, true, true>(lds, g, S, E, wv);
        }
        GRID_SYNC();
        phase_hgrn1(p, lds, layer, wv);
        GRID_SYNC();
        phase_hgrn_scan(p, wv);
        GRID_SYNC();
        phase_hgrn2(p, lds, layer, wv);
        __syncthreads();
        phase_attn(p, lds_raw, layer, wv);
        GRID_SYNC();
        {
            pg8::Gemm g{(const bf16*)(p.ws + WS_MIX), (const bf16*)(p.ws + WS_WOUT + layer * WOUT_STRIDE), M, DM, DM};
            pg8::StaticOrder S; S.init(M, DM, gridDim.x, (int)blockIdx.x);
            pg8::EpiResidSS E{layer == 0 ? p.in[I_X] : p.out, p.in[I_CTX], p.out, (float*)(p.ws + WS_XC), modl, 2, (float*)(p.ws + WS_RSS), wv};
            pg8::gemm_phase<pg8::EpiResidSS, pg8::StaticOrder, true, true>(lds, g, S, E, wv);
        }
        GRID_SYNC();
        phase_route(p, lds, layer, M, wv);
        GRID_SYNC();
        phase_moe_gu(p, lds, layer, wv);
        GRID_SYNC();
        phase_moe_down(p, lds, layer, wv);
        GRID_SYNC();
        phase_combine(p, layer, M, layer == 0, wv);
        if (layer == 0) GRID_SYNC();
    }
}

extern "C" void kernel_launch(void* const* d_in, const int* in_sizes, int n_in, void* d_out, int out_size, void* d_ws, size_t ws_size, hipStream_t stream) {
    static int grid = 0;
    if (grid == 0) {
        if (n_in != 24 || ws_size < WS_END) { fprintf(stderr, "kernel_launch: bad n_in %d or ws_size %zu < %zu\n", n_in, ws_size, (size_t)WS_END); grid = -1; return; }
        int dev = 0, cus = 0, per_cu = 0;
        hipGetDevice(&dev); hipDeviceGetAttribute(&cus, hipDeviceAttributeMultiprocessorCount, dev);
        hipFuncSetAttribute((const void*)k_mega, hipFuncAttributeMaxDynamicSharedMemorySize, LDS_BYTES);
        hipOccupancyMaxActiveBlocksPerMultiprocessor(&per_cu, (const void*)k_mega, NT, LDS_BYTES);
        if (per_cu < 1) { fprintf(stderr, "kernel_launch: occupancy query says %d blocks/CU\n", per_cu); grid = -1; return; }
        grid = cus;
        (void)hipGetLastError();
    }
    if (grid < 0) return;
    Ptrs p{};
    for (int i = 0; i < 24; ++i) p.in[i] = (const float*)d_in[i];
    p.out = (float*)d_out; p.ws = (unsigned char*)d_ws; p.layer = 0; p.pad = 0;
    hipMemsetAsync((unsigned char*)d_ws + WS_CTL, 0, 1 * MiB, stream);
    void* args[] = {&p};
    hipError_t e = hipLaunchCooperativeKernel((const void*)k_mega, dim3(grid), dim3(NT), args, LDS_BYTES, stream);
    if (e != hipSuccess) fprintf(stderr, "cooperative launch failed: %s\n", hipGetErrorString(e));
}
```

```cpp
#include <hip/hip_runtime.h>
#include <hip/hip_cooperative_groups.h>
#include <cstdio>
#include <cstdint>
#include <math.h>
namespace cg = cooperative_groups;

#define DM 1024
#define SEQ 2048
#define CTXL 256
#define NBATCH 8
#define NLAT (NBATCH * SEQ)
#define NCTX (NBATCH * CTXL)
#define MROWS (NLAT + NCTX)
#define DIN 2816
#define NMOD 6
#define MODW (NMOD * DM)
#define A_Q 0
#define A_K 256
#define A_V 512
#define B_Q 768
#define B_K 1280
#define B_V 1408
#define C_Q 1536
#define C_I 1792
#define C_FF 2048
#define C_FB 2304
#define C_G 2560

typedef unsigned short bf16;
#define LAS __attribute__((address_space(3)))
#define GAS __attribute__((address_space(1)))
typedef unsigned v4u __attribute__((ext_vector_type(4)));
typedef unsigned v2u __attribute__((ext_vector_type(2)));
typedef float v4f __attribute__((ext_vector_type(4)));

__device__ __forceinline__ unsigned f2bf(float f) { unsigned u = __builtin_bit_cast(unsigned, f); return (u + 0x7fffu + ((u >> 16) & 1u)) >> 16; }
__device__ __forceinline__ unsigned pk2(float lo, float hi) { return f2bf(lo) | (f2bf(hi) << 16); }
__device__ __forceinline__ float bf2f(unsigned short v) { return __builtin_bit_cast(float, (unsigned)v << 16); }
__device__ __forceinline__ float bflo(unsigned v) { return __builtin_bit_cast(float, v << 16); }
__device__ __forceinline__ float bfhi(unsigned v) { return __builtin_bit_cast(float, v & 0xffff0000u); }
__device__ __forceinline__ float silu_f(float x) { return x / (1.f + __expf(-x)); }
__device__ __forceinline__ float shx(float v, int mask, int lane) { return __builtin_bit_cast(float, __builtin_amdgcn_ds_bpermute((lane ^ mask) << 2, __builtin_bit_cast(int, v))); }
__device__ __forceinline__ float wave_sum(float v, int lane) {
#pragma unroll
    for (int o = 1; o < 64; o <<= 1) v += shx(v, o, lane);
    return v;
}
__device__ __forceinline__ int otid(int wv) { unsigned m = ~0u; asm volatile("" : "+s"(m)); asm volatile("" : "+s"(wv)); return wv * 64 + (int)__builtin_amdgcn_mbcnt_hi(m, __builtin_amdgcn_mbcnt_lo(m, 0u)); }
#define LDS_WAIT() asm volatile("s_waitcnt lgkmcnt(0)" ::: "memory")

constexpr size_t MiB = 1u << 20;
constexpr size_t WS_CTL = 0;
constexpr size_t WS_MOD = 1 * MiB;
constexpr size_t WS_LB = 1 * MiB + 512 * 1024;
constexpr size_t WS_EID = 2 * MiB;
constexpr size_t WS_EW = 2 * MiB + 256 * 1024;
constexpr size_t WS_IDX = 3 * MiB;
constexpr size_t WS_XC = 8 * MiB;
constexpr size_t WS_WIN = 16 * MiB;
constexpr size_t WIN_STRIDE = (size_t)DIN * DM * 2;
constexpr size_t WS_WOUT = 28 * MiB;
constexpr size_t WOUT_STRIDE = 2 * MiB;
constexpr size_t WS_WGU = 32 * MiB;
constexpr size_t WGU_STRIDE = 32 * MiB;
constexpr size_t WS_WD = 96 * MiB;
constexpr size_t WD_STRIDE = 16 * MiB;
constexpr size_t WS_H = 128 * MiB;
constexpr size_t WS_MIX = 164 * MiB;
constexpr size_t WS_P = 200 * MiB;
constexpr size_t WS_Y0 = 200 * MiB;
constexpr size_t WS_Y1 = 236 * MiB;
constexpr size_t WS_HID = 272 * MiB;
constexpr size_t WS_SCR = 300 * MiB;
constexpr size_t WS_END = 340 * MiB;

constexpr int NT = 512, NWAVES = 8;
constexpr int LDS_BYTES = 147456;
namespace pg8 {
#define PG8_LAS __attribute__((address_space(3)))
typedef unsigned short bf16_t;
typedef short bf16x8 __attribute__((ext_vector_type(8)));
typedef float f32x4 __attribute__((ext_vector_type(4)));
typedef unsigned u32x4 __attribute__((ext_vector_type(4)));
constexpr int BM = 256, BK = 64, HALF = 128, HTB = HALF * BK * 2  , STAGE_BYTES = 8 * HTB, NXCD = 8, WGM = 8;

__host__ __device__ __forceinline__ int lds_byte(int r, int c) { const int st = (r >> 4) * 2 + (c >> 5), rr = r & 15, cc = c & 31, ob = rr * 64 + cc * 2; return st * 1024 + (ob ^ (((ob >> 9) & 1) << 5)); }
__host__ __device__ __forceinline__ void stage_rc(int b, int& R, int& C) { const int st = b / 1024, sb = b % 1024, swz = sb ^ (((sb >> 9) & 1) << 5); R = (st >> 1) * 16 + swz / 64; C = (st & 1) * 32 + (swz % 64) / 2; }
__host__ __device__ __forceinline__ int perm32(int rho) { const int n = rho >> 4, i = rho & 15; return 8 * (i >> 2) + 4 * n + (i & 3); }

struct Unit { int pm, pn, aux; };
struct Gemm { const bf16_t* A; const bf16_t* Bt; int M, N, K; };

struct StaticOrder {
    int nM, nN, nwg, G, c;
    __host__ __device__ void init(int M, int N, int G_, int c_) { nM = M / BM; nN = N / BM; nwg = nM * nN; G = G_; c = c_; }
    __host__ __device__ bool next(int i, Unit& u) const {
        const long L = (long)i * G + c; if (L >= nwg) return false;
        int wgid = (int)L; { const int q = nwg / NXCD, r = nwg % NXCD, xcd = wgid % NXCD, off = wgid / NXCD; wgid = (xcd < r ? xcd * (q + 1) : r * (q + 1) + (xcd - r) * q) + off; }
        const int nig = WGM * nN, gid = wgid / nig, fm = gid * WGM, gsz = (nM - fm) < WGM ? (nM - fm) : WGM;
        u.pm = fm + ((wgid % nig) % gsz); u.pn = (wgid % nig) / gsz; return true;
    }
    __device__ __forceinline__ void a_ready(const Unit&) const {}
    __device__ __forceinline__ void done(const Unit&) const {}
};

__device__ __forceinline__ unsigned cvt_pk_bf16(float lo, float hi) { unsigned r; asm volatile("v_cvt_pk_bf16_f32 %0, %1, %2" : "=v"(r) : "v"(lo), "v"(hi)); return r; }
typedef float f32x2 __attribute__((ext_vector_type(2)));
__device__ __forceinline__ f32x2 gelu_pk(f32x2 v) {
    const f32x2 av = __builtin_elementwise_abs(v), d = av * 0.2316418882f + 1.0f;
    f32x2 t; t.x = __builtin_amdgcn_rcpf(d.x); t.y = __builtin_amdgcn_rcpf(d.y);
    f32x2 q = t * 0.5307027145f + (-0.7265760135f); q = q * t + 0.7107068705f; q = q * t + (-0.142248368f); q = q * t + 0.127414796f; q = q * t;
    const f32x2 s = (v * v) * (-0.72134752044f);
    f32x2 e; e.x = __builtin_amdgcn_exp2f(s.x); e.y = __builtin_amdgcn_exp2f(s.y);
    const f32x2 m = v * (q * e), r = v - m;
    f32x2 o; o.x = v.x < 0.f ? m.x : r.x; o.y = v.y < 0.f ? m.y : r.y; return o;
}

template <int ACT  > struct EpiBf16 {
    static constexpr bool PERM = true, AFTER_DRAIN = false; static_assert(ACT == 0 || ACT == 1, "EpiBf16: ACT is 0 (none) or 1 (gelu_pk)");
    bf16_t* O; int ldc; const float* bias; int split_cols; size_t split_stride; float scale0;
    __device__ __forceinline__ void operator()(const f32x4 (&acc)[2][2][4][2], const Unit& u, int wr, int wc, int fr, int fq) const {
        const int row0 = u.pm * BM + wr * 64 + fr; int colt = u.pn * BM; bf16_t* base = O;
        float sc = 1.f; if (split_cols) { const int t = colt / split_cols; base += (size_t)t * split_stride; colt -= t * split_cols; if (t == 0) sc = scale0; }
        const int col0 = colt + wc * 32 + 8 * fq, bcol0 = u.pn * BM + wc * 32 + 8 * fq;
        f32x4 bv[2][2];
#pragma unroll
        for (int bj = 0; bj < 2; ++bj)
#pragma unroll
            for (int n = 0; n < 2; ++n) bv[bj][n] = bias ? *(const f32x4*)(bias + bcol0 + bj * HALF + 4 * n) : (f32x4){0.f, 0.f, 0.f, 0.f};
#pragma unroll
        for (int ai = 0; ai < 2; ++ai)
#pragma unroll
            for (int m = 0; m < 4; ++m) { bf16_t* rowp = base + (size_t)(row0 + ai * HALF + m * 16) * ldc + col0;
#pragma unroll
                for (int bj = 0; bj < 2; ++bj) { f32x4 v0 = acc[ai][bj][m][0] + bv[bj][0], v1 = acc[ai][bj][m][1] + bv[bj][1];
                    if (ACT == 1) { f32x2 a = gelu_pk((f32x2){v0[0], v0[1]}), b = gelu_pk((f32x2){v0[2], v0[3]}), c = gelu_pk((f32x2){v1[0], v1[1]}), d = gelu_pk((f32x2){v1[2], v1[3]});
                        v0 = (f32x4){a.x, a.y, b.x, b.y}; v1 = (f32x4){c.x, c.y, d.x, d.y}; }
                    v0 = v0 * sc; v1 = v1 * sc; u32x4 w; w.x = cvt_pk_bf16(v0[0], v0[1]); w.y = cvt_pk_bf16(v0[2], v0[3]); w.z = cvt_pk_bf16(v1[0], v1[1]); w.w = cvt_pk_bf16(v1[2], v1[3]);
                    *(u32x4*)(rowp + bj * HALF) = w; } }
    }
};

template <class Epi, class Sched, bool ALIGN_EPI = false, bool SP2 = false, bool GATHER = false>
__device__ __forceinline__ void gemm_phase(PG8_LAS unsigned char* lds, const Gemm g, const Sched& S, const Epi& E, int wv, const PG8_LAS int* gidx = nullptr) {
    static_assert(SP2 || !GATHER, "GATHER is wired into the SP2 loop only");
    int tid_ = otid(wv);
    const int tid = tid_, wid = __builtin_amdgcn_readfirstlane(tid >> 6), lane = tid & 63, wr = wid >> 2, wc = wid & 3, fr = lane & 15, fq = lane >> 4;
    const int K = g.K, nt = K / BK;
    unsigned voffA[2][2], nvoffA[2][2], voffB[2]; int RA[2], CA[2];
#pragma unroll
    for (int i = 0; i < 2; ++i) { int R, C; stage_rc(tid * 16 + i * 8192, R, C); const int Rb = Epi::PERM ? ((R & ~31) + perm32(R & 31)) : R; RA[i] = R; CA[i] = C;
        voffA[0][i] = voffA[1][i] = nvoffA[0][i] = nvoffA[1][i] = (unsigned)(R * K + C) * 2u; voffB[i] = (unsigned)(Rb * K + C) * 2u; }
#define PG8_GVOFF(dst, uidx) do { if constexpr (GATHER) { _Pragma("unroll") for (int _h = 0; _h < 2; ++_h) _Pragma("unroll") for (int _i = 0; _i < 2; ++_i) dst[_h][_i] = (unsigned)(gidx[(uidx) * 256 + _h * 128 + RA[_i]] * K + CA[_i]) * 2u; } } while (0)
    const size_t kstep = (size_t)(BK * 2);
    const size_t hstep = (size_t)HALF * K * 2;
    const size_t hstepA = GATHER ? (size_t)0 : hstep;
    const size_t tstep = 2 * hstep;
    const unsigned ldsw = (unsigned)wid * 1024u;
    const int aoff = lds_byte(wr * 64 + fr, fq * 8), boff = lds_byte(wc * 32 + fr, fq * 8);
#define PG8_SA(b, h) (((b) * 2 + (h)) * HTB)
#define PG8_SB(b, h) ((4 + (b) * 2 + (h)) * HTB)
#define PG8_STAGE(bufoff, gbase, voff) do { _Pragma("unroll") for (int _i = 0; _i < 2; ++_i) \
        __builtin_amdgcn_global_load_lds((const unsigned*)((const char*)(gbase) + (voff)[_i]), (PG8_LAS unsigned*)(lds + (bufoff) + ldsw + _i * 8192), 16, 0, 0); } while (0)
#define PG8_LDA(dst, b, h) do { _Pragma("unroll") for (int m = 0; m < 4; ++m) _Pragma("unroll") for (int k = 0; k < 2; ++k) dst[m][k] = *(const PG8_LAS bf16x8*)(lds + PG8_SA(b, h) + aoff + m * 2048 + k * 1024); } while (0)
#define PG8_LDB(dst, b, h) do { _Pragma("unroll") for (int n = 0; n < 2; ++n) _Pragma("unroll") for (int k = 0; k < 2; ++k) dst[n][k] = *(const PG8_LAS bf16x8*)(lds + PG8_SB(b, h) + boff + n * 2048 + k * 1024); } while (0)
#define PG8_MMA(ai, bj, At, Bt) do { __builtin_amdgcn_s_setprio(1); _Pragma("unroll") for (int m = 0; m < 4; ++m) _Pragma("unroll") for (int n = 0; n < 2; ++n) _Pragma("unroll") for (int k = 0; k < 2; ++k) \
        acc[ai][bj][m][n] = __builtin_amdgcn_mfma_f32_16x16x32_bf16(Bt[n][k], At[m][k], acc[ai][bj][m][n], 0, 0, 0); __builtin_amdgcn_s_setprio(0); } while (0)
#define PG8_WAIT_V(n) asm volatile("s_waitcnt vmcnt(" #n ")" ::: "memory")
#define PG8_WAIT_L(n) asm volatile("s_waitcnt lgkmcnt(" #n ")" ::: "memory")
#define PG8_BAR __builtin_amdgcn_s_barrier()
#define PG8_SCHED __builtin_amdgcn_sched_barrier(0)
    Unit cur, nxt; int ui = 0;
    if (!S.next(0, cur)) return;
    f32x4 acc[2][2][4][2];
#pragma unroll
    for (int a = 0; a < 2; ++a)
#pragma unroll
        for (int b = 0; b < 2; ++b)
#pragma unroll
            for (int m = 0; m < 4; ++m)
#pragma unroll
                for (int n = 0; n < 2; ++n) acc[a][b][m][n] = (f32x4){0.f, 0.f, 0.f, 0.f};
    bf16x8 At[4][2], B0[2][2], B1[2][2];
    const char* cA = (const char*)g.A + (GATHER ? (size_t)0 : (size_t)cur.pm * tstep); PG8_GVOFF(voffA, 0); const char* cB = (const char*)g.Bt + (size_t)cur.pn * tstep;
    S.a_ready(cur);
    if constexpr (SP2) {
        PG8_STAGE(PG8_SB(0, 0), cB, voffB); PG8_STAGE(PG8_SB(0, 1), cB + hstep, voffB); PG8_STAGE(PG8_SA(0, 0), cA, voffA[0]); PG8_STAGE(PG8_SA(0, 1), cA + hstepA, voffA[1]);
        if (wr == 1) PG8_BAR;
        PG8_WAIT_V(2); PG8_BAR;
        PG8_STAGE(PG8_SB(1, 0), cB + kstep, voffB); PG8_STAGE(PG8_SA(1, 0), cA + kstep, voffA[0]); PG8_STAGE(PG8_SB(1, 1), cB + hstep + kstep, voffB);
        PG8_WAIT_V(6); PG8_BAR;
    } else {
        PG8_STAGE(PG8_SB(0, 0), cB, voffB); PG8_STAGE(PG8_SA(0, 0), cA, voffA[0]); PG8_STAGE(PG8_SB(0, 1), cB + hstep, voffB); PG8_STAGE(PG8_SA(0, 1), cA + hstep, voffA[0]);
        if (wr == 1) PG8_BAR;
        PG8_WAIT_V(4); PG8_BAR;
        PG8_STAGE(PG8_SB(1, 0), cB + kstep, voffB); PG8_STAGE(PG8_SA(1, 0), cA + kstep, voffA[0]); PG8_STAGE(PG8_SB(1, 1), cB + hstep + kstep, voffB);
        PG8_WAIT_V(6); PG8_BAR;
    }
    for (;;) {
        const bool has_next = S.next(ui + 1, nxt);
        const char* nA = (has_next && !GATHER) ? (const char*)g.A + (size_t)nxt.pm * tstep : cA; if (has_next) PG8_GVOFF(nvoffA, ui + 1); const char* nB = has_next ? (const char*)g.Bt + (size_t)nxt.pn * tstep : cB;
        for (int t = 0; t < nt; t += 2) {
            const bool last = (t == nt - 2);
            const char* a1 = cA + (size_t)(t + 1) * kstep;
            const char* a2 = last ? nA : cA + (size_t)(t + 2) * kstep; const char* b2 = last ? nB : cB + (size_t)(t + 2) * kstep;
            const char* a3 = a2 + kstep; const char* b3 = b2 + kstep;
            if (last && has_next) S.a_ready(nxt);
            unsigned vs2[2][2];
#pragma unroll
            for (int _h = 0; _h < 2; ++_h)
#pragma unroll
                for (int _i = 0; _i < 2; ++_i) vs2[_h][_i] = last ? nvoffA[_h][_i] : voffA[_h][_i];
            if constexpr (SP2) {
            PG8_LDB(B0, 0, 0); PG8_LDB(B1, 0, 1); PG8_SCHED; PG8_LDA(At, 0, 0); PG8_STAGE(PG8_SA(1, 1), a1 + hstepA, voffA[1]);
            PG8_WAIT_V(8); PG8_WAIT_L(0); PG8_BAR; PG8_MMA(0, 0, At, B0); PG8_MMA(0, 1, At, B1); PG8_BAR; PG8_SCHED;
            PG8_LDA(At, 0, 1); PG8_STAGE(PG8_SB(0, 0), b2, voffB); PG8_STAGE(PG8_SB(0, 1), b2 + hstep, voffB); PG8_STAGE(PG8_SA(0, 0), a2, vs2[0]);
            PG8_WAIT_V(8); PG8_WAIT_L(0); PG8_BAR; PG8_MMA(1, 0, At, B0); PG8_MMA(1, 1, At, B1); PG8_BAR; PG8_SCHED;
            PG8_LDB(B0, 1, 0); PG8_LDB(B1, 1, 1); PG8_SCHED; PG8_LDA(At, 1, 0); PG8_STAGE(PG8_SA(0, 1), a2 + hstepA, vs2[1]);
            PG8_WAIT_V(8); PG8_WAIT_L(0); PG8_BAR; PG8_MMA(0, 0, At, B0); PG8_MMA(0, 1, At, B1); PG8_BAR; PG8_SCHED;
            PG8_LDA(At, 1, 1); PG8_STAGE(PG8_SB(1, 0), b3, voffB); PG8_STAGE(PG8_SB(1, 1), b3 + hstep, voffB); PG8_STAGE(PG8_SA(1, 0), a3, vs2[0]);
            PG8_WAIT_V(8); PG8_WAIT_L(0); PG8_BAR; PG8_MMA(1, 0, At, B0); PG8_MMA(1, 1, At, B1); PG8_BAR; PG8_SCHED;
            } else {
            PG8_LDB(B0, 0, 0); PG8_SCHED; PG8_LDA(At, 0, 0); PG8_STAGE(PG8_SA(1, 1), a1 + hstep, voffA[0]);
            PG8_WAIT_L(8); PG8_BAR; PG8_WAIT_L(0); PG8_MMA(0, 0, At, B0); PG8_BAR; PG8_SCHED;
            PG8_LDB(B1, 0, 1); PG8_STAGE(PG8_SB(0, 0), b2, voffB);
            PG8_BAR; PG8_WAIT_L(0); PG8_MMA(0, 1, At, B1); PG8_BAR;
            PG8_LDA(At, 0, 1); PG8_STAGE(PG8_SA(0, 0), a2, voffA[0]);
            PG8_BAR; PG8_WAIT_L(0); PG8_MMA(1, 0, At, B0); PG8_BAR; PG8_SCHED;
            PG8_STAGE(PG8_SB(0, 1), b2 + hstep, voffB);
            PG8_WAIT_V(6); PG8_BAR; PG8_MMA(1, 1, At, B1); PG8_BAR;
            PG8_LDB(B0, 1, 0); PG8_SCHED; PG8_LDA(At, 1, 0); PG8_STAGE(PG8_SA(0, 1), a2 + hstep, voffA[0]);
            PG8_WAIT_L(8); PG8_BAR; PG8_WAIT_L(0); PG8_MMA(0, 0, At, B0); PG8_BAR; PG8_SCHED;
            PG8_LDB(B1, 1, 1); PG8_STAGE(PG8_SB(1, 0), b3, voffB);
            PG8_BAR; PG8_WAIT_L(0); PG8_MMA(0, 1, At, B1); PG8_BAR;
            PG8_LDA(At, 1, 1); PG8_STAGE(PG8_SA(1, 0), a3, voffA[0]);
            PG8_BAR; PG8_WAIT_L(0); PG8_MMA(1, 0, At, B0); PG8_BAR; PG8_SCHED;
            PG8_STAGE(PG8_SB(1, 1), b3 + hstep, voffB);
            PG8_WAIT_V(6); PG8_BAR; PG8_MMA(1, 1, At, B1); PG8_BAR;
            }
        }
        if constexpr (ALIGN_EPI) { if (wr == 0) PG8_BAR; }
        if constexpr (!Epi::AFTER_DRAIN) { E(acc, cur, wr, wc, fr, fq); S.done(cur); }
        if (!has_next) break;
#pragma unroll
        for (int a = 0; a < 2; ++a)
#pragma unroll
            for (int b = 0; b < 2; ++b)
#pragma unroll
                for (int m = 0; m < 4; ++m)
#pragma unroll
                    for (int n = 0; n < 2; ++n) acc[a][b][m][n] = (f32x4){0.f, 0.f, 0.f, 0.f};
        cur = nxt; cA = nA; cB = nB; ++ui;
#pragma unroll
        for (int _h = 0; _h < 2; ++_h)
#pragma unroll
            for (int _i = 0; _i < 2; ++_i) voffA[_h][_i] = nvoffA[_h][_i];
        if constexpr (ALIGN_EPI) { if (wr == 1) PG8_BAR; }
    }
    PG8_WAIT_V(0);
    if constexpr (!ALIGN_EPI) { if (wr == 0) PG8_BAR; }
    PG8_BAR;
    if constexpr (Epi::AFTER_DRAIN) { E.fused(acc, cur, wr, wc, fr, fq, lds, wid, lane); S.done(cur); }
#undef PG8_SA
#undef PG8_GVOFF
#undef PG8_SB
#undef PG8_STAGE
#undef PG8_LDA
#undef PG8_LDB
#undef PG8_MMA
#undef PG8_WAIT_V
#undef PG8_WAIT_L
#undef PG8_BAR
#undef PG8_SCHED
}
}


struct Ptrs { const float* in[24]; float* out; unsigned char* ws; int layer; int pad; };
enum { I_X = 0, I_C, I_CTX, I_CCTX, I_WADA, I_BADA, I_N1G, I_WIN, I_NAQN, I_NAKN, I_RPB, I_GQQN, I_GQKN, I_LB, I_HGON, I_WOUT, I_N2G, I_WRG, I_BRG, I_WRE, I_BRE, I_WEG, I_WEU, I_WED };

namespace pg8 {
struct EpiResid {
    static constexpr bool PERM = false, AFTER_DRAIN = false;
    const float* xin_lat; const float* xin_ctx; float* xout_lat; float* xout_ctx; const float* modl; int chunk;
    __device__ __forceinline__ void operator()(const f32x4 (&acc)[2][2][4][2], const Unit& u, int wr, int wc, int fr, int fq) const {
        const int rowt = u.pm * BM; const bool isctx = rowt >= NLAT;
        const float* xin = isctx ? xin_ctx + (size_t)(rowt - NLAT) * DM : xin_lat + (size_t)rowt * DM;
        float* xo = isctx ? xout_ctx + (size_t)(rowt - NLAT) * DM : xout_lat + (size_t)rowt * DM;
        const int mrow = isctx ? 8 : (rowt >> 11);
        const float* gate = modl + (size_t)mrow * MODW + chunk * DM;
        const int col0 = u.pn * BM + wc * 32 + 4 * fq;
#pragma unroll
        for (int bj = 0; bj < 2; ++bj)
#pragma unroll
            for (int n = 0; n < 2; ++n) {
                const int col = col0 + bj * HALF + n * 16;
                const f32x4 gv = *(const f32x4*)(gate + col);
#pragma unroll
                for (int ai = 0; ai < 2; ++ai)
#pragma unroll
                    for (int m = 0; m < 4; ++m) {
                        const size_t off = (size_t)(ai * HALF + wr * 64 + m * 16 + fr) * DM + col;
                        const f32x4 xi = *(const f32x4*)(xin + off);
                        *(f32x4*)(xo + off) = xi + gv * acc[ai][bj][m][n];
                    }
            }
    }
};
}

__device__ __forceinline__ void phase_mod(const Ptrs& p, LAS unsigned char* lds, int wv) {
    if (blockIdx.x >= 192) return;
    LAS float* sc = (LAS float*)lds;
    LAS float* red = (LAS float*)(lds + 36864);
    const int tid = otid(wv);
    const float* c = p.in[I_C]; const float* cc = p.in[I_CCTX];
    for (int i = tid; i < 9 * DM; i += NT) { float v = (i < 8 * DM) ? c[i] : cc[i - 8 * DM]; sc[i] = silu_f(v); }
    __syncthreads();
    float* mod = (float*)(p.ws + WS_MOD);
    for (int u = blockIdx.x; u < 192; u += gridDim.x) {
        const int layer = u / 96, cb = u % 96, cq = tid & 15, kg = tid >> 4;
        const float* w = p.in[I_WADA] + (size_t)layer * DM * MODW + cb * 64 + cq * 4;
        v4f acc[9];
#pragma unroll
        for (int r = 0; r < 9; ++r) acc[r] = (v4f){0.f, 0.f, 0.f, 0.f};
#pragma unroll 8
        for (int i = 0; i < 32; ++i) {
            const int k = kg + 32 * i;
            const v4f wv = *(const v4f*)(w + (size_t)k * MODW);
#pragma unroll
            for (int r = 0; r < 9; ++r) acc[r] += sc[r * DM + k] * wv;
        }
#pragma unroll
        for (int r = 0; r < 9; ++r) *(LAS v4f*)(red + (kg * 9 + r) * 64 + cq * 4) = acc[r];
        __syncthreads();
        for (int o = tid; o < 576; o += NT) {
            const int r = o >> 6, c2 = o & 63; float s = 0.f;
            for (int k2 = 0; k2 < 32; ++k2) s += red[(k2 * 9 + r) * 64 + c2];
            mod[((size_t)layer * 9 + r) * MODW + cb * 64 + c2] = s + p.in[I_BADA][layer * MODW + cb * 64 + c2];
        }
        __syncthreads();
    }
}
__device__ __forceinline__ void phase_lb(const Ptrs& p, int wv) {
    if (blockIdx.x == 255 % gridDim.x) {
        const int i = otid(wv);
        const float* raw = p.in[I_LB]; float* lb = (float*)(p.ws + WS_LB);
        float l0 = raw[i], l1 = raw[512 + i];
        lb[i] = 0.f; lb[512 + i] = 1.f / (1.f + __expf(l0 - l1));
    }
}
__device__ __forceinline__ void transpose_item(const float* W, int K, int N, bf16* WT, int row_off, LAS float* scr, int item, int lane) {
    const int nblk = N / 32, kb = item / nblk, nb = item % nblk, k0 = 64 * kb, n0 = 32 * nb;
    const int n4 = lane & 7, kr = lane >> 3;
    v4f t[8];
#pragma unroll
    for (int i = 0; i < 8; ++i) t[i] = *(const v4f*)(W + (size_t)(k0 + 8 * i + kr) * N + n0 + 4 * n4);
#pragma unroll
    for (int i = 0; i < 8; ++i) { LAS float* d = scr + (8 * i + kr) * 33 + 4 * n4; d[0] = t[i].x; d[1] = t[i].y; d[2] = t[i].z; d[3] = t[i].w; }
    LDS_WAIT(); asm volatile("" ::: "memory");
    const int c = lane & 7;
#pragma unroll
    for (int j = 0; j < 4; ++j) { const int n = (lane >> 3) + 8 * j; const LAS float* s = scr + (8 * c) * 33 + n;
        v4u o; o.x = pk2(s[0 * 33], s[1 * 33]); o.y = pk2(s[2 * 33], s[3 * 33]); o.z = pk2(s[4 * 33], s[5 * 33]); o.w = pk2(s[6 * 33], s[7 * 33]);
        *(v4u*)(WT + (size_t)(row_off + n0 + n) * K + k0 + 8 * c) = o; }
    LDS_WAIT(); asm volatile("" ::: "memory");
}
constexpr int CI_IN = 16 * 88, CI_OUT = 16 * 32, CI_G = 32 * 128, CI_U = 32 * 128, CI_D = 32 * 128, CI_LAYER = CI_IN + CI_OUT + CI_G + CI_U + CI_D;
constexpr int CI_DENSE = CI_IN + CI_OUT, CI_EXP = CI_G + CI_U + CI_D;
constexpr int CW_QDENSE = 2048, CW_QEXP = 2112;
__device__ __forceinline__ void convert_item(const Ptrs& p, int layer, int r, LAS float* scr, int lane) {
    if (r < CI_IN) {
        const int n0 = 32 * (r % 88), pn_ = n0 >> 8, w_ = (n0 >> 6) & 3, bj_ = (n0 >> 5) & 1;
        transpose_item(p.in[I_WIN] + (size_t)layer * DM * DIN, DM, DIN, (bf16*)(p.ws + WS_WIN + layer * WIN_STRIDE), (256 * pn_ + 128 * bj_ + 32 * w_) - n0, scr, r, lane); return; } r -= CI_IN;
    if (r < CI_OUT) { transpose_item(p.in[I_WOUT] + (size_t)layer * DM * DM, DM, DM, (bf16*)(p.ws + WS_WOUT + layer * WOUT_STRIDE), 0, scr, r, lane); return; } r -= CI_OUT;
    if (r < CI_G + CI_U) {
        const int up = r >= CI_G; if (up) r -= CI_G;
        const int e = r >> 7, rem = r & 127, nb = rem & 7, n0 = 32 * nb;
        const int mapped = (n0 >> 7) * 256 + (n0 & 127) + (up ? 128 : 0);
        transpose_item(p.in[up ? I_WEU : I_WEG] + ((size_t)layer * 32 + e) * DM * 256, DM, 256, (bf16*)(p.ws + WS_WGU + layer * WGU_STRIDE) + (size_t)e * 512 * DM, mapped - n0, scr, rem, lane);
        return;
    }
    r -= CI_G + CI_U;
    { const int e = r >> 7, rem = r & 127;
      transpose_item(p.in[I_WED] + ((size_t)layer * 32 + e) * 256 * DM, 256, DM, (bf16*)(p.ws + WS_WD + layer * WD_STRIDE) + (size_t)e * DM * 256, 0, scr, rem, lane); }
}
__device__ __forceinline__ void phase_convert(const Ptrs& p, LAS unsigned char* lds, int layer_lo, int layer_hi, int wv) {
    const int lane = otid(wv) & 63;
    LAS float* scr = (LAS float*)(lds + wv * 16384);
    const int gw = blockIdx.x * NWAVES + wv, NGW = gridDim.x * NWAVES;
    const int n_items = (layer_hi - layer_lo) * CI_LAYER;
    for (int it = gw; it < n_items; it += NGW) convert_item(p, layer_lo + it / CI_LAYER, it % CI_LAYER, scr, lane);
}
__device__ __forceinline__ void phase_convert_dense(const Ptrs& p, LAS unsigned char* lds, int wv) {
    const int lane = otid(wv) & 63; LAS float* scr = (LAS float*)(lds + wv * 16384);
    for (int it = blockIdx.x * NWAVES + wv; it < 2 * CI_DENSE; it += gridDim.x * NWAVES) convert_item(p, it / CI_DENSE, it % CI_DENSE, scr, lane);
}
constexpr int CE1 = 4608, CE2 = 8704, CE3 = 10752;
__device__ __forceinline__ void convert_expert_slice(const Ptrs& p, int layer, int lo, int hi, int worker, int nworkers, LAS float* scr, int wv) {
    const int lane = otid(wv) & 63;
    for (int it = lo + worker; it < hi; it += nworkers) convert_item(p, layer, CI_DENSE + it, scr, lane);
}
__device__ __forceinline__ int queue_pull(unsigned* head, unsigned n, int lane) {
    unsigned v = 0u;
    if (lane == 0) v = __hip_atomic_fetch_add(head, n, __ATOMIC_RELAXED, __HIP_MEMORY_SCOPE_AGENT);
    return (int)__builtin_amdgcn_readfirstlane(v);
}
__device__ __forceinline__ void convert_dense_queue(const Ptrs& p, LAS float* scr, int wv) {
    const int lane = otid(wv) & 63; unsigned* head = (unsigned*)(p.ws + WS_CTL) + CW_QDENSE;
    for (;;) { const int it0 = queue_pull(head, 4u, lane); if (it0 >= 2 * CI_DENSE) break;
        for (int it = it0; it < min(it0 + 4, 2 * CI_DENSE); ++it) convert_item(p, it / CI_DENSE, it % CI_DENSE, scr, lane); }
}
__device__ __forceinline__ void convert_expert_queue(const Ptrs& p, int layer, LAS float* scr, int wv) {
    const int lane = otid(wv) & 63; unsigned* head = (unsigned*)(p.ws + WS_CTL) + CW_QEXP + 64 * layer;
    for (;;) { const int it0 = queue_pull(head, 8u, lane); if (it0 >= CI_EXP) break;
        for (int it = it0; it < min(it0 + 8, CI_EXP); ++it) convert_item(p, layer, CI_DENSE + it, scr, lane); }
}
__device__ __forceinline__ void phase_norm(const float* xlat, const float* xctx, const float* g, const float* modl, int ch_shift, int ch_scale, bf16* H, int nrows, int wv) {
    const int lane = otid(wv) & 63, wave = wv;
    const int gw = blockIdx.x * NWAVES + wave, NGW = gridDim.x * NWAVES;
    const int per = (nrows + NGW - 1) / NGW;
    const int r0 = gw * per, r1 = min(r0 + per, nrows);
    const unsigned lc = 4 * lane;
    int cur = -1; v4f gs[4], sh[4], xn[4];
    if (r0 < r1) { const float* xr = (r0 < NLAT) ? xlat + (size_t)r0 * DM : xctx + (size_t)(r0 - NLAT) * DM;
#pragma unroll
        for (int j = 0; j < 4; ++j) xn[j] = *(const v4f*)(xr + lc + 256 * j); }
    for (int r = r0; r < r1; ++r) {
        const int mrow = (r < NLAT) ? (r >> 11) : 8;
        if (mrow != cur) {
            cur = mrow; const float* m = modl + (size_t)mrow * MODW;
#pragma unroll
            for (int j = 0; j < 4; ++j) { const unsigned c = lc + 256 * j; const v4f gg = *(const v4f*)(g + c), sc = *(const v4f*)(m + ch_scale * DM + c);
                gs[j] = gg * (1.f + sc); sh[j] = *(const v4f*)(m + ch_shift * DM + c); }
        }
        v4f v[4]; float s = 0.f;
#pragma unroll
        for (int j = 0; j < 4; ++j) { v[j] = xn[j]; s += (v[j].x * v[j].x + v[j].y * v[j].y) + (v[j].z * v[j].z + v[j].w * v[j].w); }
        if (r + 1 < r1) { const float* xq = (r + 1 < NLAT) ? xlat + (size_t)(r + 1) * DM : xctx + (size_t)(r + 1 - NLAT) * DM;
#pragma unroll
            for (int j = 0; j < 4; ++j) xn[j] = *(const v4f*)(xq + lc + 256 * j); }
        const float rstd = rsqrtf(wave_sum(s, lane) * (1.f / DM) + 1e-6f);
        bf16* orow = H + (size_t)r * DM;
#pragma unroll
        for (int j = 0; j < 4; ++j) { const v4f o = v[j] * rstd * gs[j] + sh[j]; v2u w; w.x = pk2(o.x, o.y); w.y = pk2(o.z, o.w); *(v2u*)(orow + lc + 256 * j) = w; }
    }
}

constexpr size_t WS_RSS = 6 * MiB;
constexpr size_t WS_WR = 7 * MiB + 512 * 1024;
constexpr int CW_CNT = 1024;
constexpr int LDS_TTAB = 131072;
constexpr int LDS_GIDX = 131072 + 4096;
constexpr int LDS_RT = 131072;

namespace pg8 {
struct EpiResidSS {
    static constexpr bool PERM = true, AFTER_DRAIN = false;
    const float* xin_lat; const float* xin_ctx; float* xout_lat; float* xout_ctx; const float* modl; int chunk; float* rss; int wv;
    __device__ __forceinline__ void operator()(const f32x4 (&acc)[2][2][4][2], const Unit& u, int, int, int, int) const {
        const int l_ = otid(wv) & 63, fr = l_ & 15, fq = l_ >> 4, wr = wv >> 2, wc = wv & 3;
        const int rowt = u.pm * BM; const bool isctx = rowt >= NLAT;
        const float* xin = isctx ? xin_ctx + (size_t)(rowt - NLAT) * DM : xin_lat + (size_t)rowt * DM;
        float* xo = isctx ? xout_ctx + (size_t)(rowt - NLAT) * DM : xout_lat + (size_t)rowt * DM;
        const int mrow = isctx ? 8 : (rowt >> 11);
        const float* gate = modl + (size_t)mrow * MODW + chunk * DM;
        const int col0 = u.pn * BM + wc * 32 + 8 * fq;
        f32x4 gv[2][2];
#pragma unroll
        for (int bj = 0; bj < 2; ++bj)
#pragma unroll
            for (int n = 0; n < 2; ++n) gv[bj][n] = *(const f32x4*)(gate + col0 + bj * HALF + n * 4);
#pragma unroll
        for (int ai = 0; ai < 2; ++ai)
#pragma unroll
            for (int m = 0; m < 4; ++m) {
                const int rl = ai * HALF + wr * 64 + m * 16 + fr; float ss = 0.f;
                f32x4 xi[2][2];
#pragma unroll
                for (int bj = 0; bj < 2; ++bj)
#pragma unroll
                    for (int n = 0; n < 2; ++n) xi[bj][n] = *(const f32x4*)(xin + (size_t)rl * DM + col0 + bj * HALF + n * 4);
#pragma unroll
                for (int bj = 0; bj < 2; ++bj)
#pragma unroll
                    for (int n = 0; n < 2; ++n) {
                        const f32x4 o = xi[bj][n] + gv[bj][n] * acc[ai][bj][m][n];
                        *(f32x4*)(xo + (size_t)rl * DM + col0 + bj * HALF + n * 4) = o;
                        ss += (o[0] * o[0] + o[1] * o[1]) + (o[2] * o[2] + o[3] * o[3]);
                    }
                ss += shx(ss, 16, l_); ss += shx(ss, 32, l_);
                if (fq == 0) rss[(size_t)(rowt + rl) * 16 + u.pn * 4 + wc] = ss;
                asm volatile("" ::: "memory");
            }
    }
};
struct EpiGU {
    static constexpr bool PERM = true, AFTER_DRAIN = false;
    bf16_t* HID; int wv;
    __device__ __forceinline__ void operator()(const f32x4 (&acc)[2][2][4][2], const Unit& u, int, int, int, int) const {
        const int l_ = otid(wv) & 63, fr = l_ & 15, fq = l_ >> 4, wr = wv >> 2, wc = wv & 3;
        const int pnl = u.pn & 1, row0 = u.pm * BM + wr * 64 + fr, col0 = pnl * 128 + wc * 32 + 8 * fq;
#pragma unroll
        for (int ai = 0; ai < 2; ++ai)
#pragma unroll
            for (int m = 0; m < 4; ++m) {
                bf16_t* rowp = HID + (size_t)(row0 + ai * HALF + m * 16) * 256 + col0;
                float hv[8];
#pragma unroll
                for (int n = 0; n < 2; ++n)
#pragma unroll
                    for (int i = 0; i < 4; ++i) { const float g = acc[ai][0][m][n][i], uu = acc[ai][1][m][n][i]; hv[n * 4 + i] = g / (1.f + __expf(-g)) * uu; }
                u32x4 w; w.x = cvt_pk_bf16(hv[0], hv[1]); w.y = cvt_pk_bf16(hv[2], hv[3]); w.z = cvt_pk_bf16(hv[4], hv[5]); w.w = cvt_pk_bf16(hv[6], hv[7]);
                *(u32x4*)rowp = w;
            }
    }
};
struct EpiDown {
    static constexpr bool PERM = true, AFTER_DRAIN = false;
    bf16_t* Y0; bf16_t* Y1; const PG8_LAS int* rowinfo; int wv;
    __device__ __forceinline__ void operator()(const f32x4 (&acc)[2][2][4][2], const Unit& u, int, int, int, int) const {
        const int l_ = otid(wv) & 63, fr_ = l_ & 15, fq = l_ >> 4, wr = wv >> 2, wc = wv & 3;
        const int col0 = (u.pn & 3) * BM + wc * 32 + 8 * fq;
        const PG8_LAS int* ri = rowinfo + (u.aux * 256 + wr * 64 + fr_) * 2;
#pragma unroll
        for (int ai = 0; ai < 2; ++ai)
#pragma unroll
            for (int m = 0; m < 4; ++m) {
                const int ent = ri[(ai * HALF + m * 16) * 2]; const float w = __builtin_bit_cast(float, ri[(ai * HALF + m * 16) * 2 + 1]);
                if (ent >= 0) {
                    bf16_t* rowp = Y0 + ((size_t)(ent & 1) * ((WS_Y1 - WS_Y0) / 2) + (size_t)(ent >> 1) * DM + col0);
#pragma unroll
                    for (int bj = 0; bj < 2; ++bj) {
                        const f32x4 v0 = acc[ai][bj][m][0] * w, v1 = acc[ai][bj][m][1] * w;
                        u32x4 o; o.x = cvt_pk_bf16(v0[0], v0[1]); o.y = cvt_pk_bf16(v0[2], v0[3]); o.z = cvt_pk_bf16(v1[0], v1[1]); o.w = cvt_pk_bf16(v1[2], v1[3]);
                        *(u32x4*)(rowp + bj * HALF) = o;
                    }
                }
                asm volatile("" ::: "memory");
            }
    }
};
struct MoeOrder {
    const PG8_LAS int* ttab; int ntile, npn, G, c;
    __device__ __forceinline__ bool next(int i, Unit& u) const {
        const int L = i * G + c; if (L >= ntile * npn) return false;
        const int t = L / npn, pl = L % npn; u.pm = t; u.pn = ttab[t * 4] * npn + pl; u.aux = i; return true;
    }
    __device__ __forceinline__ void a_ready(const Unit&) const {}
    __device__ __forceinline__ void done(const Unit&) const {}
};
}

__device__ __forceinline__ void phase_router_w(const Ptrs& p, int wv) {
    const int gt = blockIdx.x * NT + otid(wv), NG = gridDim.x * NT;
    for (int idx = gt; idx < 2 * 48 * DM; idx += NG) {
        const int layer = idx / (48 * DM), r = idx % (48 * DM), n = r >> 10, k = r & 1023;
        float w;
        if (n < 16) w = p.in[I_WRG][((size_t)layer * DM + k) * 4 + (n & 3)];
        else { const int g = ((n - 16) & 15) >> 2, i = n & 3, e = 8 * g + i + (n >= 32 ? 4 : 0); w = p.in[I_WRE][((size_t)layer * DM + k) * 32 + e]; }
        const unsigned hi = f2bf(w); const float lo = w - __builtin_bit_cast(float, hi << 16);
        bf16* base = (bf16*)(p.ws + WS_WR) + (size_t)layer * 2 * 48 * DM;
        base[r] = (bf16)hi; base[48 * DM + r] = (bf16)f2bf(lo);
    }
}

typedef short s8v __attribute__((ext_vector_type(8)));
constexpr size_t WS_GS2 = WS_LB + 64 * 1024;
__device__ __forceinline__ void phase_gs2(const Ptrs& p, int wv) {
    const int gt = blockIdx.x * NT + otid(wv), NG = gridDim.x * NT;
    for (int idx = gt; idx < 2 * 9 * DM; idx += NG) {
        const int layer = idx / (9 * DM), m = (idx / DM) % 9, c = idx & (DM - 1);
        const float* md = (const float*)(p.ws + WS_MOD) + ((size_t)layer * 9 + m) * MODW;
        float* o = (float*)(p.ws + WS_GS2) + ((size_t)(layer * 9 + m) * 2) * DM;
        o[c] = p.in[I_N2G][layer * DM + c] * (1.f + md[4 * DM + c]); o[DM + c] = md[3 * DM + c];
    }
}
__device__ __forceinline__ void phase_route(const Ptrs& p, LAS unsigned char* lds, int layer, int nrows, int wv) {
    const int tid = otid(wv), lane = tid & 63, wave = wv;
    LAS int* lcnt = (LAS int*)(lds + LDS_RT); LAS int* gb = lcnt + 32;
    if (tid < 32) lcnt[tid] = 0;
    __syncthreads();
    const int ntiles = nrows / 16, t = wave * gridDim.x + blockIdx.x;
    int e0 = -1, e1 = -1, lp0 = 0, lp1 = 0, ent0 = 0;
    if (t < ntiles) {
        const int row0 = t * 16, r = row0 + (lane & 15), kq = lane >> 4;
        const int mrow = (row0 < NLAT) ? (row0 >> 11) : 8;
        const float* xr = ((r < NLAT) ? p.out + (size_t)r * DM : (const float*)(p.ws + WS_XC) + (size_t)(r - NLAT) * DM) + 8 * kq;
        const float* gsp = (const float*)(p.ws + WS_GS2) + ((size_t)(layer * 9 + mrow) * 2) * DM + 8 * kq;
        bf16* hrow = (bf16*)(p.ws + WS_H) + (size_t)r * DM + 8 * kq;
        const bf16* wr_hi = (const bf16*)(p.ws + WS_WR) + (size_t)layer * 2 * 48 * DM + (size_t)(lane & 15) * DM + 8 * kq;
        float ss;
        { const v4f* rs = (const v4f*)((const float*)(p.ws + WS_RSS) + (size_t)r * 16); const v4f a = rs[0], b = rs[1], c = rs[2], d = rs[3];
          ss = ((a.x + a.y) + (a.z + a.w)) + ((b.x + b.y) + (b.z + b.w)) + ((c.x + c.y) + (c.z + c.w)) + ((d.x + d.y) + (d.z + d.w)); }
        const float rstd = rsqrtf(ss * (1.f / DM) + 1e-6f);
        v4f acc[3];
#pragma unroll
        for (int i = 0; i < 3; ++i) acc[i] = (v4f){0.f, 0.f, 0.f, 0.f};
#pragma unroll 1
        for (int s4 = 0; s4 < 32; s4 += 4) {
            v4f xa[4], xb[4], ga[4], gbv[4], ha[4], hb[4]; s8v wf[4][3];
#pragma unroll
            for (int u = 0; u < 4; ++u) {
                const int c0 = 32 * (s4 + u);
                xa[u] = *(const v4f*)(xr + c0); xb[u] = *(const v4f*)(xr + c0 + 4);
                ga[u] = *(const v4f*)(gsp + c0); gbv[u] = *(const v4f*)(gsp + c0 + 4);
                ha[u] = *(const v4f*)(gsp + DM + c0); hb[u] = *(const v4f*)(gsp + DM + c0 + 4);
#pragma unroll
                for (int nt = 0; nt < 3; ++nt) wf[u][nt] = *(const s8v*)(wr_hi + (size_t)nt * 16 * DM + c0);
            }
#pragma unroll
            for (int u = 0; u < 4; ++u) {
                const v4f h0 = xa[u] * rstd * ga[u] + ha[u], h1 = xb[u] * rstd * gbv[u] + hb[u];
                v4u hw; hw.x = pk2(h0.x, h0.y); hw.y = pk2(h0.z, h0.w); hw.z = pk2(h1.x, h1.y); hw.w = pk2(h1.z, h1.w);
                *(v4u*)(hrow + 32 * (s4 + u)) = hw;
                const s8v bh = __builtin_bit_cast(s8v, hw);
#pragma unroll
                for (int nt = 0; nt < 3; ++nt) acc[nt] = __builtin_amdgcn_mfma_f32_16x16x32_bf16(wf[u][nt], bh, acc[nt], 0, 0, 0);
            }
        }
        const float* brg = p.in[I_BRG] + layer * 4; const float* bre = p.in[I_BRE] + layer * 32;
        float gl[4];
#pragma unroll
        for (int i = 0; i < 4; ++i) gl[i] = acc[0][i] + brg[i];
        int gi = 0; float gm = gl[0];
#pragma unroll
        for (int i = 1; i < 4; ++i) if (gl[i] > gm) { gm = gl[i]; gi = i; }
        float den = 0.f;
#pragma unroll
        for (int i = 0; i < 4; ++i) den += __expf(gl[i] - gm);
        const float gtop = 1.f / den;
        if (kq == gi) {
            float el[8];
#pragma unroll
            for (int i = 0; i < 4; ++i) { el[i] = acc[1][i] + bre[8 * kq + i]; el[4 + i] = acc[2][i] + bre[8 * kq + 4 + i]; }
            int i0 = 0; float v0 = el[0];
#pragma unroll
            for (int i = 1; i < 8; ++i) if (el[i] > v0) { v0 = el[i]; i0 = i; }
            int i1 = -1; float v1 = -3.0e38f;
#pragma unroll
            for (int i = 0; i < 8; ++i) if (i != i0 && el[i] > v1) { v1 = el[i]; i1 = i; }
            const float p1 = __expf(v1 - v0), sden = 1.f / (1.f + p1);
            e0 = gi * 8 + i0; e1 = gi * 8 + i1; ent0 = r * 2;
            float* ew = (float*)(p.ws + WS_EW);
            ew[ent0] = gtop * sden; ew[ent0 + 1] = gtop * p1 * sden;
            lp0 = __hip_atomic_fetch_add(lcnt + e0, 1, __ATOMIC_RELAXED, __HIP_MEMORY_SCOPE_WORKGROUP); lp1 = __hip_atomic_fetch_add(lcnt + e1, 1, __ATOMIC_RELAXED, __HIP_MEMORY_SCOPE_WORKGROUP);
        }
    }
    __syncthreads();
    int* cnt = (int*)(p.ws + WS_CTL) + CW_CNT + layer * 64;
    if (tid < 32) gb[tid] = atomicAdd(&cnt[tid], lcnt[tid]);
    __syncthreads();
    if (e0 >= 0) {
        int* IDX = (int*)(p.ws + WS_IDX);
        IDX[(size_t)e0 * MROWS + gb[e0] + lp0] = ent0;
        IDX[(size_t)e1 * MROWS + gb[e1] + lp1] = ent0 + 1;
    }
}
__device__ __forceinline__ int moe_build_ttab(const Ptrs& p, LAS unsigned char* lds, int layer, int wv) {
    LAS int* ttab = (LAS int*)(lds + LDS_TTAB);
    const int* cnt = (const int*)(p.ws + WS_CTL) + CW_CNT + layer * 64;
    __syncthreads();
    if (otid(wv) == 0) {
        int t = 0;
        for (int e = 0; e < 32; ++e) { const int c = __hip_atomic_load(cnt + e, __ATOMIC_RELAXED, __HIP_MEMORY_SCOPE_AGENT); for (int fp = 0; fp < c; fp += 256) { ttab[t * 4] = e; ttab[t * 4 + 1] = fp; ttab[t * 4 + 2] = c; ++t; } }
        ttab[176 * 4] = t;
    }
    __syncthreads();
    return ttab[176 * 4];
}
__device__ __forceinline__ void phase_moe_gu(const Ptrs& p, LAS unsigned char* lds, int layer, int wv) {
    const int ntile = moe_build_ttab(p, lds, layer, wv);
    LAS int* ttab = (LAS int*)(lds + LDS_TTAB); LAS int* gidx = (LAS int*)(lds + LDS_GIDX);
    pg8::MoeOrder S{ttab, ntile, 2, (int)gridDim.x, (int)blockIdx.x};
    const int* IDX = (const int*)(p.ws + WS_IDX);
    for (int i = 0; i < 3; ++i) {
        pg8::Unit u; if (!S.next(i, u)) break;
        const int e = ttab[u.pm * 4], fp = ttab[u.pm * 4 + 1], c = ttab[u.pm * 4 + 2];
        for (int r = otid(wv); r < 256; r += NT) gidx[i * 256 + r] = (fp + r < c) ? (IDX[(size_t)e * MROWS + fp + r] >> 1) : 0;
    }
    __syncthreads();
    pg8::Gemm g{(const bf16*)(p.ws + WS_H), (const bf16*)(p.ws + WS_WGU + layer * WGU_STRIDE), ntile * 256, 32 * 512, DM};
    pg8::EpiGU E{(bf16*)(p.ws + WS_HID), wv};
    pg8::gemm_phase<pg8::EpiGU, pg8::MoeOrder, true, true, true>(lds, g, S, E, wv, gidx);
}
__device__ __forceinline__ void phase_moe_down(const Ptrs& p, LAS unsigned char* lds, int layer, int wv) {
    const int ntile = moe_build_ttab(p, lds, layer, wv);
    LAS int* ttab = (LAS int*)(lds + LDS_TTAB); LAS int* rowinfo = (LAS int*)(lds + LDS_GIDX);
    pg8::MoeOrder S{ttab, ntile, 4, (int)gridDim.x, (int)blockIdx.x};
    const int* IDX = (const int*)(p.ws + WS_IDX); const float* EW = (const float*)(p.ws + WS_EW);
    for (int i = 0; i < 3; ++i) {
        pg8::Unit u; if (!S.next(i, u)) break;
        const int e = ttab[u.pm * 4], fp = ttab[u.pm * 4 + 1], c = ttab[u.pm * 4 + 2];
        for (int r = otid(wv); r < 256; r += NT) {
            int ent = -1; float w = 0.f;
            if (fp + r < c) { ent = IDX[(size_t)e * MROWS + fp + r]; w = EW[ent]; }
            rowinfo[(i * 256 + r) * 2] = ent; rowinfo[(i * 256 + r) * 2 + 1] = __builtin_bit_cast(int, w);
        }
    }
    __syncthreads();
    pg8::Gemm g{(const bf16*)(p.ws + WS_HID), (const bf16*)(p.ws + WS_WD + layer * WD_STRIDE), ntile * 256, 32 * 1024, 256};
    pg8::EpiDown E{(bf16*)(p.ws + WS_Y0), (bf16*)(p.ws + WS_Y1), rowinfo, wv};
    pg8::gemm_phase<pg8::EpiDown, pg8::MoeOrder, true, true, false>(lds, g, S, E, wv);
}
__device__ __forceinline__ void phase_combine(const Ptrs& p, int layer, int nrows, bool do_norm, int wv) {
    const int lane = otid(wv) & 63, wave = wv;
    const int gw = blockIdx.x * NWAVES + wave, NGW = gridDim.x * NWAVES;
    const int per = (nrows + NGW - 1) / NGW;
    const int r0 = gw * per, r1 = min(r0 + per, nrows);
    const float* modl = (const float*)(p.ws + WS_MOD) + (size_t)layer * 9 * MODW;
    const float* modn = (const float*)(p.ws + WS_MOD) + (size_t)(layer + 1) * 9 * MODW;
    const float* g = p.in[I_N1G] + (layer + 1) * DM;
    const bf16* Y0 = (const bf16*)(p.ws + WS_Y0); const bf16* Y1 = (const bf16*)(p.ws + WS_Y1); bf16* H = (bf16*)(p.ws + WS_H);
    const unsigned lc = 4 * lane;
    int cur = -1; v4f m5v[4], gs[4], sh[4];
    v4f xn[4]; v2u an[4], bn[4];
    auto rowptr = [&](int r) -> float* { return (r < NLAT) ? p.out + (size_t)r * DM : (float*)(p.ws + WS_XC) + (size_t)(r - NLAT) * DM; };
    if (r0 < r1) {
        const float* xr = rowptr(r0);
#pragma unroll
        for (int j = 0; j < 4; ++j) { xn[j] = *(const v4f*)(xr + lc + 256 * j); an[j] = *(const v2u*)(Y0 + (size_t)r0 * DM + lc + 256 * j); bn[j] = *(const v2u*)(Y1 + (size_t)r0 * DM + lc + 256 * j); }
    }
    for (int r = r0; r < r1; ++r) {
        const int mrow = (r < NLAT) ? (r >> 11) : 8;
        if (mrow != cur) {
            cur = mrow; const float* m5 = modl + (size_t)mrow * MODW + 5 * DM; const float* mn = modn + (size_t)mrow * MODW;
#pragma unroll
            for (int j = 0; j < 4; ++j) { const unsigned c = lc + 256 * j; m5v[j] = *(const v4f*)(m5 + c);
                if (do_norm) { const v4f gg = *(const v4f*)(g + c), sc = *(const v4f*)(mn + DM + c); gs[j] = gg * (1.f + sc); sh[j] = *(const v4f*)(mn + c); } }
        }
        v4f x[4]; v2u a[4], b[4];
#pragma unroll
        for (int j = 0; j < 4; ++j) { x[j] = xn[j]; a[j] = an[j]; b[j] = bn[j]; }
        float* xr = rowptr(r);
        if (r + 1 < r1) {
            const float* xq = rowptr(r + 1);
#pragma unroll
            for (int j = 0; j < 4; ++j) { xn[j] = *(const v4f*)(xq + lc + 256 * j); an[j] = *(const v2u*)(Y0 + (size_t)(r + 1) * DM + lc + 256 * j); bn[j] = *(const v2u*)(Y1 + (size_t)(r + 1) * DM + lc + 256 * j); }
        }
        v4f v[4]; float s = 0.f;
#pragma unroll
        for (int j = 0; j < 4; ++j) {
            v4f y; y.x = bflo(a[j].x) + bflo(b[j].x); y.y = bfhi(a[j].x) + bfhi(b[j].x); y.z = bflo(a[j].y) + bflo(b[j].y); y.w = bfhi(a[j].y) + bfhi(b[j].y);
            v[j] = x[j] + m5v[j] * y;
            *(v4f*)(xr + lc + 256 * j) = v[j];
            s += (v[j].x * v[j].x + v[j].y * v[j].y) + (v[j].z * v[j].z + v[j].w * v[j].w);
        }
        if (do_norm) {
            const float rstd = rsqrtf(wave_sum(s, lane) * (1.f / DM) + 1e-6f);
#pragma unroll
            for (int j = 0; j < 4; ++j) { const v4f o = v[j] * rstd * gs[j] + sh[j]; v2u w; w.x = pk2(o.x, o.y); w.y = pk2(o.z, o.w); *(v2u*)(H + (size_t)r * DM + lc + 256 * j) = w; }
        }
    }
}

namespace hg {
typedef short s4v __attribute__((ext_vector_type(4)));
typedef short s8v __attribute__((ext_vector_type(8)));
typedef short v4i16_t __attribute__((ext_vector_type(4)));
constexpr int TS = 160;
constexpr int TILE_B = 16 * TS;
constexpr int WAVE_LDS = 2 * TILE_B;
constexpr int NSEG = 18;
constexpr size_t SEGU_B = 64 * 64 * 4, SEGA_B = 16 * 64 * 4;
constexpr size_t WS_SEGU = WS_SCR;
constexpr size_t WS_SEGA = WS_SEGU + (size_t)NBATCH * 4 * 2 * NSEG * SEGU_B;
static_assert(WS_SEGA + (size_t)NBATCH * 4 * 2 * NSEG * SEGA_B <= WS_END && 8 * WAVE_LDS <= 40960 && 40960 + 6 * 16384 <= LDS_BYTES - 64, "hgrn scratch");
template <int CTRL> __device__ __forceinline__ float dppf(float x) { return __builtin_bit_cast(float, __builtin_amdgcn_update_dpp(0, __builtin_bit_cast(int, x), CTRL, 0xf, 0xf, true)); }
__device__ __forceinline__ s4v trd(const LAS unsigned char* p) { return __builtin_bit_cast(s4v, __builtin_amdgcn_ds_read_tr16_b64_v4i16((LAS v4i16_t*)p)); }
typedef float f32x2_t __attribute__((ext_vector_type(2))); typedef __bf16 bf16x2_t __attribute__((ext_vector_type(2)));
__device__ __forceinline__ unsigned pkbf(float lo, float hi) { f32x2_t v = {lo, hi}; bf16x2_t b = __builtin_convertvector(v, bf16x2_t); return __builtin_bit_cast(unsigned, b); }
__device__ __forceinline__ float silu_r(float x) { return x * __builtin_amdgcn_rcpf(1.f + __expf(-x)); }
__device__ __forceinline__ s8v mk8(unsigned a, unsigned b, unsigned c, unsigned d) { v4u t; t.x = a; t.y = b; t.z = c; t.w = d; return __builtin_bit_cast(s8v, t); }

template <bool BWD, int OUT>
__device__ __forceinline__ void chunk(const bf16* __restrict__ P, int row0, int h, const float* __restrict__ lbh, v4f (&S)[4][4], float (&Atot)[16],
                                      LAS unsigned char* vt, LAS unsigned char* kt, int lane_, LAS v4f* OFL, int cidx, bf16* __restrict__ MIX, const float* __restrict__ on) {
    int lane = lane_; asm volatile("" : "+v"(lane));
    const int tok = lane & 15, kq = lane >> 4;
    const bf16* pb = P + (size_t)row0 * DIN + h * 64;
    const unsigned lo = (unsigned)(tok * DIN + 4 * kq);
    v2u zr[4], qr[4]; v4f lbq[4];
#pragma unroll
    for (int m = 0; m < 4; ++m) lbq[m] = *(const v4f*)(lbh + (unsigned)(16 * m + 4 * kq));
#pragma unroll
    for (int m = 0; m < 4; ++m) { zr[m] = *(const v2u*)(pb + (lo + (BWD ? C_FB : C_FF) + 16 * m)); if (OUT != 0) qr[m] = *(const v2u*)(pb + (lo + C_Q + 16 * m)); }
#pragma unroll
    for (int i = 0; i < 2; ++i) { const int pc = lane + 64 * i, r = pc >> 3, ch = pc & 7;
        const v4u vv = *(const v4u*)(pb + (unsigned)(r * DIN + C_I + 8 * ch)); *(LAS v4u*)(vt + r * TS + 16 * ch) = vv; }
    unsigned qf[8], kf[8];
    float A[16];
#pragma unroll
    for (int m = 0; m < 4; ++m)
#pragma unroll
        for (int jp = 0; jp < 2; ++jp) {
            const unsigned zw = jp ? zr[m].y : zr[m].x;
            float kt2[2], qt2[2], kh2[2];
#pragma unroll
            for (int i = 0; i < 2; ++i) {
                const int e = 4 * m + 2 * jp + i;
                const float z = i ? bfhi(zw) : bflo(zw);
                const float sg = __builtin_amdgcn_rcpf(1.f + __builtin_amdgcn_exp2f(-1.4426950408889634f * z)), lb = lbq[m][2 * jp + i];
                const float f = lb + (1.f - lb) * sg, kk = (1.f - lb) * (1.f - sg);
                const float lf = __builtin_amdgcn_logf(f);
                float c = lf, t = lf;
                if (!BWD) { c += dppf<0x111>(c); c += dppf<0x112>(c); c += dppf<0x114>(c); c += dppf<0x118>(c); }
                else      { c += dppf<0x101>(c); c += dppf<0x102>(c); c += dppf<0x104>(c); c += dppf<0x108>(c); }
                t += dppf<0x128>(t); t += dppf<0x124>(t); t += dppf<0x122>(t); t += dppf<0x121>(t);
                const float Ei = __builtin_amdgcn_exp2f(-fmaxf(c, -115.f)); A[e] = __builtin_amdgcn_exp2f(t);
                kt2[i] = kk * Ei; kh2[i] = kt2[i] * A[e];
                if (OUT != 0) { const unsigned qw = jp ? qr[m].y : qr[m].x; const float q = i ? bfhi(qw) : bflo(qw); qt2[i] = q * 0.125f * __builtin_amdgcn_exp2f(c); } else qt2[i] = 0.f;
            }
            kf[2 * m + jp] = pkbf(kt2[0], kt2[1]); if (OUT != 0) qf[2 * m + jp] = pkbf(qt2[0], qt2[1]);
            *(LAS unsigned*)(kt + tok * TS + (16 * m + 4 * kq + 2 * jp) * 2) = pkbf(kh2[0], kh2[1]);
            __builtin_amdgcn_sched_barrier(0);
        }
    asm volatile("s_waitcnt lgkmcnt(0)" ::: "memory");
    s8v vfr[4], khf[4];
    { const int i4 = tok >> 2, p4 = tok & 3; const LAS unsigned char* va = vt + (4 * kq + i4) * TS + 8 * p4; const LAS unsigned char* ka = kt + (4 * kq + i4) * TS + 8 * p4;
#pragma unroll
      for (int c = 0; c < 4; ++c) { const s4v a = trd(va + 32 * c), b = trd(ka + 32 * c);
          vfr[c] = (s8v){a[0], a[1], a[2], a[3], 0, 0, 0, 0}; khf[c] = (s8v){b[0], b[1], b[2], b[3], 0, 0, 0, 0}; } }
    if (OUT != 0) {
        const s8v q0 = mk8(qf[0], qf[1], qf[2], qf[3]), q1 = mk8(qf[4], qf[5], qf[6], qf[7]);
        const s8v k0 = mk8(kf[0], kf[1], kf[2], kf[3]), k1 = mk8(kf[4], kf[5], kf[6], kf[7]);
        v4f at = (v4f){0.f, 0.f, 0.f, 0.f};
        at = __builtin_amdgcn_mfma_f32_16x16x32_bf16(k0, q0, at, 0, 0, 0);
        at = __builtin_amdgcn_mfma_f32_16x16x32_bf16(k1, q1, at, 0, 0, 0);
#pragma unroll
        for (int j = 0; j < 4; ++j) { const int s = 4 * kq + j; const bool keep = BWD ? (s >= tok) : (s <= tok); at[j] = keep ? at[j] : 0.f; }
        const s8v af = mk8(pkbf(at[0], at[1]), pkbf(at[2], at[3]), 0u, 0u);
        v4f o[4];
#pragma unroll
        for (int vb = 0; vb < 4; ++vb) {
            o[vb] = __builtin_amdgcn_mfma_f32_16x16x32_bf16(vfr[vb], af, (v4f){0.f, 0.f, 0.f, 0.f}, 0, 0, 0);
            const s8v s0 = mk8(pkbf(S[0][vb][0], S[0][vb][1]), pkbf(S[0][vb][2], S[0][vb][3]), pkbf(S[1][vb][0], S[1][vb][1]), pkbf(S[1][vb][2], S[1][vb][3]));
            const s8v s1 = mk8(pkbf(S[2][vb][0], S[2][vb][1]), pkbf(S[2][vb][2], S[2][vb][3]), pkbf(S[3][vb][0], S[3][vb][1]), pkbf(S[3][vb][2], S[3][vb][3]));
            o[vb] = __builtin_amdgcn_mfma_f32_16x16x32_bf16(s0, q0, o[vb], 0, 0, 0);
            o[vb] = __builtin_amdgcn_mfma_f32_16x16x32_bf16(s1, q1, o[vb], 0, 0, 0);
            __builtin_amdgcn_sched_barrier(0);
        }
        LAS v4f* ofl = OFL + (cidx * 4) * 64 + lane;
        if (OUT == 1) {
#pragma unroll
            for (int vb = 0; vb < 4; ++vb) ofl[vb * 64] = o[vb];
        } else {
            float ss = 0.f;
#pragma unroll
            for (int vb = 0; vb < 4; ++vb) { o[vb] += ofl[vb * 64]; ss += (o[vb].x * o[vb].x + o[vb].y * o[vb].y) + (o[vb].z * o[vb].z + o[vb].w * o[vb].w); }
            ss += shx(ss, 16, lane); ss += shx(ss, 32, lane);
            const float rstd = rsqrtf(ss * (1.f / 64.f) + 1e-6f);
            bf16* mb = MIX + (size_t)row0 * DM + 768 + h * 64; const unsigned lom = (unsigned)(tok * DM + 4 * kq);
#pragma unroll
            for (int vb = 0; vb < 4; ++vb) {
                const v2u gw = *(const v2u*)(pb + (lo + C_G + 16 * vb)); const v4f gn = *(const v4f*)(on + (unsigned)(16 * vb + 4 * kq));
                const float g0 = bflo(gw.x), g1 = bfhi(gw.x), g2 = bflo(gw.y), g3 = bfhi(gw.y);
                v2u w; w.x = pkbf(o[vb].x * rstd * gn.x * silu_r(g0), o[vb].y * rstd * gn.y * silu_r(g1)); w.y = pkbf(o[vb].z * rstd * gn.z * silu_r(g2), o[vb].w * rstd * gn.w * silu_r(g3));
                *(v2u*)(mb + (lom + 16 * vb)) = w;
            }
        }
    }
#pragma unroll
    for (int db = 0; db < 4; ++db) {
        const v4f av = (v4f){A[4 * db], A[4 * db + 1], A[4 * db + 2], A[4 * db + 3]};
#pragma unroll
        for (int vb = 0; vb < 4; ++vb) S[db][vb] = __builtin_amdgcn_mfma_f32_16x16x32_bf16(khf[db], vfr[vb], S[db][vb] * av, 0, 0, 0);
        __builtin_amdgcn_sched_barrier(0);
    }
    if (OUT == 0) {
#pragma unroll
        for (int e = 0; e < 16; ++e) Atot[e] *= A[e];
    }
    asm volatile("s_waitcnt lgkmcnt(0)" ::: "memory");
}
__device__ __forceinline__ int seg_row0(int b, int seg) { return seg < 2 ? NLAT + b * CTXL + 128 * seg : b * SEQ + 128 * (seg - 2); }
__device__ __forceinline__ int scan_idx(int seg, int dir) { return dir == 0 ? seg : (seg < 2 ? 1 - seg : 19 - seg); }

__device__ __forceinline__ void unit_pass1(const Ptrs& p, int layer, int u, LAS unsigned char* wl, int lane) {
    const int dir = u & 1, bhs = u >> 1, seg = bhs % NSEG, bh = bhs / NSEG, h = bh & 3, b = bh >> 2;
    const bf16* P = (const bf16*)(p.ws + WS_P);
    const int row0 = seg_row0(b, seg);
    float Atot[16]; v4f S[4][4];
    const float* lbv = (const float*)(p.ws + WS_LB) + layer * 512 + dir * 256 + h * 64;
#pragma unroll
    for (int e = 0; e < 16; ++e) Atot[e] = 1.f;
#pragma unroll
    for (int i = 0; i < 4; ++i)
#pragma unroll
        for (int j = 0; j < 4; ++j) S[i][j] = (v4f){0.f, 0.f, 0.f, 0.f};
    if (dir == 0) {
#pragma unroll 1
        for (int c = 0; c < 8; ++c) chunk<false, 0>(P, row0 + 16 * c, h, lbv, S, Atot, wl, wl + TILE_B, lane, nullptr, c, nullptr, nullptr);
    } else {
#pragma unroll 1
        for (int c = 7; c >= 0; --c) chunk<true, 0>(P, row0 + 16 * c, h, lbv, S, Atot, wl, wl + TILE_B, lane, nullptr, c, nullptr, nullptr);
    }
    const size_t si = ((size_t)(bh * 2 + dir)) * NSEG + scan_idx(seg, dir);
    float* su = (float*)(p.ws + WS_SEGU + si * SEGU_B) + lane; float* sa = (float*)(p.ws + WS_SEGA + si * SEGA_B) + lane;
#pragma unroll
    for (int i = 0; i < 4; ++i)
#pragma unroll
        for (int j = 0; j < 4; ++j)
#pragma unroll
            for (int r = 0; r < 4; ++r) su[((i * 4 + j) * 4 + r) * 64] = S[i][j][r];
#pragma unroll
    for (int e = 0; e < 16; ++e) sa[e * 64] = Atot[e];
}
template <bool BWD>
__device__ __forceinline__ void unit_pass2(const Ptrs& p, int layer, int pu, LAS unsigned char* wl, LAS v4f* ofl_own, LAS v4f* ofl_partner, int lane, bool active) {
    const int seg = pu % NSEG, bh = pu / NSEG, h = bh & 3, b = bh >> 2;
    const bf16* P = (const bf16*)(p.ws + WS_P); bf16* MIX = (bf16*)(p.ws + WS_MIX);
    const float* on = p.in[I_HGON] + layer * 64;
    const int row0 = seg_row0(b, seg);
    constexpr int dir = BWD ? 1 : 0;
    float Atot[16]; v4f S[4][4];
    const float* lbv = (const float*)(p.ws + WS_LB) + layer * 512 + dir * 256 + h * 64;
    if (active) {
        {
            const size_t si = ((size_t)(bh * 2 + dir)) * NSEG + scan_idx(seg, dir);
            int ln = lane; asm volatile("" : "+v"(ln));
            const float* su = (const float*)(p.ws + WS_SEGU + si * SEGU_B) + ln;
#pragma unroll
            for (int i = 0; i < 4; ++i)
#pragma unroll
                for (int j = 0; j < 4; ++j) S[i][j] = (v4f){su[((i * 4 + j) * 4 + 0) * 64], su[((i * 4 + j) * 4 + 1) * 64], su[((i * 4 + j) * 4 + 2) * 64], su[((i * 4 + j) * 4 + 3) * 64]};
        }
#pragma unroll 1
        for (int k = 0; k < 4; ++k) { const int c = BWD ? 7 - k : k; chunk<BWD, 1>(P, row0 + 16 * c, h, lbv, S, Atot, wl, wl + TILE_B, lane, ofl_own, k, MIX, on); }
    }
    __syncthreads();
    if (active) {
#pragma unroll 1
        for (int k = 4; k < 8; ++k) { const int c = BWD ? 7 - k : k; chunk<BWD, 2>(P, row0 + 16 * c, h, lbv, S, Atot, wl, wl + TILE_B, lane, ofl_partner, 7 - k, MIX, on); }
    }
}
}
constexpr int LDS_HG_OFL = 6 * 5120, HG_OFL_B = 16384, LDS_HG_CONV = LDS_HG_OFL + 6 * HG_OFL_B;
static_assert(LDS_HG_CONV + 2 * 8704 <= LDS_BYTES - 64, "hgrn pass-2 LDS map");
constexpr int HG_DUMMY_ = 0;
__device__ __forceinline__ void phase_hgrn1(const Ptrs& p, LAS unsigned char* lds, int layer, int wv) {
    const int lane = otid(wv) & 63; const int u = wv * gridDim.x + blockIdx.x;
    if (u < 2 * 32 * hg::NSEG) hg::unit_pass1(p, layer, u, lds + wv * hg::WAVE_LDS, lane);
    if (wv >= 5) convert_expert_slice(p, layer, 0, CE1, (wv - 5) * gridDim.x + blockIdx.x, 3 * gridDim.x, (LAS float*)(lds + 40960 + (wv - 5) * 8704), wv);
}
__device__ __forceinline__ void phase_hgrn2(const Ptrs& p, LAS unsigned char* lds, int layer, int wv) {
    const int lane = otid(wv) & 63; const int pu = (wv >> 1) * gridDim.x + blockIdx.x;
    const bool active = pu < 32 * hg::NSEG && (layer == 0 || (pu % hg::NSEG) >= 2) && wv < 6;
    LAS v4f* own = (LAS v4f*)(lds + LDS_HG_OFL + (wv < 6 ? wv : 0) * HG_OFL_B); LAS v4f* partner = (LAS v4f*)(lds + LDS_HG_OFL + (wv < 6 ? (wv ^ 1) : 0) * HG_OFL_B);
    LAS float* cscr = (LAS float*)(lds + LDS_HG_CONV + (wv >= 6 ? wv - 6 : 0) * 8704);
    if (wv >= 6) convert_expert_slice(p, layer, CE2, CE3, (wv - 6) * gridDim.x + blockIdx.x, 2 * gridDim.x, cscr, wv);
    if (wv & 1) hg::unit_pass2<true>(p, layer, pu, lds + (wv < 6 ? wv : 0) * hg::WAVE_LDS, own, partner, lane, active);
    else        hg::unit_pass2<false>(p, layer, pu, lds + (wv < 6 ? wv : 0) * hg::WAVE_LDS, own, partner, lane, active);
    if (wv >= 6) convert_expert_slice(p, layer, CE3, CI_EXP, (wv - 6) * gridDim.x + blockIdx.x, 2 * gridDim.x, cscr, wv);
}

__device__ __forceinline__ void phase_hgrn_scan(const Ptrs& p, LAS unsigned char* lds, int layer, int wv) {
    const int t = blockIdx.x * NT + otid(wv);
#pragma unroll 1
    for (int half = 0; half < 2; ++half) {
        const int e = t + half * (int)(gridDim.x * NT);
        if (e >= 64 * 4096) break;
        const int bhd = e >> 12, r = (e >> 6) & 63, l = e & 63;
        float* su = (float*)(p.ws + hg::WS_SEGU + (size_t)bhd * hg::NSEG * hg::SEGU_B) + r * 64 + l;
        const float* sa = (const float*)(p.ws + hg::WS_SEGA + (size_t)bhd * hg::NSEG * hg::SEGA_B) + (4 * (r >> 4) + (r & 3)) * 64 + l;
        float u[hg::NSEG], a[hg::NSEG];
#pragma unroll
        for (int j = 0; j < hg::NSEG; ++j) { u[j] = su[(size_t)j * 4096]; a[j] = sa[(size_t)j * 1024]; }
        float st = 0.f;
#pragma unroll
        for (int j = 0; j < hg::NSEG; ++j) { su[(size_t)j * 4096] = st; st = a[j] * st + u[j]; }
    }
    convert_expert_slice(p, layer, CE1, CE2, wv * gridDim.x + blockIdx.x, NWAVES * gridDim.x, (LAS float*)(lds + wv * 16384), wv);
}
namespace att {
using bf16=unsigned short;
using bf16x8=__attribute__((ext_vector_type(8)))short;
using s16x4=__attribute__((ext_vector_type(4)))short;
using f32x16=__attribute__((ext_vector_type(16)))float;
using u32x4=__attribute__((ext_vector_type(4)))unsigned;
constexpr int D=64,PIN_=DIN,POUT=DM;
constexpr int NW=8,QBLK=32,QB=QBLK*NW,KVBLK=64;
__device__ __forceinline__ int crow(int r,int hi){return (r&3)+8*(r>>2)+4*hi;}
#define SBAR() __builtin_amdgcn_sched_barrier(0)
constexpr int NSLOT=3, SLOTB=8192;
constexpr int LDS_K=0, LDS_V=NSLOT*SLOTB, LDS_WS=2*NSLOT*SLOTB, LDS_OST=LDS_WS+NW*64*4, LDS_BYTES=LDS_OST+NW*4096;
constexpr float C2=0.125f*1.4426950408889634f;
__device__ __forceinline__ void glds16(const void*gsrc,unsigned lds_dst){unsigned keep;
  asm volatile("s_mov_b32 %0, m0\n\ts_mov_b32 m0, %2\n\ts_nop 0\n\tglobal_load_lds_dwordx4 %1, off\n\ts_mov_b32 m0, %0":"=&s"(keep):"v"(gsrc),"s"(lds_dst):"memory");}
__device__ __forceinline__ float max3f(float a,float b,float c){float r;asm("v_max3_f32 %0, %1, %2, %3":"=v"(r):"v"(a),"v"(b),"v"(c));return r;}
__device__ __forceinline__ float max2f(float a,float b){float r;asm("v_max_f32_e32 %0, %1, %2":"=v"(r):"v"(a),"v"(b));return r;}
__device__ __forceinline__ float fadd_s(float a,float b){float r;asm("v_add_f32_e32 %0, %1, %2":"=v"(r):"v"(a),"v"(b));return r;}
__device__ __forceinline__ float fsub_s(float a,float b){float r;asm("v_sub_f32_e32 %0, %1, %2":"=v"(r):"v"(a),"v"(b));return r;}
typedef float f32x2_t __attribute__((ext_vector_type(2))); typedef __bf16 bf16x2_t __attribute__((ext_vector_type(2)));
__device__ __forceinline__ unsigned cvtpk_s(float lo,float hi){f32x2_t v={lo,hi};bf16x2_t b=__builtin_convertvector(v,bf16x2_t);return __builtin_bit_cast(unsigned,b);}
#define WAIT_BAR(N) asm volatile("s_waitcnt vmcnt(" #N ") lgkmcnt(0)\n\ts_barrier":::"memory")

__device__ __forceinline__ void qkt(f32x16&p0,f32x16&p1,const char*Kslot,const bf16x8*qr,const f32x16&negm,int r32,int hi){
  const char*kb=Kslot+hi*1024+r32*16;
  #pragma unroll
  for(int d0=0;d0<4;++d0){
    const bf16x8 b0=*reinterpret_cast<const bf16x8*>(kb+d0*2048);
    const bf16x8 b1=*reinterpret_cast<const bf16x8*>(kb+d0*2048+512);
    if(d0==0){p0=__builtin_amdgcn_mfma_f32_32x32x16_bf16(b0,qr[0],negm,0,0,0);p1=__builtin_amdgcn_mfma_f32_32x32x16_bf16(b1,qr[0],negm,0,0,0);}
    else{p0=__builtin_amdgcn_mfma_f32_32x32x16_bf16(b0,qr[d0],p0,0,0,0);p1=__builtin_amdgcn_mfma_f32_32x32x16_bf16(b1,qr[d0],p1,0,0,0);}}
}
typedef __attribute__((address_space(3))) const char* lds_cptr;
typedef short v4i16_t __attribute__((ext_vector_type(4)));
__device__ __forceinline__ void kload8(bf16x8*kf,lds_cptr kp){
  kf[0]=*(const __attribute__((address_space(3))) bf16x8*)(kp);      kf[1]=*(const __attribute__((address_space(3))) bf16x8*)(kp+512);
  kf[2]=*(const __attribute__((address_space(3))) bf16x8*)(kp+2048); kf[3]=*(const __attribute__((address_space(3))) bf16x8*)(kp+2560);
  kf[4]=*(const __attribute__((address_space(3))) bf16x8*)(kp+4096); kf[5]=*(const __attribute__((address_space(3))) bf16x8*)(kp+4608);
  kf[6]=*(const __attribute__((address_space(3))) bf16x8*)(kp+6144); kf[7]=*(const __attribute__((address_space(3))) bf16x8*)(kp+6656);
}
__device__ __forceinline__ void kload2(bf16x8*kf,lds_cptr kp,int j){ kf[2*j]=*(const __attribute__((address_space(3))) bf16x8*)(kp+j*2048); kf[2*j+1]=*(const __attribute__((address_space(3))) bf16x8*)(kp+j*2048+512); }
__device__ __forceinline__ s16x4 vtr(lds_cptr p){ return __builtin_bit_cast(s16x4,__builtin_amdgcn_ds_read_tr16_b64_v4i16((__attribute__((address_space(3))) v4i16_t*)p)); }
__device__ __forceinline__ float rowmax(const f32x16&p0,const f32x16&p1){
  float a=max3f(p0[0],p0[1],p1[0]),b=max3f(p0[2],p0[3],p1[1]);a=max3f(a,p1[2],p1[3]);
  #pragma unroll
  for(int r=4;r<16;r+=4){a=max3f(a,p0[r],p0[r+1]);b=max3f(b,p0[r+2],p0[r+3]);a=max3f(a,p1[r],p1[r+1]);b=max3f(b,p1[r+2],p1[r+3]);}
  const float m=max2f(a,b);
  auto rr=__builtin_amdgcn_permlane32_swap(__float_as_uint(m),__float_as_uint(m),false,false);
  return max2f(__uint_as_float(rr[0]),__uint_as_float(rr[1]));
}
__device__ __forceinline__ void pv(f32x16*o,int vb,bf16x8 pa0,bf16x8 pa1,bf16x8 pa2,bf16x8 pa3){
  #pragma unroll
  for(int d0=0;d0<2;++d0){s16x4 lo[4],hi[4];
    #pragma unroll
    for(int ks=0;ks<4;++ks){
      asm volatile("ds_read_b64_tr_b16 %0,%1 offset:%c2":"=&v"(lo[ks]):"v"(vb),"i"(d0*4096+ks*1024):"memory");
      asm volatile("ds_read_b64_tr_b16 %0,%1 offset:%c2":"=&v"(hi[ks]):"v"(vb),"i"(d0*4096+ks*1024+512):"memory");}
    asm volatile("s_waitcnt lgkmcnt(0)":::"memory");SBAR();
    #define PK(k) (bf16x8){lo[k][0],lo[k][1],lo[k][2],lo[k][3],hi[k][0],hi[k][1],hi[k][2],hi[k][3]}
    o[d0]=__builtin_amdgcn_mfma_f32_32x32x16_bf16(pa0,PK(0),o[d0],0,0,0);
    o[d0]=__builtin_amdgcn_mfma_f32_32x32x16_bf16(pa1,PK(1),o[d0],0,0,0);
    o[d0]=__builtin_amdgcn_mfma_f32_32x32x16_bf16(pa2,PK(2),o[d0],0,0,0);
    o[d0]=__builtin_amdgcn_mfma_f32_32x32x16_bf16(pa3,PK(3),o[d0],0,0,0);
    #undef PK
  }
}

#ifndef ATTN_STORE16
#define ATTN_STORE16(p,v) (*(u32x4*)(p)=(v))
#endif
template<int THRL,class Hook> __device__ __forceinline__ void attn_unit(const bf16*Q0,const bf16*__restrict__ Kh,const bf16*__restrict__ Vh,int rowa,int na,int rowb,int NT,bf16*O0,const Hook&hook,char*shm,int wid){
  const int lane=otid(wid)&63,r32=lane&31,hi=lane>>5;
  const bf16*Qw=Q0+(long)(wid*QBLK)*PIN_;
  #define TROW(t) ((long)(((t)<na)?(rowa+64*(t)):(rowb+64*((t)-na))))
  const unsigned lds0=(unsigned)(uintptr_t)shm;
  float*wsf=(float*)(shm+LDS_WS)+wid*64;
  const bf16*ksrc=Kh+(long)lane*PIN_+wid*8;
  const bf16*vsrc=Vh+(long)(16*(wid&3)+(lane>>2))*PIN_+(wid>>2)*32+(lane&3)*8;
  const unsigned kdst=lds0+LDS_K+wid*1024, vdst=lds0+LDS_V+wid*1024;
  #define DMA_K(t,slot) glds16(ksrc+TROW(t)*PIN_,(unsigned)__builtin_amdgcn_readfirstlane(kdst+(slot)))
  #define DMA_V(t,slot) glds16(vsrc+TROW(t)*PIN_,(unsigned)__builtin_amdgcn_readfirstlane(vdst+(slot)))
  const int vb0=(int)(lds0+LDS_V)+((lane>>4)&1)*32+(lane&3)*8+(4*hi+((lane&15)>>2))*64;
  const char*Kbase=shm+LDS_K; bf16x8 kf[8];
  const lds_cptr shm3=(lds_cptr)shm; const lds_cptr kp0=shm3+LDS_K+hi*1024+r32*16; const lds_cptr vp0=shm3+LDS_V+((lane>>4)&1)*32+(lane&3)*8+(4*hi+((lane&15)>>2))*64;
  DMA_K(0,0);DMA_V(0,0);DMA_K(1,SLOTB);
  bf16x8 qr[4];
  #pragma unroll
  for(int d0=0;d0<4;++d0)qr[d0]=*reinterpret_cast<const bf16x8*>(&Qw[(long)r32*PIN_+d0*16+hi*8]);
  float zz_=0.f; asm volatile("":"+v"(zz_));
  float mhat=zz_,l_reg=zz_;f32x16 o[2],negm;
  #pragma unroll
  for(int r=0;r<16;++r){o[0][r]=zz_;o[1][r]=zz_;negm[r]=zz_;}
  asm volatile("":"+v"(negm));
  #define CMASK(P0,P1,t) hook(P0,P1,(t),wid,r32,hi)
  bool resc=false;
  #define START(P0,P1) do{ const float rm=rowmax(P0,P1); resc=false; \
    { const float dl=rm; mhat=fadd_s(mhat,dl); \
      _Pragma("unroll") for(int r=0;r<16;++r){P0[r]=fsub_s(P0[r],dl);P1[r]=fsub_s(P1[r],dl);} \
      _Pragma("unroll") for(int r=0;r<16;++r)negm[r]=-mhat; asm volatile("":"+v"(negm)); } \
    _Pragma("unroll") for(int r=0;r<16;++r)P0[r]=__builtin_amdgcn_exp2f(P0[r]); }while(0)
  #define RESC() do{ if(resc){ asm volatile("s_waitcnt lgkmcnt(0)":::"memory"); \
      _Pragma("unroll") for(int d_=0;d_<2;++d_) _Pragma("unroll") for(int r=0;r<16;++r)o[d_][r]*=wsf[crow(r,hi)]; } }while(0)
  f32x16 pA0,pA1,pB0,pB1;
  int sl_prev=0,sl_cur=0,sl_next=SLOTB;
  #define ROT() do{sl_prev=sl_cur;sl_cur=sl_next;sl_next=(sl_next==(NSLOT-1)*SLOTB)?0:sl_next+SLOTB;}while(0)
  DMA_K(2,2*SLOTB);
  WAIT_BAR(3);
  qkt(pA0,pA1,Kbase,qr,negm,r32,hi);asm volatile("s_nop 15\n\ts_nop 7":"+v"(pA0),"+v"(pA1));
  START(pA0,pA1);
  _Pragma("unroll") for(int r=0;r<16;++r)pA1[r]=__builtin_amdgcn_exp2f(pA1[r]);
  WAIT_BAR(0);
  DMA_K(3,0);DMA_V(1,SLOTB);
  ROT();
  kload8(kf,kp0+sl_cur);
  WAIT_BAR(2);
  s16x4 vlo[8],vhi[8]; u32x4 pw0,pw1,pw2,pw3;
  #define PKW(P,B) cvtpk_s(P[B],P[B+1])
  #define PAF(k) __builtin_bit_cast(bf16x8,pw##k)
  #define VFR(i) (bf16x8){vlo[i][0],vlo[i][1],vlo[i][2],vlo[i][3],vhi[i][0],vhi[i][1],vhi[i][2],vhi[i][3]}
  #define PIN(x) asm volatile("":"+v"(x))
  #define MX3(a,b,c) __builtin_fmaxf(__builtin_fmaxf((a),(b)),(c))
  #define GAPA(MF,A0,A1,A2,A3,W0,W1,PW) do{ MF; sacc+=A0; sacc+=A1; sacc+=A2; sacc+=A3; PIN(sacc); W0; W1; PIN(PW); SBAR(); }while(0)
  #define EX(v) __builtin_amdgcn_exp2f(v)
  #define GAPB(MF,X,B) do{ MF; X[B]=EX(X[B]); X[B+1]=EX(X[B+1]); X[B+2]=EX(X[B+2]); X[B+3]=EX(X[B+3]); PIN(X); SBAR(); }while(0)
  #define VRD(i) do{ vlo[i]=vtr(vp_+(((i)>>2)*4096+((i)&3)*1024)); vhi[i]=vtr(vp_+(((i)>>2)*4096+((i)&3)*1024+512)); }while(0)
  #define KRD(G,j) do{ if(G){ kload2(kf,kp0+sl_next,j); SBAR(); } }while(0)
  #define STEP(C0,C1,P0,P1,t,GK,GV,GL) do{ SBAR(); \
    const lds_cptr vp_=vp0+sl_prev; \
    VRD(0); SBAR(); float sacc=(P0[0]+P0[1]); \
    GAPA(C0=__builtin_amdgcn_mfma_f32_32x32x16_bf16(kf[0],qr[0],negm,0,0,0), P0[2],P0[3],P0[4],P0[5],     pw0[0]=PKW(P0,0), pw0[1]=PKW(P0,2), pw0); \
    VRD(4); SBAR(); GAPA(C1=__builtin_amdgcn_mfma_f32_32x32x16_bf16(kf[1],qr[0],negm,0,0,0), P0[6],P0[7],P0[8],P0[9],     pw0[2]=PKW(P0,4), pw0[3]=PKW(P0,6), pw0); \
    VRD(1); SBAR(); GAPA(C0=__builtin_amdgcn_mfma_f32_32x32x16_bf16(kf[2],qr[1],C0,0,0,0),   P0[10],P0[11],P0[12],P0[13], pw1[0]=PKW(P0,8), pw1[1]=PKW(P0,10), pw1); \
    VRD(5); SBAR(); GAPA(C1=__builtin_amdgcn_mfma_f32_32x32x16_bf16(kf[3],qr[1],C1,0,0,0),   P0[14],P0[15],P1[0],P1[1],   pw1[2]=PKW(P0,12),pw1[3]=PKW(P0,14), pw1); \
    VRD(2); SBAR(); GAPA(C0=__builtin_amdgcn_mfma_f32_32x32x16_bf16(kf[4],qr[2],C0,0,0,0),   P1[2],P1[3],P1[4],P1[5],     pw2[0]=PKW(P1,0), pw2[1]=PKW(P1,2), pw2); \
    VRD(6); SBAR(); GAPA(C1=__builtin_amdgcn_mfma_f32_32x32x16_bf16(kf[5],qr[2],C1,0,0,0),   P1[6],P1[7],P1[8],P1[9],     pw2[2]=PKW(P1,4), pw2[3]=PKW(P1,6), pw2); \
    VRD(3); SBAR(); GAPA(C0=__builtin_amdgcn_mfma_f32_32x32x16_bf16(kf[6],qr[3],C0,0,0,0),   P1[10],P1[11],P1[12],P1[13], pw3[0]=PKW(P1,8), pw3[1]=PKW(P1,10), pw3); \
    VRD(7); SBAR(); GAPA(C1=__builtin_amdgcn_mfma_f32_32x32x16_bf16(kf[7],qr[3],C1,0,0,0),   P1[14],P1[15],0.f,0.f,       pw3[2]=PKW(P1,12),pw3[3]=PKW(P1,14), pw3); \
    l_reg+=sacc; \
    if(GK){DMA_K((t)+3,sl_cur);} if(GV){DMA_V((t)+1,sl_next);} \
    CMASK(C0,C1,t); \
    { float a=MX3(C0[0],C0[1],C1[0]),b=MX3(C0[2],C0[3],C1[1]); a=MX3(a,C1[2],C1[3]); \
      _Pragma("unroll") for(int r=4;r<16;r+=4){a=MX3(a,C0[r],C0[r+1]);b=MX3(b,C0[r+2],C0[r+3]);a=MX3(a,C1[r],C1[r+1]);b=MX3(b,C1[r+2],C1[r+3]);} \
      float rm=__builtin_fmaxf(a,b); { auto rr=__builtin_amdgcn_permlane32_swap(__float_as_uint(rm),__float_as_uint(rm),false,false); rm=__builtin_fmaxf(__uint_as_float(rr[0]),__uint_as_float(rr[1])); } \
      resc=false; \
      if(__builtin_expect(__any(rm>(float)THRL),0)){ const float dl=__builtin_fmaxf(rm,0.f); mhat+=dl; \
        _Pragma("unroll") for(int r=0;r<16;++r){C0[r]-=dl;C1[r]-=dl;} \
        _Pragma("unroll") for(int r=0;r<16;++r)negm[r]=-mhat; asm volatile("":"+v"(negm)); \
        const float f=__builtin_amdgcn_exp2f(-dl); l_reg*=f; if(hi==0)wsf[r32]=f; resc=true; } } \
    SBAR(); \
    GAPB(o[0]=__builtin_amdgcn_mfma_f32_32x32x16_bf16(PAF(0),VFR(0),o[0],0,0,0), C0,0); \
    GAPB(o[1]=__builtin_amdgcn_mfma_f32_32x32x16_bf16(PAF(0),VFR(4),o[1],0,0,0), C0,4); \
    KRD(GL,0); GAPB(o[0]=__builtin_amdgcn_mfma_f32_32x32x16_bf16(PAF(1),VFR(1),o[0],0,0,0), C0,8); \
    KRD(GL,1); GAPB(o[1]=__builtin_amdgcn_mfma_f32_32x32x16_bf16(PAF(1),VFR(5),o[1],0,0,0), C0,12); \
    KRD(GL,2); GAPB(o[0]=__builtin_amdgcn_mfma_f32_32x32x16_bf16(PAF(2),VFR(2),o[0],0,0,0), C1,0); \
    KRD(GL,3); GAPB(o[1]=__builtin_amdgcn_mfma_f32_32x32x16_bf16(PAF(2),VFR(6),o[1],0,0,0), C1,4); \
    GAPB(o[0]=__builtin_amdgcn_mfma_f32_32x32x16_bf16(PAF(3),VFR(3),o[0],0,0,0), C1,8); \
    GAPB(o[1]=__builtin_amdgcn_mfma_f32_32x32x16_bf16(PAF(3),VFR(7),o[1],0,0,0), C1,12); \
    }while(0)
  int t=1;
  for(;t+5<NT;t+=2){
    STEP(pB0,pB1,pA0,pA1,t,true,true,true);     WAIT_BAR(2); RESC(); ROT();
    STEP(pA0,pA1,pB0,pB1,t+1,true,true,true);   WAIT_BAR(2); RESC(); ROT();
  }
  #define ENDW(tt) do{ if((tt)+3<NT){WAIT_BAR(2);} else if((tt)+2<NT){WAIT_BAR(1);} else {WAIT_BAR(0);} }while(0)
  for(;t+1<NT;t+=2){
    STEP(pB0,pB1,pA0,pA1,t,(t+3<NT),(t+1<NT),(t+1<NT));       ENDW(t);   RESC(); ROT();
    STEP(pA0,pA1,pB0,pB1,t+1,(t+4<NT),(t+2<NT),(t+2<NT));     ENDW(t+1); RESC(); ROT();
  }
  STEP(pB0,pB1,pA0,pA1,NT-1,false,false,false); RESC();
  { float sacc=pB0[0]+pB0[1]; _Pragma("unroll") for(int r=2;r<16;++r)sacc+=pB0[r]; _Pragma("unroll") for(int r=0;r<16;++r)sacc+=pB1[r]; l_reg+=sacc;
    pw0=(u32x4){PKW(pB0,0),PKW(pB0,2),PKW(pB0,4),PKW(pB0,6)};pw1=(u32x4){PKW(pB0,8),PKW(pB0,10),PKW(pB0,12),PKW(pB0,14)};pw2=(u32x4){PKW(pB1,0),PKW(pB1,2),PKW(pB1,4),PKW(pB1,6)};pw3=(u32x4){PKW(pB1,8),PKW(pB1,10),PKW(pB1,12),PKW(pB1,14)};
    SBAR(); pv(o,vb0+sl_cur,PAF(0),PAF(1),PAF(2),PAF(3)); }
  #undef PKW
  #undef PAF
  #undef VFR
  #undef PIN
  #undef MX3
  #undef GAPA
  #undef GAPB
  #undef EX
  #undef VRD
  #undef KRD
  #undef STEP
  #undef ENDW
  {auto rr=__builtin_amdgcn_permlane32_swap(__float_as_uint(l_reg),__float_as_uint(l_reg),false,false);l_reg=__uint_as_float(rr[0])+__uint_as_float(rr[1]);}
  if(hi==0)wsf[32+r32]=l_reg;asm volatile("s_waitcnt lgkmcnt(0)":::"memory");
  float rli[16];
  #pragma unroll
  for(int r=0;r<16;++r)rli[r]=__builtin_amdgcn_rcpf(wsf[32+crow(r,hi)]);
  bf16*Ow=O0+(long)(wid*QBLK)*POUT;
  { bf16*stg=(bf16*)(shm+LDS_OST)+wid*2048;
    #pragma unroll
    for(int r=0;r<16;++r){const int orow=crow(r,hi);
      #pragma unroll
      for(int d0=0;d0<2;++d0)stg[orow*64+d0*32+r32]=(bf16)f2bf(o[d0][r]*rli[r]);}
    asm volatile("s_waitcnt lgkmcnt(0)":::"memory");
    #pragma unroll
    for(int i=0;i<4;++i){const int row=i*8+(lane>>3),ch=lane&7; const u32x4 v=*(const u32x4*)(stg+row*64+ch*8); ATTN_STORE16(Ow+(long)row*POUT+ch*8,v);} }
  asm volatile("s_waitcnt lgkmcnt(0)\n\ts_barrier":::"memory");
  #undef DMA_K
  #undef DMA_V
  #undef TROW
  #undef CMASK
  #undef START
  #undef RESC
  #undef ROT
}
constexpr int ATTN_LDS_BYTES=LDS_BYTES;
#undef SBAR
#undef WAIT_BAR
}

namespace pg8 {
struct EpiInProj {
    static constexpr bool PERM = true, AFTER_DRAIN = false;
    bf16_t* P; const float* na_qn; const float* na_kn; const float* gq_qn; const float* gq_kn; int wv;
    __device__ __forceinline__ void operator()(const f32x4 (&acc)[2][2][4][2], const Unit& u, int, int, int, int) const {
        const int l_ = otid(wv) & 63, fr = l_ & 15, fq = l_ >> 4, wr = wv >> 2, wc = wv & 3;
        const int pn = u.pn, rowt = u.pm * BM;
        int mode = 0; const float* gain = na_qn; float qs = 1.f;
        if (pn == 0) { mode = 1; gain = na_qn; qs = att::C2; }
        else if (pn == 1) { mode = 1; gain = na_kn; }
        else if (pn == 3 || pn == 4) { mode = 2; gain = gq_qn; qs = att::C2; }
        else if (pn == 5 && wc < 2) { mode = 2; gain = gq_kn; }
        if (mode == 2 && rowt >= NLAT) mode = 1;
        bf16_t* pcol = P + pn * BM + 64 * wc + 8 * fq;
        if (mode == 0) {
#pragma unroll
            for (int ai = 0; ai < 2; ++ai)
#pragma unroll
                for (int m = 0; m < 4; ++m) { bf16_t* rowp = pcol + (size_t)(rowt + ai * HALF + wr * 64 + m * 16 + fr) * DIN;
#pragma unroll
                    for (int bj = 0; bj < 2; ++bj) { const f32x4 v0 = acc[ai][bj][m][0], v1 = acc[ai][bj][m][1];
                        u32x4 w; w.x = cvt_pk_bf16(v0[0], v0[1]); w.y = cvt_pk_bf16(v0[2], v0[3]); w.z = cvt_pk_bf16(v1[0], v1[1]); w.w = cvt_pk_bf16(v1[2], v1[3]);
                        *(u32x4*)(rowp + 32 * bj) = w; } }
            return;
        }
        f32x4 g[2][2]; float invf[2][2];
#pragma unroll
        for (int bj = 0; bj < 2; ++bj)
#pragma unroll
            for (int n = 0; n < 2; ++n) g[bj][n] = *(const f32x4*)(gain + 32 * bj + 8 * fq + 4 * n) * qs;
#pragma unroll
        for (int n = 0; n < 2; ++n)
#pragma unroll
            for (int pp = 0; pp < 2; ++pp) invf[n][pp] = exp2f(-(float)(4 * fq + 2 * n + pp) * (13.287712379549449f / 16.f));
#pragma unroll
        for (int ai = 0; ai < 2; ++ai)
#pragma unroll
            for (int m = 0; m < 4; ++m) {
                const int row = rowt + ai * HALF + wr * 64 + m * 16 + fr;
                f32x4 v[2][2]; float ss = 0.f;
#pragma unroll
                for (int bj = 0; bj < 2; ++bj)
#pragma unroll
                    for (int n = 0; n < 2; ++n) { v[bj][n] = acc[ai][bj][m][n]; ss += (v[bj][n][0] * v[bj][n][0] + v[bj][n][1] * v[bj][n][1]) + (v[bj][n][2] * v[bj][n][2] + v[bj][n][3] * v[bj][n][3]); }
                ss += shx(ss, 16, l_); ss += shx(ss, 32, l_);
                const float rstd = rsqrtf(ss * (1.f / 64.f) + 1e-6f);
#pragma unroll
                for (int bj = 0; bj < 2; ++bj)
#pragma unroll
                    for (int n = 0; n < 2; ++n) {
                        if (mode == 2) {
                        }
                        v[bj][n] = v[bj][n] * rstd * g[bj][n];
                    }
                if (mode == 2) {
                    const int t = row & (SEQ - 1); const float pos[2] = {(float)(t >> 6), (float)(t & 63)};
#pragma unroll
                    for (int bj = 0; bj < 2; ++bj)
#pragma unroll
                        for (int n = 0; n < 2; ++n)
#pragma unroll
                            for (int pp = 0; pp < 2; ++pp) {
                                const float ang = pos[bj] * invf[n][pp], cs = __cosf(ang), sn = __sinf(ang);
                                const float x1 = v[bj][n][2 * pp], x2 = v[bj][n][2 * pp + 1];
                                v[bj][n][2 * pp] = x1 * cs - x2 * sn; v[bj][n][2 * pp + 1] = x1 * sn + x2 * cs;
                            }
                }
                bf16_t* rowp = pcol + (size_t)row * DIN;
#pragma unroll
                for (int bj = 0; bj < 2; ++bj) { const f32x4 v0 = v[bj][0], v1 = v[bj][1];
                    u32x4 w; w.x = cvt_pk_bf16(v0[0], v0[1]); w.y = cvt_pk_bf16(v0[2], v0[3]); w.z = cvt_pk_bf16(v1[0], v1[1]); w.w = cvt_pk_bf16(v1[2], v1[3]);
                    *(u32x4*)(rowp + 32 * bj) = w; }
                asm volatile("" ::: "memory");
            }
    }
};
}

__device__ __forceinline__ void w_qknorm_rope(const Ptrs& p, int layer, int unit, int d) {
    const int row = unit / 18, slot = unit % 18;
    int col; const float* gain; bool rope;
    if (slot < 4) { col = A_Q + slot * 64; gain = p.in[I_NAQN] + layer * 64; rope = false; }
    else if (slot < 8) { col = A_K + (slot - 4) * 64; gain = p.in[I_NAKN] + layer * 64; rope = false; }
    else if (slot < 16) { col = B_Q + (slot - 8) * 64; gain = p.in[I_GQQN] + layer * 64; rope = true; }
    else { col = B_K + (slot - 16) * 64; gain = p.in[I_GQKN] + layer * 64; rope = true; }
    bf16* pp = (bf16*)(p.ws + WS_P) + (size_t)row * DIN + col;
    float x = bf2f(pp[d]);
    float ss = wave_sum(x * x, d);
    float y = x * rsqrtf(ss * (1.f / 64.f) + 1e-6f) * gain[d];
    if (rope && row < NLAT) {
        int t = row & (SEQ - 1);
        float partner = shx(y, 1, d);
        int pi = d >> 1;
        float pos = (pi < 16) ? (float)(t >> 6) : (float)(t & 63);
        float inv = exp2f(-(float)(pi & 15) * (13.287712379549449f / 16.f));
        float ang = pos * inv;
        float cs = __cosf(ang), sn = __sinf(ang);
        y = (d & 1) ? (partner * sn + y * cs) : (y * cs - partner * sn);
    }
    if (slot < 4 || (slot >= 8 && slot < 16)) y *= att::C2;
    pp[d] = (bf16)f2bf(y);
}
struct NoHook { __device__ __forceinline__ void operator()(att::f32x16&, att::f32x16&, int, int, int, int) const {} };
struct NaHook {
    const LAS float* tab; int r0, kr0;
    __device__ __forceinline__ void operator()(att::f32x16& p0, att::f32x16& p1, int t, int wid, int r32, int hi) const {
        if (t < 4) return;
        const int r = r0 + (wid >> 1), kr = kr0 + t - 4, rs = min(max(r - 4, 0), 24);
        const float NEG = -INFINITY;
        if ((unsigned)(kr - rs) >= 8u) {
#pragma unroll
            for (int i = 0; i < 16; ++i) { p0[i] = NEG; p1[i] = NEG; }
            return;
        }
        const int qc = 32 * (wid & 1) + r32, cs = min(max(qc - 8, 0), 48), kb = 4 * hi - cs;
        const LAS float* tp = tab + (kr - r + 7) * 31 + (4 * hi - qc + 15);
#pragma unroll
        for (int i = 0; i < 16; ++i) {
            const int c = (i & 3) + 8 * (i >> 2);
            const float b0 = tp[c], b1 = tp[c + 32];
            p0[i] = ((unsigned)(kb + c) < 16u) ? p0[i] + b0 : NEG;
            p1[i] = ((unsigned)(kb + c + 32) < 16u) ? p1[i] + b1 : NEG;
        }
    }
};
constexpr int LDS_NATAB = 88064;
__device__ __forceinline__ void phase_attn(const Ptrs& p, unsigned char* lds_gen, int layer, int wv) {
    const bf16* P = (const bf16*)(p.ws + WS_P); bf16* MIX = (bf16*)(p.ws + WS_MIX);
    char* shm = (char*)lds_gen;
    const int c = blockIdx.x, x = c & 7, ci = (c >> 3) & 31;
    for (int i = 0; i < 2; ++i) {
        const int grp = 2 * x + i, b = grp >> 1, kvh = grp & 1, g = ci >> 3, qb = ci & 7, hq = kvh * 4 + g;
        const size_t qrow = (size_t)b * SEQ + qb * 256;
        att::attn_unit<8, NoHook>(P + qrow * DIN + B_Q + hq * 64, P + B_K + kvh * 64, P + B_V + kvh * 64, b * SEQ, 32, NLAT + b * CTXL, 36,
                                  MIX + qrow * DM + 256 + hq * 64, NoHook{}, shm, wv);
    }
    {
        const int grp = 4 * x + (ci >> 3), b = grp >> 2, h = grp & 3, r0 = 4 * (ci & 7);
        const int kr0 = (r0 == 0) ? 0 : (r0 == 28 ? 24 : r0 - 4), nr = (r0 == 0 || r0 == 28) ? 8 : 12;
        LAS float* tab = (LAS float*)((LAS unsigned char*)lds_gen + LDS_NATAB);
        const float* rpb = p.in[I_RPB] + ((size_t)layer * 4 + h) * 15 * 31;
        for (int i = otid(wv); i < 15 * 31; i += NT) tab[i] = rpb[i] * 1.4426950408889634f;
        __syncthreads();
        const size_t qrow = (size_t)b * SEQ + r0 * 64;
        NaHook hook{tab, r0, kr0};
        att::attn_unit<8, NaHook>(P + qrow * DIN + A_Q + h * 64, P + A_K + h * 64, P + A_V + h * 64, NLAT + b * CTXL, 4, b * SEQ + kr0 * 64, 4 + nr,
                                  MIX + qrow * DM + h * 64, hook, shm, wv);
    }
    if (layer == 0 && c < 96) {
        if (c < 32) {
            const int b = c >> 2, h = c & 3; const size_t qrow = (size_t)NLAT + b * CTXL;
            att::attn_unit<8, NoHook>(P + qrow * DIN + A_Q + h * 64, P + A_K + h * 64, P + A_V + h * 64, NLAT + b * CTXL, 4, 0, 4, MIX + qrow * DM + h * 64, NoHook{}, shm, wv);
        } else {
            const int cc = c - 32, b = cc >> 3, hq = cc & 7, kvh = hq >> 2; const size_t qrow = (size_t)NLAT + b * CTXL;
            att::attn_unit<8, NoHook>(P + qrow * DIN + B_Q + hq * 64, P + B_K + kvh * 64, P + B_V + kvh * 64, NLAT + b * CTXL, 4, 0, 4, MIX + qrow * DM + 256 + hq * 64, NoHook{}, shm, wv);
        }
    }
}


namespace pg8 {
struct InProjOrder {
    int G, c, nctx; bool trim;
    __device__ __forceinline__ void init(int G_, int c_, bool trim_) { G = G_; c = c_; trim = trim_; nctx = 8 * (trim_ ? 6 : 11); }
    __device__ __forceinline__ bool next(int i, Unit& u) const {
        constexpr int nM = NLAT / BM, nN = DIN / BM, nwg = nM * nN;
        const int L = i * G + c;
        if (L >= nwg + nctx) return false;
        const int wl = (L % NXCD) * (nwg / NXCD) + L / NXCD;
        const int nig = WGM * nN, gid = wl / nig, fm = gid * WGM;
        const int pm_l = fm + ((wl % nig) % WGM), pn_l = (wl % nig) / WGM;
        const int k = L - nwg, t = k >> 3;
        const int pm_c = 64 + (k & 7), pn_c = trim ? (t + 1 + ((t >= 2) ? 2 : 0) + ((t >= 3) ? 1 : 0)) : t;
        const bool lat = L < nwg;
        u.pm = lat ? pm_l : pm_c; u.pn = lat ? pn_l : pn_c; u.aux = 0;
        return true;
    }
    __device__ __forceinline__ void a_ready(const Unit&) const {}
    __device__ __forceinline__ void done(const Unit&) const {}
};
}

#define XB_TMO      128
#define XB_XCNT(j)  (256  + 64 * (j))
#define XB_XSUB(j)  (1280 + 64 * (j))
#define XB_XGEN(j)  (2304 + 64 * (j))
#define XB_TOP      3328
#define XB_TOPGEN   3392
#define XCD_BAR_WORDS 3456
#define XB_SPIN_CAP (1u << 18)
constexpr int CW_BAR = 4096;
constexpr int LDS_XB = LDS_BYTES - 64;
__device__ __forceinline__ unsigned xb_ld(unsigned* p)              { return __hip_atomic_load(p, __ATOMIC_RELAXED, __HIP_MEMORY_SCOPE_AGENT); }
__device__ __forceinline__ unsigned xb_add(unsigned* p, unsigned v) { return __hip_atomic_fetch_add(p, v, __ATOMIC_RELAXED, __HIP_MEMORY_SCOPE_AGENT); }
__device__ __forceinline__ unsigned xb_xcc_id() { return (unsigned)__builtin_amdgcn_s_getreg((3 << 11) | 20) & 0xFu; }
#define XB_SPIN(cond, bar) do { unsigned _sp = 0; while (cond) { __builtin_amdgcn_s_sleep(1); \
    if ((++_sp & 255u) == 0u) { if (xb_ld(&(bar)[XB_TMO])) break; if (_sp > XB_SPIN_CAP) { atomicAdd(&(bar)[XB_TMO], 1u); break; } } } } while (0)
struct XcdBarrier { unsigned* bar; unsigned x; volatile LAS unsigned* st; };
__device__ __forceinline__ XcdBarrier xcd_barrier_post(unsigned* bar, volatile LAS unsigned* st, int wv) {
    XcdBarrier b; b.bar = bar; b.x = xb_xcc_id(); b.st = st;
    if (otid(wv) == 0) (void)xb_add(&bar[XB_XCNT(b.x)], 1u);
    return b;
}
__device__ __forceinline__ void xcd_barrier_complete(unsigned* bar, unsigned x, unsigned& nloc, unsigned& nx) {
    const unsigned G = gridDim.x * gridDim.y * gridDim.z;
    unsigned sum, cnt, mine, sp = 0u;
    for (;;) {
        sum = 0u; cnt = 0u; mine = 0u;
#pragma unroll
        for (unsigned j = 0; j < 16; ++j) { const unsigned c = xb_ld(&bar[XB_XCNT(j)]); sum += c; cnt += (c > 0u) ? 1u : 0u; mine = (j == x) ? c : mine; }
        if (sum == G) break;
        __builtin_amdgcn_s_sleep(1);
        if ((++sp & 255u) == 0u) { if (xb_ld(&bar[XB_TMO])) break; if (sp > XB_SPIN_CAP) { atomicAdd(&bar[XB_TMO], 1u); break; } }
    }
    nloc = mine > 0u ? mine : 1u; nx = cnt > 0u ? cnt : 1u;
}
__device__ __forceinline__ void xcd_barrier(const XcdBarrier& b, int wv) {
    asm volatile("s_waitcnt vmcnt(0)" ::: "memory");
    __syncthreads();
    if (otid(wv) == 0) {
        unsigned* bar = b.bar; unsigned bx = b.x; asm volatile("" : "+s"(bx));
        __builtin_amdgcn_s_waitcnt(0);
        unsigned nloc = b.st[0], nx = b.st[1];
        if (nloc == 0u) { xcd_barrier_complete(bar, bx, nloc, nx); b.st[0] = nloc; b.st[1] = nx; }
        const unsigned old = xb_add(&bar[XB_XSUB(bx)], 1u);
        const unsigned gen = old / nloc;
        if (old + 1u == (gen + 1u) * nloc) {
            __builtin_amdgcn_fence(__ATOMIC_RELEASE, "agent");
            asm volatile("s_waitcnt vmcnt(0)" ::: "memory");
            const unsigned og = xb_add(&bar[XB_TOP], 1u);
            const unsigned tg = og / nx;
            if (og + 1u == (tg + 1u) * nx) xb_add(&bar[XB_TOPGEN], 1u);
            else XB_SPIN(xb_ld(&bar[XB_TOPGEN]) == tg, bar);
            __builtin_amdgcn_fence(__ATOMIC_ACQUIRE, "agent");
            xb_add(&bar[XB_XGEN(bx)], 1u);
            asm volatile("s_waitcnt vmcnt(0)" ::: "memory");
        } else {
            XB_SPIN(xb_ld(&bar[XB_XGEN(bx)]) == gen, bar);
            __builtin_amdgcn_fence(__ATOMIC_ACQUIRE, "agent");
            asm volatile("s_waitcnt vmcnt(0)" ::: "memory");
        }
    }
    __syncthreads();
}

__global__ void __launch_bounds__(NT, 2) k_mega(Ptrs p) {
    extern __shared__ __attribute__((aligned(16))) unsigned char lds_raw[];
    LAS unsigned char* lds = (LAS unsigned char*)lds_raw;
    cg::grid_group grid = cg::this_grid();
    const int wv = __builtin_amdgcn_readfirstlane(threadIdx.x >> 6);
#define CG_SYNC() do { asm volatile("s_waitcnt vmcnt(0)" ::: "memory"); grid.sync(); __builtin_amdgcn_fence(__ATOMIC_ACQUIRE, "agent"); asm volatile("s_waitcnt vmcnt(0)" ::: "memory"); } while (0)
#define GRID_SYNC() xcd_barrier(xbar, wv)
    if (otid(wv) < 16) ((LAS unsigned*)(lds + LDS_XB))[otid(wv)] = 0u;
    __syncthreads();
    const XcdBarrier xbar = xcd_barrier_post((unsigned*)(p.ws + WS_CTL) + CW_BAR, (volatile LAS unsigned*)(lds + LDS_XB), wv);
    const int NGW = gridDim.x * NWAVES;
    phase_mod(p, lds, wv);
    phase_lb(p, wv);
    __syncthreads();
    phase_convert_dense(p, lds, wv);
    phase_router_w(p, wv);
    if (p.pad != 0) CG_SYNC();
    GRID_SYNC();
    phase_gs2(p, wv);
    phase_norm(p.in[I_X], p.in[I_CTX], p.in[I_N1G], (const float*)(p.ws + WS_MOD), 0, 1, (bf16*)(p.ws + WS_H), MROWS, wv);
    GRID_SYNC();
    for (int layer = 0; layer < 2; ++layer) {
        const int M = (layer == 0) ? MROWS : NLAT;
        const float* modl = (const float*)(p.ws + WS_MOD) + (size_t)layer * 9 * MODW;
        {
            pg8::Gemm g{(const bf16*)(p.ws + WS_H), (const bf16*)(p.ws + WS_WIN + layer * WIN_STRIDE), MROWS, DIN, DM};
            pg8::InProjOrder S; S.init(gridDim.x, (int)blockIdx.x, layer == 1);
            pg8::EpiInProj E{(bf16*)(p.ws + WS_P), p.in[I_NAQN] + layer * 64, p.in[I_NAKN] + layer * 64, p.in[I_GQQN] + layer * 64, p.in[I_GQKN] + layer * 64, wv};
            pg8::gemm_phase<pg8::EpiInProj, pg8::InProjOrder, true, true>(lds, g, S, E, wv);
        }
        GRID_SYNC();
        phase_hgrn1(p, lds, layer, wv);
        GRID_SYNC();
        phase_hgrn_scan(p, lds, layer, wv);
        GRID_SYNC();
        phase_hgrn2(p, lds, layer, wv);
        __syncthreads();
        phase_attn(p, lds_raw, layer, wv);
        GRID_SYNC();
        {
            pg8::Gemm g{(const bf16*)(p.ws + WS_MIX), (const bf16*)(p.ws + WS_WOUT + layer * WOUT_STRIDE), M, DM, DM};
            pg8::StaticOrder S; S.init(M, DM, gridDim.x, (int)blockIdx.x);
            pg8::EpiResidSS E{layer == 0 ? p.in[I_X] : p.out, p.in[I_CTX], p.out, (float*)(p.ws + WS_XC), modl, 2, (float*)(p.ws + WS_RSS), wv};
            pg8::gemm_phase<pg8::EpiResidSS, pg8::StaticOrder, true, true>(lds, g, S, E, wv);
        }
        GRID_SYNC();
        phase_route(p, lds, layer, M, wv);
        GRID_SYNC();
        phase_moe_gu(p, lds, layer, wv);
        GRID_SYNC();
        phase_moe_down(p, lds, layer, wv);
        GRID_SYNC();
        phase_combine(p, layer, M, layer == 0, wv);
        if (layer == 0) GRID_SYNC();
    }
}

extern "C" void kernel_launch(void* const* d_in, const int* in_sizes, int n_in, void* d_out, int out_size, void* d_ws, size_t ws_size, hipStream_t stream) {
    static int grid = 0;
    if (grid == 0) {
        if (n_in != 24 || ws_size < WS_END) { fprintf(stderr, "kernel_launch: bad n_in %d or ws_size %zu < %zu\n", n_in, ws_size, (size_t)WS_END); grid = -1; return; }
        int dev = 0, cus = 0, per_cu = 0;
        hipGetDevice(&dev); hipDeviceGetAttribute(&cus, hipDeviceAttributeMultiprocessorCount, dev);
        hipFuncSetAttribute((const void*)k_mega, hipFuncAttributeMaxDynamicSharedMemorySize, LDS_BYTES);
        hipOccupancyMaxActiveBlocksPerMultiprocessor(&per_cu, (const void*)k_mega, NT, LDS_BYTES);
        if (per_cu < 1) { fprintf(stderr, "kernel_launch: occupancy query says %d blocks/CU\n", per_cu); grid = -1; return; }
        grid = cus;
        (void)hipGetLastError();
    }
    if (grid < 0) return;
    Ptrs p{};
    for (int i = 0; i < 24; ++i) p.in[i] = (const float*)d_in[i];
    p.out = (float*)d_out; p.ws = (unsigned char*)d_ws; p.layer = 0; p.pad = 0;
    hipMemsetAsync((unsigned char*)d_ws + WS_CTL, 0, 1 * MiB, stream);
    void* args[] = {&p};
    hipError_t e = hipLaunchCooperativeKernel((const void*)k_mega, dim3(grid), dim3(NT), args, LDS_BYTES, stream);
    if (e != hipSuccess) fprintf(stderr, "cooperative launch failed: %s\n", hipGetErrorString(e));
}
```
